# Optimizing an MI355X kernel written in HIP

```python
import math
import jax
import jax.numpy as jnp
from jax import lax
import numpy as np

D_MODEL = 2048
BATCH = 2
SEQ = 4096
DEPTH = 1
DEC_BATCH = 32
DEC_SEQ = 1
PAST_LEN = 8192
PAGE_SIZE = 128

HEAD_DIM = 64
N_HEADS = (D_MODEL // 2) // HEAD_DIM
N_KV = N_HEADS // 4
Q_PER_KV = N_HEADS // N_KV
ATTN_W = N_HEADS * HEAD_DIM
KV_W = 2 * N_KV * HEAD_DIM
CMP_BLOCK = 32
CMP_STRIDE = 16
CMP_R = CMP_BLOCK // CMP_STRIDE
CMP_HIDDEN = 2 * HEAD_DIM
SEL_BLOCK = 64
SEL_TOPN = 16
WINDOW = 512
SEL_Q_BLOCK = 64
WIN_Q_BLOCK = 128
SELECT_FORCE = 1.0e4
ATTN_SCALE = HEAD_DIM ** -0.5
D_INNER = D_MODEL // 2
SSM_HEAD_DIM = 64
N_SSM_HEADS = D_INNER // SSM_HEAD_DIM
N_SSM_GROUPS = 2
SSM_HEADS_PER_GROUP = N_SSM_HEADS // N_SSM_GROUPS
D_STATE = 128
CONV_W = 4
CONV_DIM = D_INNER + 2 * N_SSM_GROUPS * D_STATE
SSD_CHUNK = 256
MIX_W = ATTN_W + D_INNER
D_FF = 4 * D_MODEL
IN_SPLITS = (ATTN_W, KV_W, KV_W, KV_W, 3 * N_HEADS, D_INNER, CONV_DIM, N_SSM_HEADS)
IN_COLS = sum(IN_SPLITS)
NORM_EPS = 1e-5

kernel_name = 'nsa_ssd_parallel_hybrid_step'


def rms_norm(x, w):
    xf = x.astype(jnp.float32)
    y = xf * lax.rsqrt(jnp.mean(xf * xf, axis=-1, keepdims=True) + NORM_EPS)
    return (y * w.astype(jnp.float32)).astype(x.dtype)


def masked_softmax(s, mask):
    s = jnp.where(mask, s.astype(jnp.float32), -jnp.inf)
    m = jnp.max(s, axis=-1, keepdims=True)
    m = jnp.where(jnp.isfinite(m), m, 0.0)
    e = jnp.where(mask, jnp.exp(s - m), 0.0)
    return e / jnp.maximum(jnp.sum(e, axis=-1, keepdims=True), 1e-30)


def split_projection(h, w_in):
    B, T, _ = h.shape
    proj = h @ w_in
    parts, off = [], 0
    for width in IN_SPLITS:
        parts.append(proj[..., off:off + width])
        off += width
    q, kc, ks, kw, g, z, xbc, dt_raw = parts
    q = q.reshape(B, T, N_KV, Q_PER_KV, HEAD_DIM)
    kv_shape = (B, T, 2, N_KV, HEAD_DIM)
    gates = jax.nn.sigmoid(g.astype(jnp.float32)).reshape(B, T, N_KV, Q_PER_KV, 3)
    return (q, kc.reshape(kv_shape), ks.reshape(kv_shape), kw.reshape(kv_shape),
            gates, z, xbc, dt_raw)


def compress_kv(kv, pe, w1, b1, w2, b2):
    B, T = kv.shape[:2]
    n_seg = T // CMP_STRIDE
    n_cmp = n_seg - CMP_R + 1
    seg = kv[:, :n_seg * CMP_STRIDE].reshape(B, n_seg, CMP_STRIDE, 2, N_KV, HEAD_DIM)
    w1r = w1.reshape(2, CMP_R, CMP_STRIDE, HEAD_DIM, CMP_HIDDEN)
    proj = jnp.einsum('bsjcgd,crjdf->bsrcgf', seg, w1r)
    hid = sum(proj[:, r:r + n_cmp, r] for r in range(CMP_R))
    pe_term = jnp.einsum('cld,cldf->cf', pe, w1)
    hid = jax.nn.silu(hid + (pe_term + b1)[None, None, :, None, :])
    return jnp.einsum('bncgf,cfd->bncgd', hid, w2) + b2[None, None, :, None, :]


def compressed_attention(q, kc, qpos):
    n_cmp = kc.shape[1]
    s = jnp.einsum('btgrd,bngd->bgrtn', q, kc[:, :, 0]) * ATTN_SCALE
    blk_last = jnp.arange(n_cmp) * CMP_STRIDE + (CMP_BLOCK - 1)
    p = masked_softmax(s, blk_last[None, :] <= qpos[:, None])
    o = jnp.einsum('bgrtn,bngd->btgrd', p, kc[:, :, 1])
    return o.astype(q.dtype), p


def cmp_to_sel_matrix(n_cmp, n_slc):
    ratio = SEL_BLOCK // CMP_STRIDE
    diff = jnp.arange(n_cmp)[:, None] - ratio * jnp.arange(n_slc)[None, :]
    mat = jnp.zeros((n_cmp, n_slc), jnp.float32)
    for n in range(CMP_R):
        mat = mat + ((diff + n >= 0) & (diff + n < ratio)).astype(jnp.float32)
    return mat


def select_blocks(p_cmp, qpos, n_slc):
    imp = jnp.einsum('bgrtn,nj->btgj', p_cmp, cmp_to_sel_matrix(p_cmp.shape[-1], n_slc))
    jt = (qpos // SEL_BLOCK)[:, None]
    j = jnp.arange(n_slc)[None, :]
    forced = (j == 0) | (j == jt) | (j == jt - 1)
    imp = jnp.where(forced[None, :, None, :], SELECT_FORCE, imp)
    imp = jnp.where((j > jt)[None, :, None, :], -SELECT_FORCE, imp)
    _, idx = lax.top_k(imp, min(SEL_TOPN, n_slc))
    return idx


def selected_attention(q, idx, kv, qpos):
    B, T = kv.shape[:2]
    Tq, K = q.shape[1], idx.shape[-1]
    kpos = idx[..., None] * SEL_BLOCK + jnp.arange(SEL_BLOCK)
    bi = jnp.arange(B)[:, None, None, None, None]
    gi = jnp.arange(N_KV)[None, None, :, None, None]
    rows = kv[bi, jnp.minimum(kpos, T - 1), :, gi]
    rows = rows.reshape(B, Tq, N_KV, K * SEL_BLOCK, 2, HEAD_DIM)
    mask = (kpos <= qpos[None, :, None, None, None]).reshape(B, Tq, N_KV, 1, K * SEL_BLOCK)
    s = jnp.einsum('btgrd,btgnd->btgrn', q, rows[..., 0, :]) * ATTN_SCALE
    p = masked_softmax(s, mask)
    return jnp.einsum('btgrn,btgnd->btgrd', p, rows[..., 1, :]).astype(q.dtype)


def window_attention_prompt(q, kv):
    B, T = kv.shape[:2]
    nb, nk = T // WIN_Q_BLOCK, WINDOW // WIN_Q_BLOCK
    kvp = jnp.pad(kv, ((0, 0), (WINDOW, 0), (0, 0), (0, 0), (0, 0)))
    kvp = kvp.reshape(B, nb + nk, WIN_Q_BLOCK, 2, N_KV, HEAD_DIM)
    band = jnp.concatenate([kvp[:, j:j + nb] for j in range(nk + 1)], axis=2)
    qb = q.reshape(B, nb, WIN_Q_BLOCK, N_KV, Q_PER_KV, HEAD_DIM)
    s = jnp.einsum('bnqgrd,bnkgd->bngrqk', qb, band[:, :, :, 0]) * ATTN_SCALE
    start = jnp.arange(nb) * WIN_Q_BLOCK
    qpos = start[:, None] + jnp.arange(WIN_Q_BLOCK)
    kpos = (start - WINDOW)[:, None] + jnp.arange((nk + 1) * WIN_Q_BLOCK)
    d = qpos[:, :, None] - kpos[:, None, :]
    mask = (d >= 0) & (d < WINDOW) & (kpos[:, None, :] >= 0)
    p = masked_softmax(s, mask[None, :, None, None])
    o = jnp.einsum('bngrqk,bnkgd->bnqgrd', p, band[:, :, :, 1])
    return o.reshape(B, T, N_KV, Q_PER_KV, HEAD_DIM).astype(q.dtype)


def window_attention_rows(q, kv, qpos, kpos):
    s = jnp.einsum('btgrd,bkgd->bgrtk', q, kv[:, :, 0]) * ATTN_SCALE
    d = qpos[:, None] - kpos[None, :]
    p = masked_softmax(s, (d >= 0) & (d < WINDOW))
    return jnp.einsum('bgrtk,bkgd->btgrd', p, kv[:, :, 1]).astype(q.dtype)


def gate_branches(gates, o_cmp, o_sel, o_win):
    return gates[..., 0, None] * o_cmp + gates[..., 1, None] * o_sel + gates[..., 2, None] * o_win


def ssd_chunked(x, dt, A, Bm, Cm, s0):
    f32 = jnp.float32
    Bsz, L = x.shape[:2]
    Q = min(SSD_CHUNK, L)
    nc = -(-L // Q)
    pad = nc * Q - L

    def pad_len(a):
        return jnp.pad(a.astype(f32), ((0, 0), (0, pad)) + ((0, 0),) * (a.ndim - 2))

    x, dt, Bm, Cm = pad_len(x), pad_len(dt), pad_len(Bm), pad_len(Cm)
    Gs, Hg = N_SSM_GROUPS, SSM_HEADS_PER_GROUP
    xdt = (x * dt[..., None]).reshape(Bsz, nc, Q, Gs, Hg, SSM_HEAD_DIM)
    a = (dt * A.astype(f32)).reshape(Bsz, nc, Q, Gs, Hg)
    Bc = Bm.reshape(Bsz, nc, Q, Gs, D_STATE)
    Cc = Cm.reshape(Bsz, nc, Q, Gs, D_STATE)
    a_cs = jnp.cumsum(a, axis=2)
    causal = jnp.tril(jnp.ones((Q, Q), bool))[None, None, :, :, None, None]
    seg = a_cs[:, :, :, None] - a_cs[:, :, None, :]
    decay = jnp.exp(jnp.where(causal, seg, -jnp.inf))
    cb = jnp.einsum('bclgn,bcsgn->bclsg', Cc, Bc)
    y_diag = jnp.einsum('bclsg,bclsgh,bcsghp->bclghp', cb, decay, xdt)
    to_end = jnp.exp(a_cs[:, :, -1:] - a_cs)
    chunk_states = jnp.einsum('bcsgn,bcsgh,bcsghp->bcghpn', Bc, to_end, xdt)
    chunk_decay = jnp.exp(a_cs[:, :, -1])

    def carry_step(s, inp):
        st, dc = inp
        return s * dc[..., None, None] + st, s

    s_init = s0.astype(f32).reshape(Bsz, Gs, Hg, SSM_HEAD_DIM, D_STATE)
    s_fin, s_in = lax.scan(carry_step, s_init,
                           (jnp.moveaxis(chunk_states, 1, 0), jnp.moveaxis(chunk_decay, 1, 0)))
    s_in = jnp.moveaxis(s_in, 0, 1)
    y_off = jnp.einsum('bclgn,bcghpn,bclgh->bclghp', Cc, s_in, jnp.exp(a_cs))
    y = (y_diag + y_off).reshape(Bsz, nc * Q, N_SSM_HEADS, SSM_HEAD_DIM)[:, :L]
    return y, s_fin.reshape(Bsz, N_SSM_HEADS, SSM_HEAD_DIM, D_STATE)


def mamba2_mixer(z, xbc, dt_raw, conv_prefix, s0, prm):
    f32 = jnp.float32
    B, L, _ = xbc.shape
    full = jnp.concatenate([conv_prefix.astype(xbc.dtype), xbc], axis=1)
    conv = lax.conv_general_dilated(full, prm['conv_w'][:, None, :].astype(full.dtype),
                                    window_strides=(1,), padding='VALID',
                                    dimension_numbers=('NWC', 'WIO', 'NWC'),
                                    feature_group_count=CONV_DIM)
    act = jax.nn.silu(conv + prm['conv_b'])
    nbc = N_SSM_GROUPS * D_STATE
    xs = act[..., :D_INNER].reshape(B, L, N_SSM_HEADS, SSM_HEAD_DIM)
    Bm = act[..., D_INNER:D_INNER + nbc].reshape(B, L, N_SSM_GROUPS, D_STATE)
    Cm = act[..., D_INNER + nbc:].reshape(B, L, N_SSM_GROUPS, D_STATE)
    dt = jax.nn.softplus(dt_raw.astype(f32) + prm['dt_bias'].astype(f32))
    A = -jnp.exp(prm['a_log'].astype(f32))
    y, s_fin = ssd_chunked(xs, dt, A, Bm, Cm, s0)
    y = y + prm['d_skip'].astype(f32)[:, None] * xs.astype(f32)
    y = y.reshape(B, L, D_INNER) * jax.nn.silu(z.astype(f32))
    yg = y.reshape(B, L, N_SSM_GROUPS, D_INNER // N_SSM_GROUPS)
    yg = yg * lax.rsqrt(jnp.mean(yg * yg, axis=-1, keepdims=True) + NORM_EPS)
    y = yg.reshape(B, L, D_INNER) * prm['ssm_norm'].astype(f32)
    return y.astype(z.dtype), full[:, -(CONV_W - 1):], s_fin


def finish_layer(x, attn, ssd_y, prm):
    B, T, _ = x.shape
    mix = jnp.concatenate([attn.reshape(B, T, ATTN_W).astype(x.dtype), ssd_y], axis=-1) @ prm['w_out']
    x = x + mix
    h = rms_norm(x, prm['ln_mlp'])
    return x + jnp.square(jax.nn.relu(h @ prm['w_up'])) @ prm['w_down']


def cmp_params(prm):
    return prm['cmp_pe'], prm['cmp_w1'], prm['cmp_b1'], prm['cmp_w2'], prm['cmp_b2']


def prompt_layer(x, prm):
    B, T, _ = x.shape
    h = rms_norm(x, prm['ln_mix'])
    q, kv_c, kv_s, kv_w, gates, z, xbc, dt_raw = split_projection(h, prm['w_in'])
    qpos = jnp.arange(T)
    o_cmp, p_cmp = compressed_attention(q, compress_kv(kv_c, *cmp_params(prm)), qpos)
    idx = select_blocks(p_cmp, qpos, -(-T // SEL_BLOCK))
    nb = T // SEL_Q_BLOCK

    def qblocks(a):
        return jnp.moveaxis(a.reshape((B, nb, SEL_Q_BLOCK) + a.shape[2:]), 1, 0)

    o_sel = lax.map(lambda a: selected_attention(a[0], a[1], kv_s, a[2]),
                    (qblocks(q), qblocks(idx), qpos.reshape(nb, SEL_Q_BLOCK)))
    o_sel = jnp.moveaxis(o_sel, 0, 1).reshape(q.shape)
    o_win = window_attention_prompt(q, kv_w)
    attn = gate_branches(gates, o_cmp, o_sel, o_win)
    ssd_y, conv_new, ssm_new = mamba2_mixer(
        z, xbc, dt_raw, jnp.zeros((B, CONV_W - 1, CONV_DIM), xbc.dtype),
        jnp.zeros((B, N_SSM_HEADS, SSM_HEAD_DIM, D_STATE), jnp.float32), prm)
    y = finish_layer(x, attn, ssd_y, prm)
    return y, (kv_c, kv_s, kv_w[:, -min(WINDOW, T):], conv_new, ssm_new.astype(x.dtype))


def sample_layer(x, cache_c, cache_s, win_buf, conv_st, ssm_st, page_table, prm):
    B, T, _ = x.shape
    past = page_table.shape[1] * cache_c.shape[1]
    h = rms_norm(x, prm['ln_mix'])
    q, kv_c, kv_s, kv_w, gates, z, xbc, dt_raw = split_projection(h, prm['w_in'])
    qpos = past + jnp.arange(T)

    def paged_rows(cache):
        return cache[page_table].reshape((B, past) + cache.shape[2:]).astype(x.dtype)

    full_c = jnp.concatenate([paged_rows(cache_c), kv_c], axis=1)
    full_s = jnp.concatenate([paged_rows(cache_s), kv_s], axis=1)
    o_cmp, p_cmp = compressed_attention(q, compress_kv(full_c, *cmp_params(prm)), qpos)
    idx = select_blocks(p_cmp, qpos, -(-(past + T) // SEL_BLOCK))
    o_sel = selected_attention(q, idx, full_s, qpos)
    n_buf = win_buf.shape[1]
    win_rows = jnp.concatenate([win_buf.astype(x.dtype), kv_w], axis=1)
    kpos = past - n_buf + jnp.arange(n_buf + T)
    o_win = window_attention_rows(q, win_rows, qpos, kpos)
    attn = gate_branches(gates, o_cmp, o_sel, o_win)
    ssd_y, conv_new, ssm_new = mamba2_mixer(z, xbc, dt_raw, conv_st, ssm_st, prm)
    y = finish_layer(x, attn, ssd_y, prm)
    return y, (kv_c, kv_s, win_rows[:, -min(WINDOW, past + T):], conv_new,
               ssm_new.astype(ssm_st.dtype))


def setup_inputs(seed: int = 0) -> dict:
    key = jax.random.key(seed)
    ks = jax.random.split(key, 32)
    f32 = jnp.float32

    def nrm(k, shape, scale):
        return scale * jax.random.normal(k, shape, f32)

    n_pages = PAST_LEN // PAGE_SIZE
    n_pool = (DEC_BATCH * n_pages * 5) // 4
    w_buf = min(WINDOW, PAST_LEN)
    page_table = jax.random.permutation(ks[0], n_pool)[:DEC_BATCH * n_pages]
    page_table = page_table.reshape(DEC_BATCH, n_pages).astype(jnp.int32)
    dt0 = jnp.exp(jax.random.uniform(ks[1], (DEPTH, N_SSM_HEADS), f32,
                                     math.log(1e-3), math.log(1e-1)))
    return {
        'x_prompt': nrm(ks[2], (BATCH, SEQ, D_MODEL), 1.0),
        'x_sample': nrm(ks[3], (DEC_BATCH, DEC_SEQ, D_MODEL), 1.0),
        'cache_kv_cmp': nrm(ks[4], (DEPTH, n_pool, PAGE_SIZE, 2, N_KV, HEAD_DIM), 1.0),
        'cache_kv_sel': nrm(ks[5], (DEPTH, n_pool, PAGE_SIZE, 2, N_KV, HEAD_DIM), 1.0),
        'state_kv_win': nrm(ks[6], (DEPTH, DEC_BATCH, w_buf, 2, N_KV, HEAD_DIM), 1.0),
        'state_conv': nrm(ks[7], (DEPTH, DEC_BATCH, CONV_W - 1, CONV_DIM), 1.0),
        'state_ssm': nrm(ks[8], (DEPTH, DEC_BATCH, N_SSM_HEADS, SSM_HEAD_DIM, D_STATE), 0.1),
        'page_table': page_table,
        'ln_mix': 1.0 + nrm(ks[9], (DEPTH, D_MODEL), 0.02),
        'w_in': nrm(ks[10], (DEPTH, D_MODEL, IN_COLS), D_MODEL ** -0.5),
        'cmp_pe': nrm(ks[11], (DEPTH, 2, CMP_BLOCK, HEAD_DIM), 0.1),
        'cmp_w1': nrm(ks[12], (DEPTH, 2, CMP_BLOCK, HEAD_DIM, CMP_HIDDEN), (CMP_BLOCK * HEAD_DIM) ** -0.5),
        'cmp_b1': nrm(ks[13], (DEPTH, 2, CMP_HIDDEN), 0.02),
        'cmp_w2': nrm(ks[14], (DEPTH, 2, CMP_HIDDEN, HEAD_DIM), CMP_HIDDEN ** -0.5),
        'cmp_b2': nrm(ks[15], (DEPTH, 2, HEAD_DIM), 0.02),
        'conv_w': nrm(ks[16], (DEPTH, CONV_W, CONV_DIM), CONV_W ** -0.5),
        'conv_b': nrm(ks[17], (DEPTH, CONV_DIM), 0.02),
        'dt_bias': dt0 + jnp.log(-jnp.expm1(-dt0)),
        'a_log': jnp.log(jax.random.uniform(ks[18], (DEPTH, N_SSM_HEADS), f32, 1.0, 16.0)),
        'd_skip': 1.0 + nrm(ks[19], (DEPTH, N_SSM_HEADS), 0.1),
        'ssm_norm': 1.0 + nrm(ks[20], (DEPTH, D_INNER), 0.02),
        'w_out': nrm(ks[21], (DEPTH, MIX_W, D_MODEL), MIX_W ** -0.5),
        'ln_mlp': 1.0 + nrm(ks[22], (DEPTH, D_MODEL), 0.02),
        'w_up': nrm(ks[23], (DEPTH, D_MODEL, D_FF), D_MODEL ** -0.5),
        'w_down': nrm(ks[24], (DEPTH, D_FF, D_MODEL), D_FF ** -0.5),
        'ln_final': 1.0 + nrm(ks[25], (D_MODEL,), 0.02),
    }


def reference(x_prompt, x_sample, cache_kv_cmp, cache_kv_sel, state_kv_win, state_conv,
              state_ssm, page_table, ln_mix, w_in, cmp_pe, cmp_w1, cmp_b1, cmp_w2, cmp_b2,
              conv_w, conv_b, dt_bias, a_log, d_skip, ssm_norm, w_out, ln_mlp, w_up, w_down,
              ln_final):
    hp, hs = x_prompt, x_sample
    new_p, new_s = [], []
    for l in range(DEPTH):
        prm = {'ln_mix': ln_mix[l], 'w_in': w_in[l], 'cmp_pe': cmp_pe[l], 'cmp_w1': cmp_w1[l],
               'cmp_b1': cmp_b1[l], 'cmp_w2': cmp_w2[l], 'cmp_b2': cmp_b2[l],
               'conv_w': conv_w[l], 'conv_b': conv_b[l], 'dt_bias': dt_bias[l],
               'a_log': a_log[l], 'd_skip': d_skip[l], 'ssm_norm': ssm_norm[l],
               'w_out': w_out[l], 'ln_mlp': ln_mlp[l], 'w_up': w_up[l], 'w_down': w_down[l]}
        hp, st_p = prompt_layer(hp, prm)
        hs, st_s = sample_layer(hs, cache_kv_cmp[l], cache_kv_sel[l], state_kv_win[l],
                                state_conv[l], state_ssm[l], page_table, prm)
        new_p.append(st_p)
        new_s.append(st_s)
    y_prompt = rms_norm(hp, ln_final)
    y_sample = rms_norm(hs, ln_final)
    kv_cmp_p = jnp.stack([s[0] for s in new_p])
    kv_sel_p = jnp.stack([s[1] for s in new_p])
    kv_win_p = jnp.stack([s[2] for s in new_p])
    conv_p = jnp.stack([s[3] for s in new_p])
    ssm_p = jnp.stack([s[4] for s in new_p])
    kv_cmp_s = jnp.stack([s[0] for s in new_s])
    kv_sel_s = jnp.stack([s[1] for s in new_s])
    kv_win_s = jnp.stack([s[2] for s in new_s])
    conv_s = jnp.stack([s[3] for s in new_s])
    ssm_s = jnp.stack([s[4] for s in new_s])
    return (y_prompt, y_sample, kv_cmp_p, kv_sel_p, kv_win_p, conv_p, ssm_p,
            kv_cmp_s, kv_sel_s, kv_win_s, conv_s, ssm_s)
```

```cpp
#include <hip/hip_runtime.h>
#include <cstdio>
#include <cstdint>

constexpr int DM = 2048, SEQ = 4096, NB = 2, MPROMPT = NB * SEQ, DECB = 32, PAST = 8192, MROWS = MPROMPT + DECB, MP = 8448;
constexpr int NCOLS_IN = 5184, NIN = 5376;
constexpr int DFF = 8192, CONV_DIM = 1536, DIN = 1024;
constexpr int NCMP_P = 255, NCMP_S = 511, NSLC_P = 64, NSLC_S = 129;
constexpr float NORM_EPS = 1e-5f;
constexpr size_t O_YP = 0, O_YS = O_YP + (size_t)MPROMPT * DM, O_KCP = O_YS + (size_t)DECB * DM, O_KSP = O_KCP + (size_t)MPROMPT * 512, O_KWP = O_KSP + (size_t)MPROMPT * 512,
                 O_CVP = O_KWP + (size_t)NB * 512 * 512, O_SSP = O_CVP + (size_t)NB * 3 * CONV_DIM, O_KCS = O_SSP + (size_t)NB * 16 * 64 * 128, O_KSS = O_KCS + (size_t)DECB * 512,
                 O_KWS = O_KSS + (size_t)DECB * 512, O_CVS = O_KWS + (size_t)DECB * 512 * 512, O_SSS = O_CVS + (size_t)DECB * 3 * CONV_DIM, O_END = O_SSS + (size_t)DECB * 16 * 64 * 128;
static_assert(O_END == 38790144, "d_out size");

namespace pg8 {
#define PG8_LAS __attribute__((address_space(3)))
typedef unsigned short bf16_t;
typedef short bf16x8 __attribute__((ext_vector_type(8)));
typedef float f32x4 __attribute__((ext_vector_type(4)));
typedef unsigned u32x4 __attribute__((ext_vector_type(4)));
constexpr int BM = 256, BK = 64, HALF = 128, HTB = HALF * BK * 2  , STAGE_BYTES = 8 * HTB, NXCD = 8, WGM = 8;

__host__ __device__ __forceinline__ int lds_byte(int r, int c) { const int st = (r >> 4) * 2 + (c >> 5), rr = r & 15, cc = c & 31, ob = rr * 64 + cc * 2; return st * 1024 + (ob ^ (((ob >> 9) & 1) << 5)); }
__host__ __device__ __forceinline__ void stage_rc(int b, int& R, int& C) { const int st = b / 1024, sb = b % 1024, swz = sb ^ (((sb >> 9) & 1) << 5); R = (st >> 1) * 16 + swz / 64; C = (st & 1) * 32 + (swz % 64) / 2; }
__host__ __device__ __forceinline__ int perm32(int rho) { const int n = rho >> 4, i = rho & 15; return 8 * (i >> 2) + 4 * n + (i & 3); }

struct Unit { int pm, pn; };
struct Gemm { const bf16_t* A; const bf16_t* Bt; int M, N, K; };

struct StaticOrder {
    int nM, nN, nwg, G, c;
    __host__ __device__ void init(int M, int N, int G_, int c_) { nM = M / BM; nN = N / BM; nwg = nM * nN; G = G_; c = c_; }
    __host__ __device__ bool next(int i, Unit& u) const {
        const long L = (long)i * G + c; if (L >= nwg) return false;
        int wgid = (int)L; { const int q = nwg / NXCD, r = nwg % NXCD, xcd = wgid % NXCD, off = wgid / NXCD; wgid = (xcd < r ? xcd * (q + 1) : r * (q + 1) + (xcd - r) * q) + off; }
        const int nig = WGM * nN, gid = wgid / nig, fm = gid * WGM, gsz = (nM - fm) < WGM ? (nM - fm) : WGM;
        u.pm = fm + ((wgid % nig) % gsz); u.pn = (wgid % nig) / gsz; return true;
    }
    __device__ __forceinline__ void a_ready(const Unit&) const {}
    __device__ __forceinline__ void done(const Unit&) const {}
};

__device__ __forceinline__ unsigned cvt_pk_bf16(float lo, float hi) { unsigned r; asm volatile("v_cvt_pk_bf16_f32 %0, %1, %2" : "=v"(r) : "v"(lo), "v"(hi)); return r; }
typedef float f32x2 __attribute__((ext_vector_type(2)));

__device__ __forceinline__ void st_bf16x4(bf16_t* p, const f32x4 v) { typedef unsigned u32x2v __attribute__((ext_vector_type(2))); u32x2v w; w.x = cvt_pk_bf16(v[0], v[1]); w.y = cvt_pk_bf16(v[2], v[3]); *(u32x2v*)p = w; }
__device__ __forceinline__ float sigmoidf_(float x) { return 1.0f / (1.0f + __expf(-x)); }
struct EpiInProj {
    static constexpr bool PERM = false, AFTER_DRAIN = false;
    bf16_t *QB, *KVB; size_t kvstride; float *Z, *XBC, *GD, *out;
    __device__ __forceinline__ void operator()(const f32x4 (&acc)[2][2][4][2], const Unit& u, int wr, int wc, int fr, int fq) const {
        const int pn = u.pn, rbase = u.pm * BM + wr * 64 + fr, cl = wc * 32 + 4 * fq;
        if (pn < 4) {
#pragma unroll
            for (int ai = 0; ai < 2; ++ai)
#pragma unroll
                for (int m = 0; m < 4; ++m) { const int row = rbase + ai * HALF + m * 16; if (row < MROWS) { bf16_t* p = QB + (size_t)row * 1024 + pn * 256 + cl;
#pragma unroll
                    for (int bj = 0; bj < 2; ++bj)
#pragma unroll
                        for (int n = 0; n < 2; ++n) st_bf16x4(p + bj * HALF + n * 16, acc[ai][bj][m][n]); } }
        } else if (pn < 10) {
            const int which = (pn - 4) >> 1, cb = ((pn - 4) & 1) * 256 + cl; bf16_t* B = KVB + (size_t)which * kvstride;
#pragma unroll
            for (int ai = 0; ai < 2; ++ai)
#pragma unroll
                for (int m = 0; m < 4; ++m) { const int row = rbase + ai * HALF + m * 16; if (row < MROWS) {
                    float* fo = nullptr;
                    if (row < MPROMPT) { if (which == 0) fo = out + O_KCP + (size_t)row * 512; else if (which == 1) fo = out + O_KSP + (size_t)row * 512; else { const int t = row & (SEQ - 1); if (t >= SEQ - 512) fo = out + O_KWP + (size_t)((row >> 12) * 512 + t - (SEQ - 512)) * 512; } }
                    else { const int s = row - MPROMPT; fo = which == 0 ? out + O_KCS + (size_t)s * 512 : (which == 1 ? out + O_KSS + (size_t)s * 512 : out + O_KWS + (size_t)(s * 512 + 511) * 512); }
                    bf16_t* p = B + (size_t)row * 512 + cb;
#pragma unroll
                    for (int bj = 0; bj < 2; ++bj)
#pragma unroll
                        for (int n = 0; n < 2; ++n) { const f32x4 v = acc[ai][bj][m][n]; st_bf16x4(p + bj * HALF + n * 16, v); if (fo) *(f32x4*)(fo + cb + bj * HALF + n * 16) = v; } } }
        } else if (pn < 20) {
            float* base = pn < 14 ? Z : XBC; const int ld = pn < 14 ? 1024 : CONV_DIM, cb = (pn < 14 ? (pn - 10) : (pn - 14)) * 256 + cl;
#pragma unroll
            for (int ai = 0; ai < 2; ++ai)
#pragma unroll
                for (int m = 0; m < 4; ++m) { const int row = rbase + ai * HALF + m * 16; if (row < MROWS) { float* p = base + (size_t)row * ld + cb;
#pragma unroll
                    for (int bj = 0; bj < 2; ++bj)
#pragma unroll
                        for (int n = 0; n < 2; ++n) *(f32x4*)(p + bj * HALF + n * 16) = acc[ai][bj][m][n]; } }
        } else {
#pragma unroll
            for (int ai = 0; ai < 2; ++ai)
#pragma unroll
                for (int m = 0; m < 4; ++m) { const int row = rbase + ai * HALF + m * 16; if (row < MROWS) {
#pragma unroll
                    for (int n = 0; n < 2; ++n) { const int col = cl + n * 16; if (col < 64) { f32x4 v = acc[ai][0][m][n]; if (col < 48) { v[0] = sigmoidf_(v[0]); v[1] = sigmoidf_(v[1]); v[2] = sigmoidf_(v[2]); v[3] = sigmoidf_(v[3]); } *(f32x4*)(GD + (size_t)row * 64 + col) = v; } } } }
        }
    }
};
struct EpiResid {
    static constexpr bool PERM = false, AFTER_DRAIN = false;
    const float* xp; const float* xs; int ldx; float* X1; bf16_t* X1B; float* SS;
    __device__ __forceinline__ void operator()(const f32x4 (&acc)[2][2][4][2], const Unit& u, int wr, int wc, int fr, int fq) const {
        const int pn = u.pn, rbase = u.pm * BM + wr * 64 + fr, cb = pn * 256 + wc * 32 + 4 * fq;
#pragma unroll
        for (int ai = 0; ai < 2; ++ai)
#pragma unroll
            for (int m = 0; m < 4; ++m) { const int row = rbase + ai * HALF + m * 16; const bool ok = row < MROWS;
                const float* xr = row < MPROMPT ? xp + (size_t)row * ldx : xs + (size_t)(row - MPROMPT) * ldx; float ss = 0.f;
#pragma unroll
                for (int bj = 0; bj < 2; ++bj)
#pragma unroll
                    for (int n = 0; n < 2; ++n) { const int col = cb + bj * HALF + n * 16; f32x4 v = acc[ai][bj][m][n];
                        if (ok) { v += *(const f32x4*)(xr + col); *(f32x4*)(X1 + (size_t)row * DM + col) = v; if (X1B) st_bf16x4(X1B + (size_t)row * DM + col, v); }
                        ss += (v[0] * v[0] + v[1] * v[1]) + (v[2] * v[2] + v[3] * v[3]); }
                ss += __shfl_xor(ss, 16); ss += __shfl_xor(ss, 32);
                if (ok && fq == 0) SS[(size_t)row * 32 + pn * 4 + wc] = ss; }
    }
};
struct EpiUp {
    static constexpr bool PERM = false, AFTER_DRAIN = false;
    bf16_t* H; const float* SS;
    __device__ __forceinline__ void operator()(const f32x4 (&acc)[2][2][4][2], const Unit& u, int wr, int wc, int fr, int fq) const {
        const int pn = u.pn, rbase = u.pm * BM + wr * 64 + fr, cb = pn * 256 + wc * 32 + 4 * fq;
#pragma unroll
        for (int ai = 0; ai < 2; ++ai)
#pragma unroll
            for (int m = 0; m < 4; ++m) { const int row = rbase + ai * HALF + m * 16; const bool ok = row < MROWS;
                float t = 0.f; if (ok) { const f32x4 a = *(const f32x4*)(SS + (size_t)row * 32 + fq * 8), b = *(const f32x4*)(SS + (size_t)row * 32 + fq * 8 + 4); t = ((a[0] + a[1]) + (a[2] + a[3])) + ((b[0] + b[1]) + (b[2] + b[3])); }
                t += __shfl_xor(t, 16); t += __shfl_xor(t, 32);
                const float rstd = 1.0f / sqrtf(t * (1.0f / DM) + NORM_EPS);
                if (ok) { bf16_t* p = H + (size_t)row * DFF + cb;
#pragma unroll
                    for (int bj = 0; bj < 2; ++bj)
#pragma unroll
                        for (int n = 0; n < 2; ++n) { f32x4 v = acc[ai][bj][m][n] * rstd; v[0] = fmaxf(v[0], 0.f); v[1] = fmaxf(v[1], 0.f); v[2] = fmaxf(v[2], 0.f); v[3] = fmaxf(v[3], 0.f); v = v * v; st_bf16x4(p + bj * HALF + n * 16, v); } } }
    }
};

template <class Epi, class Sched, bool ALIGN_EPI = false, bool SP2 = false>
__device__ __forceinline__ void gemm_phase(PG8_LAS unsigned char* lds, const Gemm g, const Sched& S, const Epi& E) {
    const int tid = threadIdx.x, wid = __builtin_amdgcn_readfirstlane(tid >> 6), lane = tid & 63, wr = wid >> 2, wc = wid & 3, fr = lane & 15, fq = lane >> 4;
    const int K = g.K, nt = K / BK;
    unsigned voffA[2], voffB[2];
#pragma unroll
    for (int i = 0; i < 2; ++i) { int R, C; stage_rc(tid * 16 + i * 8192, R, C); const int Rb = Epi::PERM ? ((R & ~31) + perm32(R & 31)) : R;
        voffA[i] = (unsigned)(R * K + C) * 2u; voffB[i] = (unsigned)(Rb * K + C) * 2u; }
    const size_t kstep = (size_t)(BK * 2);
    const size_t hstep = (size_t)HALF * K * 2;
    const size_t tstep = 2 * hstep;
    const unsigned ldsw = (unsigned)wid * 1024u;
    const int aoff = lds_byte(wr * 64 + fr, fq * 8), boff = lds_byte(wc * 32 + fr, fq * 8);
#define PG8_SA(b, h) (((b) * 2 + (h)) * HTB)
#define PG8_SB(b, h) ((4 + (b) * 2 + (h)) * HTB)
#define PG8_STAGE(bufoff, gbase, voff) do { _Pragma("unroll") for (int _i = 0; _i < 2; ++_i) \
        __builtin_amdgcn_global_load_lds((const unsigned*)((const char*)(gbase) + (voff)[_i]), (PG8_LAS unsigned*)(lds + (bufoff) + ldsw + _i * 8192), 16, 0, 0); } while (0)
#define PG8_LDA(dst, b, h) do { _Pragma("unroll") for (int m = 0; m < 4; ++m) _Pragma("unroll") for (int k = 0; k < 2; ++k) dst[m][k] = *(const PG8_LAS bf16x8*)(lds + PG8_SA(b, h) + aoff + m * 2048 + k * 1024); } while (0)
#define PG8_LDB(dst, b, h) do { _Pragma("unroll") for (int n = 0; n < 2; ++n) _Pragma("unroll") for (int k = 0; k < 2; ++k) dst[n][k] = *(const PG8_LAS bf16x8*)(lds + PG8_SB(b, h) + boff + n * 2048 + k * 1024); } while (0)
#define PG8_MMA(ai, bj, At, Bt) do { __builtin_amdgcn_s_setprio(1); _Pragma("unroll") for (int m = 0; m < 4; ++m) _Pragma("unroll") for (int n = 0; n < 2; ++n) _Pragma("unroll") for (int k = 0; k < 2; ++k) \
        acc[ai][bj][m][n] = __builtin_amdgcn_mfma_f32_16x16x32_bf16(Bt[n][k], At[m][k], acc[ai][bj][m][n], 0, 0, 0); __builtin_amdgcn_s_setprio(0); } while (0)
#define PG8_WAIT_V(n) asm volatile("s_waitcnt vmcnt(" #n ")" ::: "memory")
#define PG8_WAIT_L(n) asm volatile("s_waitcnt lgkmcnt(" #n ")" ::: "memory")
#define PG8_BAR __builtin_amdgcn_s_barrier()
#define PG8_SCHED __builtin_amdgcn_sched_barrier(0)
    Unit cur, nxt; int ui = 0;
    if (!S.next(0, cur)) return;
    f32x4 acc[2][2][4][2];
#pragma unroll
    for (int a = 0; a < 2; ++a)
#pragma unroll
        for (int b = 0; b < 2; ++b)
#pragma unroll
            for (int m = 0; m < 4; ++m)
#pragma unroll
                for (int n = 0; n < 2; ++n) acc[a][b][m][n] = (f32x4){0.f, 0.f, 0.f, 0.f};
    bf16x8 At[4][2], B0[2][2], B1[2][2];
    const char* cA = (const char*)g.A + (size_t)cur.pm * tstep; const char* cB = (const char*)g.Bt + (size_t)cur.pn * tstep;
    S.a_ready(cur);
    if constexpr (SP2) {
        PG8_STAGE(PG8_SB(0, 0), cB, voffB); PG8_STAGE(PG8_SB(0, 1), cB + hstep, voffB); PG8_STAGE(PG8_SA(0, 0), cA, voffA); PG8_STAGE(PG8_SA(0, 1), cA + hstep, voffA);
        if (wr == 1) PG8_BAR;
        PG8_WAIT_V(2); PG8_BAR;
        PG8_STAGE(PG8_SB(1, 0), cB + kstep, voffB); PG8_STAGE(PG8_SA(1, 0), cA + kstep, voffA); PG8_STAGE(PG8_SB(1, 1), cB + hstep + kstep, voffB);
        PG8_WAIT_V(6); PG8_BAR;
    } else {
        PG8_STAGE(PG8_SB(0, 0), cB, voffB); PG8_STAGE(PG8_SA(0, 0), cA, voffA); PG8_STAGE(PG8_SB(0, 1), cB + hstep, voffB); PG8_STAGE(PG8_SA(0, 1), cA + hstep, voffA);
        if (wr == 1) PG8_BAR;
        PG8_WAIT_V(4); PG8_BAR;
        PG8_STAGE(PG8_SB(1, 0), cB + kstep, voffB); PG8_STAGE(PG8_SA(1, 0), cA + kstep, voffA); PG8_STAGE(PG8_SB(1, 1), cB + hstep + kstep, voffB);
        PG8_WAIT_V(6); PG8_BAR;
    }
    for (;;) {
        const bool has_next = S.next(ui + 1, nxt);
        const char* nA = has_next ? (const char*)g.A + (size_t)nxt.pm * tstep : cA; const char* nB = has_next ? (const char*)g.Bt + (size_t)nxt.pn * tstep : cB;
        for (int t = 0; t < nt; t += 2) {
            const bool last = (t == nt - 2);
            const char* a1 = cA + (size_t)(t + 1) * kstep;
            const char* a2 = last ? nA : cA + (size_t)(t + 2) * kstep; const char* b2 = last ? nB : cB + (size_t)(t + 2) * kstep;
            const char* a3 = a2 + kstep; const char* b3 = b2 + kstep;
            if (last && has_next) S.a_ready(nxt);
            if constexpr (SP2) {
            PG8_LDB(B0, 0, 0); PG8_LDB(B1, 0, 1); PG8_SCHED; PG8_LDA(At, 0, 0); PG8_STAGE(PG8_SA(1, 1), a1 + hstep, voffA);
            PG8_WAIT_V(8); PG8_WAIT_L(0); PG8_BAR; PG8_MMA(0, 0, At, B0); PG8_MMA(0, 1, At, B1); PG8_BAR; PG8_SCHED;
            PG8_LDA(At, 0, 1); PG8_STAGE(PG8_SB(0, 0), b2, voffB); PG8_STAGE(PG8_SB(0, 1), b2 + hstep, voffB); PG8_STAGE(PG8_SA(0, 0), a2, voffA);
            PG8_WAIT_V(8); PG8_WAIT_L(0); PG8_BAR; PG8_MMA(1, 0, At, B0); PG8_MMA(1, 1, At, B1); PG8_BAR; PG8_SCHED;
            PG8_LDB(B0, 1, 0); PG8_LDB(B1, 1, 1); PG8_SCHED; PG8_LDA(At, 1, 0); PG8_STAGE(PG8_SA(0, 1), a2 + hstep, voffA);
            PG8_WAIT_V(8); PG8_WAIT_L(0); PG8_BAR; PG8_MMA(0, 0, At, B0); PG8_MMA(0, 1, At, B1); PG8_BAR; PG8_SCHED;
            PG8_LDA(At, 1, 1); PG8_STAGE(PG8_SB(1, 0), b3, voffB); PG8_STAGE(PG8_SB(1, 1), b3 + hstep, voffB); PG8_STAGE(PG8_SA(1, 0), a3, voffA);
            PG8_WAIT_V(8); PG8_WAIT_L(0); PG8_BAR; PG8_MMA(1, 0, At, B0); PG8_MMA(1, 1, At, B1); PG8_BAR; PG8_SCHED;
            } else {
            PG8_LDB(B0, 0, 0); PG8_SCHED; PG8_LDA(At, 0, 0); PG8_STAGE(PG8_SA(1, 1), a1 + hstep, voffA);
            PG8_WAIT_L(8); PG8_BAR; PG8_WAIT_L(0); PG8_MMA(0, 0, At, B0); PG8_BAR; PG8_SCHED;
            PG8_LDB(B1, 0, 1); PG8_STAGE(PG8_SB(0, 0), b2, voffB);
            PG8_BAR; PG8_WAIT_L(0); PG8_MMA(0, 1, At, B1); PG8_BAR;
            PG8_LDA(At, 0, 1); PG8_STAGE(PG8_SA(0, 0), a2, voffA);
            PG8_BAR; PG8_WAIT_L(0); PG8_MMA(1, 0, At, B0); PG8_BAR; PG8_SCHED;
            PG8_STAGE(PG8_SB(0, 1), b2 + hstep, voffB);
            PG8_WAIT_V(6); PG8_BAR; PG8_MMA(1, 1, At, B1); PG8_BAR;
            PG8_LDB(B0, 1, 0); PG8_SCHED; PG8_LDA(At, 1, 0); PG8_STAGE(PG8_SA(0, 1), a2 + hstep, voffA);
            PG8_WAIT_L(8); PG8_BAR; PG8_WAIT_L(0); PG8_MMA(0, 0, At, B0); PG8_BAR; PG8_SCHED;
            PG8_LDB(B1, 1, 1); PG8_STAGE(PG8_SB(1, 0), b3, voffB);
            PG8_BAR; PG8_WAIT_L(0); PG8_MMA(0, 1, At, B1); PG8_BAR;
            PG8_LDA(At, 1, 1); PG8_STAGE(PG8_SA(1, 0), a3, voffA);
            PG8_BAR; PG8_WAIT_L(0); PG8_MMA(1, 0, At, B0); PG8_BAR; PG8_SCHED;
            PG8_STAGE(PG8_SB(1, 1), b3 + hstep, voffB);
            PG8_WAIT_V(6); PG8_BAR; PG8_MMA(1, 1, At, B1); PG8_BAR;
            }
        }
        if constexpr (ALIGN_EPI) { if (wr == 0) PG8_BAR; }
        if constexpr (!Epi::AFTER_DRAIN) { E(acc, cur, wr, wc, fr, fq); S.done(cur); }
        if (!has_next) break;
#pragma unroll
        for (int a = 0; a < 2; ++a)
#pragma unroll
            for (int b = 0; b < 2; ++b)
#pragma unroll
                for (int m = 0; m < 4; ++m)
#pragma unroll
                    for (int n = 0; n < 2; ++n) acc[a][b][m][n] = (f32x4){0.f, 0.f, 0.f, 0.f};
        cur = nxt; cA = nA; cB = nB; ++ui;
        if constexpr (ALIGN_EPI) { if (wr == 1) PG8_BAR; }
    }
    PG8_WAIT_V(0);
    if constexpr (!ALIGN_EPI) { if (wr == 0) PG8_BAR; }
    PG8_BAR;
    if constexpr (Epi::AFTER_DRAIN) { E.fused(acc, cur, wr, wc, fr, fq, lds, wid, lane); S.done(cur); }
#undef PG8_SA
#undef PG8_SB
#undef PG8_STAGE
#undef PG8_LDA
#undef PG8_LDB
#undef PG8_MMA
#undef PG8_WAIT_V
#undef PG8_WAIT_L
#undef PG8_BAR
#undef PG8_SCHED
}
}

#define GAS __attribute__((address_space(1)))
#define LAS __attribute__((address_space(3)))
typedef unsigned short bf16;
typedef unsigned v4u __attribute__((ext_vector_type(4)));
typedef float f32x4 __attribute__((ext_vector_type(4)));
typedef short bf16x8 __attribute__((ext_vector_type(8)));
typedef GAS unsigned gu32;
typedef GAS unsigned long long gu64;
#define RLX_AGENT __ATOMIC_RELAXED, __HIP_MEMORY_SCOPE_AGENT
#define LDS_WAIT() asm volatile("s_waitcnt lgkmcnt(0)" ::: "memory")
#define VM_WAIT() asm volatile("s_waitcnt vmcnt(0)" ::: "memory")
__device__ __forceinline__ unsigned long long rt() { return __builtin_amdgcn_s_memrealtime(); }
__device__ __forceinline__ unsigned f2bf(float f) { unsigned u = __builtin_bit_cast(unsigned, f); return (u + 0x7fffu + ((u >> 16) & 1u)) >> 16; }
__device__ __forceinline__ unsigned pk2(float lo, float hi) { return f2bf(lo) | (f2bf(hi) << 16); }

#define XB_TMO      128
#define XB_XCNT(j)  (256  + 64 * (j))
#define XB_XSUB(j)  (1280 + 64 * (j))
#define XB_XGEN(j)  (2304 + 64 * (j))
#define XB_TOP      3328
#define XB_TOPGEN   3392
#define XCD_BAR_WORDS 3456
#define XB_SPIN_CAP (1u << 18)

__device__ __forceinline__ unsigned xb_ld(unsigned* p)              { return __hip_atomic_load(p, __ATOMIC_RELAXED, __HIP_MEMORY_SCOPE_AGENT); }
__device__ __forceinline__ unsigned xb_add(unsigned* p, unsigned v) { return __hip_atomic_fetch_add(p, v, __ATOMIC_RELAXED, __HIP_MEMORY_SCOPE_AGENT); }
__device__ __forceinline__ unsigned xb_xcc_id() { return (unsigned)__builtin_amdgcn_s_getreg((3 << 11) | 20) & 0xFu; }
#define XB_SPIN(cond, bar) do { unsigned _sp = 0; while (cond) { __builtin_amdgcn_s_sleep(1); \
    if ((++_sp & 255u) == 0u) { if (xb_ld(&(bar)[XB_TMO])) break; if (_sp > XB_SPIN_CAP) { atomicAdd(&(bar)[XB_TMO], 1u); break; } } } } while (0)

struct XcdBarrier {
    unsigned* bar; unsigned x;
    volatile LAS unsigned* st;
};

__device__ __forceinline__ XcdBarrier xcd_barrier_post(unsigned* bar, volatile LAS unsigned* st) {
    XcdBarrier b; b.bar = bar; b.x = xb_xcc_id(); b.st = st;
    if (threadIdx.x == 0) (void)xb_add(&bar[XB_XCNT(b.x)], 1u);
    return b;
}
__device__ __forceinline__ void xcd_barrier_complete(unsigned* bar, unsigned x, unsigned& nloc, unsigned& nx) {
    const unsigned G = gridDim.x * gridDim.y * gridDim.z;
    unsigned sum, cnt, mine, sp = 0u;
    for (;;) {
        sum = 0u; cnt = 0u; mine = 0u;
#pragma unroll
        for (unsigned j = 0; j < 16; ++j) { const unsigned c = xb_ld(&bar[XB_XCNT(j)]); sum += c; cnt += (c > 0u) ? 1u : 0u; mine = (j == x) ? c : mine; }
        if (sum == G) break;
        __builtin_amdgcn_s_sleep(1);
        if ((++sp & 255u) == 0u) { if (xb_ld(&bar[XB_TMO])) break; if (sp > XB_SPIN_CAP) { atomicAdd(&bar[XB_TMO], 1u); break; } }
    }
    nloc = mine > 0u ? mine : 1u; nx = cnt > 0u ? cnt : 1u;
}

__device__ __forceinline__ void xcd_barrier(const XcdBarrier& b) {
    asm volatile("s_waitcnt vmcnt(0)" ::: "memory");
    __syncthreads();
    if (threadIdx.x == 0) {
        unsigned* bar = b.bar;
        __builtin_amdgcn_s_waitcnt(0);
        unsigned nloc = b.st[0], nx = b.st[1];
        if (nloc == 0u) { xcd_barrier_complete(bar, b.x, nloc, nx); b.st[0] = nloc; b.st[1] = nx; }
        const unsigned old = xb_add(&bar[XB_XSUB(b.x)], 1u);
        const unsigned gen = old / nloc;
        if (old + 1u == (gen + 1u) * nloc) {
            __builtin_amdgcn_fence(__ATOMIC_RELEASE, "agent");
            asm volatile("s_waitcnt vmcnt(0)" ::: "memory");
            const unsigned og = xb_add(&bar[XB_TOP], 1u);
            const unsigned tg = og / nx;
            if (og + 1u == (tg + 1u) * nx) xb_add(&bar[XB_TOPGEN], 1u);
            else XB_SPIN(xb_ld(&bar[XB_TOPGEN]) == tg, bar);
            __builtin_amdgcn_fence(__ATOMIC_ACQUIRE, "agent");
            xb_add(&bar[XB_XGEN(b.x)], 1u);
            asm volatile("s_waitcnt vmcnt(0)" ::: "memory");
        } else {
            XB_SPIN(xb_ld(&bar[XB_XGEN(b.x)]) == gen, bar);
            __builtin_amdgcn_fence(__ATOMIC_ACQUIRE, "agent");
            asm volatile("s_waitcnt vmcnt(0)" ::: "memory");
        }
    }
    __syncthreads();
}


constexpr int NWAVES = 8;
#ifndef MK_N_LAUNCHES
#define MK_N_LAUNCHES 9
#endif
constexpr int N_PHASES = 9;
constexpr int N_LAUNCHES = MK_N_LAUNCHES;
static_assert(N_LAUNCHES == 1 || N_LAUNCHES == N_PHASES, "MK_N_LAUNCHES is 1 or 9");

constexpr size_t MiB = 1u << 20;
constexpr size_t al(size_t x) { return (x + MiB - 1) / MiB * MiB; }
constexpr size_t WS_CTL = 0, CTL_ZERO_BYTES = 1 * MiB;
constexpr size_t WS_WIN = 2 * MiB;
constexpr size_t WS_WOUT = WS_WIN + al((size_t)NIN * DM * 2);
constexpr size_t WS_WUP = WS_WOUT + al((size_t)DM * DM * 2);
constexpr size_t WS_WDN = WS_WUP + al((size_t)DFF * DM * 2);
constexpr size_t WS_XN = WS_WDN + al((size_t)DM * DFF * 2);
constexpr size_t WS_QB = WS_XN + al((size_t)MP * DM * 2);
constexpr size_t WS_KCB = WS_QB + al((size_t)MP * 1024 * 2);
constexpr size_t WS_KSB = WS_KCB + al((size_t)MP * 512 * 2);
constexpr size_t WS_KWB = WS_KSB + al((size_t)MP * 512 * 2);
constexpr size_t WS_Z = WS_KWB + al((size_t)MP * 512 * 2);
constexpr size_t WS_XBC = WS_Z + al((size_t)MP * 1024 * 4);
constexpr size_t WS_GD = WS_XBC + al((size_t)MP * CONV_DIM * 4);
constexpr size_t WS_XBCA = WS_GD + al((size_t)MP * 64 * 4);
constexpr size_t WS_DT = WS_XBCA + al((size_t)MP * CONV_DIM * 4);
constexpr size_t WS_KCMPP = WS_DT + al((size_t)MP * 16 * 4);
constexpr size_t WS_KCMPS = WS_KCMPP + al((size_t)NB * NCMP_P * 512 * 4);
constexpr size_t WS_OWIN = WS_KCMPS + al((size_t)DECB * NCMP_S * 512 * 4);
constexpr size_t WS_OCMP = WS_OWIN + al((size_t)MP * 1024 * 4);
constexpr size_t WS_SELIDX = WS_OCMP + al((size_t)MP * 1024 * 4);
constexpr size_t WS_SELMASK = WS_SELIDX + al((size_t)MP * 64 * 4);
constexpr size_t WS_YSSD = WS_SELMASK + al((size_t)MPROMPT * 4 * 8);
constexpr size_t WS_MIX = WS_YSSD + al((size_t)MP * 1024 * 4);
constexpr size_t WS_X1 = WS_MIX + al((size_t)MP * DM * 2);
constexpr size_t WS_X1B = WS_X1 + al((size_t)MP * DM * 4);
constexpr size_t WS_SS1 = WS_X1B + al((size_t)MP * DM * 2);
constexpr size_t WS_H = WS_SS1 + al((size_t)MP * 32 * 4);
constexpr size_t WS_X2 = WS_H + al((size_t)MP * DFF * 2);
constexpr size_t WS_SS2 = WS_X2 + al((size_t)MP * DM * 4);
constexpr size_t WS_END = WS_SS2 + al((size_t)MP * 32 * 4);
constexpr int CW_TMO = 0, CW_CODE = 1, CW_BAR = 4096;

constexpr int RING_OFF = 0, RING_BYTES = 131072;
constexpr int LDSCTL_OFF = RING_BYTES, MISC_OFF = LDSCTL_OFF + 320;
constexpr int LDS_BYTES = 147456;
static_assert(MISC_OFF + 128 <= LDS_BYTES, "LDS map");


struct Ctx {
    LAS unsigned char* lds; volatile LAS unsigned* MISC; gu32* ctl;
    int tid, lane, wave, vcu, G;
    const __attribute__((address_space(4))) unsigned long long* ka;
    __device__ __forceinline__ const float* x_prompt() const { return (const float*)ka[0]; }
    __device__ __forceinline__ const float* x_sample() const { return (const float*)ka[1]; }
    __device__ __forceinline__ const float* cache_cmp() const { return (const float*)ka[2]; }
    __device__ __forceinline__ const float* cache_sel() const { return (const float*)ka[3]; }
    __device__ __forceinline__ const float* st_win() const { return (const float*)ka[4]; }
    __device__ __forceinline__ const float* st_conv() const { return (const float*)ka[5]; }
    __device__ __forceinline__ const float* st_ssm() const { return (const float*)ka[6]; }
    __device__ __forceinline__ const int* page_table() const { return (const int*)ka[7]; }
    __device__ __forceinline__ const float* ln_mix() const { return (const float*)ka[8]; }
    __device__ __forceinline__ const float* w_in() const { return (const float*)ka[9]; }
    __device__ __forceinline__ const float* cmp_pe() const { return (const float*)ka[10]; }
    __device__ __forceinline__ const float* cmp_w1() const { return (const float*)ka[11]; }
    __device__ __forceinline__ const float* cmp_b1() const { return (const float*)ka[12]; }
    __device__ __forceinline__ const float* cmp_w2() const { return (const float*)ka[13]; }
    __device__ __forceinline__ const float* cmp_b2() const { return (const float*)ka[14]; }
    __device__ __forceinline__ const float* conv_w() const { return (const float*)ka[15]; }
    __device__ __forceinline__ const float* conv_b() const { return (const float*)ka[16]; }
    __device__ __forceinline__ const float* dt_bias() const { return (const float*)ka[17]; }
    __device__ __forceinline__ const float* a_log() const { return (const float*)ka[18]; }
    __device__ __forceinline__ const float* d_skip() const { return (const float*)ka[19]; }
    __device__ __forceinline__ const float* ssm_norm() const { return (const float*)ka[20]; }
    __device__ __forceinline__ const float* w_out() const { return (const float*)ka[21]; }
    __device__ __forceinline__ const float* ln_mlp() const { return (const float*)ka[22]; }
    __device__ __forceinline__ const float* w_up() const { return (const float*)ka[23]; }
    __device__ __forceinline__ const float* w_down() const { return (const float*)ka[24]; }
    __device__ __forceinline__ const float* ln_final() const { return (const float*)ka[25]; }
    __device__ __forceinline__ float* out() const { return (float*)ka[26]; }
    __device__ __forceinline__ unsigned char* ws() const { return (unsigned char*)ka[27]; }
    __device__ __forceinline__ bf16* WIN() const { return (bf16*)(ws() + WS_WIN); }
    __device__ __forceinline__ bf16* WOUT() const { return (bf16*)(ws() + WS_WOUT); }
    __device__ __forceinline__ bf16* WUP() const { return (bf16*)(ws() + WS_WUP); }
    __device__ __forceinline__ bf16* WDN() const { return (bf16*)(ws() + WS_WDN); }
    __device__ __forceinline__ bf16* XN() const { return (bf16*)(ws() + WS_XN); }
    __device__ __forceinline__ bf16* QB() const { return (bf16*)(ws() + WS_QB); }
    __device__ __forceinline__ bf16* KCB() const { return (bf16*)(ws() + WS_KCB); }
    __device__ __forceinline__ bf16* KSB() const { return (bf16*)(ws() + WS_KSB); }
    __device__ __forceinline__ bf16* KWB() const { return (bf16*)(ws() + WS_KWB); }
    __device__ __forceinline__ bf16* MIX() const { return (bf16*)(ws() + WS_MIX); }
    __device__ __forceinline__ bf16* X1B() const { return (bf16*)(ws() + WS_X1B); }
    __device__ __forceinline__ bf16* H() const { return (bf16*)(ws() + WS_H); }
    __device__ __forceinline__ float* Z() const { return (float*)(ws() + WS_Z); }
    __device__ __forceinline__ float* XBC() const { return (float*)(ws() + WS_XBC); }
    __device__ __forceinline__ float* GD() const { return (float*)(ws() + WS_GD); }
    __device__ __forceinline__ float* XBCA() const { return (float*)(ws() + WS_XBCA); }
    __device__ __forceinline__ float* DT() const { return (float*)(ws() + WS_DT); }
    __device__ __forceinline__ float* KCMPP() const { return (float*)(ws() + WS_KCMPP); }
    __device__ __forceinline__ float* KCMPS() const { return (float*)(ws() + WS_KCMPS); }
    __device__ __forceinline__ float* OWIN() const { return (float*)(ws() + WS_OWIN); }
    __device__ __forceinline__ float* OCMP() const { return (float*)(ws() + WS_OCMP); }
    __device__ __forceinline__ float* YSSD() const { return (float*)(ws() + WS_YSSD); }
    __device__ __forceinline__ float* X1() const { return (float*)(ws() + WS_X1); }
    __device__ __forceinline__ float* SS1() const { return (float*)(ws() + WS_SS1); }
    __device__ __forceinline__ float* X2() const { return (float*)(ws() + WS_X2); }
    __device__ __forceinline__ float* SS2() const { return (float*)(ws() + WS_SS2); }
    __device__ __forceinline__ int* SELIDX() const { return (int*)(ws() + WS_SELIDX); }
    __device__ __forceinline__ unsigned long long* SELMASK() const { return (unsigned long long*)(ws() + WS_SELMASK); }
};
__device__ __forceinline__ float bf2f(bf16 x) { return __uint_as_float((unsigned)x << 16); }
__device__ __forceinline__ float wave_sum(float v) {
#pragma unroll
    for (int o = 1; o < 64; o <<= 1) v += __shfl_xor(v, o);
    return v;
}
__device__ __forceinline__ float wave_max(float v) {
#pragma unroll
    for (int o = 1; o < 64; o <<= 1) v = fmaxf(v, __shfl_xor(v, o));
    return v;
}
__device__ __forceinline__ float siluf_(float x) { return x / (1.0f + __expf(-x)); }
__device__ __forceinline__ float rdlane(float v, int l) { return __int_as_float(__builtin_amdgcn_readlane(__float_as_int(v), l)); }

__device__ __forceinline__ int win_oldcol(int n) { return n < 2560 ? n : (n < 5120 ? n + 48 : (n < 5168 ? n - 2560 : (n < NCOLS_IN ? n : -1))); }
template <int MODE  >
__device__ __forceinline__ void p0_transpose_item(const float* W, int K, int Nsrc, int Ndst, bf16* WT, const float* rowscale, LAS float* scr, int item, int lane) {
    const int nblk = Ndst / 32, kb = item / nblk, nb = item % nblk, k0 = 64 * kb, n0 = 32 * nb;
    const int ncol = MODE == 1 ? win_oldcol(n0 + (lane & 31)) : n0 + (lane & 31);
#pragma unroll 8
    for (int i = 0; i < 32; ++i) { const int kk = 2 * i + (lane >> 5); float v = 0.f; if (ncol >= 0) v = W[(size_t)(k0 + kk) * Nsrc + ncol]; if (rowscale) v *= rowscale[k0 + kk]; scr[kk * 33 + (lane & 31)] = v; }
    LDS_WAIT(); asm volatile("" ::: "memory");
    const int c = lane & 7;
#pragma unroll
    for (int j = 0; j < 4; ++j) { const int n = (lane >> 3) + 8 * j; const LAS float* s = scr + (8 * c) * 33 + n;
        v4u o; o.x = pk2(s[0 * 33], s[1 * 33]); o.y = pk2(s[2 * 33], s[3 * 33]); o.z = pk2(s[4 * 33], s[5 * 33]); o.w = pk2(s[6 * 33], s[7 * 33]);
        *(GAS v4u*)(WT + (size_t)(n0 + n) * K + k0 + 8 * c) = o; }
    LDS_WAIT(); asm volatile("" ::: "memory");
}
__device__ __forceinline__ void p0_prologue(const Ctx& F) {
    LAS float* scr = (LAS float*)(F.lds + RING_OFF + F.wave * 16384);
    const int gw = F.vcu * NWAVES + F.wave, NGW = F.G * NWAVES;
    constexpr int I_IN = (DM / 64) * (NIN / 32), I_OUT = (DM / 64) * (DM / 32), I_UP = (DM / 64) * (DFF / 32), I_DN = (DFF / 64) * (DM / 32);
    constexpr int NITEMS = I_IN + I_OUT + I_UP + I_DN;
    for (int it = gw; it < NITEMS; it += NGW) {
        int r = it;
        if (r < I_IN) { p0_transpose_item<1>(F.w_in(), DM, NCOLS_IN, NIN, F.WIN(), nullptr, scr, r, F.lane); continue; } r -= I_IN;
        if (r < I_OUT) { p0_transpose_item<0>(F.w_out(), DM, DM, DM, F.WOUT(), nullptr, scr, r, F.lane); continue; } r -= I_OUT;
        if (r < I_UP) { p0_transpose_item<0>(F.w_up(), DM, DFF, DFF, F.WUP(), F.ln_mlp(), scr, r, F.lane); continue; } r -= I_UP;
        p0_transpose_item<0>(F.w_down(), DFF, DM, DM, F.WDN(), nullptr, scr, r, F.lane);
    }
    for (int m = gw; m < MP; m += NGW) {
        GAS unsigned long long* o8 = (GAS unsigned long long*)(F.XN() + (size_t)m * DM) + F.lane;
        if (m >= MROWS) { GAS unsigned long long* z8 = (GAS unsigned long long*)(F.MIX() + (size_t)m * DM) + F.lane;
#pragma unroll
            for (int j = 0; j < 8; ++j) { o8[64 * j] = 0ull; z8[64 * j] = 0ull; }
            continue; }
        const float* xrow = m < MPROMPT ? F.x_prompt() + (size_t)m * DM : F.x_sample() + (size_t)(m - MPROMPT) * DM;
        const GAS f32x4* xr = (const GAS f32x4*)xrow + F.lane; const GAS f32x4* wr = (const GAS f32x4*)F.ln_mix() + F.lane;
        f32x4 v[8]; float s = 0.f;
#pragma unroll
        for (int j = 0; j < 8; ++j) { v[j] = xr[64 * j]; s += (v[j].x * v[j].x + v[j].y * v[j].y) + (v[j].z * v[j].z + v[j].w * v[j].w); }
        const float rstd = 1.0f / sqrtf(wave_sum(s) * (1.0f / DM) + NORM_EPS);
#pragma unroll
        for (int j = 0; j < 8; ++j) { const f32x4 w = wr[64 * j]; o8[64 * j] = (unsigned long long)pk2(v[j].x * rstd * w.x, v[j].y * rstd * w.y) | ((unsigned long long)pk2(v[j].z * rstd * w.z, v[j].w * rstd * w.w) << 32); }
    }
    { const int gt = F.vcu * (NWAVES * 64) + F.tid, NGT = F.G * NWAVES * 64; constexpr int TOT = DECB * 511 * 128;
      for (int i = gt; i < TOT; i += NGT) { const int b = i / (511 * 128), r = i % (511 * 128), row = r >> 7, c4 = r & 127;
          *(f32x4*)(F.out() + O_KWS + ((size_t)(b * 512 + row) * 512) + c4 * 4) = *(const f32x4*)(F.st_win() + ((size_t)(b * 512 + row + 1) * 512) + c4 * 4); } }
}

struct KeyRef { const void* k; const void* v; int f32; int valid; };
template <int NCH, class KF>
__device__ __forceinline__ void naive_attn2(const bf16* q2, const KF& kf, LAS float* qs, LAS float* sc, LAS float* ps, bool use_ps, int lane, float& o0, float& o1) {
    qs[lane] = bf2f(q2[lane]) * 0.125f; qs[64 + lane] = bf2f(q2[64 + lane]) * 0.125f;
    for (int c = 0; c < NCH; ++c) {
        const KeyRef kr = kf(c, lane);
        float s0 = -INFINITY, s1 = -INFINITY;
        if (kr.valid) {
            float k[64];
            if (kr.f32) { const f32x4* p = (const f32x4*)kr.k;
#pragma unroll
                for (int i = 0; i < 16; ++i) { const f32x4 t = p[i]; k[4 * i] = t.x; k[4 * i + 1] = t.y; k[4 * i + 2] = t.z; k[4 * i + 3] = t.w; } }
            else { const v4u* p = (const v4u*)kr.k;
#pragma unroll
                for (int i = 0; i < 8; ++i) { const v4u t = p[i]; k[8 * i] = __uint_as_float(t.x << 16); k[8 * i + 1] = __uint_as_float(t.x & 0xffff0000u); k[8 * i + 2] = __uint_as_float(t.y << 16); k[8 * i + 3] = __uint_as_float(t.y & 0xffff0000u);
                    k[8 * i + 4] = __uint_as_float(t.z << 16); k[8 * i + 5] = __uint_as_float(t.z & 0xffff0000u); k[8 * i + 6] = __uint_as_float(t.w << 16); k[8 * i + 7] = __uint_as_float(t.w & 0xffff0000u); } }
            s0 = 0.f; s1 = 0.f;
#pragma unroll
            for (int d = 0; d < 64; ++d) { s0 += qs[d] * k[d]; s1 += qs[64 + d] * k[d]; }
        }
        sc[c * 64 + lane] = s0; sc[NCH * 64 + c * 64 + lane] = s1;
    }
#pragma unroll
    for (int hh = 0; hh < 2; ++hh) { LAS float* s = sc + hh * NCH * 64; float m = -INFINITY;
        for (int c = 0; c < NCH; ++c) m = fmaxf(m, s[c * 64 + lane]);
        m = wave_max(m); if (m == -INFINITY) m = 0.f;
        float sum = 0.f;
        for (int c = 0; c < NCH; ++c) { const float e = __expf(s[c * 64 + lane] - m); s[c * 64 + lane] = e; sum += e; }
        sum = wave_sum(sum); const float inv = 1.0f / fmaxf(sum, 1e-30f);
        for (int c = 0; c < NCH; ++c) { const float p = s[c * 64 + lane] * inv; s[c * 64 + lane] = p; if (use_ps) ps[1 + c * 64 + lane] += p; } }
    o0 = 0.f; o1 = 0.f;
    for (int c = 0; c < NCH; ++c)
        for (int k = 0; k < 64; ++k) { const KeyRef kr = kf(c, k); if (!kr.valid) continue;
            const float v = kr.f32 ? ((const float*)kr.v)[lane] : bf2f(((const bf16*)kr.v)[lane]);
            o0 += sc[c * 64 + k] * v; o1 += sc[NCH * 64 + c * 64 + k] * v; }
}
struct CmpKeys { const float* base; int g, ncmp, qpos;
    __device__ __forceinline__ KeyRef operator()(int c, int l) const { const int n = c * 64 + l; KeyRef r; r.valid = (n < ncmp) && (16 * n + 31 <= qpos); r.f32 = 1; r.k = base + (size_t)(r.valid ? n : 0) * 512 + g * 64; r.v = (const float*)r.k + 256; return r; } };
struct WinKeysP { const bf16* kw; int g, t;
    __device__ __forceinline__ KeyRef operator()(int c, int l) const { const int pos = t - 511 + c * 64 + l; KeyRef r; r.valid = pos >= 0; r.f32 = 0; r.k = kw + (size_t)(r.valid ? pos : 0) * 512 + g * 64; r.v = (const bf16*)r.k + 256; return r; } };
struct WinKeysS { const float* st; const bf16* nw; int g;
    __device__ __forceinline__ KeyRef operator()(int c, int l) const { const int i = 1 + c * 64 + l; KeyRef r; r.valid = 1;
        if (i < 512) { r.f32 = 1; r.k = st + (size_t)i * 512 + g * 64; r.v = (const float*)r.k + 256; } else { r.f32 = 0; r.k = nw + g * 64; r.v = nw + 256 + g * 64; } return r; } };
struct SelKeysP { const int* idx; const bf16* ks; int g, qpos;
    __device__ __forceinline__ KeyRef operator()(int c, int l) const { const int pos = idx[c] * 64 + l; KeyRef r; r.valid = pos <= qpos; r.f32 = 0; r.k = ks + (size_t)(r.valid ? pos : 0) * 512 + g * 64; r.v = (const bf16*)r.k + 256; return r; } };
struct SelKeysS { const int* idx; const int* pt; const float* cache; const bf16* nw; int g;
    __device__ __forceinline__ KeyRef operator()(int c, int l) const { const int pos = idx[c] * 64 + l; KeyRef r; r.valid = pos <= PAST;
        if (pos < PAST) { const int page = pt[pos >> 7]; r.f32 = 1; r.k = cache + ((size_t)page * 128 + (pos & 127)) * 512 + g * 64; r.v = (const float*)r.k + 256; } else { r.f32 = 0; r.k = nw + g * 64; r.v = nw + 256 + g * 64; } return r; } };

constexpr int NA_WAVE_LDS = 14336;
__device__ __forceinline__ void na_ptrs(const Ctx& F, LAS float*& qs, LAS float*& sc, LAS float*& ps, LAS float*& imp) {
    LAS unsigned char* b = F.lds + RING_OFF + F.wave * NA_WAVE_LDS; qs = (LAS float*)b; sc = (LAS float*)(b + 512); ps = (LAS float*)(b + 8704); imp = (LAS float*)(b + 10880); }

__device__ __forceinline__ void compress_task(const Ctx& F, int task, int lane) {
    constexpr int NT_P = NB * NCMP_P * 2;
    const bool dec = task >= NT_P; const int tt = dec ? task - NT_P : task, ncmp = dec ? NCMP_S : NCMP_P, bb = tt / (ncmp * 2), rr = tt % (ncmp * 2), n = rr >> 1, c = rr & 1;
    float h0[4] = {0.f, 0.f, 0.f, 0.f}, h1[4] = {0.f, 0.f, 0.f, 0.f};
    const float* w1 = F.cmp_w1() + (size_t)c * 2048 * 128; const float* pe = F.cmp_pe() + c * 2048;
    for (int l = 0; l < 32; ++l) {
        const int pos = 16 * n + l; const float* row;
        if (!dec) row = F.out() + O_KCP + (size_t)(bb * SEQ + pos) * 512; else { const int page = F.page_table()[bb * 64 + (pos >> 7)]; row = F.cache_cmp() + ((size_t)page * 128 + (pos & 127)) * 512; }
        const float pv = pe[l * 64 + lane]; float xg[4];
#pragma unroll
        for (int g = 0; g < 4; ++g) xg[g] = row[c * 256 + g * 64 + lane] + pv;
        const float* wl = w1 + (size_t)l * 64 * 128;
#pragma unroll 8
        for (int d = 0; d < 64; ++d) { const float wa = wl[d * 128 + lane], wb = wl[d * 128 + 64 + lane];
#pragma unroll
            for (int g = 0; g < 4; ++g) { const float xv = rdlane(xg[g], d); h0[g] += xv * wa; h1[g] += xv * wb; } }
    }
    const float ba = F.cmp_b1()[c * 128 + lane], bb1 = F.cmp_b1()[c * 128 + 64 + lane];
#pragma unroll
    for (int g = 0; g < 4; ++g) { h0[g] = siluf_(h0[g] + ba); h1[g] = siluf_(h1[g] + bb1); }
    const float* w2 = F.cmp_w2() + (size_t)c * 128 * 64; const float b2 = F.cmp_b2()[c * 64 + lane];
    float o[4] = {b2, b2, b2, b2};
    for (int f = 0; f < 64; ++f) { const float wa = w2[f * 64 + lane], wb = w2[(64 + f) * 64 + lane];
#pragma unroll
        for (int g = 0; g < 4; ++g) o[g] += rdlane(h0[g], f) * wa + rdlane(h1[g], f) * wb; }
    float* dst = (dec ? F.KCMPS() : F.KCMPP()) + ((size_t)(bb * ncmp + n) * 2 + c) * 256;
#pragma unroll
    for (int g = 0; g < 4; ++g) dst[g * 64 + lane] = o[g];
}
__device__ __forceinline__ void conv_prepass(const Ctx& F) {
    const int gt = F.vcu * (NWAVES * 64) + F.tid, NGT = F.G * NWAVES * 64; constexpr int TOT = MROWS * (CONV_DIM / 4);
    for (int i = gt; i < TOT; i += NGT) {
        const int m = i / (CONV_DIM / 4), c4 = i % (CONV_DIM / 4), col = c4 * 4; const bool dec = m >= MPROMPT; const int b = dec ? m - MPROMPT : m >> 12, t = dec ? 0 : (m & (SEQ - 1));
        f32x4 acc = *(const f32x4*)(F.conv_b() + col); f32x4 xcur = (f32x4){0.f, 0.f, 0.f, 0.f};
#pragma unroll
        for (int w = 0; w < 4; ++w) { const int tt = t - 3 + w; f32x4 xv = (f32x4){0.f, 0.f, 0.f, 0.f};
            if (tt >= 0) xv = *(const f32x4*)(F.XBC() + (size_t)(m - 3 + w) * CONV_DIM + col); else if (dec) xv = *(const f32x4*)(F.st_conv() + (size_t)(b * 3 + w) * CONV_DIM + col);
            if (w == 3) xcur = xv;
            acc += xv * *(const f32x4*)(F.conv_w() + (size_t)w * CONV_DIM + col); }
        f32x4 a; a.x = siluf_(acc.x); a.y = siluf_(acc.y); a.z = siluf_(acc.z); a.w = siluf_(acc.w);
        *(f32x4*)(F.XBCA() + (size_t)m * CONV_DIM + col) = a;
        if (!dec && t >= SEQ - 3) *(f32x4*)(F.out() + O_CVP + (size_t)(b * 3 + (t - (SEQ - 3))) * CONV_DIM + col) = xcur;
        if (dec) { *(f32x4*)(F.out() + O_CVS + (size_t)(b * 3 + 0) * CONV_DIM + col) = *(const f32x4*)(F.st_conv() + (size_t)(b * 3 + 1) * CONV_DIM + col);
                   *(f32x4*)(F.out() + O_CVS + (size_t)(b * 3 + 1) * CONV_DIM + col) = *(const f32x4*)(F.st_conv() + (size_t)(b * 3 + 2) * CONV_DIM + col);
                   *(f32x4*)(F.out() + O_CVS + (size_t)(b * 3 + 2) * CONV_DIM + col) = xcur; }
        if (c4 < 4) {
#pragma unroll
            for (int e = 0; e < 4; ++e) { const int h = c4 * 4 + e; const float x = F.GD()[(size_t)m * 64 + 48 + h] + F.dt_bias()[h]; F.DT()[(size_t)m * 16 + h] = x > 20.f ? x : log1pf(__expf(x)); } }
    }
}
__device__ __forceinline__ void win_task(const Ctx& F, int task, int lane) {
    LAS float *qs, *sc, *ps, *imp; na_ptrs(F, qs, sc, ps, imp);
    const int m = task >> 2, g = task & 3; const bool dec = m >= MPROMPT; const int b = dec ? m - MPROMPT : m >> 12, t = m & (SEQ - 1);
#pragma unroll
    for (int pr = 0; pr < 2; ++pr) { float o0, o1; const bf16* q2 = F.QB() + (size_t)m * 1024 + g * 256 + pr * 128;
        if (!dec) { const WinKeysP kf{F.KWB() + (size_t)b * SEQ * 512, g, t}; naive_attn2<8>(q2, kf, qs, sc, ps, false, lane, o0, o1); }
        else { const WinKeysS kf{F.st_win() + (size_t)b * 512 * 512, F.KWB() + (size_t)m * 512, g}; naive_attn2<8>(q2, kf, qs, sc, ps, false, lane, o0, o1); }
        F.OWIN()[(size_t)m * 1024 + (g * 4 + pr * 2) * 64 + lane] = o0; F.OWIN()[(size_t)m * 1024 + (g * 4 + pr * 2 + 1) * 64 + lane] = o1; }
}
__device__ __forceinline__ void cmp_task(const Ctx& F, int task, int lane) {
    LAS float *qs, *sc, *ps, *imp; na_ptrs(F, qs, sc, ps, imp);
    const int m = task >> 2, g = task & 3; const bool dec = m >= MPROMPT; const int b = dec ? m - MPROMPT : m >> 12, t = m & (SEQ - 1);
    const int qpos = dec ? PAST : t, ncmp = dec ? NCMP_S : NCMP_P, nslc = dec ? NSLC_S : NSLC_P, jt = qpos >> 6;
    for (int i = lane; i < 544; i += 64) ps[i] = 0.f;
    const CmpKeys kf{dec ? F.KCMPS() + (size_t)b * NCMP_S * 512 : F.KCMPP() + (size_t)b * NCMP_P * 512, g, ncmp, qpos};
#pragma unroll
    for (int pr = 0; pr < 2; ++pr) { float o0, o1; naive_attn2<8>(F.QB() + (size_t)m * 1024 + g * 256 + pr * 128, kf, qs, sc, ps, true, lane, o0, o1);
        F.OCMP()[(size_t)m * 1024 + (g * 4 + pr * 2) * 64 + lane] = o0; F.OCMP()[(size_t)m * 1024 + (g * 4 + pr * 2 + 1) * 64 + lane] = o1; }
    float mine[3]; int cnt[3];
#pragma unroll
    for (int jj = 0; jj < 3; ++jj) { const int j = jj * 64 + lane; float v = 0.f; cnt[jj] = 0;
        if (j < nslc) { v = ps[4 * j] + 2.0f * (ps[4 * j + 1] + ps[4 * j + 2] + ps[4 * j + 3]) + ps[4 * j + 4]; if (j == 0 || j == jt || j == jt - 1) v = 1.0e4f; if (j > jt) v = -1.0e4f; imp[j] = v; }
        mine[jj] = v; }
    for (int k = 0; k < nslc; ++k) { const float v = imp[k];
#pragma unroll
        for (int jj = 0; jj < 3; ++jj) { const int j = jj * 64 + lane; cnt[jj] += ((v > mine[jj]) || (v == mine[jj] && k < j)) ? 1 : 0; } }
    int base = 0;
#pragma unroll
    for (int jj = 0; jj < 3; ++jj) { const int j = jj * 64 + lane; const bool sel = (j < nslc) && (cnt[jj] < 16); const unsigned long long bal = __ballot(sel);
        if (sel) F.SELIDX()[(size_t)task * 16 + base + __popcll(bal & ((1ull << lane) - 1ull))] = j;
        if (!dec && jj == 0 && lane == 0) F.SELMASK()[task] = bal;
        base += __popcll(bal); }
}
__device__ __forceinline__ void sel_task(const Ctx& F, int task, int lane) {
    LAS float *qs, *sc, *ps, *imp; na_ptrs(F, qs, sc, ps, imp);
    const int m = task >> 2, g = task & 3; const bool dec = m >= MPROMPT; const int b = dec ? m - MPROMPT : m >> 12, t = m & (SEQ - 1);
#pragma unroll
    for (int pr = 0; pr < 2; ++pr) { float o0, o1; const bf16* q2 = F.QB() + (size_t)m * 1024 + g * 256 + pr * 128;
        if (!dec) { const SelKeysP kf{F.SELIDX() + (size_t)task * 16, F.KSB() + (size_t)b * SEQ * 512, g, t}; naive_attn2<16>(q2, kf, qs, sc, ps, false, lane, o0, o1); }
        else { const SelKeysS kf{F.SELIDX() + (size_t)task * 16, F.page_table() + b * 64, F.cache_sel(), F.KSB() + (size_t)m * 512, g}; naive_attn2<16>(q2, kf, qs, sc, ps, false, lane, o0, o1); }
#pragma unroll
        for (int e = 0; e < 2; ++e) { const int hd = g * 4 + pr * 2 + e; const float* gt = F.GD() + (size_t)m * 64 + hd * 3; const size_t oi = (size_t)m * 1024 + hd * 64 + lane;
            const float a = gt[0] * F.OCMP()[oi] + gt[1] * (e ? o1 : o0) + gt[2] * F.OWIN()[oi]; F.MIX()[(size_t)m * DM + hd * 64 + lane] = (bf16)f2bf(a); } }
}
template <int U>
__device__ __forceinline__ void ssd_chain(const Ctx& F, int rowbase, int L, int h, int p, const float* s0, float* sfin, int lane) {
    const int grp = h >> 3; float h0 = 0.f, h1 = 0.f; if (s0) { h0 = s0[lane]; h1 = s0[64 + lane]; }
    const float A = -__expf(F.a_log()[h]), Dk = F.d_skip()[h];
    for (int t0 = 0; t0 < L; t0 += U) {
        float dt[U], x[U], B0[U], B1[U], C0[U], C1[U];
#pragma unroll
        for (int u = 0; u < U; ++u) { const size_t m = (size_t)(rowbase + t0 + u); dt[u] = F.DT()[m * 16 + h]; const float* r = F.XBCA() + m * CONV_DIM; x[u] = r[h * 64 + p];
            B0[u] = r[1024 + grp * 128 + lane]; B1[u] = r[1024 + grp * 128 + 64 + lane]; C0[u] = r[1280 + grp * 128 + lane]; C1[u] = r[1280 + grp * 128 + 64 + lane]; }
        float y[U];
#pragma unroll
        for (int u = 0; u < U; ++u) { const float dA = __expf(dt[u] * A), xd = dt[u] * x[u]; h0 = h0 * dA + xd * B0[u]; h1 = h1 * dA + xd * B1[u]; y[u] = wave_sum(C0[u] * h0 + C1[u] * h1) + Dk * x[u]; }
        if (lane == 0) {
#pragma unroll
            for (int u = 0; u < U; ++u) F.YSSD()[(size_t)(rowbase + t0 + u) * 1024 + h * 64 + p] = y[u]; }
    }
    sfin[lane] = h0; sfin[64 + lane] = h1;
}
__device__ __forceinline__ void ssd_task(const Ctx& F, int task, int lane) {
    if (task < NB * 16 * 64) { const int b = task >> 10, h = (task >> 6) & 15, p = task & 63; ssd_chain<4>(F, b * SEQ, SEQ, h, p, nullptr, F.out() + O_SSP + (size_t)task * 128, lane); }
    else { const int tk = task - NB * 16 * 64, b = tk >> 10, h = (tk >> 6) & 15, p = tk & 63; ssd_chain<1>(F, MPROMPT + b, 1, h, p, F.st_ssm() + (size_t)tk * 128, F.out() + O_SSS + (size_t)tk * 128, lane); }
}
__device__ __forceinline__ void ssd_gate_task(const Ctx& F, int task, int lane) {
    const int m = task >> 1, grp = task & 1; const size_t o = (size_t)m * 1024 + grp * 512 + lane * 8;
    const f32x4 y0 = *(const f32x4*)(F.YSSD() + o), y1 = *(const f32x4*)(F.YSSD() + o + 4), z0 = *(const f32x4*)(F.Z() + o), z1 = *(const f32x4*)(F.Z() + o + 4);
    float v[8] = {y0.x * siluf_(z0.x), y0.y * siluf_(z0.y), y0.z * siluf_(z0.z), y0.w * siluf_(z0.w), y1.x * siluf_(z1.x), y1.y * siluf_(z1.y), y1.z * siluf_(z1.z), y1.w * siluf_(z1.w)};
    float ss = 0.f;
#pragma unroll
    for (int e = 0; e < 8; ++e) ss += v[e] * v[e];
    const float rstd = 1.0f / sqrtf(wave_sum(ss) * (1.0f / 512.0f) + NORM_EPS);
    const float* w = F.ssm_norm() + grp * 512 + lane * 8;
    v4u ow; ow.x = pk2(v[0] * rstd * w[0], v[1] * rstd * w[1]); ow.y = pk2(v[2] * rstd * w[2], v[3] * rstd * w[3]); ow.z = pk2(v[4] * rstd * w[4], v[5] * rstd * w[5]); ow.w = pk2(v[6] * rstd * w[6], v[7] * rstd * w[7]);
    *(v4u*)(F.MIX() + (size_t)m * DM + 1024 + grp * 512 + lane * 8) = ow;
}
__device__ __forceinline__ void final_norm_row(const Ctx& F, int m, int lane) {
    float s = lane < 32 ? F.SS2()[(size_t)m * 32 + lane] : 0.f; s = wave_sum(s);
    const float rstd = 1.0f / sqrtf(s * (1.0f / DM) + NORM_EPS);
    const f32x4* xr = (const f32x4*)(F.X2() + (size_t)m * DM) + lane; const f32x4* wr = (const f32x4*)F.ln_final() + lane;
    f32x4* o = (f32x4*)(m < MPROMPT ? F.out() + O_YP + (size_t)m * DM : F.out() + O_YS + (size_t)(m - MPROMPT) * DM) + lane;
#pragma unroll
    for (int j = 0; j < 8; ++j) o[64 * j] = xr[64 * j] * rstd * wr[64 * j];
}

struct Args { const void* in[26]; float* out; unsigned char* ws; int ph_lo, ph_hi, li, pad; };
__global__ void __launch_bounds__(NWAVES * 64, 2) fwd_kernel(Args args) {
    extern __shared__ __attribute__((aligned(16))) unsigned char lds[];
    Ctx F;
    F.lds = (LAS unsigned char*)lds; F.MISC = (volatile LAS unsigned*)(F.lds + MISC_OFF);
    F.tid = threadIdx.x; F.lane = F.tid & 63; F.wave = __builtin_amdgcn_readfirstlane(F.tid >> 6);
    F.G = gridDim.x; { const int bx = blockIdx.x; F.vcu = (F.G % 8 == 0) ? (bx % 8) * (F.G / 8) + bx / 8 : bx; }
    F.ka = (const __attribute__((address_space(4))) unsigned long long*)__builtin_amdgcn_kernarg_segment_ptr();
    F.ctl = (gu32*)(F.ws() + WS_CTL);
    for (int u = F.tid; u < (LDS_BYTES - LDSCTL_OFF) / 4; u += NWAVES * 64) ((LAS unsigned*)(F.lds + LDSCTL_OFF))[u] = 0u;
    __syncthreads();
    XcdBarrier bar; bar.bar = (unsigned*)(F.ctl + CW_BAR); bar.x = 0; bar.st = nullptr;
    if (N_LAUNCHES == 1) bar = xcd_barrier_post((unsigned*)(F.ctl + CW_BAR), F.MISC + 8);
#define GRID_BAR(seam) do { if (N_LAUNCHES != 1) { if (F.tid == 0) __hip_atomic_store(F.ctl + CW_TMO, 0xBADBA0u | (unsigned)(seam), RLX_AGENT); } else { xcd_barrier(bar); } } while (0)
    const int lo = args.ph_lo, hi = args.ph_hi;
#define IN(k) (lo <= (k) && (k) < hi)
#define BOTH(k) (IN(k) && IN((k) + 1))
    const int gw = F.vcu * NWAVES + F.wave, NGW = F.G * NWAVES;

    if (IN(0)) { p0_prologue(F); if (BOTH(0)) GRID_BAR(0); }
    if (IN(1)) {
        pg8::Gemm g{F.XN(), F.WIN(), MP, NIN, DM}; pg8::StaticOrder S; S.init(MP, NIN, F.G, (int)blockIdx.x);
        static_assert(WS_KSB - WS_KCB == WS_KWB - WS_KSB, "kv copies equally spaced");
        pg8::EpiInProj E{F.QB(), F.KCB(), (WS_KSB - WS_KCB) / 2, F.Z(), F.XBC(), F.GD(), F.out()};
        pg8::gemm_phase<pg8::EpiInProj, pg8::StaticOrder, true, true>(F.lds + RING_OFF, g, S, E);
        if (BOTH(1)) GRID_BAR(1);
    }
    if (IN(2)) {
        constexpr int NT_C = NB * NCMP_P * 2 + DECB * NCMP_S * 2;
        for (int it = gw; it < NT_C; it += NGW) compress_task(F, it, F.lane);
        conv_prepass(F);
        for (int it = gw; it < MROWS * 4; it += NGW) win_task(F, it, F.lane);
        if (BOTH(2)) GRID_BAR(2);
    }
    if (IN(3)) {
        constexpr int NT_S = NB * 16 * 64 + DECB * 16 * 64;
        for (int it = gw; it < NT_S; it += NGW) ssd_task(F, it, F.lane);
        for (int it = gw; it < MROWS * 4; it += NGW) cmp_task(F, it, F.lane);
        if (BOTH(3)) GRID_BAR(3);
    }
    if (IN(4)) {
        for (int it = gw; it < MROWS * 4; it += NGW) sel_task(F, it, F.lane);
        for (int it = gw; it < MROWS * 2; it += NGW) ssd_gate_task(F, it, F.lane);
        if (BOTH(4)) GRID_BAR(4);
    }
    if (IN(5)) {
        pg8::Gemm g{F.MIX(), F.WOUT(), MP, DM, DM}; pg8::StaticOrder S; S.init(MP, DM, F.G, (int)blockIdx.x);
        pg8::EpiResid E{F.x_prompt(), F.x_sample(), DM, F.X1(), F.X1B(), F.SS1()};
        pg8::gemm_phase<pg8::EpiResid, pg8::StaticOrder, true, true>(F.lds + RING_OFF, g, S, E);
        if (BOTH(5)) GRID_BAR(5);
    }
    if (IN(6)) {
        pg8::Gemm g{F.X1B(), F.WUP(), MP, DFF, DM}; pg8::StaticOrder S; S.init(MP, DFF, F.G, (int)blockIdx.x);
        pg8::EpiUp E{F.H(), F.SS1()};
        pg8::gemm_phase<pg8::EpiUp, pg8::StaticOrder, true, true>(F.lds + RING_OFF, g, S, E);
        if (BOTH(6)) GRID_BAR(6);
    }
    if (IN(7)) {
        pg8::Gemm g{F.H(), F.WDN(), MP, DM, DFF}; pg8::StaticOrder S; S.init(MP, DM, F.G, (int)blockIdx.x);
        pg8::EpiResid E{F.X1(), F.X1() + (size_t)MPROMPT * DM, DM, F.X2(), nullptr, F.SS2()};
        pg8::gemm_phase<pg8::EpiResid, pg8::StaticOrder, true, true>(F.lds + RING_OFF, g, S, E);
        if (BOTH(7)) GRID_BAR(7);
    }
    if (IN(8)) { for (int m = gw; m < MROWS; m += NGW) final_norm_row(F, m, F.lane); }
#undef IN
#undef BOTH
}

extern "C" void kernel_launch(void* const* d_in, const int* in_sizes, int n_in, void* d_out, int out_size, void* d_ws, size_t ws_size, hipStream_t stream) {
    static int grid = 0;
    if (grid == 0) {
        if (n_in != 26 || (size_t)out_size != O_END || ws_size < WS_END) { fprintf(stderr, "kernel_launch: unexpected shapes: n_in %d out %d ws %zu (need %zu)\n", n_in, out_size, ws_size, (size_t)WS_END); grid = -1; return; }
        int dev = 0, cus = 0, per_cu = 0;
        if (hipGetDevice(&dev) != hipSuccess || hipDeviceGetAttribute(&cus, hipDeviceAttributeMultiprocessorCount, dev) != hipSuccess) { grid = -1; return; }
        if (hipFuncSetAttribute((const void*)fwd_kernel, hipFuncAttributeMaxDynamicSharedMemorySize, LDS_BYTES) != hipSuccess) { fprintf(stderr, "kernel_launch: hipFuncSetAttribute failed\n"); grid = -1; return; }
        if (hipOccupancyMaxActiveBlocksPerMultiprocessor(&per_cu, (const void*)fwd_kernel, NWAVES * 64, LDS_BYTES) != hipSuccess || per_cu < 1) fprintf(stderr, "kernel_launch: occupancy query reports %d\n", per_cu);
        (void)hipGetLastError();
        grid = cus;
    }
    if (grid < 0) return;
    if (hipMemsetAsync((char*)d_ws + WS_CTL, 0, CTL_ZERO_BYTES, stream) != hipSuccess) return;
    Args a{};
    for (int i = 0; i < 26; ++i) a.in[i] = d_in[i];
    a.out = (float*)d_out; a.ws = (unsigned char*)d_ws;
    for (int li = 0; li < N_LAUNCHES; ++li) {
        a.ph_lo = (N_LAUNCHES == 1) ? 0 : li; a.ph_hi = (N_LAUNCHES == 1) ? N_PHASES : li + 1; a.li = li; a.pad = 0;
        hipLaunchKernelGGL(fwd_kernel, dim3(grid), dim3(NWAVES * 64), LDS_BYTES, stream, a);
        if (hipPeekAtLastError() != hipSuccess) { fprintf(stderr, "kernel_launch: launch %d failed\n", li); break; }
    }
}
```

```cpp
#include <hip/hip_runtime.h>
#include <cstdio>
#include <cstdint>

constexpr int DM = 2048, SEQ = 4096, NB = 2, MPROMPT = NB * SEQ, DECB = 32, PAST = 8192, MROWS = MPROMPT + DECB, MP = 8448;
constexpr int NCOLS_IN = 5184, NIN = 5376;
constexpr int DFF = 8192, CONV_DIM = 1536, DIN = 1024;
constexpr int NCMP_P = 255, NCMP_S = 511, NSLC_P = 64, NSLC_S = 129;
constexpr float NORM_EPS = 1e-5f;
constexpr size_t O_YP = 0, O_YS = O_YP + (size_t)MPROMPT * DM, O_KCP = O_YS + (size_t)DECB * DM, O_KSP = O_KCP + (size_t)MPROMPT * 512, O_KWP = O_KSP + (size_t)MPROMPT * 512,
                 O_CVP = O_KWP + (size_t)NB * 512 * 512, O_SSP = O_CVP + (size_t)NB * 3 * CONV_DIM, O_KCS = O_SSP + (size_t)NB * 16 * 64 * 128, O_KSS = O_KCS + (size_t)DECB * 512,
                 O_KWS = O_KSS + (size_t)DECB * 512, O_CVS = O_KWS + (size_t)DECB * 512 * 512, O_SSS = O_CVS + (size_t)DECB * 3 * CONV_DIM, O_END = O_SSS + (size_t)DECB * 16 * 64 * 128;
static_assert(O_END == 38790144, "d_out size");
namespace pg8 {
#define PG8_LAS __attribute__((address_space(3)))
typedef unsigned short bf16_t;
typedef short bf16x8 __attribute__((ext_vector_type(8)));
typedef float f32x4 __attribute__((ext_vector_type(4)));
typedef unsigned u32x4 __attribute__((ext_vector_type(4)));
constexpr int BM = 256, BK = 64, HALF = 128, HTB = HALF * BK * 2  , STAGE_BYTES = 8 * HTB, NXCD = 8, WGM = 8;

__host__ __device__ __forceinline__ int lds_byte(int r, int c) { const int st = (r >> 4) * 2 + (c >> 5), rr = r & 15, cc = c & 31, ob = rr * 64 + cc * 2; return st * 1024 + (ob ^ (((ob >> 9) & 1) << 5)); }
__host__ __device__ __forceinline__ void stage_rc(int b, int& R, int& C) { const int st = b / 1024, sb = b % 1024, swz = sb ^ (((sb >> 9) & 1) << 5); R = (st >> 1) * 16 + swz / 64; C = (st & 1) * 32 + (swz % 64) / 2; }
__host__ __device__ __forceinline__ int perm32(int rho) { const int n = rho >> 4, i = rho & 15; return 8 * (i >> 2) + 4 * n + (i & 3); }

struct Unit { int pm, pn; };
struct Gemm { const bf16_t* A; const bf16_t* Bt; int M, N, K; };

struct StaticOrder {
    int nM, nN, nwg, G, c;
    __host__ __device__ void init(int M, int N, int G_, int c_) { nM = M / BM; nN = N / BM; nwg = nM * nN; G = G_; c = c_; }
    __host__ __device__ bool next(int i, Unit& u) const {
        const long L = (long)i * G + c; if (L >= nwg) return false;
        int wgid = (int)L; { const int q = nwg / NXCD, r = nwg % NXCD, xcd = wgid % NXCD, off = wgid / NXCD; wgid = (xcd < r ? xcd * (q + 1) : r * (q + 1) + (xcd - r) * q) + off; }
        const int nig = WGM * nN, gid = wgid / nig, fm = gid * WGM, gsz = (nM - fm) < WGM ? (nM - fm) : WGM;
        u.pm = fm + ((wgid % nig) % gsz); u.pn = (wgid % nig) / gsz; return true;
    }
    __device__ __forceinline__ void a_ready(const Unit&) const {}
    __device__ __forceinline__ void done(const Unit&) const {}
};

__device__ __forceinline__ unsigned cvt_pk_bf16(float lo, float hi) { unsigned r; asm volatile("v_cvt_pk_bf16_f32 %0, %1, %2" : "=v"(r) : "v"(lo), "v"(hi)); return r; }
typedef float f32x2 __attribute__((ext_vector_type(2)));
__device__ __forceinline__ void st_bf16x4(bf16_t* p, const f32x4 v) { typedef unsigned u32x2v __attribute__((ext_vector_type(2))); u32x2v w; w.x = cvt_pk_bf16(v[0], v[1]); w.y = cvt_pk_bf16(v[2], v[3]); *(u32x2v*)p = w; }
__device__ __forceinline__ float sigmoidf_(float x) { return 1.0f / (1.0f + __expf(-x)); }
struct EpiInProj {
    static constexpr bool PERM = false, AFTER_DRAIN = false;
    bf16_t *QB, *KVB; size_t kvstride; float *Z, *XBC, *GD, *out;
    __device__ __forceinline__ void operator()(const f32x4 (&acc)[2][2][4][2], const Unit& u, int wr, int wc, int fr, int fq) const {
        const int pn = u.pn, rbase = u.pm * BM + wr * 64 + fr, cl = wc * 32 + 4 * fq;
        if (pn < 4) {
#pragma unroll
            for (int ai = 0; ai < 2; ++ai)
#pragma unroll
                for (int m = 0; m < 4; ++m) { const int row = rbase + ai * HALF + m * 16; if (row < MROWS) { bf16_t* p = QB + (size_t)row * 1024 + pn * 256 + cl;
#pragma unroll
                    for (int bj = 0; bj < 2; ++bj)
#pragma unroll
                        for (int n = 0; n < 2; ++n) st_bf16x4(p + bj * HALF + n * 16, acc[ai][bj][m][n]); } }
        } else if (pn < 10) {
            const int which = (pn - 4) >> 1, cb = ((pn - 4) & 1) * 256 + cl; bf16_t* B = KVB + (size_t)which * kvstride;
#pragma unroll
            for (int ai = 0; ai < 2; ++ai)
#pragma unroll
                for (int m = 0; m < 4; ++m) { const int row = rbase + ai * HALF + m * 16; if (row < MROWS) {
                    float* fo = nullptr;
                    if (row < MPROMPT) { if (which == 0) fo = out + O_KCP + (size_t)row * 512; else if (which == 1) fo = out + O_KSP + (size_t)row * 512; else { const int t = row & (SEQ - 1); if (t >= SEQ - 512) fo = out + O_KWP + (size_t)((row >> 12) * 512 + t - (SEQ - 512)) * 512; } }
                    else { const int s = row - MPROMPT; fo = which == 0 ? out + O_KCS + (size_t)s * 512 : (which == 1 ? out + O_KSS + (size_t)s * 512 : out + O_KWS + (size_t)(s * 512 + 511) * 512); }
                    bf16_t* p = B + (size_t)row * 512 + cb;
#pragma unroll
                    for (int bj = 0; bj < 2; ++bj)
#pragma unroll
                        for (int n = 0; n < 2; ++n) { const f32x4 v = acc[ai][bj][m][n]; st_bf16x4(p + bj * HALF + n * 16, v); if (fo) *(f32x4*)(fo + cb + bj * HALF + n * 16) = v; } } }
        } else if (pn < 20) {
            float* base = pn < 14 ? Z : XBC; const int ld = pn < 14 ? 1024 : CONV_DIM, cb = (pn < 14 ? (pn - 10) : (pn - 14)) * 256 + cl;
#pragma unroll
            for (int ai = 0; ai < 2; ++ai)
#pragma unroll
                for (int m = 0; m < 4; ++m) { const int row = rbase + ai * HALF + m * 16; if (row < MROWS) { float* p = base + (size_t)row * ld + cb;
#pragma unroll
                    for (int bj = 0; bj < 2; ++bj)
#pragma unroll
                        for (int n = 0; n < 2; ++n) *(f32x4*)(p + bj * HALF + n * 16) = acc[ai][bj][m][n]; } }
        } else {
#pragma unroll
            for (int ai = 0; ai < 2; ++ai)
#pragma unroll
                for (int m = 0; m < 4; ++m) { const int row = rbase + ai * HALF + m * 16; if (row < MROWS) {
#pragma unroll
                    for (int n = 0; n < 2; ++n) { const int col = cl + n * 16; if (col < 64) { f32x4 v = acc[ai][0][m][n]; if (col < 48) { v[0] = sigmoidf_(v[0]); v[1] = sigmoidf_(v[1]); v[2] = sigmoidf_(v[2]); v[3] = sigmoidf_(v[3]); } *(f32x4*)(GD + (size_t)row * 64 + col) = v; } } } }
        }
    }
};
struct EpiResid {
    static constexpr bool PERM = false, AFTER_DRAIN = false;
    const float* xp; const float* xs; int ldx; float* X1; bf16_t* X1B; float* SS;
    __device__ __forceinline__ void operator()(const f32x4 (&acc)[2][2][4][2], const Unit& u, int wr, int wc, int fr, int fq) const {
        const int pn = u.pn, rbase = u.pm * BM + wr * 64 + fr, cb = pn * 256 + wc * 32 + 4 * fq;
#pragma unroll
        for (int ai = 0; ai < 2; ++ai) {
            f32x4 pre[4][2][2];
#pragma unroll
            for (int m = 0; m < 4; ++m) { const int row = rbase + ai * HALF + m * 16; const float* xr = row < MPROMPT ? xp + (size_t)row * ldx : xs + (size_t)(row - MPROMPT) * ldx;
#pragma unroll
                for (int bj = 0; bj < 2; ++bj)
#pragma unroll
                    for (int n = 0; n < 2; ++n) pre[m][bj][n] = row < MROWS ? *(const f32x4*)(xr + cb + bj * HALF + n * 16) : (f32x4){0.f, 0.f, 0.f, 0.f}; }
            asm volatile("" ::: "memory");
#pragma unroll
            for (int m = 0; m < 4; ++m) { const int row = rbase + ai * HALF + m * 16; const bool ok = row < MROWS; float ss = 0.f;
#pragma unroll
                for (int bj = 0; bj < 2; ++bj)
#pragma unroll
                    for (int n = 0; n < 2; ++n) { const int col = cb + bj * HALF + n * 16; const f32x4 v = acc[ai][bj][m][n] + pre[m][bj][n];
                        if (ok) { *(f32x4*)(X1 + (size_t)row * DM + col) = v; if (X1B) st_bf16x4(X1B + (size_t)row * DM + col, v); }
                        ss += (v[0] * v[0] + v[1] * v[1]) + (v[2] * v[2] + v[3] * v[3]); }
                ss += __shfl_xor(ss, 16); ss += __shfl_xor(ss, 32);
                if (ok && fq == 0) SS[(size_t)row * 32 + pn * 4 + wc] = ss; }
        }
    }
};
struct EpiUp {
    static constexpr bool PERM = false, AFTER_DRAIN = false;
    bf16_t* H; const float* SS;
    __device__ __forceinline__ void operator()(const f32x4 (&acc)[2][2][4][2], const Unit& u, int wr, int wc, int fr, int fq) const {
        const int pn = u.pn, rbase = u.pm * BM + wr * 64 + fr, cb = pn * 256 + wc * 32 + 4 * fq;
        f32x4 sa[2][4], sb[2][4];
#pragma unroll
        for (int ai = 0; ai < 2; ++ai)
#pragma unroll
            for (int m = 0; m < 4; ++m) { const int row = rbase + ai * HALF + m * 16; const bool ok = row < MROWS; const float* sp = SS + (size_t)(ok ? row : 0) * 32 + fq * 8; sa[ai][m] = *(const f32x4*)sp; sb[ai][m] = *(const f32x4*)(sp + 4); }
        asm volatile("" ::: "memory");
#pragma unroll
        for (int ai = 0; ai < 2; ++ai)
#pragma unroll
            for (int m = 0; m < 4; ++m) { const int row = rbase + ai * HALF + m * 16; const bool ok = row < MROWS;
                const f32x4 a = sa[ai][m], b = sb[ai][m]; float t = ((a[0] + a[1]) + (a[2] + a[3])) + ((b[0] + b[1]) + (b[2] + b[3]));
                t += __shfl_xor(t, 16); t += __shfl_xor(t, 32);
                const float rstd = 1.0f / sqrtf(t * (1.0f / DM) + NORM_EPS);
                if (ok) { bf16_t* p = H + (size_t)row * DFF + cb;
#pragma unroll
                    for (int bj = 0; bj < 2; ++bj)
#pragma unroll
                        for (int n = 0; n < 2; ++n) { f32x4 v = acc[ai][bj][m][n] * rstd; v[0] = fmaxf(v[0], 0.f); v[1] = fmaxf(v[1], 0.f); v[2] = fmaxf(v[2], 0.f); v[3] = fmaxf(v[3], 0.f); v = v * v; st_bf16x4(p + bj * HALF + n * 16, v); } } }
    }
};
template <class Epi, class Sched, bool ALIGN_EPI = false, bool SP2 = false>
__device__ __forceinline__ void gemm_phase(PG8_LAS unsigned char* lds, const Gemm g, const Sched& S, const Epi& E) {
    const int tid = threadIdx.x, wid = __builtin_amdgcn_readfirstlane(tid >> 6), lane = tid & 63, wr = wid >> 2, wc = wid & 3, fr = lane & 15, fq = lane >> 4;
    const int K = g.K, nt = K / BK;
    unsigned voffA[2], voffB[2];
#pragma unroll
    for (int i = 0; i < 2; ++i) { int R, C; stage_rc(tid * 16 + i * 8192, R, C); const int Rb = Epi::PERM ? ((R & ~31) + perm32(R & 31)) : R;
        voffA[i] = (unsigned)(R * K + C) * 2u; voffB[i] = (unsigned)(Rb * K + C) * 2u; }
    const size_t kstep = (size_t)(BK * 2);
    const size_t hstep = (size_t)HALF * K * 2;
    const size_t tstep = 2 * hstep;
    const unsigned ldsw = (unsigned)wid * 1024u;
    const int aoff = lds_byte(wr * 64 + fr, fq * 8), boff = lds_byte(wc * 32 + fr, fq * 8);
#define PG8_SA(b, h) (((b) * 2 + (h)) * HTB)
#define PG8_SB(b, h) ((4 + (b) * 2 + (h)) * HTB)
#define PG8_STAGE(bufoff, gbase, voff) do { _Pragma("unroll") for (int _i = 0; _i < 2; ++_i) \
        __builtin_amdgcn_global_load_lds((const unsigned*)((const char*)(gbase) + (voff)[_i]), (PG8_LAS unsigned*)(lds + (bufoff) + ldsw + _i * 8192), 16, 0, 0); } while (0)
#define PG8_LDA(dst, b, h) do { _Pragma("unroll") for (int m = 0; m < 4; ++m) _Pragma("unroll") for (int k = 0; k < 2; ++k) dst[m][k] = *(const PG8_LAS bf16x8*)(lds + PG8_SA(b, h) + aoff + m * 2048 + k * 1024); } while (0)
#define PG8_LDB(dst, b, h) do { _Pragma("unroll") for (int n = 0; n < 2; ++n) _Pragma("unroll") for (int k = 0; k < 2; ++k) dst[n][k] = *(const PG8_LAS bf16x8*)(lds + PG8_SB(b, h) + boff + n * 2048 + k * 1024); } while (0)
#define PG8_MMA(ai, bj, At, Bt) do { __builtin_amdgcn_s_setprio(1); _Pragma("unroll") for (int m = 0; m < 4; ++m) _Pragma("unroll") for (int n = 0; n < 2; ++n) _Pragma("unroll") for (int k = 0; k < 2; ++k) \
        acc[ai][bj][m][n] = __builtin_amdgcn_mfma_f32_16x16x32_bf16(Bt[n][k], At[m][k], acc[ai][bj][m][n], 0, 0, 0); __builtin_amdgcn_s_setprio(0); } while (0)
#define PG8_WAIT_V(n) asm volatile("s_waitcnt vmcnt(" #n ")" ::: "memory")
#define PG8_WAIT_L(n) asm volatile("s_waitcnt lgkmcnt(" #n ")" ::: "memory")
#define PG8_BAR __builtin_amdgcn_s_barrier()
#define PG8_SCHED __builtin_amdgcn_sched_barrier(0)
    Unit cur, nxt; int ui = 0;
    if (!S.next(0, cur)) return;
    f32x4 acc[2][2][4][2];
#pragma unroll
    for (int a = 0; a < 2; ++a)
#pragma unroll
        for (int b = 0; b < 2; ++b)
#pragma unroll
            for (int m = 0; m < 4; ++m)
#pragma unroll
                for (int n = 0; n < 2; ++n) acc[a][b][m][n] = (f32x4){0.f, 0.f, 0.f, 0.f};
    bf16x8 At[4][2], B0[2][2], B1[2][2];
    const char* cA = (const char*)g.A + (size_t)cur.pm * tstep; const char* cB = (const char*)g.Bt + (size_t)cur.pn * tstep;
    S.a_ready(cur);
    if constexpr (SP2) {
        PG8_STAGE(PG8_SB(0, 0), cB, voffB); PG8_STAGE(PG8_SB(0, 1), cB + hstep, voffB); PG8_STAGE(PG8_SA(0, 0), cA, voffA); PG8_STAGE(PG8_SA(0, 1), cA + hstep, voffA);
        if (wr == 1) PG8_BAR;
        PG8_WAIT_V(2); PG8_BAR;
        PG8_STAGE(PG8_SB(1, 0), cB + kstep, voffB); PG8_STAGE(PG8_SA(1, 0), cA + kstep, voffA); PG8_STAGE(PG8_SB(1, 1), cB + hstep + kstep, voffB);
        PG8_WAIT_V(6); PG8_BAR;
    } else {
        PG8_STAGE(PG8_SB(0, 0), cB, voffB); PG8_STAGE(PG8_SA(0, 0), cA, voffA); PG8_STAGE(PG8_SB(0, 1), cB + hstep, voffB); PG8_STAGE(PG8_SA(0, 1), cA + hstep, voffA);
        if (wr == 1) PG8_BAR;
        PG8_WAIT_V(4); PG8_BAR;
        PG8_STAGE(PG8_SB(1, 0), cB + kstep, voffB); PG8_STAGE(PG8_SA(1, 0), cA + kstep, voffA); PG8_STAGE(PG8_SB(1, 1), cB + hstep + kstep, voffB);
        PG8_WAIT_V(6); PG8_BAR;
    }
    for (;;) {
        const bool has_next = S.next(ui + 1, nxt);
        const char* nA = has_next ? (const char*)g.A + (size_t)nxt.pm * tstep : cA; const char* nB = has_next ? (const char*)g.Bt + (size_t)nxt.pn * tstep : cB;
        for (int t = 0; t < nt; t += 2) {
            const bool last = (t == nt - 2);
            const char* a1 = cA + (size_t)(t + 1) * kstep;
            const char* a2 = last ? nA : cA + (size_t)(t + 2) * kstep; const char* b2 = last ? nB : cB + (size_t)(t + 2) * kstep;
            const char* a3 = a2 + kstep; const char* b3 = b2 + kstep;
            if (last && has_next) S.a_ready(nxt);
            if constexpr (SP2) {
            PG8_LDB(B0, 0, 0); PG8_LDB(B1, 0, 1); PG8_SCHED; PG8_LDA(At, 0, 0); PG8_STAGE(PG8_SA(1, 1), a1 + hstep, voffA);
            PG8_WAIT_V(8); PG8_WAIT_L(0); PG8_BAR; PG8_MMA(0, 0, At, B0); PG8_MMA(0, 1, At, B1); PG8_BAR; PG8_SCHED;
            PG8_LDA(At, 0, 1); PG8_STAGE(PG8_SB(0, 0), b2, voffB); PG8_STAGE(PG8_SB(0, 1), b2 + hstep, voffB); PG8_STAGE(PG8_SA(0, 0), a2, voffA);
            PG8_WAIT_V(8); PG8_WAIT_L(0); PG8_BAR; PG8_MMA(1, 0, At, B0); PG8_MMA(1, 1, At, B1); PG8_BAR; PG8_SCHED;
            PG8_LDB(B0, 1, 0); PG8_LDB(B1, 1, 1); PG8_SCHED; PG8_LDA(At, 1, 0); PG8_STAGE(PG8_SA(0, 1), a2 + hstep, voffA);
            PG8_WAIT_V(8); PG8_WAIT_L(0); PG8_BAR; PG8_MMA(0, 0, At, B0); PG8_MMA(0, 1, At, B1); PG8_BAR; PG8_SCHED;
            PG8_LDA(At, 1, 1); PG8_STAGE(PG8_SB(1, 0), b3, voffB); PG8_STAGE(PG8_SB(1, 1), b3 + hstep, voffB); PG8_STAGE(PG8_SA(1, 0), a3, voffA);
            PG8_WAIT_V(8); PG8_WAIT_L(0); PG8_BAR; PG8_MMA(1, 0, At, B0); PG8_MMA(1, 1, At, B1); PG8_BAR; PG8_SCHED;
            } else {
            PG8_LDB(B0, 0, 0); PG8_SCHED; PG8_LDA(At, 0, 0); PG8_STAGE(PG8_SA(1, 1), a1 + hstep, voffA);
            PG8_WAIT_L(8); PG8_BAR; PG8_WAIT_L(0); PG8_MMA(0, 0, At, B0); PG8_BAR; PG8_SCHED;
            PG8_LDB(B1, 0, 1); PG8_STAGE(PG8_SB(0, 0), b2, voffB);
            PG8_BAR; PG8_WAIT_L(0); PG8_MMA(0, 1, At, B1); PG8_BAR;
            PG8_LDA(At, 0, 1); PG8_STAGE(PG8_SA(0, 0), a2, voffA);
            PG8_BAR; PG8_WAIT_L(0); PG8_MMA(1, 0, At, B0); PG8_BAR; PG8_SCHED;
            PG8_STAGE(PG8_SB(0, 1), b2 + hstep, voffB);
            PG8_WAIT_V(6); PG8_BAR; PG8_MMA(1, 1, At, B1); PG8_BAR;
            PG8_LDB(B0, 1, 0); PG8_SCHED; PG8_LDA(At, 1, 0); PG8_STAGE(PG8_SA(0, 1), a2 + hstep, voffA);
            PG8_WAIT_L(8); PG8_BAR; PG8_WAIT_L(0); PG8_MMA(0, 0, At, B0); PG8_BAR; PG8_SCHED;
            PG8_LDB(B1, 1, 1); PG8_STAGE(PG8_SB(1, 0), b3, voffB);
            PG8_BAR; PG8_WAIT_L(0); PG8_MMA(0, 1, At, B1); PG8_BAR;
            PG8_LDA(At, 1, 1); PG8_STAGE(PG8_SA(1, 0), a3, voffA);
            PG8_BAR; PG8_WAIT_L(0); PG8_MMA(1, 0, At, B0); PG8_BAR; PG8_SCHED;
            PG8_STAGE(PG8_SB(1, 1), b3 + hstep, voffB);
            PG8_WAIT_V(6); PG8_BAR; PG8_MMA(1, 1, At, B1); PG8_BAR;
            }
        }
        if constexpr (ALIGN_EPI) { if (wr == 0) PG8_BAR; }
        if constexpr (!Epi::AFTER_DRAIN) { E(acc, cur, wr, wc, fr, fq); S.done(cur); }
        if (!has_next) break;
#pragma unroll
        for (int a = 0; a < 2; ++a)
#pragma unroll
            for (int b = 0; b < 2; ++b)
#pragma unroll
                for (int m = 0; m < 4; ++m)
#pragma unroll
                    for (int n = 0; n < 2; ++n) acc[a][b][m][n] = (f32x4){0.f, 0.f, 0.f, 0.f};
        cur = nxt; cA = nA; cB = nB; ++ui;
        if constexpr (ALIGN_EPI) { if (wr == 1) PG8_BAR; }
    }
    PG8_WAIT_V(0);
    if constexpr (!ALIGN_EPI) { if (wr == 0) PG8_BAR; }
    PG8_BAR;
    if constexpr (Epi::AFTER_DRAIN) { E.fused(acc, cur, wr, wc, fr, fq, lds, wid, lane); S.done(cur); }
#undef PG8_SA
#undef PG8_SB
#undef PG8_STAGE
#undef PG8_LDA
#undef PG8_LDB
#undef PG8_MMA
#undef PG8_WAIT_V
#undef PG8_WAIT_L
#undef PG8_BAR
#undef PG8_SCHED
}
}
#define GAS __attribute__((address_space(1)))
#define LAS __attribute__((address_space(3)))
typedef unsigned short bf16;
typedef unsigned v4u __attribute__((ext_vector_type(4)));
typedef float f32x4 __attribute__((ext_vector_type(4)));
typedef short bf16x8 __attribute__((ext_vector_type(8)));
typedef GAS unsigned gu32;
typedef GAS unsigned long long gu64;
#define RLX_AGENT __ATOMIC_RELAXED, __HIP_MEMORY_SCOPE_AGENT
#define LDS_WAIT() asm volatile("s_waitcnt lgkmcnt(0)" ::: "memory")
#define VM_WAIT() asm volatile("s_waitcnt vmcnt(0)" ::: "memory")
__device__ __forceinline__ unsigned long long rt() { return __builtin_amdgcn_s_memrealtime(); }
__device__ __forceinline__ unsigned f2bf(float f) { unsigned u = __builtin_bit_cast(unsigned, f); return (u + 0x7fffu + ((u >> 16) & 1u)) >> 16; }
__device__ __forceinline__ unsigned pk2(float lo, float hi) { return f2bf(lo) | (f2bf(hi) << 16); }

#define XB_TMO      128
#define XB_XCNT(j)  (256  + 64 * (j))
#define XB_XSUB(j)  (1280 + 64 * (j))
#define XB_XGEN(j)  (2304 + 64 * (j))
#define XB_TOP      3328
#define XB_TOPGEN   3392
#define XCD_BAR_WORDS 3456
#define XB_SPIN_CAP (1u << 18)

__device__ __forceinline__ unsigned xb_ld(unsigned* p)              { return __hip_atomic_load(p, __ATOMIC_RELAXED, __HIP_MEMORY_SCOPE_AGENT); }
__device__ __forceinline__ unsigned xb_add(unsigned* p, unsigned v) { return __hip_atomic_fetch_add(p, v, __ATOMIC_RELAXED, __HIP_MEMORY_SCOPE_AGENT); }
__device__ __forceinline__ unsigned xb_xcc_id() { return (unsigned)__builtin_amdgcn_s_getreg((3 << 11) | 20) & 0xFu; }
#define XB_SPIN(cond, bar) do { unsigned _sp = 0; while (cond) { __builtin_amdgcn_s_sleep(1); \
    if ((++_sp & 255u) == 0u) { if (xb_ld(&(bar)[XB_TMO])) break; if (_sp > XB_SPIN_CAP) { atomicAdd(&(bar)[XB_TMO], 1u); break; } } } } while (0)

struct XcdBarrier {
    unsigned* bar; unsigned x;
    volatile LAS unsigned* st;
};

__device__ __forceinline__ XcdBarrier xcd_barrier_post(unsigned* bar, volatile LAS unsigned* st) {
    XcdBarrier b; b.bar = bar; b.x = xb_xcc_id(); b.st = st;
    if (threadIdx.x == 0) (void)xb_add(&bar[XB_XCNT(b.x)], 1u);
    return b;
}
__device__ __forceinline__ void xcd_barrier_complete(unsigned* bar, unsigned x, unsigned& nloc, unsigned& nx) {
    const unsigned G = gridDim.x * gridDim.y * gridDim.z;
    unsigned sum, cnt, mine, sp = 0u;
    for (;;) {
        sum = 0u; cnt = 0u; mine = 0u;
#pragma unroll
        for (unsigned j = 0; j < 16; ++j) { const unsigned c = xb_ld(&bar[XB_XCNT(j)]); sum += c; cnt += (c > 0u) ? 1u : 0u; mine = (j == x) ? c : mine; }
        if (sum == G) break;
        __builtin_amdgcn_s_sleep(1);
        if ((++sp & 255u) == 0u) { if (xb_ld(&bar[XB_TMO])) break; if (sp > XB_SPIN_CAP) { atomicAdd(&bar[XB_TMO], 1u); break; } }
    }
    nloc = mine > 0u ? mine : 1u; nx = cnt > 0u ? cnt : 1u;
}

__device__ __forceinline__ void xcd_barrier(const XcdBarrier& b) {
    asm volatile("s_waitcnt vmcnt(0)" ::: "memory");
    __syncthreads();
    if (threadIdx.x == 0) {
        unsigned* bar = b.bar;
        __builtin_amdgcn_s_waitcnt(0);
        unsigned nloc = b.st[0], nx = b.st[1];
        if (nloc == 0u) { xcd_barrier_complete(bar, b.x, nloc, nx); b.st[0] = nloc; b.st[1] = nx; }
        const unsigned old = xb_add(&bar[XB_XSUB(b.x)], 1u);
        const unsigned gen = old / nloc;
        if (old + 1u == (gen + 1u) * nloc) {
            __builtin_amdgcn_fence(__ATOMIC_RELEASE, "agent");
            asm volatile("s_waitcnt vmcnt(0)" ::: "memory");
            const unsigned og = xb_add(&bar[XB_TOP], 1u);
            const unsigned tg = og / nx;
            if (og + 1u == (tg + 1u) * nx) xb_add(&bar[XB_TOPGEN], 1u);
            else XB_SPIN(xb_ld(&bar[XB_TOPGEN]) == tg, bar);
            __builtin_amdgcn_fence(__ATOMIC_ACQUIRE, "agent");
            xb_add(&bar[XB_XGEN(b.x)], 1u);
            asm volatile("s_waitcnt vmcnt(0)" ::: "memory");
        } else {
            XB_SPIN(xb_ld(&bar[XB_XGEN(b.x)]) == gen, bar);
            __builtin_amdgcn_fence(__ATOMIC_ACQUIRE, "agent");
            asm volatile("s_waitcnt vmcnt(0)" ::: "memory");
        }
    }
    __syncthreads();
}

constexpr int NWAVES = 8;
#ifndef MK_N_LAUNCHES
#define MK_N_LAUNCHES 1
#endif
constexpr int N_PHASES = 10;
constexpr int N_LAUNCHES = MK_N_LAUNCHES;
static_assert(N_LAUNCHES == 1 || N_LAUNCHES == N_PHASES, "MK_N_LAUNCHES is 1 or 10");

constexpr size_t MiB = 1u << 20;
constexpr size_t al(size_t x) { return (x + MiB - 1) / MiB * MiB; }
constexpr size_t WS_CTL = 0, CTL_ZERO_BYTES = 32768;
constexpr size_t WS_WIN = 2 * MiB;
constexpr size_t WS_WOUT = WS_WIN + al((size_t)NIN * DM * 2);
constexpr size_t WS_WUP = WS_WOUT + al((size_t)DM * DM * 2);
constexpr size_t WS_WDN = WS_WUP + al((size_t)DFF * DM * 2);
constexpr size_t WS_XN = WS_WDN + al((size_t)DM * DFF * 2);
constexpr size_t WS_QB = WS_XN + al((size_t)MP * DM * 2);
constexpr size_t WS_KCB = WS_QB + al((size_t)MP * 1024 * 2);
constexpr size_t WS_KSB = WS_KCB + al((size_t)MP * 512 * 2);
constexpr size_t WS_KWB = WS_KSB + al((size_t)MP * 512 * 2);
constexpr size_t WS_Z = WS_KWB + al((size_t)MP * 512 * 2);
constexpr size_t WS_XBC = WS_Z + al((size_t)MP * 1024 * 4);
constexpr size_t WS_GD = WS_XBC + al((size_t)MP * CONV_DIM * 4);
constexpr size_t WS_XBCA = WS_GD + al((size_t)MP * 64 * 4);
constexpr size_t WS_DT = WS_XBCA + al((size_t)MP * CONV_DIM * 4);
constexpr size_t WS_KCMPP = WS_DT + al((size_t)MP * 16 * 4);
constexpr size_t WS_KCMPS = WS_KCMPP + al((size_t)NB * NCMP_P * 512 * 4);
constexpr size_t WS_OWIN = WS_KCMPS + al((size_t)DECB * NCMP_S * 512 * 4);
constexpr size_t WS_OCMP = WS_OWIN + al((size_t)MP * 1024 * 4);
constexpr size_t WS_SELIDX = WS_OCMP + al((size_t)MP * 1024 * 4);
constexpr size_t WS_SELMASK = WS_SELIDX + al((size_t)MP * 64 * 4);
constexpr size_t WS_YSSD = WS_SELMASK + al((size_t)MPROMPT * 4 * 8);
constexpr size_t WS_MIX = WS_YSSD + al((size_t)MP * 1024 * 4);
constexpr size_t WS_X1 = WS_MIX + al((size_t)MP * DM * 2);
constexpr size_t WS_X1B = WS_X1 + al((size_t)MP * DM * 4);
constexpr size_t WS_SS1 = WS_X1B + al((size_t)MP * DM * 2);
constexpr size_t WS_H = WS_SS1 + al((size_t)MP * 32 * 4);
constexpr size_t WS_X2 = WS_H + al((size_t)MP * DFF * 2);
constexpr size_t WS_SS2 = WS_X2 + al((size_t)MP * DM * 4);
constexpr size_t WS_W1T = WS_SS2 + al((size_t)MP * 32 * 4);
constexpr size_t WS_PEB = WS_W1T + al((size_t)2 * 128 * 2048 * 2);
constexpr size_t WS_XBCA16 = WS_PEB + MiB;
constexpr size_t WS_ST = WS_XBCA16 + al((size_t)MP * CONV_DIM * 2);
constexpr size_t WS_DEC = WS_ST + al((size_t)NB * 16 * 16 * 8192 * 4);
constexpr size_t WS_ACS = WS_DEC + MiB;
constexpr size_t WS_SS1S = WS_ACS + al((size_t)MPROMPT * 16 * 4);
constexpr size_t WS_SS2S = WS_SS1S + MiB;
constexpr size_t WS_SIN = WS_SS2S + MiB;
constexpr size_t WS_END = WS_SIN + al((size_t)NB * 16 * 16 * 8192 * 2);
constexpr int CW_TMO = 0, CW_CODE = 1, CW_CHK = 8, CW_BAR = 4096;

constexpr int RING_OFF = 0, RING_BYTES = 155648;
constexpr int LDSCTL_OFF = RING_BYTES, MISC_OFF = LDSCTL_OFF + 320;
constexpr int LDS_BYTES = 156160;
static_assert(MISC_OFF + 128 <= LDS_BYTES, "LDS map");

struct Ctx {
    LAS unsigned char* lds; volatile LAS unsigned* MISC; gu32* ctl;
    int tid, lane, wave, vcu, G;
    const __attribute__((address_space(4))) unsigned long long* ka;
    __device__ __forceinline__ const float* x_prompt() const { return (const float*)ka[0]; }
    __device__ __forceinline__ const float* x_sample() const { return (const float*)ka[1]; }
    __device__ __forceinline__ const float* cache_cmp() const { return (const float*)ka[2]; }
    __device__ __forceinline__ const float* cache_sel() const { return (const float*)ka[3]; }
    __device__ __forceinline__ const float* st_win() const { return (const float*)ka[4]; }
    __device__ __forceinline__ const float* st_conv() const { return (const float*)ka[5]; }
    __device__ __forceinline__ const float* st_ssm() const { return (const float*)ka[6]; }
    __device__ __forceinline__ const int* page_table() const { return (const int*)ka[7]; }
    __device__ __forceinline__ const float* ln_mix() const { return (const float*)ka[8]; }
    __device__ __forceinline__ const float* w_in() const { return (const float*)ka[9]; }
    __device__ __forceinline__ const float* cmp_pe() const { return (const float*)ka[10]; }
    __device__ __forceinline__ const float* cmp_w1() const { return (const float*)ka[11]; }
    __device__ __forceinline__ const float* cmp_b1() const { return (const float*)ka[12]; }
    __device__ __forceinline__ const float* cmp_w2() const { return (const float*)ka[13]; }
    __device__ __forceinline__ const float* cmp_b2() const { return (const float*)ka[14]; }
    __device__ __forceinline__ const float* conv_w() const { return (const float*)ka[15]; }
    __device__ __forceinline__ const float* conv_b() const { return (const float*)ka[16]; }
    __device__ __forceinline__ const float* dt_bias() const { return (const float*)ka[17]; }
    __device__ __forceinline__ const float* a_log() const { return (const float*)ka[18]; }
    __device__ __forceinline__ const float* d_skip() const { return (const float*)ka[19]; }
    __device__ __forceinline__ const float* ssm_norm() const { return (const float*)ka[20]; }
    __device__ __forceinline__ const float* w_out() const { return (const float*)ka[21]; }
    __device__ __forceinline__ const float* ln_mlp() const { return (const float*)ka[22]; }
    __device__ __forceinline__ const float* w_up() const { return (const float*)ka[23]; }
    __device__ __forceinline__ const float* w_down() const { return (const float*)ka[24]; }
    __device__ __forceinline__ const float* ln_final() const { return (const float*)ka[25]; }
    __device__ __forceinline__ float* out() const { return (float*)ka[26]; }
    __device__ __forceinline__ unsigned char* ws() const { return (unsigned char*)ka[27]; }
    __device__ __forceinline__ bf16* WIN() const { return (bf16*)(ws() + WS_WIN); }
    __device__ __forceinline__ bf16* WOUT() const { return (bf16*)(ws() + WS_WOUT); }
    __device__ __forceinline__ bf16* WUP() const { return (bf16*)(ws() + WS_WUP); }
    __device__ __forceinline__ bf16* WDN() const { return (bf16*)(ws() + WS_WDN); }
    __device__ __forceinline__ bf16* XN() const { return (bf16*)(ws() + WS_XN); }
    __device__ __forceinline__ bf16* QB() const { return (bf16*)(ws() + WS_QB); }
    __device__ __forceinline__ bf16* KCB() const { return (bf16*)(ws() + WS_KCB); }
    __device__ __forceinline__ bf16* KSB() const { return (bf16*)(ws() + WS_KSB); }
    __device__ __forceinline__ bf16* KWB() const { return (bf16*)(ws() + WS_KWB); }
    __device__ __forceinline__ bf16* MIX() const { return (bf16*)(ws() + WS_MIX); }
    __device__ __forceinline__ bf16* X1B() const { return (bf16*)(ws() + WS_X1B); }
    __device__ __forceinline__ bf16* H() const { return (bf16*)(ws() + WS_H); }
    __device__ __forceinline__ float* Z() const { return (float*)(ws() + WS_Z); }
    __device__ __forceinline__ float* XBC() const { return (float*)(ws() + WS_XBC); }
    __device__ __forceinline__ float* GD() const { return (float*)(ws() + WS_GD); }
    __device__ __forceinline__ float* XBCA() const { return (float*)(ws() + WS_XBCA); }
    __device__ __forceinline__ float* DT() const { return (float*)(ws() + WS_DT); }
    __device__ __forceinline__ float* KCMPP() const { return (float*)(ws() + WS_KCMPP); }
    __device__ __forceinline__ float* KCMPS() const { return (float*)(ws() + WS_KCMPS); }
    __device__ __forceinline__ float* OWIN() const { return (float*)(ws() + WS_OWIN); }
    __device__ __forceinline__ float* OCMP() const { return (float*)(ws() + WS_OCMP); }
    __device__ __forceinline__ float* YSSD() const { return (float*)(ws() + WS_YSSD); }
    __device__ __forceinline__ float* X1() const { return (float*)(ws() + WS_X1); }
    __device__ __forceinline__ float* SS1() const { return (float*)(ws() + WS_SS1); }
    __device__ __forceinline__ float* X2() const { return (float*)(ws() + WS_X2); }
    __device__ __forceinline__ float* SS2() const { return (float*)(ws() + WS_SS2); }
    __device__ __forceinline__ int* SELIDX() const { return (int*)(ws() + WS_SELIDX); }
    __device__ __forceinline__ unsigned long long* SELMASK() const { return (unsigned long long*)(ws() + WS_SELMASK); }
    __device__ __forceinline__ bf16* W1T() const { return (bf16*)(ws() + WS_W1T); }
    __device__ __forceinline__ float* PEB() const { return (float*)(ws() + WS_PEB); }
    __device__ __forceinline__ bf16* XBCA16() const { return (bf16*)(ws() + WS_XBCA16); }
    __device__ __forceinline__ float* ST() const { return (float*)(ws() + WS_ST); }
    __device__ __forceinline__ float* DEC() const { return (float*)(ws() + WS_DEC); }
    __device__ __forceinline__ float* ACS() const { return (float*)(ws() + WS_ACS); }
    __device__ __forceinline__ float* SS1S() const { return (float*)(ws() + WS_SS1S); }
    __device__ __forceinline__ float* SS2S() const { return (float*)(ws() + WS_SS2S); }
    __device__ __forceinline__ bf16* SIN() const { return (bf16*)(ws() + WS_SIN); }
};
__device__ __forceinline__ float bf2f(bf16 x) { return __uint_as_float((unsigned)x << 16); }
__device__ __forceinline__ float wave_sum(float v) {
#pragma unroll
    for (int o = 1; o < 64; o <<= 1) v += __shfl_xor(v, o);
    return v;
}
__device__ __forceinline__ float wave_max(float v) {
#pragma unroll
    for (int o = 1; o < 64; o <<= 1) v = fmaxf(v, __shfl_xor(v, o));
    return v;
}
__device__ __forceinline__ float wave_reduce_t64(float (&a)[64], int lane) {
#pragma unroll
    for (int i = 0; i < 32; ++i) { const bool up = (lane & 32) != 0; const float keep = up ? a[i + 32] : a[i], send = up ? a[i] : a[i + 32]; a[i] = keep + __shfl_xor(send, 32); }
#pragma unroll
    for (int i = 0; i < 16; ++i) { const bool up = (lane & 16) != 0; const float keep = up ? a[i + 16] : a[i], send = up ? a[i] : a[i + 16]; a[i] = keep + __shfl_xor(send, 16); }
#pragma unroll
    for (int i = 0; i < 8; ++i) { const bool up = (lane & 8) != 0; const float keep = up ? a[i + 8] : a[i], send = up ? a[i] : a[i + 8]; a[i] = keep + __shfl_xor(send, 8); }
#pragma unroll
    for (int i = 0; i < 4; ++i) { const bool up = (lane & 4) != 0; const float keep = up ? a[i + 4] : a[i], send = up ? a[i] : a[i + 4]; a[i] = keep + __shfl_xor(send, 4); }
#pragma unroll
    for (int i = 0; i < 2; ++i) { const bool up = (lane & 2) != 0; const float keep = up ? a[i + 2] : a[i], send = up ? a[i] : a[i + 2]; a[i] = keep + __shfl_xor(send, 2); }
    { const bool up = (lane & 1) != 0; const float keep = up ? a[1] : a[0], send = up ? a[0] : a[1]; a[0] = keep + __shfl_xor(send, 1); }
    return a[0];
}
__device__ __forceinline__ float siluf_(float x) { return x / (1.0f + __expf(-x)); }
__device__ __forceinline__ float rdlane(float v, int l) { return __int_as_float(__builtin_amdgcn_readlane(__float_as_int(v), l)); }

__device__ __forceinline__ int win_oldcol(int n) { return n < 2560 ? n : (n < 5120 ? n + 48 : (n < 5168 ? n - 2560 : (n < NCOLS_IN ? n : -1))); }
template <int MODE  >
__device__ __forceinline__ void p0_transpose_item(const float* W, int K, int Nsrc, int Ndst, bf16* WT, const float* rowscale, LAS float* scr, int item, int lane) {
    const int nblk = Ndst / 32, kb = item / nblk, nb = item % nblk, k0 = 64 * kb, n0 = 32 * nb;
    const int ncol = MODE == 1 ? win_oldcol(n0 + (lane & 31)) : n0 + (lane & 31);
    float tv[32];
#pragma unroll
    for (int i = 0; i < 32; ++i) { const int kk = 2 * i + (lane >> 5); float v = 0.f; if (ncol >= 0) v = W[(size_t)(k0 + kk) * Nsrc + ncol]; tv[i] = v; }
#pragma unroll
    for (int i = 0; i < 32; ++i) { const int kk = 2 * i + (lane >> 5); float v = tv[i]; if (rowscale) v *= rowscale[k0 + kk]; scr[kk * 33 + (lane & 31)] = v; }
    LDS_WAIT(); asm volatile("" ::: "memory");
    const int c = lane & 7;
#pragma unroll
    for (int j = 0; j < 4; ++j) { const int n = (lane >> 3) + 8 * j; const LAS float* s = scr + (8 * c) * 33 + n;
        v4u o; o.x = pk2(s[0 * 33], s[1 * 33]); o.y = pk2(s[2 * 33], s[3 * 33]); o.z = pk2(s[4 * 33], s[5 * 33]); o.w = pk2(s[6 * 33], s[7 * 33]);
        *(GAS v4u*)(WT + (size_t)(n0 + n) * K + k0 + 8 * c) = o; }
    LDS_WAIT(); asm volatile("" ::: "memory");
}
__device__ __forceinline__ void p0_prologue(const Ctx& F) {
    LAS float* scr = (LAS float*)(F.lds + RING_OFF + F.wave * 16384);
    const int gw = F.vcu * NWAVES + F.wave, NGW = F.G * NWAVES;
    constexpr int I_IN = (DM / 64) * (NIN / 32);
    for (int it = gw; it < I_IN; it += NGW) p0_transpose_item<1>(F.w_in(), DM, NCOLS_IN, NIN, F.WIN(), nullptr, scr, it, F.lane);
    for (int it = gw; it < 2 * 128; it += NGW) { const int c = it >> 7; p0_transpose_item<0>(F.cmp_w1() + (size_t)c * 2048 * 128, 2048, 128, 128, F.W1T() + (size_t)c * 128 * 2048, nullptr, scr, it & 127, F.lane); }
    for (int it = gw; it < 64; it += NGW) { const int c = it >> 5, fh = (it >> 4) & 1, kc = it & 15, f = fh * 64 + F.lane; const float* w = F.cmp_w1() + ((size_t)c * 2048 + kc * 128) * 128 + f; const float* pe = F.cmp_pe() + c * 2048 + kc * 128; float acc = 0.f;
#pragma unroll 16
        for (int k = 0; k < 128; ++k) acc += pe[k] * w[(size_t)k * 128];
        F.PEB()[(c * 16 + kc) * 128 + f] = acc; }
    for (int m = gw; m < MP; m += NGW) {
        GAS unsigned long long* o8 = (GAS unsigned long long*)(F.XN() + (size_t)m * DM) + F.lane;
        if (m >= MROWS) { GAS unsigned long long* z8 = (GAS unsigned long long*)(F.MIX() + (size_t)m * DM) + F.lane;
#pragma unroll
            for (int j = 0; j < 8; ++j) { o8[64 * j] = 0ull; z8[64 * j] = 0ull; }
            continue; }
        const float* xrow = m < MPROMPT ? F.x_prompt() + (size_t)m * DM : F.x_sample() + (size_t)(m - MPROMPT) * DM;
        const GAS f32x4* xr = (const GAS f32x4*)xrow + F.lane; const GAS f32x4* wr = (const GAS f32x4*)F.ln_mix() + F.lane;
        f32x4 v[8]; float s = 0.f;
#pragma unroll
        for (int j = 0; j < 8; ++j) { v[j] = xr[64 * j]; s += (v[j].x * v[j].x + v[j].y * v[j].y) + (v[j].z * v[j].z + v[j].w * v[j].w); }
        const float rstd = 1.0f / sqrtf(wave_sum(s) * (1.0f / DM) + NORM_EPS);
#pragma unroll
        for (int j = 0; j < 8; ++j) { const f32x4 w = wr[64 * j]; o8[64 * j] = (unsigned long long)pk2(v[j].x * rstd * w.x, v[j].y * rstd * w.y) | ((unsigned long long)pk2(v[j].z * rstd * w.z, v[j].w * rstd * w.w) << 32); }
    }
}
constexpr int W_ITEMS = (DM / 64) * (DM / 32) + (DM / 64) * (DFF / 32) + (DFF / 64) * (DM / 32), W_ITEMS_P1 = 7680;
__device__ __forceinline__ void weight_items(const Ctx& F, int it0, int it1, int wv, int nw) {
    LAS float* scr = (LAS float*)(F.lds + RING_OFF + F.wave * 16384);
    constexpr int I_OUT = (DM / 64) * (DM / 32), I_UP = (DM / 64) * (DFF / 32);
    for (int it = it0 + wv; it < it1; it += nw) {
        int r = it;
        if (r < I_OUT) { p0_transpose_item<0>(F.w_out(), DM, DM, DM, F.WOUT(), nullptr, scr, r, F.lane); continue; } r -= I_OUT;
        if (r < I_UP) { p0_transpose_item<0>(F.w_up(), DM, DFF, DFF, F.WUP(), F.ln_mlp(), scr, r, F.lane); continue; } r -= I_UP;
        p0_transpose_item<0>(F.w_down(), DFF, DM, DM, F.WDN(), nullptr, scr, r, F.lane);
    }
}
__device__ __forceinline__ void winbuf_copy(const Ctx& F) {
    { const int gt = F.vcu * (NWAVES * 64) + F.tid, NGT = F.G * NWAVES * 64; constexpr int TOT = DECB * 511 * 128;
      for (int i = gt; i < TOT; i += NGT) { const int b = i / (511 * 128), r = i % (511 * 128), row = r >> 7, c4 = r & 127;
          *(f32x4*)(F.out() + O_KWS + ((size_t)(b * 512 + row) * 512) + c4 * 4) = *(const f32x4*)(F.st_win() + ((size_t)(b * 512 + row + 1) * 512) + c4 * 4); } }
}

struct KeyRef { const void* k; const void* v; int f32; int valid; };
template <int NCH, class KF>
__device__ __forceinline__ void naive_attn2(const bf16* q2, const KF& kf, LAS float* qs, LAS float* sc, LAS float* ps, bool use_ps, int lane, float& o0, float& o1) {
    qs[lane] = bf2f(q2[lane]) * 0.125f; qs[64 + lane] = bf2f(q2[64 + lane]) * 0.125f;
    for (int c = 0; c < NCH; ++c) {
        const KeyRef kr = kf(c, lane);
        float s0 = -INFINITY, s1 = -INFINITY;
        if (kr.valid) {
            float k[64];
            if (kr.f32) { const f32x4* p = (const f32x4*)kr.k;
#pragma unroll
                for (int i = 0; i < 16; ++i) { const f32x4 t = p[i]; k[4 * i] = t.x; k[4 * i + 1] = t.y; k[4 * i + 2] = t.z; k[4 * i + 3] = t.w; } }
            else { const v4u* p = (const v4u*)kr.k;
#pragma unroll
                for (int i = 0; i < 8; ++i) { const v4u t = p[i]; k[8 * i] = __uint_as_float(t.x << 16); k[8 * i + 1] = __uint_as_float(t.x & 0xffff0000u); k[8 * i + 2] = __uint_as_float(t.y << 16); k[8 * i + 3] = __uint_as_float(t.y & 0xffff0000u);
                    k[8 * i + 4] = __uint_as_float(t.z << 16); k[8 * i + 5] = __uint_as_float(t.z & 0xffff0000u); k[8 * i + 6] = __uint_as_float(t.w << 16); k[8 * i + 7] = __uint_as_float(t.w & 0xffff0000u); } }
            s0 = 0.f; s1 = 0.f;
#pragma unroll
            for (int d = 0; d < 64; ++d) { s0 += qs[d] * k[d]; s1 += qs[64 + d] * k[d]; }
        }
        sc[c * 64 + lane] = s0; sc[NCH * 64 + c * 64 + lane] = s1;
    }
#pragma unroll
    for (int hh = 0; hh < 2; ++hh) { LAS float* s = sc + hh * NCH * 64; float m = -INFINITY;
        for (int c = 0; c < NCH; ++c) m = fmaxf(m, s[c * 64 + lane]);
        m = wave_max(m); if (m == -INFINITY) m = 0.f;
        float sum = 0.f;
        for (int c = 0; c < NCH; ++c) { const float e = __expf(s[c * 64 + lane] - m); s[c * 64 + lane] = e; sum += e; }
        sum = wave_sum(sum); const float inv = 1.0f / fmaxf(sum, 1e-30f);
        for (int c = 0; c < NCH; ++c) { const float p = s[c * 64 + lane] * inv; s[c * 64 + lane] = p; if (use_ps) ps[1 + c * 64 + lane] += p; } }
    o0 = 0.f; o1 = 0.f;
#pragma unroll
    for (int hh = 0; hh < 2; ++hh) {
        float a0[64];
#pragma unroll
        for (int d = 0; d < 64; ++d) a0[d] = 0.f;
        for (int c = 0; c < NCH; ++c) {
            const KeyRef kr = kf(c, lane);
            if (kr.valid) {
                const float p0 = sc[hh * NCH * 64 + c * 64 + lane];
                if (kr.f32) { const f32x4* p = (const f32x4*)kr.v;
#pragma unroll
                    for (int i = 0; i < 16; ++i) { const f32x4 t = p[i]; a0[4 * i] += p0 * t.x; a0[4 * i + 1] += p0 * t.y; a0[4 * i + 2] += p0 * t.z; a0[4 * i + 3] += p0 * t.w; } }
                else { const v4u* p = (const v4u*)kr.v;
#pragma unroll
                    for (int i = 0; i < 8; ++i) { const v4u t = p[i]; a0[8 * i] += p0 * __uint_as_float(t.x << 16); a0[8 * i + 1] += p0 * __uint_as_float(t.x & 0xffff0000u); a0[8 * i + 2] += p0 * __uint_as_float(t.y << 16); a0[8 * i + 3] += p0 * __uint_as_float(t.y & 0xffff0000u);
                        a0[8 * i + 4] += p0 * __uint_as_float(t.z << 16); a0[8 * i + 5] += p0 * __uint_as_float(t.z & 0xffff0000u); a0[8 * i + 6] += p0 * __uint_as_float(t.w << 16); a0[8 * i + 7] += p0 * __uint_as_float(t.w & 0xffff0000u); } }
            }
        }
        const float s0 = wave_reduce_t64(a0, lane); if (hh == 0) o0 = s0; else o1 = s0;
    }
}
struct CmpKeys { const float* base; int g, ncmp, qpos;
    __device__ __forceinline__ KeyRef operator()(int c, int l) const { const int n = c * 64 + l; KeyRef r; r.valid = (n < ncmp) && (16 * n + 31 <= qpos); r.f32 = 1; r.k = base + (size_t)(r.valid ? n : 0) * 512 + g * 64; r.v = (const float*)r.k + 256; return r; } };
struct WinKeysP { const bf16* kw; int g, t;
    __device__ __forceinline__ KeyRef operator()(int c, int l) const { const int pos = t - 511 + c * 64 + l; KeyRef r; r.valid = pos >= 0; r.f32 = 0; r.k = kw + (size_t)(r.valid ? pos : 0) * 512 + g * 64; r.v = (const bf16*)r.k + 256; return r; } };
struct WinKeysS { const float* st; const bf16* nw; int g;
    __device__ __forceinline__ KeyRef operator()(int c, int l) const { const int i = 1 + c * 64 + l; KeyRef r; r.valid = 1;
        if (i < 512) { r.f32 = 1; r.k = st + (size_t)i * 512 + g * 64; r.v = (const float*)r.k + 256; } else { r.f32 = 0; r.k = nw + g * 64; r.v = nw + 256 + g * 64; } return r; } };
struct SelKeysP { const int* idx; const bf16* ks; int g, qpos;
    __device__ __forceinline__ KeyRef operator()(int c, int l) const { const int pos = idx[c] * 64 + l; KeyRef r; r.valid = pos <= qpos; r.f32 = 0; r.k = ks + (size_t)(r.valid ? pos : 0) * 512 + g * 64; r.v = (const bf16*)r.k + 256; return r; } };
struct SelKeysS { const int* idx; const int* pt; const float* cache; const bf16* nw; int g;
    __device__ __forceinline__ KeyRef operator()(int c, int l) const { const int pos = idx[c] * 64 + l; KeyRef r; r.valid = pos <= PAST;
        if (pos < PAST) { const int page = pt[pos >> 7]; r.f32 = 1; r.k = cache + ((size_t)page * 128 + (pos & 127)) * 512 + g * 64; r.v = (const float*)r.k + 256; } else { r.f32 = 0; r.k = nw + g * 64; r.v = nw + 256 + g * 64; } return r; } };

constexpr int NA_WAVE_LDS = 14336;
__device__ __forceinline__ void na_ptrs(const Ctx& F, LAS float*& qs, LAS float*& sc, LAS float*& ps, LAS float*& imp) {
    LAS unsigned char* b = F.lds + RING_OFF + F.wave * NA_WAVE_LDS; qs = (LAS float*)b; sc = (LAS float*)(b + 512); ps = (LAS float*)(b + 8704); imp = (LAS float*)(b + 10880); }

template <bool CHK>
__device__ __forceinline__ void compress_task(const Ctx& F, int task, int lane) {
    constexpr int NT_P = NB * NCMP_P * 2;
    const bool dec = task >= NT_P; const int tt = dec ? task - NT_P : task, ncmp = dec ? NCMP_S : NCMP_P, bb = tt / (ncmp * 2), rr = tt % (ncmp * 2), n = rr >> 1, c = rr & 1;
    float h0[4] = {0.f, 0.f, 0.f, 0.f}, h1[4] = {0.f, 0.f, 0.f, 0.f};
    const float* w1 = F.cmp_w1() + (size_t)c * 2048 * 128; const float* pe = F.cmp_pe() + c * 2048;
    for (int l = 0; l < 32; ++l) {
        const int pos = 16 * n + l; const float* row;
        if (!dec) row = F.out() + O_KCP + (size_t)(bb * SEQ + pos) * 512; else { const int page = F.page_table()[bb * 64 + (pos >> 7)]; row = F.cache_cmp() + ((size_t)page * 128 + (pos & 127)) * 512; }
        const float pv = pe[l * 64 + lane]; float xg[4];
#pragma unroll
        for (int g = 0; g < 4; ++g) xg[g] = row[c * 256 + g * 64 + lane] + pv;
        const float* wl = w1 + (size_t)l * 64 * 128;
#pragma unroll 8
        for (int d = 0; d < 64; ++d) { const float wa = wl[d * 128 + lane], wb = wl[d * 128 + 64 + lane];
#pragma unroll
            for (int g = 0; g < 4; ++g) { const float xv = rdlane(xg[g], d); h0[g] += xv * wa; h1[g] += xv * wb; } }
    }
    const float ba = F.cmp_b1()[c * 128 + lane], bb1 = F.cmp_b1()[c * 128 + 64 + lane];
#pragma unroll
    for (int g = 0; g < 4; ++g) { h0[g] = siluf_(h0[g] + ba); h1[g] = siluf_(h1[g] + bb1); }
    const float* w2 = F.cmp_w2() + (size_t)c * 128 * 64; const float b2 = F.cmp_b2()[c * 64 + lane];
    float o[4] = {b2, b2, b2, b2};
    for (int f = 0; f < 64; ++f) { const float wa = w2[f * 64 + lane], wb = w2[(64 + f) * 64 + lane];
#pragma unroll
        for (int g = 0; g < 4; ++g) o[g] += rdlane(h0[g], f) * wa + rdlane(h1[g], f) * wb; }
    float* dst = (dec ? F.KCMPS() : F.KCMPP()) + ((size_t)(bb * ncmp + n) * 2 + c) * 256;
#pragma unroll
    for (int g = 0; g < 4; ++g) { if (CHK) { const float df = fabsf(o[g] - dst[g * 64 + lane]);
            if (!(df <= 0.02f + 0.02f * fabsf(o[g]))) __hip_atomic_fetch_or((unsigned*)F.ctl + CW_CHK + (!dec ? 0 : ((n & 127) == 127 ? 1 : 2)), 1u, RLX_AGENT);
            if (!(df <= 0.2f)) __hip_atomic_fetch_or((unsigned*)F.ctl + CW_CHK + 3, 1u, RLX_AGENT); } else dst[g * 64 + lane] = o[g]; }
}
__device__ __forceinline__ void compress_ref_check(const Ctx& F, int task, int g, int lane, int dbgslot) {
    constexpr int NT_P = NB * NCMP_P * 2;
    const bool dec = task >= NT_P; const int tt = dec ? task - NT_P : task, ncmp = dec ? NCMP_S : NCMP_P, bb = tt / (ncmp * 2), rr = tt % (ncmp * 2), n = rr >> 1, c = rr & 1;
    LAS float* hl = (LAS float*)(F.lds + RING_OFF + F.wave * NA_WAVE_LDS);
    float ha = 0.f, hb2 = 0.f;
    for (int k = 0; k < 2048; ++k) { const int l = k >> 6, d = k & 63, pos = 16 * n + l; const float* row;
        if (!dec) row = F.out() + O_KCP + (size_t)(bb * SEQ + pos) * 512; else { const int page = F.page_table()[bb * 64 + (pos >> 7)]; row = F.cache_cmp() + ((size_t)page * 128 + (pos & 127)) * 512; }
        const float x = row[c * 256 + g * 64 + d] + F.cmp_pe()[c * 2048 + k]; const float* w = F.cmp_w1() + ((size_t)c * 2048 + k) * 128;
        ha += x * w[lane]; hb2 += x * w[64 + lane]; }
    if (dbgslot >= 0) { const float* HD = (const float*)F.H() + (size_t)dbgslot * 512 * 128 + (size_t)(((n & 127) << 2) + g) * 128; float pa = 0.f, pb = 0.f; for (int kc = 0; kc < 16; ++kc) { pa += F.PEB()[(c * 16 + kc) * 128 + lane]; pb += F.PEB()[(c * 16 + kc) * 128 + 64 + lane]; }
        if (!(fabsf(HD[lane] + pa - ha) <= 0.05f + 0.05f * fabsf(ha)) || !(fabsf(HD[64 + lane] + pb - hb2) <= 0.05f + 0.05f * fabsf(hb2))) __hip_atomic_fetch_or((unsigned*)F.ctl + CW_CHK + 5 + dbgslot, 1u, RLX_AGENT); }
    ha += F.cmp_b1()[c * 128 + lane]; hb2 += F.cmp_b1()[c * 128 + 64 + lane];
    hl[lane] = ha / (1.0f + __expf(-ha)); hl[64 + lane] = hb2 / (1.0f + __expf(-hb2));
    float o = F.cmp_b2()[c * 64 + lane];
    for (int f = 0; f < 128; ++f) o += hl[f] * F.cmp_w2()[((size_t)c * 128 + f) * 64 + lane];
    const float got = (dec ? F.KCMPS() : F.KCMPP())[((size_t)(bb * ncmp + n) * 2 + c) * 256 + g * 64 + lane];
    if (!(fabsf(o - got) <= 0.05f + 0.05f * fabsf(o))) __hip_atomic_fetch_or((unsigned*)F.ctl + CW_CHK + 4, 1u, RLX_AGENT);
}
__device__ __forceinline__ void conv_prepass(const Ctx& F) {
    const int gt = F.vcu * (NWAVES * 64) + F.tid, NGT = F.G * NWAVES * 64;
    constexpr int TOTP = (MPROMPT / 8) * (CONV_DIM / 4);
    for (int i = gt; i < TOTP; i += NGT) {
        const int rb = i / (CONV_DIM / 4), c4 = i % (CONV_DIM / 4), col = c4 * 4, m0 = rb * 8, t0 = m0 & (SEQ - 1), b = m0 >> 12;
        f32x4 xr[11];
#pragma unroll
        for (int k = 0; k < 11; ++k) xr[k] = (t0 - 3 + k >= 0) ? *(const f32x4*)(F.XBC() + (size_t)(m0 - 3 + k) * CONV_DIM + col) : (f32x4){0.f, 0.f, 0.f, 0.f};
        const f32x4 bias = *(const f32x4*)(F.conv_b() + col), w0 = *(const f32x4*)(F.conv_w() + col), w1 = *(const f32x4*)(F.conv_w() + CONV_DIM + col), w2 = *(const f32x4*)(F.conv_w() + 2 * CONV_DIM + col), w3 = *(const f32x4*)(F.conv_w() + 3 * CONV_DIM + col);
#pragma unroll
        for (int r = 0; r < 8; ++r) { const f32x4 acc = bias + xr[r] * w0 + xr[r + 1] * w1 + xr[r + 2] * w2 + xr[r + 3] * w3;
            typedef unsigned u32x2v __attribute__((ext_vector_type(2))); u32x2v w; w.x = pk2(siluf_(acc.x), siluf_(acc.y)); w.y = pk2(siluf_(acc.z), siluf_(acc.w)); *(u32x2v*)(F.XBCA16() + (size_t)(m0 + r) * CONV_DIM + col) = w;
            if (t0 + r >= SEQ - 3) *(f32x4*)(F.out() + O_CVP + (size_t)(b * 3 + (t0 + r - (SEQ - 3))) * CONV_DIM + col) = xr[r + 3]; }
        if (c4 < 4) {
#pragma unroll
            for (int r = 0; r < 8; ++r)
#pragma unroll
                for (int e = 0; e < 4; ++e) { const int h = c4 * 4 + e; const float x = F.GD()[(size_t)(m0 + r) * 64 + 48 + h] + F.dt_bias()[h]; F.DT()[(size_t)(m0 + r) * 16 + h] = x > 20.f ? x : log1pf(__expf(x)); } }
    }
    constexpr int TOTS = DECB * (CONV_DIM / 4);
    for (int i = gt; i < TOTS; i += NGT) {
        const int b = i / (CONV_DIM / 4), c4 = i % (CONV_DIM / 4), col = c4 * 4; const size_t m = (size_t)MPROMPT + b;
        f32x4 acc = *(const f32x4*)(F.conv_b() + col);
#pragma unroll
        for (int w = 0; w < 3; ++w) acc += *(const f32x4*)(F.st_conv() + (size_t)(b * 3 + w) * CONV_DIM + col) * *(const f32x4*)(F.conv_w() + (size_t)w * CONV_DIM + col);
        const f32x4 xcur = *(const f32x4*)(F.XBC() + m * CONV_DIM + col); acc += xcur * *(const f32x4*)(F.conv_w() + (size_t)3 * CONV_DIM + col);
        f32x4 a; a.x = siluf_(acc.x); a.y = siluf_(acc.y); a.z = siluf_(acc.z); a.w = siluf_(acc.w);
        *(f32x4*)(F.XBCA() + m * CONV_DIM + col) = a;
        { typedef unsigned u32x2v __attribute__((ext_vector_type(2))); u32x2v w; w.x = pk2(a.x, a.y); w.y = pk2(a.z, a.w); *(u32x2v*)(F.XBCA16() + m * CONV_DIM + col) = w; }
        *(f32x4*)(F.out() + O_CVS + (size_t)(b * 3 + 0) * CONV_DIM + col) = *(const f32x4*)(F.st_conv() + (size_t)(b * 3 + 1) * CONV_DIM + col);
        *(f32x4*)(F.out() + O_CVS + (size_t)(b * 3 + 1) * CONV_DIM + col) = *(const f32x4*)(F.st_conv() + (size_t)(b * 3 + 2) * CONV_DIM + col);
        *(f32x4*)(F.out() + O_CVS + (size_t)(b * 3 + 2) * CONV_DIM + col) = xcur;
        if (c4 < 4) {
#pragma unroll
            for (int e = 0; e < 4; ++e) { const int h = c4 * 4 + e; const float x = F.GD()[m * 64 + 48 + h] + F.dt_bias()[h]; F.DT()[m * 16 + h] = x > 20.f ? x : log1pf(__expf(x)); } }
    }
}
template <bool CHK>
__device__ __forceinline__ void win_task(const Ctx& F, int task, int lane) {
    LAS float *qs, *sc, *ps, *imp; na_ptrs(F, qs, sc, ps, imp);
    const int m = task >> 2, g = task & 3; const bool dec = m >= MPROMPT; const int b = dec ? m - MPROMPT : m >> 12, t = m & (SEQ - 1);
#pragma unroll
    for (int pr = 0; pr < 2; ++pr) { float o0, o1; const bf16* q2 = F.QB() + (size_t)m * 1024 + g * 256 + pr * 128;
        if (!dec) { const WinKeysP kf{F.KWB() + (size_t)b * SEQ * 512, g, t}; naive_attn2<8>(q2, kf, qs, sc, ps, false, lane, o0, o1); }
        else { const WinKeysS kf{F.st_win() + (size_t)b * 512 * 512, F.KWB() + (size_t)m * 512, g}; naive_attn2<8>(q2, kf, qs, sc, ps, false, lane, o0, o1); }
        float* d0 = F.OWIN() + (size_t)m * 1024 + (g * 4 + pr * 2) * 64 + lane;
        if (CHK) { if (!(fabsf(o0 - d0[0]) <= 2e-3f) || !(fabsf(o1 - d0[64]) <= 2e-3f)) __hip_atomic_fetch_or((unsigned*)F.ctl + CW_CHK + 0, 1u, RLX_AGENT); }
        else { d0[0] = o0; d0[64] = o1; } }
}
template <bool CHK>
__device__ __forceinline__ void cmp_task(const Ctx& F, int task, int lane) {
    LAS float *qs, *sc, *ps, *imp; na_ptrs(F, qs, sc, ps, imp);
    const int m = task >> 2, g = task & 3; const bool dec = m >= MPROMPT; const int b = dec ? m - MPROMPT : m >> 12, t = m & (SEQ - 1);
    const int qpos = dec ? PAST : t, ncmp = dec ? NCMP_S : NCMP_P, nslc = dec ? NSLC_S : NSLC_P, jt = qpos >> 6;
    for (int i = lane; i < 544; i += 64) ps[i] = 0.f;
    const CmpKeys kf{dec ? F.KCMPS() + (size_t)b * NCMP_S * 512 : F.KCMPP() + (size_t)b * NCMP_P * 512, g, ncmp, qpos};
#pragma unroll
    for (int pr = 0; pr < 2; ++pr) { float o0, o1; naive_attn2<8>(F.QB() + (size_t)m * 1024 + g * 256 + pr * 128, kf, qs, sc, ps, true, lane, o0, o1);
        float* d0 = F.OCMP() + (size_t)m * 1024 + (g * 4 + pr * 2) * 64 + lane;
        if (CHK) { if (!(fabsf(o0 - d0[0]) <= 5e-3f + 0.02f * fabsf(o0)) || !(fabsf(o1 - d0[64]) <= 5e-3f + 0.02f * fabsf(o1))) __hip_atomic_fetch_or((unsigned*)F.ctl + CW_CHK + 0, 1u, RLX_AGENT);
                   if (!(fabsf(o0 - d0[0]) <= 0.05f) || !(fabsf(o1 - d0[64]) <= 0.05f)) __hip_atomic_fetch_or((unsigned*)F.ctl + CW_CHK + 3, 1u, RLX_AGENT); }
        else { d0[0] = o0; d0[64] = o1; } }
    float mine[3]; int cnt[3];
#pragma unroll
    for (int jj = 0; jj < 3; ++jj) { const int j = jj * 64 + lane; float v = 0.f; cnt[jj] = 0;
        if (j < nslc) { v = ps[4 * j] + 2.0f * (ps[4 * j + 1] + ps[4 * j + 2] + ps[4 * j + 3]) + ps[4 * j + 4]; if (j == 0 || j == jt || j == jt - 1) v = 1.0e4f; if (j > jt) v = -1.0e4f; imp[j] = v; }
        mine[jj] = v; }
    for (int k = 0; k < nslc; ++k) { const float v = imp[k];
#pragma unroll
        for (int jj = 0; jj < 3; ++jj) { const int j = jj * 64 + lane; cnt[jj] += ((v > mine[jj]) || (v == mine[jj] && k < j)) ? 1 : 0; } }
    int base = 0;
#pragma unroll
    for (int jj = 0; jj < 3; ++jj) { const int j = jj * 64 + lane; const bool sel = (j < nslc) && (cnt[jj] < 16); const unsigned long long bal = __ballot(sel);
        if (CHK && dec) { bool stored = false; for (int i = 0; i < 16; ++i) stored = stored || (F.SELIDX()[(size_t)task * 16 + i] == j);
            if (__ballot((j < nslc) && (stored != sel)) != 0ull && lane == 0) __hip_atomic_fetch_or((unsigned*)F.ctl + CW_CHK + 2, 1u, RLX_AGENT); }
        else if (CHK) { if (jj == 0 && lane == 0 && F.SELMASK()[task] != bal) { if (__hip_atomic_fetch_add((unsigned*)F.ctl + CW_CHK + 8, 1u, RLX_AGENT) >= 100u) __hip_atomic_fetch_or((unsigned*)F.ctl + CW_CHK + 1, 1u, RLX_AGENT); if (__popcll(F.SELMASK()[task] ^ bal) > 2) __hip_atomic_fetch_or((unsigned*)F.ctl + CW_CHK + 2, 1u, RLX_AGENT); } }
        else { if (sel) F.SELIDX()[(size_t)task * 16 + base + __popcll(bal & ((1ull << lane) - 1ull))] = j;
        if (!dec && jj == 0 && lane == 0) F.SELMASK()[task] = bal; }
        base += __popcll(bal); }
}
template <bool CHK>
__device__ __forceinline__ void sel_task(const Ctx& F, int task, int lane) {
    LAS float *qs, *sc, *ps, *imp; na_ptrs(F, qs, sc, ps, imp);
    const int m = task >> 2, g = task & 3; const bool dec = m >= MPROMPT; const int b = dec ? m - MPROMPT : m >> 12, t = m & (SEQ - 1);
#pragma unroll
    for (int pr = 0; pr < 2; ++pr) { float o0, o1; const bf16* q2 = F.QB() + (size_t)m * 1024 + g * 256 + pr * 128;
        if (!dec) { LAS int* il = (LAS int*)imp;
            const unsigned long long mk = F.SELMASK()[task]; if ((mk >> lane) & 1ull) il[__popcll(mk & ((1ull << lane) - 1ull))] = lane;
            const SelKeysP kf{(const int*)il, F.KSB() + (size_t)b * SEQ * 512, g, t}; naive_attn2<16>(q2, kf, qs, sc, ps, false, lane, o0, o1); }
        else { const SelKeysS kf{F.SELIDX() + (size_t)task * 16, F.page_table() + b * 64, F.cache_sel(), F.KSB() + (size_t)m * 512, g}; naive_attn2<16>(q2, kf, qs, sc, ps, false, lane, o0, o1); }
#pragma unroll
        for (int e = 0; e < 2; ++e) { const int hd = g * 4 + pr * 2 + e; const float* gt = F.GD() + (size_t)m * 64 + hd * 3; const size_t oi = (size_t)m * 1024 + hd * 64 + lane;
            const float a = gt[0] * F.OCMP()[oi] + gt[1] * (e ? o1 : o0) + gt[2] * F.OWIN()[oi]; bf16* dm = F.MIX() + (size_t)m * DM + hd * 64 + lane;
            if (CHK) { if (!(fabsf(a - bf2f(*dm)) <= 2e-3f + 0.01f * fabsf(a))) __hip_atomic_fetch_or((unsigned*)F.ctl + CW_CHK + 1, 1u, RLX_AGENT); } else *dm = (bf16)f2bf(a); } }
}
template <int U>
__device__ __forceinline__ void ssd_chain(const Ctx& F, int rowbase, int L, int h, int p, const float* s0, float* sfin, int lane) {
    const int grp = h >> 3; float h0 = 0.f, h1 = 0.f; if (s0) { h0 = s0[lane]; h1 = s0[64 + lane]; }
    const float A = -__expf(F.a_log()[h]), Dk = F.d_skip()[h];
    for (int t0 = 0; t0 < L; t0 += U) {
        float dt[U], x[U], B0[U], B1[U], C0[U], C1[U];
#pragma unroll
        for (int u = 0; u < U; ++u) { const size_t m = (size_t)(rowbase + t0 + u); dt[u] = F.DT()[m * 16 + h]; const float* r = F.XBCA() + m * CONV_DIM; x[u] = r[h * 64 + p];
            B0[u] = r[1024 + grp * 128 + lane]; B1[u] = r[1024 + grp * 128 + 64 + lane]; C0[u] = r[1280 + grp * 128 + lane]; C1[u] = r[1280 + grp * 128 + 64 + lane]; }
        float y[U];
#pragma unroll
        for (int u = 0; u < U; ++u) { const float dA = __expf(dt[u] * A), xd = dt[u] * x[u]; h0 = h0 * dA + xd * B0[u]; h1 = h1 * dA + xd * B1[u]; y[u] = wave_sum(C0[u] * h0 + C1[u] * h1) + Dk * x[u]; }
        if (lane == 0) {
#pragma unroll
            for (int u = 0; u < U; ++u) F.YSSD()[(size_t)(rowbase + t0 + u) * 1024 + h * 64 + p] = y[u]; }
    }
    sfin[lane] = h0; sfin[64 + lane] = h1;
}
__device__ __forceinline__ void ssd_task(const Ctx& F, int task, int lane) {
    if (task < NB * 16 * 64) { const int b = task >> 10, h = (task >> 6) & 15, p = task & 63; ssd_chain<4>(F, b * SEQ, SEQ, h, p, nullptr, F.out() + O_SSP + (size_t)task * 128, lane); }
    else { const int tk = task - NB * 16 * 64, b = tk >> 10, h = (tk >> 6) & 15, p = tk & 63; ssd_chain<1>(F, MPROMPT + b, 1, h, p, F.st_ssm() + (size_t)tk * 128, F.out() + O_SSS + (size_t)tk * 128, lane); }
}
__device__ __forceinline__ void ssd_decode_task(const Ctx& F, int task, int lane) {
    const int pg = task & 7, h = (task >> 3) & 15, b = task >> 7, grp = h >> 3; const size_t m = (size_t)MPROMPT + b;
    const float* r = F.XBCA() + m * CONV_DIM; const float dt = F.DT()[m * 16 + h], A = -__expf(F.a_log()[h]), Dk = F.d_skip()[h], dA = __expf(dt * A);
    const float B0 = r[1024 + grp * 128 + lane], B1 = r[1024 + grp * 128 + 64 + lane], C0 = r[1280 + grp * 128 + lane], C1 = r[1280 + grp * 128 + 64 + lane];
    const size_t sb = ((size_t)(b * 16 + h) * 64 + pg * 8) * 128;
    float h0[8], h1[8], x[8];
#pragma unroll
    for (int i = 0; i < 8; ++i) { h0[i] = F.st_ssm()[sb + i * 128 + lane]; h1[i] = F.st_ssm()[sb + i * 128 + 64 + lane]; x[i] = r[h * 64 + pg * 8 + i]; }
#pragma unroll
    for (int i = 0; i < 8; ++i) { const float xd = dt * x[i]; h0[i] = h0[i] * dA + xd * B0; h1[i] = h1[i] * dA + xd * B1;
        F.out()[O_SSS + sb + i * 128 + lane] = h0[i]; F.out()[O_SSS + sb + i * 128 + 64 + lane] = h1[i];
        const float y = wave_sum(C0 * h0[i] + C1 * h1[i]) + Dk * x[i]; if (lane == 0) F.YSSD()[m * 1024 + h * 64 + pg * 8 + i] = y; }
}
__device__ __forceinline__ void ssd_gate_task(const Ctx& F, int task, int lane) {
    const int m = task >> 1, grp = task & 1; const size_t o = (size_t)m * 1024 + grp * 512 + lane * 8;
    const f32x4 y0 = *(const f32x4*)(F.YSSD() + o), y1 = *(const f32x4*)(F.YSSD() + o + 4), z0 = *(const f32x4*)(F.Z() + o), z1 = *(const f32x4*)(F.Z() + o + 4);
    float v[8] = {y0.x * siluf_(z0.x), y0.y * siluf_(z0.y), y0.z * siluf_(z0.z), y0.w * siluf_(z0.w), y1.x * siluf_(z1.x), y1.y * siluf_(z1.y), y1.z * siluf_(z1.z), y1.w * siluf_(z1.w)};
    float ss = 0.f;
#pragma unroll
    for (int e = 0; e < 8; ++e) ss += v[e] * v[e];
    const float rstd = 1.0f / sqrtf(wave_sum(ss) * (1.0f / 512.0f) + NORM_EPS);
    const float* w = F.ssm_norm() + grp * 512 + lane * 8;
    v4u ow; ow.x = pk2(v[0] * rstd * w[0], v[1] * rstd * w[1]); ow.y = pk2(v[2] * rstd * w[2], v[3] * rstd * w[3]); ow.z = pk2(v[4] * rstd * w[4], v[5] * rstd * w[5]); ow.w = pk2(v[6] * rstd * w[6], v[7] * rstd * w[7]);
    *(v4u*)(F.MIX() + (size_t)m * DM + 1024 + grp * 512 + lane * 8) = ow;
}
__device__ __forceinline__ void final_norm_row(const Ctx& F, int m, int lane) {
    float s = m < MPROMPT ? (lane < 32 ? F.SS2()[(size_t)m * 32 + lane] : 0.f) : F.SS2S()[(size_t)(m - MPROMPT) * 64 + lane]; s = wave_sum(s);
    const float rstd = 1.0f / sqrtf(s * (1.0f / DM) + NORM_EPS);
    const f32x4* xr = (const f32x4*)(F.X2() + (size_t)m * DM) + lane; const f32x4* wr = (const f32x4*)F.ln_final() + lane;
    f32x4* o = (f32x4*)(m < MPROMPT ? F.out() + O_YP + (size_t)m * DM : F.out() + O_YS + (size_t)(m - MPROMPT) * DM) + lane;
#pragma unroll
    for (int j = 0; j < 8; ++j) o[64 * j] = xr[64 * j] * rstd * wr[64 * j];
}

namespace fa {
typedef short bf16x8 __attribute__((ext_vector_type(8)));
typedef short s16x4 __attribute__((ext_vector_type(4)));
typedef float f32x16 __attribute__((ext_vector_type(16)));
constexpr float C2 = 0.125f * 1.4426950408889634f, MASKV = -1.0e30f;
constexpr int LK = 0, LV = 16384, LWS = 32768, LDS_BYTES_FA = 34816;
__device__ __forceinline__ int crow(int r, int hi) { return (r & 3) + 8 * (r >> 2) + 4 * hi; }
__device__ __forceinline__ float max3f(float a, float b, float c) { float r; asm("v_max3_f32 %0, %1, %2, %3" : "=v"(r) : "v"(a), "v"(b), "v"(c)); return r; }
typedef float f32x2_t __attribute__((ext_vector_type(2))); typedef __bf16 bf16x2_t __attribute__((ext_vector_type(2)));
__device__ __forceinline__ unsigned cvtpk(float lo, float hi) { f32x2_t v = {lo, hi}; bf16x2_t b = __builtin_convertvector(v, bf16x2_t); return __builtin_bit_cast(unsigned, b); }
__device__ __forceinline__ float xmax(float v) { auto rr = __builtin_amdgcn_permlane32_swap(__float_as_uint(v), __float_as_uint(v), false, false); return fmaxf(__uint_as_float(rr[0]), __uint_as_float(rr[1])); }
__device__ __forceinline__ float xsum(float v) { auto rr = __builtin_amdgcn_permlane32_swap(__float_as_uint(v), __float_as_uint(v), false, false); return __uint_as_float(rr[0]) + __uint_as_float(rr[1]); }
__device__ __forceinline__ void qkt(f32x16& p0, f32x16& p1, const LAS unsigned char* Kt, const bf16x8* qr, int r32, int hi) {
    const LAS unsigned char* kb = Kt + hi * 1024 + r32 * 16;
    p0 = f32x16{}; p1 = f32x16{};
#pragma unroll
    for (int d0 = 0; d0 < 4; ++d0) {
        const bf16x8 b0 = *(const LAS bf16x8*)(kb + d0 * 2048), b1 = *(const LAS bf16x8*)(kb + d0 * 2048 + 512);
        p0 = __builtin_amdgcn_mfma_f32_32x32x16_bf16(b0, qr[d0], p0, 0, 0, 0); p1 = __builtin_amdgcn_mfma_f32_32x32x16_bf16(b1, qr[d0], p1, 0, 0, 0); }
}
__device__ __forceinline__ void pv(f32x16* o, unsigned vb, bf16x8 pa0, bf16x8 pa1, bf16x8 pa2, bf16x8 pa3) {
#pragma unroll
    for (int d0 = 0; d0 < 2; ++d0) { s16x4 lo[4], hi[4];
#pragma unroll
        for (int ks = 0; ks < 4; ++ks) {
            asm volatile("ds_read_b64_tr_b16 %0,%1 offset:%c2" : "=&v"(lo[ks]) : "v"(vb), "i"(d0 * 4096 + ks * 1024) : "memory");
            asm volatile("ds_read_b64_tr_b16 %0,%1 offset:%c2" : "=&v"(hi[ks]) : "v"(vb), "i"(d0 * 4096 + ks * 1024 + 512) : "memory"); }
        asm volatile("s_waitcnt lgkmcnt(0)" ::: "memory"); __builtin_amdgcn_sched_barrier(0);
#define FA_PK(k) (bf16x8){lo[k][0], lo[k][1], lo[k][2], lo[k][3], hi[k][0], hi[k][1], hi[k][2], hi[k][3]}
        o[d0] = __builtin_amdgcn_mfma_f32_32x32x16_bf16(pa0, FA_PK(0), o[d0], 0, 0, 0);
        o[d0] = __builtin_amdgcn_mfma_f32_32x32x16_bf16(pa1, FA_PK(1), o[d0], 0, 0, 0);
        o[d0] = __builtin_amdgcn_mfma_f32_32x32x16_bf16(pa2, FA_PK(2), o[d0], 0, 0, 0);
        o[d0] = __builtin_amdgcn_mfma_f32_32x32x16_bf16(pa3, FA_PK(3), o[d0], 0, 0, 0);
#undef FA_PK
    }
}
__device__ __forceinline__ float rowmax(const f32x16& p0, const f32x16& p1) {
    float a = max3f(p0[0], p0[1], p1[0]), b = max3f(p0[2], p0[3], p1[1]); a = max3f(a, p1[2], p1[3]);
#pragma unroll
    for (int r = 4; r < 16; r += 4) { a = max3f(a, p0[r], p0[r + 1]); b = max3f(b, p0[r + 2], p0[r + 3]); a = max3f(a, p1[r], p1[r + 1]); b = max3f(b, p1[r + 2], p1[r + 3]); }
    const float m = fmaxf(a, b);
    return xmax(m);
}
#define FA_BAR() asm volatile("s_waitcnt vmcnt(0) lgkmcnt(0)\n\ts_barrier" ::: "memory")

template <int MODE>
__device__ __forceinline__ void attn_unit(const Ctx& F, LAS unsigned char* shm, int b, int g, int qb) {
    const int tid = threadIdx.x, lane = tid & 63, r32 = lane & 31, hi = lane >> 5; const int wid = __builtin_amdgcn_readfirstlane(tid >> 6);
    const int hd = 4 * g + (wid & 3), th = wid >> 2, trel = 32 * th + r32; const size_t m = (size_t)b * SEQ + 64 * qb + trel;
    const int j_lo = MODE == 0 ? 0 : (qb > 8 ? qb - 8 : 0), j_hi = qb;
    const bf16* KV = (MODE == 0 ? F.KSB() : F.KWB()) + (size_t)b * SEQ * 512 + g * 64;
    const unsigned long long smask = MODE == 0 ? F.SELMASK()[m * 4 + g] : ~0ull;
    bf16x8 qr[4];
    { const bf16* Qp = F.QB() + m * 1024 + hd * 64 + hi * 8;
#pragma unroll
      for (int d0 = 0; d0 < 4; ++d0) qr[d0] = *(const bf16x8*)(Qp + 16 * d0); }
    const bf16* ksrc = KV + (size_t)lane * 512 + wid * 8;
    const bf16* vsrc = KV + 256 + (size_t)(16 * (wid & 3) + (lane >> 2)) * 512 + (wid >> 2) * 32 + (lane & 3) * 8;
    LAS unsigned char* kdst = shm + LK + wid * 1024 + lane * 16; LAS unsigned char* vdst = shm + LV + wid * 1024 + lane * 16;
    const unsigned vb0 = (unsigned)(uintptr_t)(shm + LV) + ((lane >> 4) & 1) * 32 + (lane & 3) * 8 + (4 * hi + ((lane & 15) >> 2)) * 64;
    LAS float* wsf = (LAS float*)(shm + LWS) + wid * 64;
    v4u kreg = *(const v4u*)(ksrc + (size_t)j_lo * 64 * 512), vreg = *(const v4u*)(vsrc + (size_t)j_lo * 64 * 512);
    *(LAS v4u*)kdst = kreg; *(LAS v4u*)vdst = vreg;
    FA_BAR();
    float mref = MASKV, lsum = 0.f; f32x16 o[2]; o[0] = f32x16{}; o[1] = f32x16{};
#define FA_TILE(DIAG) do { \
        const int buf = (j - j_lo) & 1; \
        if (!(DIAG)) { kreg = *(const v4u*)(ksrc + (size_t)(j + 1) * 64 * 512); vreg = *(const v4u*)(vsrc + (size_t)(j + 1) * 64 * 512); } \
        f32x16 p0, p1; \
        qkt(p0, p1, shm + LK + buf * 8192, qr, r32, hi); \
        if (DIAG) { _Pragma("unroll") for (int r = 0; r < 16; ++r) { const int kv = crow(r, hi); if (kv > trel) p0[r] = MASKV; if (kv + 32 > trel) p1[r] = MASKV; } } \
        if (MODE == 1 && qb >= 8 && j == j_lo) { _Pragma("unroll") for (int r = 0; r < 16; ++r) { const int kv = crow(r, hi); if (kv <= trel) p0[r] = MASKV; if (kv + 32 <= trel) p1[r] = MASKV; } } \
        const bool blocked = MODE == 0 && !((smask >> j) & 1ull); \
        float mt = rowmax(p0, p1); mt = (blocked || mt < -1.0e29f) ? MASKV : mt * C2; \
        const bool need = mt > mref + 8.0f; \
        if (__any(need)) { \
            const float mnew = need ? mt : mref, f = __builtin_amdgcn_exp2f(mref - mnew); lsum *= f; mref = mnew; \
            if (hi == 0) wsf[r32] = f; \
            asm volatile("s_waitcnt lgkmcnt(0)" ::: "memory"); \
            _Pragma("unroll") for (int r = 0; r < 16; ++r) { const float fr = wsf[crow(r, hi)]; o[0][r] *= fr; o[1][r] *= fr; } \
        } \
        const float nref = blocked ? -1.0e30f : (mref < -1.0e29f ? 0.f : -mref); float sacc = 0.f;        \
        _Pragma("unroll") for (int r = 0; r < 16; ++r) { p0[r] = __builtin_amdgcn_exp2f(__builtin_fmaf(p0[r], C2, nref)); p1[r] = __builtin_amdgcn_exp2f(__builtin_fmaf(p1[r], C2, nref)); sacc += p0[r] + p1[r]; } \
        lsum += sacc; \
        v4u pw0, pw1, pw2, pw3; \
        pw0.x = cvtpk(p0[0], p0[1]); pw0.y = cvtpk(p0[2], p0[3]); pw0.z = cvtpk(p0[4], p0[5]); pw0.w = cvtpk(p0[6], p0[7]); \
        pw1.x = cvtpk(p0[8], p0[9]); pw1.y = cvtpk(p0[10], p0[11]); pw1.z = cvtpk(p0[12], p0[13]); pw1.w = cvtpk(p0[14], p0[15]); \
        pw2.x = cvtpk(p1[0], p1[1]); pw2.y = cvtpk(p1[2], p1[3]); pw2.z = cvtpk(p1[4], p1[5]); pw2.w = cvtpk(p1[6], p1[7]); \
        pw3.x = cvtpk(p1[8], p1[9]); pw3.y = cvtpk(p1[10], p1[11]); pw3.z = cvtpk(p1[12], p1[13]); pw3.w = cvtpk(p1[14], p1[15]); \
        pv(o, vb0 + buf * 8192, __builtin_bit_cast(bf16x8, pw0), __builtin_bit_cast(bf16x8, pw1), __builtin_bit_cast(bf16x8, pw2), __builtin_bit_cast(bf16x8, pw3)); \
        if (!(DIAG)) { *(LAS v4u*)(kdst + (buf ^ 1) * 8192) = kreg; *(LAS v4u*)(vdst + (buf ^ 1) * 8192) = vreg; } \
        FA_BAR(); } while (0)
    int j = j_lo;
    for (; j < j_hi; ++j) FA_TILE(false);
    FA_TILE(true);
#undef FA_TILE
    lsum = xsum(lsum);
    if (hi == 0) wsf[32 + r32] = lsum;
    asm volatile("s_waitcnt lgkmcnt(0)" ::: "memory");
#pragma unroll
    for (int r = 0; r < 16; ++r) {
        const int q = crow(r, hi); const float rl = 1.0f / wsf[32 + q]; const size_t mm = (size_t)b * SEQ + 64 * qb + 32 * th + q; const size_t oi = mm * 1024 + hd * 64 + r32;
        if (MODE == 1) { F.OWIN()[oi] = o[0][r] * rl; F.OWIN()[oi + 32] = o[1][r] * rl; }
        else { const float* gt = F.GD() + mm * 64 + hd * 3; const float gc = gt[0], gs = gt[1], gw = gt[2];
            const float a0 = gc * F.OCMP()[oi] + gs * (o[0][r] * rl) + gw * F.OWIN()[oi], a1 = gc * F.OCMP()[oi + 32] + gs * (o[1][r] * rl) + gw * F.OWIN()[oi + 32];
            F.MIX()[mm * DM + hd * 64 + r32] = (bf16)f2bf(a0); F.MIX()[mm * DM + hd * 64 + 32 + r32] = (bf16)f2bf(a1); }
    }
    FA_BAR();
}
__device__ __forceinline__ void sel_phase(const Ctx& F, LAS unsigned char* shm) {
    for (int p = blockIdx.x; p < NB * 4 * 32; p += gridDim.x) { const int bg = p >> 5, s = p & 31; attn_unit<0>(F, shm, bg >> 2, bg & 3, 63 - s); attn_unit<0>(F, shm, bg >> 2, bg & 3, s); }
}
__device__ __forceinline__ void win_phase(const Ctx& F, LAS unsigned char* shm) {
    for (int u = blockIdx.x; u < NB * 4 * 64; u += gridDim.x) { const int bg = u >> 6, qb = u & 63; attn_unit<1>(F, shm, bg >> 2, bg & 3, qb); }
}
}
namespace cmpg {
typedef short bf16x8 __attribute__((ext_vector_type(8)));
typedef short s16x4 __attribute__((ext_vector_type(4)));
typedef float f32x16 __attribute__((ext_vector_type(16)));
constexpr int A_CH = 516 * 16, A_BYTES = 4 * A_CH, B_BYTES = 16384, STG = A_BYTES + B_BYTES, L_W2 = 2 * STG, L_BIAS = L_W2 + 16384, LDS_BYTES_CMP = L_BIAS + 512;
static_assert(LDS_BYTES_CMP <= RING_BYTES, "compress LDS");
typedef float f32x2_t __attribute__((ext_vector_type(2))); typedef __bf16 bf16x2_t __attribute__((ext_vector_type(2)));
__device__ __forceinline__ unsigned cvtpk(float lo, float hi) { f32x2_t v = {lo, hi}; bf16x2_t b = __builtin_convertvector(v, bf16x2_t); return __builtin_bit_cast(unsigned, b); }
__device__ __forceinline__ void unit(const Ctx& F, LAS unsigned char* shm, int unit_id) {
    const int tid = threadIdx.x, lane = tid & 63, r32 = lane & 31, hi = lane >> 5; const int wid = __builtin_amdgcn_readfirstlane(tid >> 6);
    const bool dec = unit_id < 256; const int uu = dec ? unit_id : unit_id - 256;
    const int b = dec ? uu >> 3 : uu >> 2, c = dec ? (uu >> 2) & 1 : (uu >> 1) & 1, q = dec ? uu & 3 : uu & 1, n0 = 128 * q, ncmp = dec ? NCMP_S : NCMP_P, maxpos = dec ? PAST - 1 : SEQ - 1;
    const float* src0 = dec ? F.cache_cmp() : F.out() + O_KCP + (size_t)b * SEQ * 512; const int* pt = F.page_table() + b * 64;
    const bf16* W1T = F.W1T() + (size_t)c * 128 * 2048;
    const int ai = tid >> 2, ag = tid & 3;
    const int xg = tid >> 3, xf = tid & 7;
    const int bu = tid >> 8, bf_ = (tid >> 1) & 127, bh = tid & 1;
    f32x4 ar[8]; f32x4 xr = (f32x4){0.f, 0.f, 0.f, 0.f}; v4u br[2];
#define CG_BASE(blk) ({ int pos_ = 16 * (n0 + (blk)); pos_ = pos_ > maxpos - 15 ? maxpos - 15 : pos_; \
        const float* p_ = dec ? src0 + ((size_t)pt[pos_ >> 7] * 128 + (pos_ & 127)) * 512 : src0 + (size_t)pos_ * 512; p_ + c * 256; })
    const float* abase = CG_BASE(ai) + ag * 64; const float* xbase = CG_BASE(128) + xg * 64 + 4 * xf;
#define CG_LOAD(s) do { const int l_ = (s) >> 1, dh_ = (s) & 1; const float* rp_ = abase + (size_t)l_ * 512 + dh_ * 32; \
        _Pragma("unroll") for (int e_ = 0; e_ < 8; ++e_) ar[e_] = *(const f32x4*)(rp_ + 4 * e_); \
        if (tid < 32) { xr = *(const f32x4*)(xbase + (size_t)l_ * 512 + dh_ * 32); } \
        const bf16* bp_ = W1T + (size_t)bf_ * 2048 + (l_ + 16 * bu) * 64 + dh_ * 32 + bh * 16; br[0] = *(const v4u*)bp_; br[1] = *(const v4u*)(bp_ + 8); } while (0)
#define CG_STORE(bufoff) do { LAS unsigned char* a_ = shm + (bufoff) + (4 * ai + ag) * 16; \
        _Pragma("unroll") for (int ch_ = 0; ch_ < 4; ++ch_) { v4u w_; w_.x = cvtpk(ar[2 * ch_].x, ar[2 * ch_].y); w_.y = cvtpk(ar[2 * ch_].z, ar[2 * ch_].w); w_.z = cvtpk(ar[2 * ch_ + 1].x, ar[2 * ch_ + 1].y); w_.w = cvtpk(ar[2 * ch_ + 1].z, ar[2 * ch_ + 1].w); *(LAS v4u*)(a_ + ch_ * A_CH) = w_; } \
        if (tid < 32) { typedef unsigned u32x2v_ __attribute__((ext_vector_type(2))); u32x2v_ w2_; w2_.x = cvtpk(xr.x, xr.y); w2_.y = cvtpk(xr.z, xr.w); *(LAS u32x2v_*)(shm + (bufoff) + (xf >> 1) * A_CH + (512 + xg) * 16 + (xf & 1) * 8) = w2_; } \
        LAS unsigned char* b_ = shm + (bufoff) + A_BYTES + bu * 8192 + (2 * bh) * 2048 + bf_ * 16; *(LAS v4u*)b_ = br[0]; *(LAS v4u*)(b_ + 2048) = br[1]; } while (0)
    { const int f = tid >> 2, d0 = (tid & 3) * 16; const float* wp = F.cmp_w2() + ((size_t)c * 128 + f) * 64 + d0;
      const f32x4 w0 = *(const f32x4*)wp, w1 = *(const f32x4*)(wp + 4), w2 = *(const f32x4*)(wp + 8), w3 = *(const f32x4*)(wp + 12);
      v4u o0, o1; o0.x = cvtpk(w0.x, w0.y); o0.y = cvtpk(w0.z, w0.w); o0.z = cvtpk(w1.x, w1.y); o0.w = cvtpk(w1.z, w1.w); o1.x = cvtpk(w2.x, w2.y); o1.y = cvtpk(w2.z, w2.w); o1.z = cvtpk(w3.x, w3.y); o1.w = cvtpk(w3.z, w3.w);
      LAS unsigned char* wd = shm + L_W2 + ((d0 >> 5) * 8 + (f >> 4)) * 1024 + (f & 15) * 64 + (d0 & 31) * 2; *(LAS v4u*)wd = o0; *(LAS v4u*)(wd + 16) = o1;
      if (tid < 128) { float pe = 0.f;
#pragma unroll
          for (int kc = 0; kc < 16; ++kc) pe += F.PEB()[(c * 16 + kc) * 128 + tid];
          ((LAS float*)(shm + L_BIAS))[tid] = F.cmp_b1()[c * 128 + tid] + pe; } }
    f32x16 acc[2][4];
#pragma unroll
    for (int rb = 0; rb < 2; ++rb)
#pragma unroll
        for (int fb = 0; fb < 4; ++fb) acc[rb][fb] = f32x16{};
    CG_LOAD(0); CG_STORE(0);
    asm volatile("s_waitcnt vmcnt(0) lgkmcnt(0)\n\ts_barrier" ::: "memory");
    for (int s = 0; s < 32; ++s) {
        const int boff = (s & 1) * STG;
        if (s < 31) CG_LOAD(s + 1);
#pragma unroll
        for (int u = 0; u < 2; ++u)
#pragma unroll
            for (int kk = 0; kk < 2; ++kk) {
                bf16x8 xfr[2], wfr[4];
#pragma unroll
                for (int rb = 0; rb < 2; ++rb) xfr[rb] = *(const LAS bf16x8*)(shm + boff + (2 * kk + hi) * A_CH + (64 * wid + 32 * rb + r32 + 4 * u) * 16);
#pragma unroll
                for (int fb = 0; fb < 4; ++fb) wfr[fb] = *(const LAS bf16x8*)(shm + boff + A_BYTES + u * 8192 + (2 * kk + hi) * 2048 + (32 * fb + r32) * 16);
#pragma unroll
                for (int rb = 0; rb < 2; ++rb)
#pragma unroll
                    for (int fb = 0; fb < 4; ++fb) acc[rb][fb] = __builtin_amdgcn_mfma_f32_32x32x16_bf16(wfr[fb], xfr[rb], acc[rb][fb], 0, 0, 0);
            }
        if (s < 31) CG_STORE(((s + 1) & 1) * STG);
        asm volatile("s_waitcnt vmcnt(0) lgkmcnt(0)\n\ts_barrier" ::: "memory");
    }
#ifdef CHK_CMP
    if (unit_id == 5 || unit_id == 256) { float* HD = (float*)F.H() + (size_t)(unit_id == 5 ? 0 : 1) * 512 * 128;
#pragma unroll
        for (int rb = 0; rb < 2; ++rb)
#pragma unroll
            for (int fb = 0; fb < 4; ++fb)
#pragma unroll
                for (int r = 0; r < 16; ++r) HD[(size_t)(64 * wid + 32 * rb + r32) * 128 + 32 * fb + (r & 3) + 8 * (r >> 2) + 4 * hi] = acc[rb][fb][r]; }
#endif
    const LAS float* hb = (const LAS float*)(shm + L_BIAS);
    const unsigned vb = (unsigned)(uintptr_t)(shm + L_W2) + ((lane >> 4) & 1) * 32 + (lane & 3) * 8 + (4 * hi + ((lane & 15) >> 2)) * 64;
    float* dstb = (dec ? F.KCMPS() : F.KCMPP()) + (size_t)b * ncmp * 512 + c * 256;
    const float b2a = F.cmp_b2()[c * 64 + r32], b2b = F.cmp_b2()[c * 64 + 32 + r32];
#pragma unroll
    for (int rb = 0; rb < 2; ++rb) {
        f32x16 o[2]; o[0] = f32x16{}; o[1] = f32x16{};
#pragma unroll
        for (int fb = 0; fb < 4; ++fb) {
            float h[16];
#pragma unroll
            for (int r = 0; r < 16; ++r) { const float x = acc[rb][fb][r] + hb[32 * fb + (r & 3) + 8 * (r >> 2) + 4 * hi]; h[r] = x / (1.0f + __expf(-x)); }
#pragma unroll
            for (int s2 = 0; s2 < 2; ++s2) {
                v4u pw; pw.x = cvtpk(h[8 * s2], h[8 * s2 + 1]); pw.y = cvtpk(h[8 * s2 + 2], h[8 * s2 + 3]); pw.z = cvtpk(h[8 * s2 + 4], h[8 * s2 + 5]); pw.w = cvtpk(h[8 * s2 + 6], h[8 * s2 + 7]);
                const int ks = 2 * fb + s2;
#pragma unroll
                for (int d0 = 0; d0 < 2; ++d0) { s16x4 lo, hi4;
                    asm volatile("ds_read_b64_tr_b16 %0,%1 offset:%c2" : "=&v"(lo) : "v"(vb), "i"(d0 * 8192 + ks * 1024) : "memory");
                    asm volatile("ds_read_b64_tr_b16 %0,%1 offset:%c2" : "=&v"(hi4) : "v"(vb), "i"(d0 * 8192 + ks * 1024 + 512) : "memory");
                    asm volatile("s_waitcnt lgkmcnt(0)" ::: "memory"); __builtin_amdgcn_sched_barrier(0);
                    const bf16x8 wf = (bf16x8){lo[0], lo[1], lo[2], lo[3], hi4[0], hi4[1], hi4[2], hi4[3]};
                    o[d0] = __builtin_amdgcn_mfma_f32_32x32x16_bf16(__builtin_bit_cast(bf16x8, pw), wf, o[d0], 0, 0, 0); }
            }
        }
#pragma unroll
        for (int r = 0; r < 16; ++r) { const int R = 64 * wid + 32 * rb + (r & 3) + 8 * (r >> 2) + 4 * hi, n = n0 + (R >> 2), g = R & 3;
            if (n < ncmp) { float* d = dstb + (size_t)n * 512 + g * 64; d[r32] = o[0][r] + b2a; d[32 + r32] = o[1][r] + b2b; } }
    }
    asm volatile("s_waitcnt vmcnt(0) lgkmcnt(0)\n\ts_barrier" ::: "memory");
#undef CG_BASE
#undef CG_LOAD
#undef CG_STORE
}

__device__ __forceinline__ void small_unit(const Ctx& F, LAS unsigned char* shm, int u) {
    const int tid = threadIdx.x, lane = tid & 63, r32 = lane & 31, hi = lane >> 5; const int wid = __builtin_amdgcn_readfirstlane(tid >> 6);
    const int b = u >> 6, c = (u >> 5) & 1, n0 = 8 * (u & 31), fb = wid & 3, lh = wid >> 2;
    constexpr int L_W2S = 0, L_BS = 16384, L_PA = 20480, L_PO = 36864;
    { const int f = tid >> 2, d0 = (tid & 3) * 16; const float* wp = F.cmp_w2() + ((size_t)c * 128 + f) * 64 + d0;
      const f32x4 w0 = *(const f32x4*)wp, w1 = *(const f32x4*)(wp + 4), w2 = *(const f32x4*)(wp + 8), w3 = *(const f32x4*)(wp + 12);
      v4u o0, o1; o0.x = cvtpk(w0.x, w0.y); o0.y = cvtpk(w0.z, w0.w); o0.z = cvtpk(w1.x, w1.y); o0.w = cvtpk(w1.z, w1.w); o1.x = cvtpk(w2.x, w2.y); o1.y = cvtpk(w2.z, w2.w); o1.z = cvtpk(w3.x, w3.y); o1.w = cvtpk(w3.z, w3.w);
      LAS unsigned char* wd = shm + L_W2S + ((d0 >> 5) * 8 + (f >> 4)) * 1024 + (f & 15) * 64 + (d0 & 31) * 2; *(LAS v4u*)wd = o0; *(LAS v4u*)(wd + 16) = o1;
      if (tid < 128) { float pe = 0.f;
#pragma unroll
          for (int kc = 0; kc < 16; ++kc) pe += F.PEB()[(c * 16 + kc) * 128 + tid];
          ((LAS float*)(shm + L_BS))[tid] = F.cmp_b1()[c * 128 + tid] + pe; } }
    const int bi = r32 >> 2, g = r32 & 3;
    const float* xb = F.out() + O_KCP + (size_t)b * SEQ * 512 + c * 256 + g * 64 + hi * 8;
    const bf16* wb = F.W1T() + (size_t)c * 128 * 2048 + (size_t)(32 * fb + r32) * 2048 + hi * 8;
    f32x16 acc = f32x16{};
    for (int li = 0; li < 8; ++li) { const int l = 2 * li + lh;
#pragma unroll
        for (int uu = 0; uu < 2; ++uu) { int pos = 16 * (n0 + bi + uu) + l; pos = pos > SEQ - 1 ? SEQ - 1 : pos; const float* xr = xb + (size_t)pos * 512; const bf16* wr = wb + (l + 16 * uu) * 64;
#pragma unroll
            for (int kk = 0; kk < 4; ++kk) { const f32x4 x0 = *(const f32x4*)(xr + 16 * kk), x1 = *(const f32x4*)(xr + 16 * kk + 4);
                v4u xw; xw.x = cvtpk(x0.x, x0.y); xw.y = cvtpk(x0.z, x0.w); xw.z = cvtpk(x1.x, x1.y); xw.w = cvtpk(x1.z, x1.w);
                acc = __builtin_amdgcn_mfma_f32_32x32x16_bf16(*(const bf16x8*)(wr + 16 * kk), __builtin_bit_cast(bf16x8, xw), acc, 0, 0, 0); } } }
    LAS float* pa = (LAS float*)(shm + L_PA) + fb * 1024;
    if (lh == 1) {
#pragma unroll
        for (int r = 0; r < 16; ++r) pa[r * 64 + lane] = acc[r]; }
    asm volatile("s_waitcnt vmcnt(0) lgkmcnt(0)\n\ts_barrier" ::: "memory");
    LAS float* po = (LAS float*)(shm + L_PO) + fb * 2048;
    if (lh == 0) {
        const LAS float* hb = (const LAS float*)(shm + L_BS);
        const unsigned vb = (unsigned)(uintptr_t)(shm + L_W2S) + ((lane >> 4) & 1) * 32 + (lane & 3) * 8 + (4 * hi + ((lane & 15) >> 2)) * 64 + fb * 2048;
        float h[16];
#pragma unroll
        for (int r = 0; r < 16; ++r) { const float x = acc[r] + pa[r * 64 + lane] + hb[32 * fb + (r & 3) + 8 * (r >> 2) + 4 * hi]; h[r] = x / (1.0f + __expf(-x)); }
        f32x16 o[2]; o[0] = f32x16{}; o[1] = f32x16{};
#pragma unroll
        for (int s2 = 0; s2 < 2; ++s2) {
            v4u pw; pw.x = cvtpk(h[8 * s2], h[8 * s2 + 1]); pw.y = cvtpk(h[8 * s2 + 2], h[8 * s2 + 3]); pw.z = cvtpk(h[8 * s2 + 4], h[8 * s2 + 5]); pw.w = cvtpk(h[8 * s2 + 6], h[8 * s2 + 7]);
#pragma unroll
            for (int d0 = 0; d0 < 2; ++d0) { s16x4 lo, hi4;
                asm volatile("ds_read_b64_tr_b16 %0,%1 offset:%c2" : "=&v"(lo) : "v"(vb), "i"(d0 * 8192 + s2 * 1024) : "memory");
                asm volatile("ds_read_b64_tr_b16 %0,%1 offset:%c2" : "=&v"(hi4) : "v"(vb), "i"(d0 * 8192 + s2 * 1024 + 512) : "memory");
                asm volatile("s_waitcnt lgkmcnt(0)" ::: "memory"); __builtin_amdgcn_sched_barrier(0);
                const bf16x8 wf = (bf16x8){lo[0], lo[1], lo[2], lo[3], hi4[0], hi4[1], hi4[2], hi4[3]};
                o[d0] = __builtin_amdgcn_mfma_f32_32x32x16_bf16(__builtin_bit_cast(bf16x8, pw), wf, o[d0], 0, 0, 0); } }
#pragma unroll
        for (int r = 0; r < 16; ++r) { po[r * 64 + lane] = o[0][r]; po[1024 + r * 64 + lane] = o[1][r]; }
    }
    asm volatile("s_waitcnt vmcnt(0) lgkmcnt(0)\n\ts_barrier" ::: "memory");
#pragma unroll
    for (int e = 0; e < 4; ++e) { const int idx = e * 512 + tid, d0 = idx >> 10, r = (idx >> 6) & 15, ln = idx & 63; const LAS float* pp = (const LAS float*)(shm + L_PO) + d0 * 1024 + r * 64 + ln;
        const float v = (pp[0] + pp[2048]) + (pp[4096] + pp[6144]);
        const int R = (r & 3) + 8 * (r >> 2) + 4 * (ln >> 5), n = n0 + (R >> 2), gg = R & 3, d = 32 * d0 + (ln & 31);
        if (n < NCMP_P) F.KCMPP()[((size_t)(b * NCMP_P + n) * 2 + c) * 256 + gg * 64 + d] = v + F.cmp_b2()[c * 64 + d]; }
    asm volatile("s_waitcnt vmcnt(0) lgkmcnt(0)\n\ts_barrier" ::: "memory");
}
}
namespace ssd {
typedef short bf16x8 __attribute__((ext_vector_type(8)));
typedef short s16x4 __attribute__((ext_vector_type(4)));
typedef float f32x16 __attribute__((ext_vector_type(16)));
typedef float f32x2_t __attribute__((ext_vector_type(2))); typedef __bf16 bf16x2_t __attribute__((ext_vector_type(2)));
__device__ __forceinline__ unsigned cvtpk(float lo, float hi) { f32x2_t v = {lo, hi}; bf16x2_t b = __builtin_convertvector(v, bf16x2_t); return __builtin_bit_cast(unsigned, b); }
constexpr int L_B = 0, L_X = 65536, L_ACS = 98304, L_E = 99328, LDS_BYTES_SSD = 100352;
__device__ __forceinline__ int crow(int r, int hi) { return (r & 3) + 8 * (r >> 2) + 4 * hi; }
#define SSD_BAR() asm volatile("s_waitcnt vmcnt(0) lgkmcnt(0)\n\ts_barrier" ::: "memory")
__device__ __forceinline__ void local_unit(const Ctx& F, LAS unsigned char* shm, int u) {
    const int tid = threadIdx.x, lane = tid & 63, r32 = lane & 31, hi = lane >> 5; const int wid = __builtin_amdgcn_readfirstlane(tid >> 6);
    const int b = u >> 8, c = (u >> 4) & 15, h = u & 15, grp = h >> 3; const size_t m0 = (size_t)b * SEQ + c * 256;
    const bf16* XA = F.XBCA16() + m0 * CONV_DIM; const float* DTp = F.DT() + m0 * 16 + h;
    LAS float* acs = (LAS float*)(shm + L_ACS); LAS float* et = (LAS float*)(shm + L_E);
    const float A = -__expf(F.a_log()[h]);
    if (wid == 0) { float a[4], tot = 0.f;
#pragma unroll
        for (int e = 0; e < 4; ++e) { tot += DTp[(size_t)(4 * lane + e) * 16] * A; a[e] = tot; }
        float x = tot;
#pragma unroll
        for (int o = 1; o < 64; o <<= 1) { const float y = __shfl_up(x, o); if (lane >= o) x += y; }
        const float excl = x - tot;
#pragma unroll
        for (int e = 0; e < 4; ++e) { acs[4 * lane + e] = excl + a[e]; F.ACS()[(m0 + 4 * lane + e) * 16 + h] = excl + a[e]; }
        if (lane == 63) F.DEC()[(b * 16 + c) * 16 + h] = __expf(x); }
    { const int s = tid >> 1, hf = tid & 1; const bf16* br = XA + (size_t)s * CONV_DIM + 1024 + grp * 128 + hf * 64;
#pragma unroll
      for (int i = 0; i < 8; ++i) *(LAS v4u*)(shm + L_B + (hf * 8 + i) * 4096 + s * 16) = *(const v4u*)(br + 8 * i);
      const bf16* xr = XA + (size_t)s * CONV_DIM + h * 64 + hf * 32; const float dt = DTp[(size_t)s * 16];
      LAS unsigned char* xd = shm + L_X + (hf * 16 + (s >> 4)) * 1024 + (s & 15) * 64;
#pragma unroll
      for (int i = 0; i < 4; ++i) { const v4u t = *(const v4u*)(xr + 8 * i); v4u o;
          o.x = cvtpk(__uint_as_float(t.x << 16) * dt, __uint_as_float(t.x & 0xffff0000u) * dt); o.y = cvtpk(__uint_as_float(t.y << 16) * dt, __uint_as_float(t.y & 0xffff0000u) * dt);
          o.z = cvtpk(__uint_as_float(t.z << 16) * dt, __uint_as_float(t.z & 0xffff0000u) * dt); o.w = cvtpk(__uint_as_float(t.w << 16) * dt, __uint_as_float(t.w & 0xffff0000u) * dt);
          *(LAS v4u*)(xd + i * 16) = o; } }
    bf16x8 cf[8];
    { const bf16* cr = XA + (size_t)(32 * wid + r32) * CONV_DIM + 1280 + grp * 128 + hi * 8;
#pragma unroll
      for (int kk = 0; kk < 8; ++kk) cf[kk] = *(const bf16x8*)(cr + 16 * kk); }
    SSD_BAR();
    if (tid < 256) et[tid] = __expf(acs[255] - acs[tid]);
    const float acl = acs[32 * wid + r32];
    f32x16 o[2]; o[0] = f32x16{}; o[1] = f32x16{};
    const int jmax = (32 * wid + 31) >> 6, lrel = 32 * wid + r32;
    const unsigned vbx = (unsigned)(uintptr_t)(shm + L_X) + ((lane >> 4) & 1) * 32 + (lane & 3) * 8 + (4 * hi + ((lane & 15) >> 2)) * 64;
    for (int j = 0; j <= jmax; ++j) {
        f32x16 p0 = f32x16{}, p1 = f32x16{};
        const LAS unsigned char* kb = shm + L_B + hi * 4096 + (64 * j + r32) * 16;
#pragma unroll
        for (int kk = 0; kk < 8; ++kk) { const bf16x8 b0 = *(const LAS bf16x8*)(kb + kk * 8192), b1 = *(const LAS bf16x8*)(kb + kk * 8192 + 512);
            p0 = __builtin_amdgcn_mfma_f32_32x32x16_bf16(b0, cf[kk], p0, 0, 0, 0); p1 = __builtin_amdgcn_mfma_f32_32x32x16_bf16(b1, cf[kk], p1, 0, 0, 0); }
#pragma unroll
        for (int q = 0; q < 4; ++q) { const f32x4 a0 = *(const LAS f32x4*)(acs + 64 * j + 8 * q + 4 * hi), a1 = *(const LAS f32x4*)(acs + 64 * j + 32 + 8 * q + 4 * hi);
#pragma unroll
            for (int e = 0; e < 4; ++e) { const int r = 4 * q + e, s0 = 64 * j + 8 * q + 4 * hi + e;
                p0[r] = (s0 <= lrel) ? p0[r] * __expf(acl - a0[e]) : 0.f; p1[r] = (s0 + 32 <= lrel) ? p1[r] * __expf(acl - a1[e]) : 0.f; } }
        v4u pw0, pw1, pw2, pw3;
        pw0.x = cvtpk(p0[0], p0[1]); pw0.y = cvtpk(p0[2], p0[3]); pw0.z = cvtpk(p0[4], p0[5]); pw0.w = cvtpk(p0[6], p0[7]);
        pw1.x = cvtpk(p0[8], p0[9]); pw1.y = cvtpk(p0[10], p0[11]); pw1.z = cvtpk(p0[12], p0[13]); pw1.w = cvtpk(p0[14], p0[15]);
        pw2.x = cvtpk(p1[0], p1[1]); pw2.y = cvtpk(p1[2], p1[3]); pw2.z = cvtpk(p1[4], p1[5]); pw2.w = cvtpk(p1[6], p1[7]);
        pw3.x = cvtpk(p1[8], p1[9]); pw3.y = cvtpk(p1[10], p1[11]); pw3.z = cvtpk(p1[12], p1[13]); pw3.w = cvtpk(p1[14], p1[15]);
        const unsigned vb = vbx + j * 4096;
#pragma unroll
        for (int d0 = 0; d0 < 2; ++d0) { s16x4 lo[4], hi4[4];
#pragma unroll
            for (int ks = 0; ks < 4; ++ks) {
                asm volatile("ds_read_b64_tr_b16 %0,%1 offset:%c2" : "=&v"(lo[ks]) : "v"(vb), "i"(d0 * 16384 + ks * 1024) : "memory");
                asm volatile("ds_read_b64_tr_b16 %0,%1 offset:%c2" : "=&v"(hi4[ks]) : "v"(vb), "i"(d0 * 16384 + ks * 1024 + 512) : "memory"); }
            asm volatile("s_waitcnt lgkmcnt(0)" ::: "memory"); __builtin_amdgcn_sched_barrier(0);
#define SSD_PK(k) (bf16x8){lo[k][0], lo[k][1], lo[k][2], lo[k][3], hi4[k][0], hi4[k][1], hi4[k][2], hi4[k][3]}
            o[d0] = __builtin_amdgcn_mfma_f32_32x32x16_bf16(__builtin_bit_cast(bf16x8, pw0), SSD_PK(0), o[d0], 0, 0, 0);
            o[d0] = __builtin_amdgcn_mfma_f32_32x32x16_bf16(__builtin_bit_cast(bf16x8, pw1), SSD_PK(1), o[d0], 0, 0, 0);
            o[d0] = __builtin_amdgcn_mfma_f32_32x32x16_bf16(__builtin_bit_cast(bf16x8, pw2), SSD_PK(2), o[d0], 0, 0, 0);
            o[d0] = __builtin_amdgcn_mfma_f32_32x32x16_bf16(__builtin_bit_cast(bf16x8, pw3), SSD_PK(3), o[d0], 0, 0, 0);
#undef SSD_PK
        }
    }
#pragma unroll
    for (int r = 0; r < 16; ++r) { float* yp = F.YSSD() + (m0 + 32 * wid + crow(r, hi)) * 1024 + h * 64 + r32; yp[0] = o[0][r]; yp[32] = o[1][r]; }
    { const int pb = wid & 1, nb = wid >> 1; f32x16 st = f32x16{};
      const int li = lane & 15, g16 = (lane >> 4) & 1, c4 = li & 3;
      const unsigned vbB = (unsigned)(uintptr_t)(shm + L_B) + (4 * nb + 2 * g16 + (c4 >> 1)) * 4096 + (4 * hi + (li >> 2)) * 16 + (c4 & 1) * 8;
      const unsigned vbA = vbx + pb * 16384;
      SSD_BAR();
      for (int ks = 0; ks < 16; ++ks) { s16x4 xl, xh, bl, bh;
          asm volatile("ds_read_b64_tr_b16 %0,%1" : "=&v"(xl) : "v"(vbA + ks * 1024) : "memory");
          asm volatile("ds_read_b64_tr_b16 %0,%1 offset:512" : "=&v"(xh) : "v"(vbA + ks * 1024) : "memory");
          asm volatile("ds_read_b64_tr_b16 %0,%1" : "=&v"(bl) : "v"(vbB + ks * 256) : "memory");
          asm volatile("ds_read_b64_tr_b16 %0,%1 offset:128" : "=&v"(bh) : "v"(vbB + ks * 256) : "memory");
          const f32x4 e0 = *(const LAS f32x4*)(et + 16 * ks + 4 * hi), e1 = *(const LAS f32x4*)(et + 16 * ks + 8 + 4 * hi);
          asm volatile("s_waitcnt lgkmcnt(0)" ::: "memory"); __builtin_amdgcn_sched_barrier(0);
          v4u xa;
          xa.x = cvtpk(__uint_as_float((unsigned)(unsigned short)xl[0] << 16) * e0[0], __uint_as_float((unsigned)(unsigned short)xl[1] << 16) * e0[1]);
          xa.y = cvtpk(__uint_as_float((unsigned)(unsigned short)xl[2] << 16) * e0[2], __uint_as_float((unsigned)(unsigned short)xl[3] << 16) * e0[3]);
          xa.z = cvtpk(__uint_as_float((unsigned)(unsigned short)xh[0] << 16) * e1[0], __uint_as_float((unsigned)(unsigned short)xh[1] << 16) * e1[1]);
          xa.w = cvtpk(__uint_as_float((unsigned)(unsigned short)xh[2] << 16) * e1[2], __uint_as_float((unsigned)(unsigned short)xh[3] << 16) * e1[3]);
          const bf16x8 bfr = (bf16x8){bl[0], bl[1], bl[2], bl[3], bh[0], bh[1], bh[2], bh[3]};
          st = __builtin_amdgcn_mfma_f32_32x32x16_bf16(__builtin_bit_cast(bf16x8, xa), bfr, st, 0, 0, 0); }
      float* sp = F.ST() + ((size_t)((b * 16 + c) * 16 + h)) * 8192 + 32 * nb + r32;
#pragma unroll
      for (int r = 0; r < 16; ++r) sp[(size_t)(32 * pb + crow(r, hi)) * 128] = st[r]; }
    SSD_BAR();
}

__device__ __forceinline__ void final_unit(const Ctx& F, LAS unsigned char* shm, int u) {
    const int tid = threadIdx.x, lane = tid & 63, r32 = lane & 31, hi = lane >> 5; const int wid = __builtin_amdgcn_readfirstlane(tid >> 6);
    const int qq = u & 3, grp = (u >> 2) & 1, c = (u >> 3) & 15, b = u >> 7, h = 8 * grp + wid; const size_t m0 = (size_t)b * SEQ + c * 256 + qq * 64;
    f32x16 acc[2][2];
#pragma unroll
    for (int pb = 0; pb < 2; ++pb) {
        bf16x8 sfr[8];
        { int lane_o = lane; asm volatile("" : "+v"(lane_o));
          const bf16* sp = F.SIN() + ((size_t)((b * 16 + c) * 16 + h) * 16 + pb * 8) * 512 + lane_o * 8;
#pragma unroll
          for (int kk = 0; kk < 8; ++kk) sfr[kk] = *(const bf16x8*)(sp + kk * 512); }
#pragma unroll
        for (int lb = 0; lb < 2; ++lb) { const bf16* cr = F.XBCA16() + (m0 + 32 * lb + r32) * CONV_DIM + 1280 + grp * 128 + hi * 8; f32x16 a = f32x16{};
#pragma unroll
            for (int kk = 0; kk < 8; ++kk) a = __builtin_amdgcn_mfma_f32_32x32x16_bf16(*(const bf16x8*)(cr + 16 * kk), sfr[kk], a, 0, 0, 0);
            acc[lb][pb] = a; }
    }
    LAS float* yt = (LAS float*)shm;
#pragma unroll
    for (int lb = 0; lb < 2; ++lb)
#pragma unroll
        for (int r = 0; r < 16; ++r) { LAS float* yp = yt + (32 * lb + crow(r, hi)) * 512 + wid * 64 + r32; yp[0] = acc[lb][0][r]; yp[32] = acc[lb][1][r]; }
    SSD_BAR();
    { const int hl = lane >> 3, hh = 8 * grp + hl, ch = hh * 64 + 8 * (lane & 7);
      const float Dk = F.d_skip()[hh]; const f32x4 n0 = *(const f32x4*)(F.ssm_norm() + ch), n1 = *(const f32x4*)(F.ssm_norm() + ch + 4);
#pragma unroll
      for (int half = 0; half < 2; ++half) {
          f32x4 yd[4][2], zz[4][2]; v4u xx[4]; float ea[4];
#pragma unroll
          for (int i = 0; i < 4; ++i) { const size_t mm = m0 + 8 * wid + 4 * half + i;
              yd[i][0] = *(const f32x4*)(F.YSSD() + mm * 1024 + ch); yd[i][1] = *(const f32x4*)(F.YSSD() + mm * 1024 + ch + 4); zz[i][0] = *(const f32x4*)(F.Z() + mm * 1024 + ch); zz[i][1] = *(const f32x4*)(F.Z() + mm * 1024 + ch + 4);
              xx[i] = *(const v4u*)(F.XBCA16() + mm * CONV_DIM + ch); ea[i] = __expf(F.ACS()[mm * 16 + hh]); }
#pragma unroll
          for (int i = 0; i < 4; ++i) { const int row = 8 * wid + 4 * half + i; const size_t mm = m0 + row;
              const f32x4 a0 = *(const LAS f32x4*)(yt + row * 512 + hl * 64 + 8 * (lane & 7)), a1 = *(const LAS f32x4*)(yt + row * 512 + hl * 64 + 8 * (lane & 7) + 4);
              float v[8] = {a0.x, a0.y, a0.z, a0.w, a1.x, a1.y, a1.z, a1.w};
              const float xv[8] = {__uint_as_float(xx[i].x << 16), __uint_as_float(xx[i].x & 0xffff0000u), __uint_as_float(xx[i].y << 16), __uint_as_float(xx[i].y & 0xffff0000u), __uint_as_float(xx[i].z << 16), __uint_as_float(xx[i].z & 0xffff0000u), __uint_as_float(xx[i].w << 16), __uint_as_float(xx[i].w & 0xffff0000u)};
              const float yv[8] = {yd[i][0].x, yd[i][0].y, yd[i][0].z, yd[i][0].w, yd[i][1].x, yd[i][1].y, yd[i][1].z, yd[i][1].w}, zv[8] = {zz[i][0].x, zz[i][0].y, zz[i][0].z, zz[i][0].w, zz[i][1].x, zz[i][1].y, zz[i][1].z, zz[i][1].w};
              float ss = 0.f;
#pragma unroll
              for (int e = 0; e < 8; ++e) { float y = v[e] * ea[i] + yv[e] + Dk * xv[e]; y *= zv[e] / (1.0f + __expf(-zv[e])); v[e] = y; ss += y * y; }
              const float rstd = 1.0f / sqrtf(wave_sum(ss) * (1.0f / 512.0f) + NORM_EPS);
              v4u w; w.x = cvtpk(v[0] * rstd * n0.x, v[1] * rstd * n0.y); w.y = cvtpk(v[2] * rstd * n0.z, v[3] * rstd * n0.w); w.z = cvtpk(v[4] * rstd * n1.x, v[5] * rstd * n1.y); w.w = cvtpk(v[6] * rstd * n1.z, v[7] * rstd * n1.w);
              *(v4u*)(F.MIX() + mm * DM + 1024 + ch) = w; } } }
    SSD_BAR();
}


__device__ __forceinline__ void carry_phase(const Ctx& F) {
    const int gt = blockIdx.x * (NWAVES * 64) + threadIdx.x, NGT = gridDim.x * NWAVES * 64;
    for (int i = gt; i < NB * 16 * 64 * 16; i += NGT) { const int n8 = i & 15, p = (i >> 4) & 63, h = (i >> 10) & 15, b = i >> 14;
        const int pb = p >> 5, kk = n8 >> 1, ln = (n8 & 1) * 32 + (p & 31);
        float sv[8] = {0.f, 0.f, 0.f, 0.f, 0.f, 0.f, 0.f, 0.f};
        for (int c = 0; c < 16; ++c) { const size_t ci = (size_t)(b * 16 + c) * 16 + h;
            v4u w; w.x = cvtpk(sv[0], sv[1]); w.y = cvtpk(sv[2], sv[3]); w.z = cvtpk(sv[4], sv[5]); w.w = cvtpk(sv[6], sv[7]);
            *(v4u*)(F.SIN() + ((ci * 16 + pb * 8 + kk) * 64 + ln) * 8) = w;
            const float dec = F.DEC()[ci]; const float* sp = F.ST() + ci * 8192 + (size_t)p * 128 + n8 * 8; const f32x4 a = *(const f32x4*)sp, d = *(const f32x4*)(sp + 4);
            sv[0] = sv[0] * dec + a.x; sv[1] = sv[1] * dec + a.y; sv[2] = sv[2] * dec + a.z; sv[3] = sv[3] * dec + a.w; sv[4] = sv[4] * dec + d.x; sv[5] = sv[5] * dec + d.y; sv[6] = sv[6] * dec + d.z; sv[7] = sv[7] * dec + d.w; }
        float* op = F.out() + O_SSP + ((size_t)(b * 16 + h) * 64 + p) * 128 + n8 * 8;
        *(f32x4*)op = (f32x4){sv[0], sv[1], sv[2], sv[3]}; *(f32x4*)(op + 4) = (f32x4){sv[4], sv[5], sv[6], sv[7]}; }
}
}
namespace cmpa {
using fa::bf16x8; using fa::f32x16;
constexpr int LK = 0, LV = 32768, LPS = 65536, PS_W = 8 * 264 * 4, IMP_W = 8 * 64 * 4, WAVE_B = PS_W + IMP_W;
static_assert(LPS + 8 * WAVE_B <= RING_BYTES, "cmpa LDS");
__device__ __forceinline__ float quad_sum(float v) {
    v += __int_as_float(__builtin_amdgcn_mov_dpp(__float_as_int(v), 0xB1, 0xF, 0xF, true));
    v += __int_as_float(__builtin_amdgcn_mov_dpp(__float_as_int(v), 0x4E, 0xF, 0xF, true));
    return v; }
__device__ __forceinline__ void unit(const Ctx& F, LAS unsigned char* shm, int b, int g, int qb) {
    const int tid = threadIdx.x, lane = tid & 63, r32 = lane & 31, hi = lane >> 5; const int wid = __builtin_amdgcn_readfirstlane(tid >> 6);
    const int ntile = (4 * qb + 3 + 63) >> 6;
    const float* KC = F.KCMPP() + (size_t)b * NCMP_P * 512 + g * 64;
    for (int t = 0; t < ntile; ++t) {
        int nk = 64 * t + lane; nk = nk > NCMP_P - 1 ? NCMP_P - 1 : nk; const float* kp = KC + (size_t)nk * 512 + wid * 8; const f32x4 k0 = *(const f32x4*)kp, k1 = *(const f32x4*)(kp + 4);
        v4u kw; kw.x = fa::cvtpk(k0.x, k0.y); kw.y = fa::cvtpk(k0.z, k0.w); kw.z = fa::cvtpk(k1.x, k1.y); kw.w = fa::cvtpk(k1.z, k1.w);
        *(LAS v4u*)(shm + LK + t * 8192 + wid * 1024 + lane * 16) = kw;
        int nv = 64 * t + 16 * (wid & 3) + (lane >> 2); nv = nv > NCMP_P - 1 ? NCMP_P - 1 : nv; const float* vp = KC + 256 + (size_t)nv * 512 + (wid >> 2) * 32 + (lane & 3) * 8; const f32x4 v0 = *(const f32x4*)vp, v1 = *(const f32x4*)(vp + 4);
        v4u vw; vw.x = fa::cvtpk(v0.x, v0.y); vw.y = fa::cvtpk(v0.z, v0.w); vw.z = fa::cvtpk(v1.x, v1.y); vw.w = fa::cvtpk(v1.z, v1.w);
        *(LAS v4u*)(shm + LV + t * 8192 + wid * 1024 + lane * 16) = vw; }
    const int tl = r32 >> 2, hd = 4 * g + (r32 & 3), t = 64 * qb + 8 * wid + tl; const size_t m = (size_t)b * SEQ + t;
    bf16x8 qr[4];
    { const bf16* Qp = F.QB() + m * 1024 + hd * 64 + hi * 8;
#pragma unroll
      for (int d0 = 0; d0 < 4; ++d0) qr[d0] = *(const bf16x8*)(Qp + 16 * d0); }
    FA_BAR();
    const int nvis = t >= 31 ? ((t - 31) >> 4) + 1 : 0;
    float mx = fa::MASKV, lsum = 0.f;
    for (int tt = 0; tt < ntile; ++tt) { f32x16 p0, p1; fa::qkt(p0, p1, shm + LK + tt * 8192, qr, r32, hi);
#pragma unroll
        for (int r = 0; r < 16; ++r) { const int n0 = 64 * tt + fa::crow(r, hi); p0[r] = n0 < nvis ? p0[r] * fa::C2 : fa::MASKV; p1[r] = n0 + 32 < nvis ? p1[r] * fa::C2 : fa::MASKV; }
        const float mn = fmaxf(mx, fa::rowmax(p0, p1)); float acc = 0.f;
#pragma unroll
        for (int r = 0; r < 16; ++r) { const int n0 = 64 * tt + fa::crow(r, hi); acc += (n0 < nvis ? __builtin_amdgcn_exp2f(p0[r] - mn) : 0.f) + (n0 + 32 < nvis ? __builtin_amdgcn_exp2f(p1[r] - mn) : 0.f); }
        lsum = lsum * __builtin_amdgcn_exp2f(mx - mn) + acc; mx = mn; }
    lsum = fa::xsum(lsum); const float inv = 1.0f / fmaxf(lsum, 1e-30f);
    LAS float* ps = (LAS float*)(shm + LPS + wid * WAVE_B); LAS float* impl = (LAS float*)(shm + LPS + wid * WAVE_B + PS_W);
    for (int i = lane; i < 8 * 264; i += 64) ps[i] = 0.f;
    asm volatile("s_waitcnt lgkmcnt(0)" ::: "memory");
    f32x16 o[2]; o[0] = f32x16{}; o[1] = f32x16{};
    const unsigned vb0 = (unsigned)(uintptr_t)(shm + LV) + ((lane >> 4) & 1) * 32 + (lane & 3) * 8 + (4 * hi + ((lane & 15) >> 2)) * 64;
    for (int tt = 0; tt < ntile; ++tt) { f32x16 p0, p1; fa::qkt(p0, p1, shm + LK + tt * 8192, qr, r32, hi);
#pragma unroll
        for (int r = 0; r < 16; ++r) { const int n0 = 64 * tt + fa::crow(r, hi); p0[r] = n0 < nvis ? __builtin_amdgcn_exp2f(p0[r] * fa::C2 - mx) * inv : 0.f; p1[r] = n0 + 32 < nvis ? __builtin_amdgcn_exp2f(p1[r] * fa::C2 - mx) * inv : 0.f; }
        v4u pw0, pw1, pw2, pw3;
        pw0.x = fa::cvtpk(p0[0], p0[1]); pw0.y = fa::cvtpk(p0[2], p0[3]); pw0.z = fa::cvtpk(p0[4], p0[5]); pw0.w = fa::cvtpk(p0[6], p0[7]);
        pw1.x = fa::cvtpk(p0[8], p0[9]); pw1.y = fa::cvtpk(p0[10], p0[11]); pw1.z = fa::cvtpk(p0[12], p0[13]); pw1.w = fa::cvtpk(p0[14], p0[15]);
        pw2.x = fa::cvtpk(p1[0], p1[1]); pw2.y = fa::cvtpk(p1[2], p1[3]); pw2.z = fa::cvtpk(p1[4], p1[5]); pw2.w = fa::cvtpk(p1[6], p1[7]);
        pw3.x = fa::cvtpk(p1[8], p1[9]); pw3.y = fa::cvtpk(p1[10], p1[11]); pw3.z = fa::cvtpk(p1[12], p1[13]); pw3.w = fa::cvtpk(p1[14], p1[15]);
        fa::pv(o, vb0 + tt * 8192, __builtin_bit_cast(bf16x8, pw0), __builtin_bit_cast(bf16x8, pw1), __builtin_bit_cast(bf16x8, pw2), __builtin_bit_cast(bf16x8, pw3));
#pragma unroll
        for (int r = 0; r < 16; ++r) { const float s0 = quad_sum(p0[r]), s1 = quad_sum(p1[r]);
            if ((r32 & 3) == (tt & 3)) { const int n0 = 64 * tt + fa::crow(r, hi); ps[tl * 264 + 1 + n0] = s0; ps[tl * 264 + 1 + n0 + 32] = s1; } } }
#pragma unroll
    for (int r = 0; r < 16; ++r) { const int q = fa::crow(r, hi); float* op = F.OCMP() + ((size_t)b * SEQ + 64 * qb + 8 * wid + (q >> 2)) * 1024 + (4 * g + (q & 3)) * 64 + r32; op[0] = o[0][r]; op[32] = o[1][r]; }
    asm volatile("s_waitcnt lgkmcnt(0)" ::: "memory");
    const int tk = lane >> 3, jsub = lane & 7; float mine[8];
#pragma unroll
    for (int k = 0; k < 8; ++k) { const int j = jsub + 8 * k; const LAS float* pp = ps + tk * 264 + 4 * j;
        float v = pp[0] + 2.0f * (pp[1] + pp[2] + pp[3]) + pp[4];
        if (j == 0 || j == qb || j == qb - 1) v = 1.0e4f; if (j > qb) v = -1.0e4f;
        mine[k] = v; impl[tk * 64 + j] = v; }
    asm volatile("s_waitcnt lgkmcnt(0)" ::: "memory");
    int cnt[8];
#pragma unroll
    for (int k = 0; k < 8; ++k) cnt[k] = 0;
    for (int i4 = 0; i4 < 16; ++i4) { const f32x4 vv = *(const LAS f32x4*)(impl + tk * 64 + 4 * i4);
#pragma unroll
        for (int e = 0; e < 4; ++e) { const float v = vv[e]; const int kk = 4 * i4 + e;
#pragma unroll
            for (int k = 0; k < 8; ++k) { const int j = jsub + 8 * k; cnt[k] += ((v > mine[k]) || (v == mine[k] && kk < j)) ? 1 : 0; } } }
    unsigned mlo = 0u, mhi = 0u;
#pragma unroll
    for (int k = 0; k < 8; ++k) { if (cnt[k] < 16) { const int j = jsub + 8 * k; if (j < 32) mlo |= 1u << j; else mhi |= 1u << (j - 32); } }
#pragma unroll
    for (int o2 = 1; o2 < 8; o2 <<= 1) { mlo |= (unsigned)__shfl_xor((int)mlo, o2); mhi |= (unsigned)__shfl_xor((int)mhi, o2); }
    if (jsub == 0) F.SELMASK()[((size_t)b * SEQ + 64 * qb + 8 * wid + tk) * 4 + g] = ((unsigned long long)mhi << 32) | mlo;
    FA_BAR();
}
__device__ __forceinline__ void phase(const Ctx& F, LAS unsigned char* shm) {
    for (int u = blockIdx.x; u < NB * 4 * 64; u += gridDim.x) { const int bg = u >> 6; int qb = u & 63; qb = (u >= 256) ? 63 - qb : qb; unit(F, shm, bg >> 2, bg & 3, qb); }
}
}
namespace sk {
typedef short bf16x8 __attribute__((ext_vector_type(8)));
typedef float f32x16 __attribute__((ext_vector_type(16)));
__device__ __forceinline__ int crow(int r, int hi) { return (r & 3) + 8 * (r >> 2) + 4 * hi; }
__device__ __forceinline__ float half_sum(float v) {
#pragma unroll
    for (int o = 1; o < 32; o <<= 1) v += __shfl_xor(v, o);
    return v; }
#define SK_BAR() asm volatile("s_waitcnt vmcnt(0) lgkmcnt(0)\n\ts_barrier" ::: "memory")
template <class Epi>
__device__ __forceinline__ void phase(LAS unsigned char* shm, const bf16* A, const bf16* Bt, int N, int K, int wg_rel, int nwg, const Epi& E) {
    const int tid = threadIdx.x, lane = tid & 63, r32 = lane & 31, hi = lane >> 5; const int wid = __builtin_amdgcn_readfirstlane(tid >> 6);
    const int ks = K >> 3; LAS float* red = (LAS float*)shm;
    for (int blk = wg_rel; blk < (N >> 5); blk += nwg) {
        const bf16* ap = A + (size_t)r32 * K + wid * ks + hi * 8; const bf16* bp = Bt + (size_t)(blk * 32 + r32) * K + wid * ks + hi * 8;
        f32x16 acc = f32x16{};
        for (int k = 0; k < ks; k += 256) { bf16x8 a[16], b[16];
#pragma unroll
            for (int i = 0; i < 16; ++i) { a[i] = *(const bf16x8*)(ap + k + 16 * i); b[i] = *(const bf16x8*)(bp + k + 16 * i); }
#pragma unroll
            for (int i = 0; i < 16; ++i) acc = __builtin_amdgcn_mfma_f32_32x32x16_bf16(a[i], b[i], acc, 0, 0, 0); }
#pragma unroll
        for (int r = 0; r < 16; ++r) red[(wid * 16 + r) * 64 + lane] = acc[r];
        SK_BAR();
        float v0 = 0.f, v1 = 0.f;
#pragma unroll
        for (int w = 0; w < 8; ++w) { v0 += red[(w * 16 + 2 * wid) * 64 + lane]; v1 += red[(w * 16 + 2 * wid + 1) * 64 + lane]; }
        E(blk, blk * 32 + r32, crow(2 * wid, hi), v0, crow(2 * wid + 1, hi), v1, r32);
        SK_BAR();
    }
}
struct EpiInS { bf16 *QB, *KVB; size_t kvstride; float *Z, *XBC, *GD, *out;
    __device__ __forceinline__ void one(int cp, int row, float v) const { const size_t m = (size_t)MPROMPT + row;
        if (cp < 1024) QB[m * 1024 + cp] = (bf16)f2bf(v);
        else if (cp < 2560) { const int which = (cp - 1024) >> 9, cc = (cp - 1024) & 511; KVB[(size_t)which * kvstride + m * 512 + cc] = (bf16)f2bf(v);
            float* fo = which == 0 ? out + O_KCS + (size_t)row * 512 : (which == 1 ? out + O_KSS + (size_t)row * 512 : out + O_KWS + (size_t)(row * 512 + 511) * 512); fo[cc] = v; }
        else if (cp < 3584) Z[m * 1024 + cp - 2560] = v;
        else if (cp < 5120) XBC[m * CONV_DIM + cp - 3584] = v;
        else if (cp < 5168) GD[m * 64 + cp - 5120] = 1.0f / (1.0f + __expf(-v));
        else if (cp < NCOLS_IN) GD[m * 64 + cp - 5120] = v; }
    __device__ __forceinline__ void operator()(int, int col, int r0, float v0, int r1, float v1, int) const { one(col, r0, v0); one(col, r1, v1); } };
struct EpiResS { const float* xres; float* X1; bf16* X1B; float* SS;
    __device__ __forceinline__ void operator()(int blk, int col, int r0, float v0, int r1, float v1, int r32) const {
        v0 += xres[(size_t)r0 * DM + col]; v1 += xres[(size_t)r1 * DM + col]; X1[(size_t)r0 * DM + col] = v0; X1[(size_t)r1 * DM + col] = v1;
        if (X1B) { X1B[(size_t)r0 * DM + col] = (bf16)f2bf(v0); X1B[(size_t)r1 * DM + col] = (bf16)f2bf(v1); }
        const float s0 = half_sum(v0 * v0), s1 = half_sum(v1 * v1); if (r32 == 0) { SS[r0 * 64 + blk] = s0; SS[r1 * 64 + blk] = s1; } } };
struct EpiUpS { bf16* H; const LAS float* rs;
    __device__ __forceinline__ void operator()(int, int col, int r0, float v0, int r1, float v1, int) const {
        float a = fmaxf(v0 * rs[r0], 0.f), b = fmaxf(v1 * rs[r1], 0.f); H[(size_t)r0 * DFF + col] = (bf16)f2bf(a * a); H[(size_t)r1 * DFF + col] = (bf16)f2bf(b * b); } };
}
namespace deca {
constexpr int L_QS = 0, L_SC = 1024, L_PART = 17408, L_PS = 25600, L_IMP = 27776;
#define DA_BAR() asm volatile("s_waitcnt vmcnt(0) lgkmcnt(0)\n\ts_barrier" ::: "memory")
__device__ __forceinline__ void load_row(const KeyRef& kr, const void* p, float (&k)[64]) {
    if (kr.f32) { const f32x4* q = (const f32x4*)p;
#pragma unroll
        for (int i = 0; i < 16; ++i) { const f32x4 t = q[i]; k[4 * i] = t.x; k[4 * i + 1] = t.y; k[4 * i + 2] = t.z; k[4 * i + 3] = t.w; } }
    else { const v4u* q = (const v4u*)p;
#pragma unroll
        for (int i = 0; i < 8; ++i) { const v4u t = q[i]; k[8 * i] = __uint_as_float(t.x << 16); k[8 * i + 1] = __uint_as_float(t.x & 0xffff0000u); k[8 * i + 2] = __uint_as_float(t.y << 16); k[8 * i + 3] = __uint_as_float(t.y & 0xffff0000u);
            k[8 * i + 4] = __uint_as_float(t.z << 16); k[8 * i + 5] = __uint_as_float(t.z & 0xffff0000u); k[8 * i + 6] = __uint_as_float(t.w << 16); k[8 * i + 7] = __uint_as_float(t.w & 0xffff0000u); } }
}
template <int NCH, int MODE, class KF>
__device__ __forceinline__ void unit(const Ctx& F, LAS unsigned char* shm, int m, int g, const KF& kf) {
    const int tid = threadIdx.x, lane = tid & 63; const int wid = __builtin_amdgcn_readfirstlane(tid >> 6);
    LAS float* qs = (LAS float*)(shm + L_QS); LAS float* sc = (LAS float*)(shm + L_SC); LAS float* part = (LAS float*)(shm + L_PART);
    constexpr int NK = NCH * 64, CPW = NCH / 8;
    if (tid < 256) qs[tid] = bf2f(F.QB()[(size_t)m * 1024 + g * 256 + tid]) * 0.125f;
    DA_BAR();
#pragma unroll
    for (int i = 0; i < CPW; ++i) { const int c = wid + 8 * i; const KeyRef kr = kf(c, lane); float s[4] = {-INFINITY, -INFINITY, -INFINITY, -INFINITY};
        if (kr.valid) { float k[64]; load_row(kr, kr.k, k);
#pragma unroll
            for (int h = 0; h < 4; ++h) { float a = 0.f;
#pragma unroll
                for (int d4 = 0; d4 < 16; ++d4) { const f32x4 q4 = *(const LAS f32x4*)(qs + h * 64 + 4 * d4); a += q4.x * k[4 * d4] + q4.y * k[4 * d4 + 1] + q4.z * k[4 * d4 + 2] + q4.w * k[4 * d4 + 3]; }
                s[h] = a; } }
#pragma unroll
        for (int h = 0; h < 4; ++h) sc[h * NK + c * 64 + lane] = s[h]; }
    DA_BAR();
    float mh[4], ih[4];
#pragma unroll
    for (int h = 0; h < 4; ++h) { float mx = -INFINITY;
        for (int c = 0; c < NCH; ++c) mx = fmaxf(mx, sc[h * NK + c * 64 + lane]);
        mx = wave_max(mx); if (mx == -INFINITY) mx = 0.f;
        float sm = 0.f;
        for (int c = 0; c < NCH; ++c) sm += __expf(sc[h * NK + c * 64 + lane] - mx);
        sm = wave_sum(sm); mh[h] = mx; ih[h] = 1.0f / fmaxf(sm, 1e-30f); }
    DA_BAR();
#pragma unroll
    for (int i = 0; i < CPW; ++i) { const int c = wid + 8 * i;
#pragma unroll
        for (int h = 0; h < 4; ++h) sc[h * NK + c * 64 + lane] = __expf(sc[h * NK + c * 64 + lane] - mh[h]) * ih[h]; }
#pragma unroll
    for (int h = 0; h < 4; ++h) { float a0[64];
#pragma unroll
        for (int d = 0; d < 64; ++d) a0[d] = 0.f;
#pragma unroll
        for (int i = 0; i < CPW; ++i) { const int c = wid + 8 * i; const KeyRef kr = kf(c, lane);
            if (kr.valid) { const float p0 = sc[h * NK + c * 64 + lane];
                if (kr.f32) { const f32x4* p = (const f32x4*)kr.v;
#pragma unroll
                    for (int j = 0; j < 16; ++j) { const f32x4 t = p[j]; a0[4 * j] += p0 * t.x; a0[4 * j + 1] += p0 * t.y; a0[4 * j + 2] += p0 * t.z; a0[4 * j + 3] += p0 * t.w; } }
                else { const v4u* p = (const v4u*)kr.v;
#pragma unroll
                    for (int j = 0; j < 8; ++j) { const v4u t = p[j]; a0[8 * j] += p0 * __uint_as_float(t.x << 16); a0[8 * j + 1] += p0 * __uint_as_float(t.x & 0xffff0000u); a0[8 * j + 2] += p0 * __uint_as_float(t.y << 16); a0[8 * j + 3] += p0 * __uint_as_float(t.y & 0xffff0000u);
                        a0[8 * j + 4] += p0 * __uint_as_float(t.z << 16); a0[8 * j + 5] += p0 * __uint_as_float(t.z & 0xffff0000u); a0[8 * j + 6] += p0 * __uint_as_float(t.w << 16); a0[8 * j + 7] += p0 * __uint_as_float(t.w & 0xffff0000u); } } } }
        part[(wid * 4 + h) * 64 + lane] = wave_reduce_t64(a0, lane); }
    DA_BAR();
    if (tid < 256) { const int h = tid >> 6, d = tid & 63; float o = 0.f;
#pragma unroll
        for (int w = 0; w < 8; ++w) o += part[(w * 4 + h) * 64 + d];
        const int hd = g * 4 + h; const size_t oi = (size_t)m * 1024 + hd * 64 + d;
        if (MODE == 0) F.OCMP()[oi] = o;
        else if (MODE == 1) F.OWIN()[oi] = o;
        else { const float* gt = F.GD() + (size_t)m * 64 + hd * 3; F.MIX()[(size_t)m * DM + hd * 64 + d] = (bf16)f2bf(gt[0] * F.OCMP()[oi] + gt[1] * o + gt[2] * F.OWIN()[oi]); } }
    if (MODE == 0 && wid == 0) {
        LAS float* ps = (LAS float*)(shm + L_PS); LAS float* imp = (LAS float*)(shm + L_IMP);
        for (int i = lane; i < 544; i += 64) ps[i] = 0.f;
        for (int c = 0; c < NCH; ++c) ps[1 + c * 64 + lane] = (sc[c * 64 + lane] + sc[NK + c * 64 + lane]) + (sc[2 * NK + c * 64 + lane] + sc[3 * NK + c * 64 + lane]);
        constexpr int nslc = NSLC_S, jt = PAST >> 6; float mine[3]; int cnt[3];
#pragma unroll
        for (int jj = 0; jj < 3; ++jj) { const int j = jj * 64 + lane; float v = 0.f; cnt[jj] = 0;
            if (j < nslc) { v = ps[4 * j] + 2.0f * (ps[4 * j + 1] + ps[4 * j + 2] + ps[4 * j + 3]) + ps[4 * j + 4]; if (j == 0 || j == jt || j == jt - 1) v = 1.0e4f; if (j > jt) v = -1.0e4f; imp[j] = v; }
            mine[jj] = v; }
        for (int k = 0; k < nslc; ++k) { const float v = imp[k];
#pragma unroll
            for (int jj = 0; jj < 3; ++jj) { const int j = jj * 64 + lane; cnt[jj] += ((v > mine[jj]) || (v == mine[jj] && k < j)) ? 1 : 0; } }
        int base = 0; const size_t task = (size_t)m * 4 + g;
#pragma unroll
        for (int jj = 0; jj < 3; ++jj) { const int j = jj * 64 + lane; const bool sel = (j < nslc) && (cnt[jj] < 16); const unsigned long long bal = __ballot(sel);
            if (sel) F.SELIDX()[task * 16 + base + __popcll(bal & ((1ull << lane) - 1ull))] = j;
            base += __popcll(bal); } }
    DA_BAR();
}
}
struct Args { const void* in[26]; float* out; unsigned char* ws; int ph_lo, ph_hi, li, pad; };
__global__ void __launch_bounds__(NWAVES * 64, 2) fwd_kernel(Args args) {
    extern __shared__ __attribute__((aligned(16))) unsigned char lds[];
    Ctx F;
    F.lds = (LAS unsigned char*)lds; F.MISC = (volatile LAS unsigned*)(F.lds + MISC_OFF);
    F.tid = threadIdx.x; F.lane = F.tid & 63; F.wave = __builtin_amdgcn_readfirstlane(F.tid >> 6);
    F.G = gridDim.x; { const int bx = blockIdx.x; F.vcu = (F.G % 8 == 0) ? (bx % 8) * (F.G / 8) + bx / 8 : bx; }
    F.ka = (const __attribute__((address_space(4))) unsigned long long*)__builtin_amdgcn_kernarg_segment_ptr();
    F.ctl = (gu32*)(F.ws() + WS_CTL);
    for (int u = F.tid; u < (LDS_BYTES - LDSCTL_OFF) / 4; u += NWAVES * 64) ((LAS unsigned*)(F.lds + LDSCTL_OFF))[u] = 0u;
    __syncthreads();
    XcdBarrier bar; bar.bar = (unsigned*)(F.ctl + CW_BAR); bar.x = 0; bar.st = nullptr;
    if (N_LAUNCHES == 1) bar = xcd_barrier_post((unsigned*)(F.ctl + CW_BAR), F.MISC + 8);
#ifdef PROBE_DBLBAR
#define PROBE_EXTRA_BAR xcd_barrier(bar);
#else
#define PROBE_EXTRA_BAR
#endif
#define GRID_BAR(seam) do { if (N_LAUNCHES != 1) { if (F.tid == 0) __hip_atomic_store(F.ctl + CW_TMO, 0xBADBA0u | (unsigned)(seam), RLX_AGENT); } else { xcd_barrier(bar); PROBE_EXTRA_BAR } } while (0)
    const int lo = args.ph_lo, hi = args.ph_hi;
#define IN(k) (lo <= (k) && (k) < hi)
#define BOTH(k) (IN(k) && IN((k) + 1))
    const int gw = F.vcu * NWAVES + F.wave, NGW = F.G * NWAVES;

    if (IN(0)) { p0_prologue(F); if (BOTH(0)) GRID_BAR(0); }
    if (IN(1)) {
        pg8::Gemm g{F.XN(), F.WIN(), MPROMPT, NIN, DM}; pg8::StaticOrder S; S.init(MPROMPT, NIN, F.G, (int)blockIdx.x);
        static_assert(WS_KSB - WS_KCB == WS_KWB - WS_KSB, "kv copies equally spaced");
        pg8::EpiInProj E{F.QB(), F.KCB(), (WS_KSB - WS_KCB) / 2, F.Z(), F.XBC(), F.GD(), F.out()};
        pg8::gemm_phase<pg8::EpiInProj, pg8::StaticOrder, true, true>(F.lds + RING_OFF, g, S, E);
        {
          const int rel = (F.G == 256) ? (int)blockIdx.x - 160 : (int)blockIdx.x, nw = (F.G == 256) ? 96 : F.G;
          if (rel >= 0) { const sk::EpiInS ES{F.QB(), F.KCB(), (WS_KSB - WS_KCB) / 2, F.Z(), F.XBC(), F.GD(), F.out()};
              sk::phase(F.lds + RING_OFF, F.XN() + (size_t)MPROMPT * DM, F.WIN(), NCOLS_IN, DM, rel, nw, ES); } }
        if (F.G == 256 && blockIdx.x >= 160) { __syncthreads(); weight_items(F, 0, W_ITEMS_P1, ((int)blockIdx.x - 160) * NWAVES + F.wave, 96 * NWAVES); }
        if (BOTH(1)) GRID_BAR(1);
    }
    if (IN(2)) {
        constexpr int NT_C = NB * NCMP_P * 2 + DECB * NCMP_S * 2;
        for (int u = blockIdx.x; u < 256; u += gridDim.x) cmpg::unit(F, F.lds + RING_OFF, u);
        for (int u = blockIdx.x; u < NB * 2 * 32; u += gridDim.x) cmpg::small_unit(F, F.lds + RING_OFF, u);
        __syncthreads();
        conv_prepass(F);
        fa::win_phase(F, F.lds + RING_OFF); __syncthreads();
        for (int u = F.G - 1 - (int)blockIdx.x; u < DECB * 4; u += F.G) { const int b = u >> 2, g = u & 3, m = MPROMPT + b;
            const WinKeysS kf{F.st_win() + (size_t)b * 512 * 512, F.KWB() + (size_t)m * 512, g}; deca::unit<8, 1>(F, F.lds + RING_OFF, m, g, kf); }
        if (BOTH(2)) GRID_BAR(2);
    }
    if (IN(3)) {
        constexpr int NT_S = NB * 16 * 64 + DECB * 16 * 64;
#ifdef CHK_DEC
        for (int it = MPROMPT * 4 + gw; it < MROWS * 4; it += NGW) win_task<true>(F, it, F.lane);
        __syncthreads();
#endif
#ifdef CHK_CMP
        { constexpr int NT_C2 = NB * NCMP_P * 2 + DECB * NCMP_S * 2; for (int it = gw; it < 200; it += NGW) compress_ref_check(F, (int)(((long)it * 168 + 7) % NT_C2), it & 3, F.lane, -1); }
        { constexpr int NT_C = NB * NCMP_P * 2 + DECB * NCMP_S * 2; for (int it = gw; it < 600; it += NGW) compress_task<true>(F, (int)(((long)it * 56 + 7) % NT_C), F.lane); }
        __syncthreads();
#endif
#ifdef CHK_ATT
        for (int it = gw; it < 135 * 4; it += NGW) win_task<true>(F, (it >> 2) * 61 * 4 + (it & 3), F.lane);
        __syncthreads();
#endif
#ifdef SSD_NAIVE
        for (int it = gw; it < NT_S; it += NGW) ssd_task(F, it, F.lane);
#else
#ifdef REP_LOC
        for (int rep = 0; rep <= args.pad; ++rep)
#endif
        for (int u = blockIdx.x; u < NB * 16 * 16; u += gridDim.x) ssd::local_unit(F, F.lds + RING_OFF, u);
        __syncthreads();
        if (F.G == 256) { if (blockIdx.x < 128) for (int it = (int)blockIdx.x * NWAVES + F.wave; it < DECB * 16 * 8; it += 128 * NWAVES) ssd_decode_task(F, it, F.lane); }
        else for (int it = gw; it < DECB * 16 * 8; it += NGW) ssd_decode_task(F, it, F.lane);
#endif
        __syncthreads();
#ifdef REP_CMPA
        for (int rep = 0; rep <= args.pad; ++rep)
#endif
        { cmpa::phase(F, F.lds + RING_OFF); __syncthreads(); }
        for (int u = F.G - 1 - (int)blockIdx.x; u < DECB * 4; u += F.G) { const int b = u >> 2, g = u & 3, m = MPROMPT + b;
            const CmpKeys kf{F.KCMPS() + (size_t)b * NCMP_S * 512, g, NCMP_S, PAST}; deca::unit<8, 0>(F, F.lds + RING_OFF, m, g, kf); }
        if (BOTH(3)) GRID_BAR(3);
    }
    if (IN(4)) {
#ifdef REP_DECA
        for (int rep = 0; rep <= args.pad; ++rep)
#endif
        for (int u = F.G - 1 - (int)blockIdx.x; u < DECB * 4; u += F.G) { const int b = u >> 2, g = u & 3, m = MPROMPT + b;
            const SelKeysS kf{F.SELIDX() + ((size_t)m * 4 + g) * 16, F.page_table() + b * 64, F.cache_sel(), F.KSB() + (size_t)m * 512, g}; deca::unit<16, 2>(F, F.lds + RING_OFF, m, g, kf); }
        __syncthreads();
        ssd::carry_phase(F); winbuf_copy(F);
        if (F.G == 256) { if (blockIdx.x < 128) weight_items(F, W_ITEMS_P1, W_ITEMS, (int)blockIdx.x * NWAVES + F.wave, 128 * NWAVES); }
        else weight_items(F, 0, W_ITEMS, gw, NGW);
        if (BOTH(4)) GRID_BAR(4); }
    if (IN(5)) {
#ifdef CHK_DEC
        for (int it = MPROMPT * 4 + gw; it < MROWS * 4; it += NGW) cmp_task<true>(F, it, F.lane);
        __syncthreads();
#endif
#ifdef CHK_CMPA
        for (int it = gw; it < 135 * 4; it += NGW) cmp_task<true>(F, (it >> 2) * 61 * 4 + (it & 3), F.lane);
        __syncthreads();
#endif
        fa::sel_phase(F, F.lds + RING_OFF); __syncthreads();
#ifdef REP_SEL
        fa::sel_phase(F, F.lds + RING_OFF); __syncthreads();
#endif
#ifdef DRY_SEL
        fa::sel_phase_dry<DRY_SEL>(F, F.lds + RING_OFF); __syncthreads();
#endif
#ifdef SSD_NAIVE
        for (int it = gw; it < MROWS * 2; it += NGW) ssd_gate_task(F, it, F.lane);
#else
        __syncthreads();
#ifdef REP_FIN
        for (int rep = 0; rep <= args.pad; ++rep)
#endif
        for (int u = blockIdx.x; u < NB * 16 * 2 * 4; u += gridDim.x) ssd::final_unit(F, F.lds + RING_OFF, u);
        for (int it = MPROMPT * 2 + gw; it < MROWS * 2; it += NGW) ssd_gate_task(F, it, F.lane);
#endif
        if (BOTH(5)) GRID_BAR(5);
    }
    if (IN(6)) {
#ifdef CHK_DEC
        for (int it = MPROMPT * 4 + gw; it < MROWS * 4; it += NGW) sel_task<true>(F, it, F.lane);
        __syncthreads();
#endif
#ifdef CHK_ATT
        for (int it = gw; it < 135 * 4; it += NGW) sel_task<true>(F, (it >> 2) * 61 * 4 + (it & 3), F.lane);
        __syncthreads();
#endif
        pg8::Gemm g{F.MIX(), F.WOUT(), MPROMPT, DM, DM}; pg8::StaticOrder S; S.init(MPROMPT, DM, F.G, (int)blockIdx.x);
        pg8::EpiResid E{F.x_prompt(), F.x_sample(), DM, F.X1(), F.X1B(), F.SS1()};
        pg8::gemm_phase<pg8::EpiResid, pg8::StaticOrder, true, true>(F.lds + RING_OFF, g, S, E);
        { const sk::EpiResS ES{F.x_sample(), F.X1() + (size_t)MPROMPT * DM, F.X1B() + (size_t)MPROMPT * DM, F.SS1S()};
          sk::phase(F.lds + RING_OFF, F.MIX() + (size_t)MPROMPT * DM, F.WOUT(), DM, DM, (int)blockIdx.x, F.G, ES); }
        if (BOTH(6)) GRID_BAR(6);
    }
    if (IN(7)) {
        pg8::Gemm g{F.X1B(), F.WUP(), MPROMPT, DFF, DM}; pg8::StaticOrder S; S.init(MPROMPT, DFF, F.G, (int)blockIdx.x);
        pg8::EpiUp E{F.H(), F.SS1()};
        pg8::gemm_phase<pg8::EpiUp, pg8::StaticOrder, true, true>(F.lds + RING_OFF, g, S, E);
        { LAS float* rs = (LAS float*)(F.lds + RING_OFF + 32768);
          if (F.tid < 32) { float t = 0.f; for (int i = 0; i < 64; ++i) t += F.SS1S()[F.tid * 64 + i]; rs[F.tid] = 1.0f / sqrtf(t * (1.0f / DM) + NORM_EPS); }
          __syncthreads();
          const sk::EpiUpS ES{F.H() + (size_t)MPROMPT * DFF, rs};
          sk::phase(F.lds + RING_OFF, F.X1B() + (size_t)MPROMPT * DM, F.WUP(), DFF, DM, (int)blockIdx.x, F.G, ES); }
        if (BOTH(7)) GRID_BAR(7);
    }
    if (IN(8)) {
        pg8::Gemm g{F.H(), F.WDN(), MPROMPT, DM, DFF}; pg8::StaticOrder S; S.init(MPROMPT, DM, F.G, (int)blockIdx.x);
        pg8::EpiResid E{F.X1(), F.X1() + (size_t)MPROMPT * DM, DM, F.X2(), nullptr, F.SS2()};
        pg8::gemm_phase<pg8::EpiResid, pg8::StaticOrder, true, true>(F.lds + RING_OFF, g, S, E);
        { const sk::EpiResS ES{F.X1() + (size_t)MPROMPT * DM, F.X2() + (size_t)MPROMPT * DM, nullptr, F.SS2S()};
          sk::phase(F.lds + RING_OFF, F.H() + (size_t)MPROMPT * DFF, F.WDN(), DM, DFF, (int)blockIdx.x, F.G, ES); }
        if (BOTH(8)) GRID_BAR(8);
    }
    if (IN(9)) { for (int m = gw; m < MROWS; m += NGW) final_norm_row(F, m, F.lane);
#if defined(CHK_ATT) || defined(CHK_CMP) || defined(CHK_CMPA) || defined(CHK_DEC) || defined(CHK_ANY)
        if (blockIdx.x == 0 && F.tid == 0) { unsigned mask = 0u;
            for (int k = 0; k < 8; ++k) if (__hip_atomic_load((unsigned*)F.ctl + CW_CHK + k, RLX_AGENT)) mask |= 1u << k;
            if (mask & 31u) F.out()[O_KCS] = 1.0e6f * (float)(1u + (mask & 31u));
            if (mask >> 5) F.out()[O_KSS] = 1.0e9f * (float)(1u + (mask >> 5)); }
#endif
    }
#undef IN
#undef BOTH
}

extern "C" void kernel_launch(void* const* d_in, const int* in_sizes, int n_in, void* d_out, int out_size, void* d_ws, size_t ws_size, hipStream_t stream) {
    static int grid = 0;
    if (grid == 0) {
        if (n_in != 26 || (size_t)out_size != O_END || ws_size < WS_END) { fprintf(stderr, "kernel_launch: unexpected shapes: n_in %d out %d ws %zu (need %zu)\n", n_in, out_size, ws_size, (size_t)WS_END); grid = -1; return; }
        int dev = 0, cus = 0, per_cu = 0;
        if (hipGetDevice(&dev) != hipSuccess || hipDeviceGetAttribute(&cus, hipDeviceAttributeMultiprocessorCount, dev) != hipSuccess) { grid = -1; return; }
        if (hipFuncSetAttribute((const void*)fwd_kernel, hipFuncAttributeMaxDynamicSharedMemorySize, LDS_BYTES) != hipSuccess) { fprintf(stderr, "kernel_launch: hipFuncSetAttribute failed\n"); grid = -1; return; }
        if (hipOccupancyMaxActiveBlocksPerMultiprocessor(&per_cu, (const void*)fwd_kernel, NWAVES * 64, LDS_BYTES) != hipSuccess || per_cu < 1) fprintf(stderr, "kernel_launch: occupancy query reports %d\n", per_cu);
        (void)hipGetLastError();
        grid = cus;
    }
    if (grid < 0) return;
    if (hipMemsetAsync((char*)d_ws + WS_CTL, 0, CTL_ZERO_BYTES, stream) != hipSuccess) return;
    Args a{};
    for (int i = 0; i < 26; ++i) a.in[i] = d_in[i];
    a.out = (float*)d_out; a.ws = (unsigned char*)d_ws;
    for (int li = 0; li < N_LAUNCHES; ++li) {
        a.ph_lo = (N_LAUNCHES == 1) ? 0 : li; a.ph_hi = (N_LAUNCHES == 1) ? N_PHASES : li + 1; a.li = li; a.pad = 0;
#if defined(REP_CMPG) || defined(REP_FIN) || defined(REP_LOC) || defined(REP_DECA) || defined(REP_CMPA)
        a.pad = 1;
#endif
        hipLaunchKernelGGL(fwd_kernel, dim3(grid), dim3(NWAVES * 64), LDS_BYTES, stream, a);
        if (hipPeekAtLastError() != hipSuccess) { fprintf(stderr, "kernel_launch: launch %d failed\n", li); break; }
    }
}
```

```cpp
#include <hip/hip_runtime.h>
#include <cstdio>
#include <cstdint>

constexpr int DM = 2048, SEQ = 4096, NB = 2, MPROMPT = NB * SEQ, DECB = 32, PAST = 8192, MROWS = MPROMPT + DECB, MP = 8448;
constexpr int NCOLS_IN = 5184, NIN = 5376;
constexpr int DFF = 8192, CONV_DIM = 1536, DIN = 1024;
constexpr int NCMP_P = 255, NCMP_S = 511, NSLC_P = 64, NSLC_S = 129;
constexpr float NORM_EPS = 1e-5f;
constexpr size_t O_YP = 0, O_YS = O_YP + (size_t)MPROMPT * DM, O_KCP = O_YS + (size_t)DECB * DM, O_KSP = O_KCP + (size_t)MPROMPT * 512, O_KWP = O_KSP + (size_t)MPROMPT * 512,
                 O_CVP = O_KWP + (size_t)NB * 512 * 512, O_SSP = O_CVP + (size_t)NB * 3 * CONV_DIM, O_KCS = O_SSP + (size_t)NB * 16 * 64 * 128, O_KSS = O_KCS + (size_t)DECB * 512,
                 O_KWS = O_KSS + (size_t)DECB * 512, O_CVS = O_KWS + (size_t)DECB * 512 * 512, O_SSS = O_CVS + (size_t)DECB * 3 * CONV_DIM, O_END = O_SSS + (size_t)DECB * 16 * 64 * 128;
static_assert(O_END == 38790144, "d_out size");
namespace pg8 {
#define PG8_LAS __attribute__((address_space(3)))
typedef unsigned short bf16_t;
typedef short bf16x8 __attribute__((ext_vector_type(8)));
typedef float f32x4 __attribute__((ext_vector_type(4)));
typedef unsigned u32x4 __attribute__((ext_vector_type(4)));
constexpr int BM = 256, BK = 64, HALF = 128, HTB = HALF * BK * 2  , STAGE_BYTES = 8 * HTB, NXCD = 8, WGM = 8;

__host__ __device__ __forceinline__ int lds_byte(int r, int c) { const int st = (r >> 4) * 2 + (c >> 5), rr = r & 15, cc = c & 31, ob = rr * 64 + cc * 2; return st * 1024 + (ob ^ (((ob >> 9) & 1) << 5)); }
__host__ __device__ __forceinline__ void stage_rc(int b, int& R, int& C) { const int st = b / 1024, sb = b % 1024, swz = sb ^ (((sb >> 9) & 1) << 5); R = (st >> 1) * 16 + swz / 64; C = (st & 1) * 32 + (swz % 64) / 2; }
__host__ __device__ __forceinline__ int perm32(int rho) { const int n = rho >> 4, i = rho & 15; return 8 * (i >> 2) + 4 * n + (i & 3); }

struct Unit { int pm, pn; };
struct Gemm { const bf16_t* A; const bf16_t* Bt; int M, N, K; };

struct StaticOrder {
    int nM, nN, nwg, G, c;
    __host__ __device__ void init(int M, int N, int G_, int c_) { nM = M / BM; nN = N / BM; nwg = nM * nN; G = G_; c = c_; }
    __host__ __device__ bool next(int i, Unit& u) const {
        const long L = (long)i * G + c; if (L >= nwg) return false;
        int wgid = (int)L; { const int q = nwg / NXCD, r = nwg % NXCD, xcd = wgid % NXCD, off = wgid / NXCD; wgid = (xcd < r ? xcd * (q + 1) : r * (q + 1) + (xcd - r) * q) + off; }
        const int nig = WGM * nN, gid = wgid / nig, fm = gid * WGM, gsz = (nM - fm) < WGM ? (nM - fm) : WGM;
        u.pm = fm + ((wgid % nig) % gsz); u.pn = (wgid % nig) / gsz; return true;
    }
    __device__ __forceinline__ void a_ready(const Unit&) const {}
    __device__ __forceinline__ void done(const Unit&) const {}
};

__device__ __forceinline__ unsigned cvt_pk_bf16(float lo, float hi) { unsigned r; asm volatile("v_cvt_pk_bf16_f32 %0, %1, %2" : "=v"(r) : "v"(lo), "v"(hi)); return r; }
typedef float f32x2 __attribute__((ext_vector_type(2)));
__device__ __forceinline__ void st_bf16x4(bf16_t* p, const f32x4 v) { typedef unsigned u32x2v __attribute__((ext_vector_type(2))); u32x2v w; w.x = cvt_pk_bf16(v[0], v[1]); w.y = cvt_pk_bf16(v[2], v[3]); *(u32x2v*)p = w; }
__device__ __forceinline__ float sigmoidf_(float x) { return 1.0f / (1.0f + __expf(-x)); }
struct EpiInProj {
    static constexpr bool PERM = false, AFTER_DRAIN = false;
    bf16_t *QB, *KVB; size_t kvstride; float *Z, *XBC, *GD, *out;
    __device__ __forceinline__ void operator()(const f32x4 (&acc)[2][2][4][2], const Unit& u, int wr, int wc, int fr, int fq) const {
        const int pn = u.pn, rbase = u.pm * BM + wr * 64 + fr, cl = wc * 32 + 4 * fq;
        if (pn < 4) {
#pragma unroll
            for (int ai = 0; ai < 2; ++ai)
#pragma unroll
                for (int m = 0; m < 4; ++m) { const int row = rbase + ai * HALF + m * 16; if (row < MROWS) { bf16_t* p = QB + (size_t)row * 1024 + pn * 256 + cl;
#pragma unroll
                    for (int bj = 0; bj < 2; ++bj)
#pragma unroll
                        for (int n = 0; n < 2; ++n) st_bf16x4(p + bj * HALF + n * 16, acc[ai][bj][m][n]); } }
        } else if (pn < 10) {
            const int which = (pn - 4) >> 1, cb = ((pn - 4) & 1) * 256 + cl; bf16_t* B = KVB + (size_t)which * kvstride;
#pragma unroll
            for (int ai = 0; ai < 2; ++ai)
#pragma unroll
                for (int m = 0; m < 4; ++m) { const int row = rbase + ai * HALF + m * 16; if (row < MROWS) {
                    float* fo = nullptr;
                    if (row < MPROMPT) { if (which == 0) fo = out + O_KCP + (size_t)row * 512; else if (which == 1) fo = out + O_KSP + (size_t)row * 512; else { const int t = row & (SEQ - 1); if (t >= SEQ - 512) fo = out + O_KWP + (size_t)((row >> 12) * 512 + t - (SEQ - 512)) * 512; } }
                    else { const int s = row - MPROMPT; fo = which == 0 ? out + O_KCS + (size_t)s * 512 : (which == 1 ? out + O_KSS + (size_t)s * 512 : out + O_KWS + (size_t)(s * 512 + 511) * 512); }
                    bf16_t* p = B + (size_t)row * 512 + cb;
#pragma unroll
                    for (int bj = 0; bj < 2; ++bj)
#pragma unroll
                        for (int n = 0; n < 2; ++n) { const f32x4 v = acc[ai][bj][m][n]; st_bf16x4(p + bj * HALF + n * 16, v); if (fo) *(f32x4*)(fo + cb + bj * HALF + n * 16) = v; } } }
        } else if (pn < 20) {
            float* base = pn < 14 ? Z : XBC; const int ld = pn < 14 ? 1024 : CONV_DIM, cb = (pn < 14 ? (pn - 10) : (pn - 14)) * 256 + cl;
#pragma unroll
            for (int ai = 0; ai < 2; ++ai)
#pragma unroll
                for (int m = 0; m < 4; ++m) { const int row = rbase + ai * HALF + m * 16; if (row < MROWS) { float* p = base + (size_t)row * ld + cb;
#pragma unroll
                    for (int bj = 0; bj < 2; ++bj)
#pragma unroll
                        for (int n = 0; n < 2; ++n) *(f32x4*)(p + bj * HALF + n * 16) = acc[ai][bj][m][n]; } }
        } else {
#pragma unroll
            for (int ai = 0; ai < 2; ++ai)
#pragma unroll
                for (int m = 0; m < 4; ++m) { const int row = rbase + ai * HALF + m * 16; if (row < MROWS) {
#pragma unroll
                    for (int n = 0; n < 2; ++n) { const int col = cl + n * 16; if (col < 64) { f32x4 v = acc[ai][0][m][n]; if (col < 48) { v[0] = sigmoidf_(v[0]); v[1] = sigmoidf_(v[1]); v[2] = sigmoidf_(v[2]); v[3] = sigmoidf_(v[3]); } *(f32x4*)(GD + (size_t)row * 64 + col) = v; } } } }
        }
    }
};
struct EpiResid {
    static constexpr bool PERM = false, AFTER_DRAIN = false;
    const float* xp; const float* xs; int ldx; float* X1; bf16_t* X1B; float* SS;
    __device__ __forceinline__ void operator()(const f32x4 (&acc)[2][2][4][2], const Unit& u, int wr, int wc, int fr, int fq) const {
        const int pn = u.pn, rbase = u.pm * BM + wr * 64 + fr, cb = pn * 256 + wc * 32 + 4 * fq;
#pragma unroll
        for (int ai = 0; ai < 2; ++ai) {
            f32x4 pre[4][2][2];
#pragma unroll
            for (int m = 0; m < 4; ++m) { const int row = rbase + ai * HALF + m * 16; const float* xr = row < MPROMPT ? xp + (size_t)row * ldx : xs + (size_t)(row - MPROMPT) * ldx;
#pragma unroll
                for (int bj = 0; bj < 2; ++bj)
#pragma unroll
                    for (int n = 0; n < 2; ++n) pre[m][bj][n] = row < MROWS ? *(const f32x4*)(xr + cb + bj * HALF + n * 16) : (f32x4){0.f, 0.f, 0.f, 0.f}; }
            asm volatile("" ::: "memory");
#pragma unroll
            for (int m = 0; m < 4; ++m) { const int row = rbase + ai * HALF + m * 16; const bool ok = row < MROWS; float ss = 0.f;
#pragma unroll
                for (int bj = 0; bj < 2; ++bj)
#pragma unroll
                    for (int n = 0; n < 2; ++n) { const int col = cb + bj * HALF + n * 16; const f32x4 v = acc[ai][bj][m][n] + pre[m][bj][n];
                        if (ok) { *(f32x4*)(X1 + (size_t)row * DM + col) = v; if (X1B) st_bf16x4(X1B + (size_t)row * DM + col, v); }
                        ss += (v[0] * v[0] + v[1] * v[1]) + (v[2] * v[2] + v[3] * v[3]); }
                ss += __shfl_xor(ss, 16); ss += __shfl_xor(ss, 32);
                if (ok && fq == 0) SS[(size_t)row * 32 + pn * 4 + wc] = ss; }
        }
    }
};
struct EpiUp {
    static constexpr bool PERM = false, AFTER_DRAIN = false;
    bf16_t* H; const float* SS;
    __device__ __forceinline__ void operator()(const f32x4 (&acc)[2][2][4][2], const Unit& u, int wr, int wc, int fr, int fq) const {
        const int pn = u.pn, rbase = u.pm * BM + wr * 64 + fr, cb = pn * 256 + wc * 32 + 4 * fq;
#pragma unroll
        for (int ai = 0; ai < 2; ++ai)
#pragma unroll
            for (int m = 0; m < 4; ++m) { const int row = rbase + ai * HALF + m * 16; const bool ok = row < MROWS;
                float t = 0.f; if (ok) { const f32x4 a = *(const f32x4*)(SS + (size_t)row * 32 + fq * 8), b = *(const f32x4*)(SS + (size_t)row * 32 + fq * 8 + 4); t = ((a[0] + a[1]) + (a[2] + a[3])) + ((b[0] + b[1]) + (b[2] + b[3])); }
                t += __shfl_xor(t, 16); t += __shfl_xor(t, 32);
                const float rstd = 1.0f / sqrtf(t * (1.0f / DM) + NORM_EPS);
                if (ok) { bf16_t* p = H + (size_t)row * DFF + cb;
#pragma unroll
                    for (int bj = 0; bj < 2; ++bj)
#pragma unroll
                        for (int n = 0; n < 2; ++n) { f32x4 v = acc[ai][bj][m][n] * rstd; v[0] = fmaxf(v[0], 0.f); v[1] = fmaxf(v[1], 0.f); v[2] = fmaxf(v[2], 0.f); v[3] = fmaxf(v[3], 0.f); v = v * v; st_bf16x4(p + bj * HALF + n * 16, v); } } }
    }
};
template <class Epi, class Sched, bool ALIGN_EPI = false, bool SP2 = false>
__device__ __forceinline__ void gemm_phase(PG8_LAS unsigned char* lds, const Gemm g, const Sched& S, const Epi& E) {
    const int tid = threadIdx.x, wid = __builtin_amdgcn_readfirstlane(tid >> 6), lane = tid & 63, wr = wid >> 2, wc = wid & 3, fr = lane & 15, fq = lane >> 4;
    const int K = g.K, nt = K / BK;
    unsigned voffA[2], voffB[2];
#pragma unroll
    for (int i = 0; i < 2; ++i) { int R, C; stage_rc(tid * 16 + i * 8192, R, C); const int Rb = Epi::PERM ? ((R & ~31) + perm32(R & 31)) : R;
        voffA[i] = (unsigned)(R * K + C) * 2u; voffB[i] = (unsigned)(Rb * K + C) * 2u; }
    const size_t kstep = (size_t)(BK * 2);
    const size_t hstep = (size_t)HALF * K * 2;
    const size_t tstep = 2 * hstep;
    const unsigned ldsw = (unsigned)wid * 1024u;
    const int aoff = lds_byte(wr * 64 + fr, fq * 8), boff = lds_byte(wc * 32 + fr, fq * 8);
#define PG8_SA(b, h) (((b) * 2 + (h)) * HTB)
#define PG8_SB(b, h) ((4 + (b) * 2 + (h)) * HTB)
#define PG8_STAGE(bufoff, gbase, voff) do { _Pragma("unroll") for (int _i = 0; _i < 2; ++_i) \
        __builtin_amdgcn_global_load_lds((const unsigned*)((const char*)(gbase) + (voff)[_i]), (PG8_LAS unsigned*)(lds + (bufoff) + ldsw + _i * 8192), 16, 0, 0); } while (0)
#define PG8_LDA(dst, b, h) do { _Pragma("unroll") for (int m = 0; m < 4; ++m) _Pragma("unroll") for (int k = 0; k < 2; ++k) dst[m][k] = *(const PG8_LAS bf16x8*)(lds + PG8_SA(b, h) + aoff + m * 2048 + k * 1024); } while (0)
#define PG8_LDB(dst, b, h) do { _Pragma("unroll") for (int n = 0; n < 2; ++n) _Pragma("unroll") for (int k = 0; k < 2; ++k) dst[n][k] = *(const PG8_LAS bf16x8*)(lds + PG8_SB(b, h) + boff + n * 2048 + k * 1024); } while (0)
#define PG8_MMA(ai, bj, At, Bt) do { __builtin_amdgcn_s_setprio(1); _Pragma("unroll") for (int m = 0; m < 4; ++m) _Pragma("unroll") for (int n = 0; n < 2; ++n) _Pragma("unroll") for (int k = 0; k < 2; ++k) \
        acc[ai][bj][m][n] = __builtin_amdgcn_mfma_f32_16x16x32_bf16(Bt[n][k], At[m][k], acc[ai][bj][m][n], 0, 0, 0); __builtin_amdgcn_s_setprio(0); } while (0)
#define PG8_WAIT_V(n) asm volatile("s_waitcnt vmcnt(" #n ")" ::: "memory")
#define PG8_WAIT_L(n) asm volatile("s_waitcnt lgkmcnt(" #n ")" ::: "memory")
#define PG8_BAR __builtin_amdgcn_s_barrier()
#define PG8_SCHED __builtin_amdgcn_sched_barrier(0)
    Unit cur, nxt; int ui = 0;
    if (!S.next(0, cur)) return;
    f32x4 acc[2][2][4][2];
#pragma unroll
    for (int a = 0; a < 2; ++a)
#pragma unroll
        for (int b = 0; b < 2; ++b)
#pragma unroll
            for (int m = 0; m < 4; ++m)
#pragma unroll
                for (int n = 0; n < 2; ++n) acc[a][b][m][n] = (f32x4){0.f, 0.f, 0.f, 0.f};
    bf16x8 At[4][2], B0[2][2], B1[2][2];
    const char* cA = (const char*)g.A + (size_t)cur.pm * tstep; const char* cB = (const char*)g.Bt + (size_t)cur.pn * tstep;
    S.a_ready(cur);
    if constexpr (SP2) {
        PG8_STAGE(PG8_SB(0, 0), cB, voffB); PG8_STAGE(PG8_SB(0, 1), cB + hstep, voffB); PG8_STAGE(PG8_SA(0, 0), cA, voffA); PG8_STAGE(PG8_SA(0, 1), cA + hstep, voffA);
        if (wr == 1) PG8_BAR;
        PG8_WAIT_V(2); PG8_BAR;
        PG8_STAGE(PG8_SB(1, 0), cB + kstep, voffB); PG8_STAGE(PG8_SA(1, 0), cA + kstep, voffA); PG8_STAGE(PG8_SB(1, 1), cB + hstep + kstep, voffB);
        PG8_WAIT_V(6); PG8_BAR;
    } else {
        PG8_STAGE(PG8_SB(0, 0), cB, voffB); PG8_STAGE(PG8_SA(0, 0), cA, voffA); PG8_STAGE(PG8_SB(0, 1), cB + hstep, voffB); PG8_STAGE(PG8_SA(0, 1), cA + hstep, voffA);
        if (wr == 1) PG8_BAR;
        PG8_WAIT_V(4); PG8_BAR;
        PG8_STAGE(PG8_SB(1, 0), cB + kstep, voffB); PG8_STAGE(PG8_SA(1, 0), cA + kstep, voffA); PG8_STAGE(PG8_SB(1, 1), cB + hstep + kstep, voffB);
        PG8_WAIT_V(6); PG8_BAR;
    }
    for (;;) {
        const bool has_next = S.next(ui + 1, nxt);
        const char* nA = has_next ? (const char*)g.A + (size_t)nxt.pm * tstep : cA; const char* nB = has_next ? (const char*)g.Bt + (size_t)nxt.pn * tstep : cB;
        for (int t = 0; t < nt; t += 2) {
            const bool last = (t == nt - 2);
            const char* a1 = cA + (size_t)(t + 1) * kstep;
            const char* a2 = last ? nA : cA + (size_t)(t + 2) * kstep; const char* b2 = last ? nB : cB + (size_t)(t + 2) * kstep;
            const char* a3 = a2 + kstep; const char* b3 = b2 + kstep;
            if (last && has_next) S.a_ready(nxt);
            if constexpr (SP2) {
            PG8_LDB(B0, 0, 0); PG8_LDB(B1, 0, 1); PG8_SCHED; PG8_LDA(At, 0, 0); PG8_STAGE(PG8_SA(1, 1), a1 + hstep, voffA);
            PG8_WAIT_V(8); PG8_WAIT_L(0); PG8_BAR; PG8_MMA(0, 0, At, B0); PG8_MMA(0, 1, At, B1); PG8_BAR; PG8_SCHED;
            PG8_LDA(At, 0, 1); PG8_STAGE(PG8_SB(0, 0), b2, voffB); PG8_STAGE(PG8_SB(0, 1), b2 + hstep, voffB); PG8_STAGE(PG8_SA(0, 0), a2, voffA);
            PG8_WAIT_V(8); PG8_WAIT_L(0); PG8_BAR; PG8_MMA(1, 0, At, B0); PG8_MMA(1, 1, At, B1); PG8_BAR; PG8_SCHED;
            PG8_LDB(B0, 1, 0); PG8_LDB(B1, 1, 1); PG8_SCHED; PG8_LDA(At, 1, 0); PG8_STAGE(PG8_SA(0, 1), a2 + hstep, voffA);
            PG8_WAIT_V(8); PG8_WAIT_L(0); PG8_BAR; PG8_MMA(0, 0, At, B0); PG8_MMA(0, 1, At, B1); PG8_BAR; PG8_SCHED;
            PG8_LDA(At, 1, 1); PG8_STAGE(PG8_SB(1, 0), b3, voffB); PG8_STAGE(PG8_SB(1, 1), b3 + hstep, voffB); PG8_STAGE(PG8_SA(1, 0), a3, voffA);
            PG8_WAIT_V(8); PG8_WAIT_L(0); PG8_BAR; PG8_MMA(1, 0, At, B0); PG8_MMA(1, 1, At, B1); PG8_BAR; PG8_SCHED;
            } else {
            PG8_LDB(B0, 0, 0); PG8_SCHED; PG8_LDA(At, 0, 0); PG8_STAGE(PG8_SA(1, 1), a1 + hstep, voffA);
            PG8_WAIT_L(8); PG8_BAR; PG8_WAIT_L(0); PG8_MMA(0, 0, At, B0); PG8_BAR; PG8_SCHED;
            PG8_LDB(B1, 0, 1); PG8_STAGE(PG8_SB(0, 0), b2, voffB);
            PG8_BAR; PG8_WAIT_L(0); PG8_MMA(0, 1, At, B1); PG8_BAR;
            PG8_LDA(At, 0, 1); PG8_STAGE(PG8_SA(0, 0), a2, voffA);
            PG8_BAR; PG8_WAIT_L(0); PG8_MMA(1, 0, At, B0); PG8_BAR; PG8_SCHED;
            PG8_STAGE(PG8_SB(0, 1), b2 + hstep, voffB);
            PG8_WAIT_V(6); PG8_BAR; PG8_MMA(1, 1, At, B1); PG8_BAR;
            PG8_LDB(B0, 1, 0); PG8_SCHED; PG8_LDA(At, 1, 0); PG8_STAGE(PG8_SA(0, 1), a2 + hstep, voffA);
            PG8_WAIT_L(8); PG8_BAR; PG8_WAIT_L(0); PG8_MMA(0, 0, At, B0); PG8_BAR; PG8_SCHED;
            PG8_LDB(B1, 1, 1); PG8_STAGE(PG8_SB(1, 0), b3, voffB);
            PG8_BAR; PG8_WAIT_L(0); PG8_MMA(0, 1, At, B1); PG8_BAR;
            PG8_LDA(At, 1, 1); PG8_STAGE(PG8_SA(1, 0), a3, voffA);
            PG8_BAR; PG8_WAIT_L(0); PG8_MMA(1, 0, At, B0); PG8_BAR; PG8_SCHED;
            PG8_STAGE(PG8_SB(1, 1), b3 + hstep, voffB);
            PG8_WAIT_V(6); PG8_BAR; PG8_MMA(1, 1, At, B1); PG8_BAR;
            }
        }
        if constexpr (ALIGN_EPI) { if (wr == 0) PG8_BAR; }
        if constexpr (!Epi::AFTER_DRAIN) { E(acc, cur, wr, wc, fr, fq); S.done(cur); }
        if (!has_next) break;
#pragma unroll
        for (int a = 0; a < 2; ++a)
#pragma unroll
            for (int b = 0; b < 2; ++b)
#pragma unroll
                for (int m = 0; m < 4; ++m)
#pragma unroll
                    for (int n = 0; n < 2; ++n) acc[a][b][m][n] = (f32x4){0.f, 0.f, 0.f, 0.f};
        cur = nxt; cA = nA; cB = nB; ++ui;
        if constexpr (ALIGN_EPI) { if (wr == 1) PG8_BAR; }
    }
    PG8_WAIT_V(0);
    if constexpr (!ALIGN_EPI) { if (wr == 0) PG8_BAR; }
    PG8_BAR;
    if constexpr (Epi::AFTER_DRAIN) { E.fused(acc, cur, wr, wc, fr, fq, lds, wid, lane); S.done(cur); }
#undef PG8_SA
#undef PG8_SB
#undef PG8_STAGE
#undef PG8_LDA
#undef PG8_LDB
#undef PG8_MMA
#undef PG8_WAIT_V
#undef PG8_WAIT_L
#undef PG8_BAR
#undef PG8_SCHED
}
}
#define GAS __attribute__((address_space(1)))
#define LAS __attribute__((address_space(3)))
typedef unsigned short bf16;
typedef unsigned v4u __attribute__((ext_vector_type(4)));
typedef float f32x4 __attribute__((ext_vector_type(4)));
typedef short bf16x8 __attribute__((ext_vector_type(8)));
typedef GAS unsigned gu32;
typedef GAS unsigned long long gu64;
#define RLX_AGENT __ATOMIC_RELAXED, __HIP_MEMORY_SCOPE_AGENT
#define LDS_WAIT() asm volatile("s_waitcnt lgkmcnt(0)" ::: "memory")
#define VM_WAIT() asm volatile("s_waitcnt vmcnt(0)" ::: "memory")
__device__ __forceinline__ unsigned long long rt() { return __builtin_amdgcn_s_memrealtime(); }
__device__ __forceinline__ unsigned f2bf(float f) { unsigned u = __builtin_bit_cast(unsigned, f); return (u + 0x7fffu + ((u >> 16) & 1u)) >> 16; }
__device__ __forceinline__ unsigned pk2(float lo, float hi) { return f2bf(lo) | (f2bf(hi) << 16); }

#define XB_TMO      128
#define XB_XCNT(j)  (256  + 64 * (j))
#define XB_XSUB(j)  (1280 + 64 * (j))
#define XB_XGEN(j)  (2304 + 64 * (j))
#define XB_TOP      3328
#define XB_TOPGEN   3392
#define XCD_BAR_WORDS 3456
#define XB_SPIN_CAP (1u << 18)

__device__ __forceinline__ unsigned xb_ld(unsigned* p)              { return __hip_atomic_load(p, __ATOMIC_RELAXED, __HIP_MEMORY_SCOPE_AGENT); }
__device__ __forceinline__ unsigned xb_add(unsigned* p, unsigned v) { return __hip_atomic_fetch_add(p, v, __ATOMIC_RELAXED, __HIP_MEMORY_SCOPE_AGENT); }
__device__ __forceinline__ unsigned xb_xcc_id() { return (unsigned)__builtin_amdgcn_s_getreg((3 << 11) | 20) & 0xFu; }
#define XB_SPIN(cond, bar) do { unsigned _sp = 0; while (cond) { __builtin_amdgcn_s_sleep(1); \
    if ((++_sp & 255u) == 0u) { if (xb_ld(&(bar)[XB_TMO])) break; if (_sp > XB_SPIN_CAP) { atomicAdd(&(bar)[XB_TMO], 1u); break; } } } } while (0)

struct XcdBarrier {
    unsigned* bar; unsigned x;
    volatile LAS unsigned* st;
};

__device__ __forceinline__ XcdBarrier xcd_barrier_post(unsigned* bar, volatile LAS unsigned* st) {
    XcdBarrier b; b.bar = bar; b.x = xb_xcc_id(); b.st = st;
    if (threadIdx.x == 0) (void)xb_add(&bar[XB_XCNT(b.x)], 1u);
    return b;
}
__device__ __forceinline__ void xcd_barrier_complete(unsigned* bar, unsigned x, unsigned& nloc, unsigned& nx) {
    const unsigned G = gridDim.x * gridDim.y * gridDim.z;
    unsigned sum, cnt, mine, sp = 0u;
    for (;;) {
        sum = 0u; cnt = 0u; mine = 0u;
#pragma unroll
        for (unsigned j = 0; j < 16; ++j) { const unsigned c = xb_ld(&bar[XB_XCNT(j)]); sum += c; cnt += (c > 0u) ? 1u : 0u; mine = (j == x) ? c : mine; }
        if (sum == G) break;
        __builtin_amdgcn_s_sleep(1);
        if ((++sp & 255u) == 0u) { if (xb_ld(&bar[XB_TMO])) break; if (sp > XB_SPIN_CAP) { atomicAdd(&bar[XB_TMO], 1u); break; } }
    }
    nloc = mine > 0u ? mine : 1u; nx = cnt > 0u ? cnt : 1u;
}

__device__ __forceinline__ void xcd_barrier(const XcdBarrier& b) {
    asm volatile("s_waitcnt vmcnt(0)" ::: "memory");
    __syncthreads();
    if (threadIdx.x == 0) {
        unsigned* bar = b.bar;
        __builtin_amdgcn_s_waitcnt(0);
        unsigned nloc = b.st[0], nx = b.st[1];
        if (nloc == 0u) { xcd_barrier_complete(bar, b.x, nloc, nx); b.st[0] = nloc; b.st[1] = nx; }
        const unsigned old = xb_add(&bar[XB_XSUB(b.x)], 1u);
        const unsigned gen = old / nloc;
        if (old + 1u == (gen + 1u) * nloc) {
            __builtin_amdgcn_fence(__ATOMIC_RELEASE, "agent");
            asm volatile("s_waitcnt vmcnt(0)" ::: "memory");
            const unsigned og = xb_add(&bar[XB_TOP], 1u);
            const unsigned tg = og / nx;
            if (og + 1u == (tg + 1u) * nx) xb_add(&bar[XB_TOPGEN], 1u);
            else XB_SPIN(xb_ld(&bar[XB_TOPGEN]) == tg, bar);
            __builtin_amdgcn_fence(__ATOMIC_ACQUIRE, "agent");
            xb_add(&bar[XB_XGEN(b.x)], 1u);
            asm volatile("s_waitcnt vmcnt(0)" ::: "memory");
        } else {
            XB_SPIN(xb_ld(&bar[XB_XGEN(b.x)]) == gen, bar);
            __builtin_amdgcn_fence(__ATOMIC_ACQUIRE, "agent");
            asm volatile("s_waitcnt vmcnt(0)" ::: "memory");
        }
    }
    __syncthreads();
}

constexpr int NWAVES = 8;
#ifndef MK_N_LAUNCHES
#define MK_N_LAUNCHES 1
#endif
constexpr int N_PHASES = 10;
constexpr int N_LAUNCHES = MK_N_LAUNCHES;
static_assert(N_LAUNCHES == 1 || N_LAUNCHES == N_PHASES, "MK_N_LAUNCHES is 1 or 10");

constexpr size_t MiB = 1u << 20;
constexpr size_t al(size_t x) { return (x + MiB - 1) / MiB * MiB; }
constexpr size_t WS_CTL = 0, CTL_ZERO_BYTES = 32768;
constexpr size_t WS_WIN = 2 * MiB;
constexpr size_t WS_WOUT = WS_WIN + al((size_t)NIN * DM * 2);
constexpr size_t WS_WUP = WS_WOUT + al((size_t)DM * DM * 2);
constexpr size_t WS_WDN = WS_WUP + al((size_t)DFF * DM * 2);
constexpr size_t WS_XN = WS_WDN + al((size_t)DM * DFF * 2);
constexpr size_t WS_QB = WS_XN + al((size_t)MP * DM * 2);
constexpr size_t WS_KCB = WS_QB + al((size_t)MP * 1024 * 2);
constexpr size_t WS_KSB = WS_KCB + al((size_t)MP * 512 * 2);
constexpr size_t WS_KWB = WS_KSB + al((size_t)MP * 512 * 2);
constexpr size_t WS_Z = WS_KWB + al((size_t)MP * 512 * 2);
constexpr size_t WS_XBC = WS_Z + al((size_t)MP * 1024 * 4);
constexpr size_t WS_GD = WS_XBC + al((size_t)MP * CONV_DIM * 4);
constexpr size_t WS_XBCA = WS_GD + al((size_t)MP * 64 * 4);
constexpr size_t WS_DT = WS_XBCA + al((size_t)MP * CONV_DIM * 4);
constexpr size_t WS_KCMPP = WS_DT + al((size_t)MP * 16 * 4);
constexpr size_t WS_KCMPS = WS_KCMPP + al((size_t)NB * NCMP_P * 512 * 4);
constexpr size_t WS_OWIN = WS_KCMPS + al((size_t)DECB * NCMP_S * 512 * 4);
constexpr size_t WS_OCMP = WS_OWIN + al((size_t)MP * 1024 * 4);
constexpr size_t WS_SELIDX = WS_OCMP + al((size_t)MP * 1024 * 4);
constexpr size_t WS_SELMASK = WS_SELIDX + al((size_t)MP * 64 * 4);
constexpr size_t WS_YSSD = WS_SELMASK + al((size_t)MPROMPT * 4 * 8);
constexpr size_t WS_MIX = WS_YSSD + al((size_t)MP * 1024 * 4);
constexpr size_t WS_X1 = WS_MIX + al((size_t)MP * DM * 2);
constexpr size_t WS_X1B = WS_X1 + al((size_t)MP * DM * 4);
constexpr size_t WS_SS1 = WS_X1B + al((size_t)MP * DM * 2);
constexpr size_t WS_H = WS_SS1 + al((size_t)MP * 32 * 4);
constexpr size_t WS_X2 = WS_H + al((size_t)MP * DFF * 2);
constexpr size_t WS_SS2 = WS_X2 + al((size_t)MP * DM * 4);
constexpr size_t WS_W1T = WS_SS2 + al((size_t)MP * 32 * 4);
constexpr size_t WS_PEB = WS_W1T + al((size_t)2 * 128 * 2048 * 2);
constexpr size_t WS_XBCA16 = WS_PEB + MiB;
constexpr size_t WS_ST = WS_XBCA16 + al((size_t)MP * CONV_DIM * 2);
constexpr size_t WS_DEC = WS_ST + al((size_t)NB * 16 * 16 * 8192 * 4);
constexpr size_t WS_ACS = WS_DEC + MiB;
constexpr size_t WS_SS1S = WS_ACS + al((size_t)MPROMPT * 16 * 4);
constexpr size_t WS_SS2S = WS_SS1S + MiB;
constexpr size_t WS_SIN = WS_SS2S + MiB;
constexpr size_t WS_END = WS_SIN + al((size_t)NB * 16 * 16 * 8192 * 2);
constexpr int CW_TMO = 0, CW_CODE = 1, CW_CHK = 8, CW_BAR = 4096;

constexpr int RING_OFF = 0, RING_BYTES = 155648;
constexpr int LDSCTL_OFF = RING_BYTES, MISC_OFF = LDSCTL_OFF + 320;
constexpr int LDS_BYTES = 156160;
static_assert(MISC_OFF + 128 <= LDS_BYTES, "LDS map");

struct Ctx {
    LAS unsigned char* lds; volatile LAS unsigned* MISC; gu32* ctl;
    int tid, lane, wave, vcu, G;
    const __attribute__((address_space(4))) unsigned long long* ka;
    __device__ __forceinline__ const float* x_prompt() const { return (const float*)ka[0]; }
    __device__ __forceinline__ const float* x_sample() const { return (const float*)ka[1]; }
    __device__ __forceinline__ const float* cache_cmp() const { return (const float*)ka[2]; }
    __device__ __forceinline__ const float* cache_sel() const { return (const float*)ka[3]; }
    __device__ __forceinline__ const float* st_win() const { return (const float*)ka[4]; }
    __device__ __forceinline__ const float* st_conv() const { return (const float*)ka[5]; }
    __device__ __forceinline__ const float* st_ssm() const { return (const float*)ka[6]; }
    __device__ __forceinline__ const int* page_table() const { return (const int*)ka[7]; }
    __device__ __forceinline__ const float* ln_mix() const { return (const float*)ka[8]; }
    __device__ __forceinline__ const float* w_in() const { return (const float*)ka[9]; }
    __device__ __forceinline__ const float* cmp_pe() const { return (const float*)ka[10]; }
    __device__ __forceinline__ const float* cmp_w1() const { return (const float*)ka[11]; }
    __device__ __forceinline__ const float* cmp_b1() const { return (const float*)ka[12]; }
    __device__ __forceinline__ const float* cmp_w2() const { return (const float*)ka[13]; }
    __device__ __forceinline__ const float* cmp_b2() const { return (const float*)ka[14]; }
    __device__ __forceinline__ const float* conv_w() const { return (const float*)ka[15]; }
    __device__ __forceinline__ const float* conv_b() const { return (const float*)ka[16]; }
    __device__ __forceinline__ const float* dt_bias() const { return (const float*)ka[17]; }
    __device__ __forceinline__ const float* a_log() const { return (const float*)ka[18]; }
    __device__ __forceinline__ const float* d_skip() const { return (const float*)ka[19]; }
    __device__ __forceinline__ const float* ssm_norm() const { return (const float*)ka[20]; }
    __device__ __forceinline__ const float* w_out() const { return (const float*)ka[21]; }
    __device__ __forceinline__ const float* ln_mlp() const { return (const float*)ka[22]; }
    __device__ __forceinline__ const float* w_up() const { return (const float*)ka[23]; }
    __device__ __forceinline__ const float* w_down() const { return (const float*)ka[24]; }
    __device__ __forceinline__ const float* ln_final() const { return (const float*)ka[25]; }
    __device__ __forceinline__ float* out() const { return (float*)ka[26]; }
    __device__ __forceinline__ unsigned char* ws() const { return (unsigned char*)ka[27]; }
    __device__ __forceinline__ bf16* WIN() const { return (bf16*)(ws() + WS_WIN); }
    __device__ __forceinline__ bf16* WOUT() const { return (bf16*)(ws() + WS_WOUT); }
    __device__ __forceinline__ bf16* WUP() const { return (bf16*)(ws() + WS_WUP); }
    __device__ __forceinline__ bf16* WDN() const { return (bf16*)(ws() + WS_WDN); }
    __device__ __forceinline__ bf16* XN() const { return (bf16*)(ws() + WS_XN); }
    __device__ __forceinline__ bf16* QB() const { return (bf16*)(ws() + WS_QB); }
    __device__ __forceinline__ bf16* KCB() const { return (bf16*)(ws() + WS_KCB); }
    __device__ __forceinline__ bf16* KSB() const { return (bf16*)(ws() + WS_KSB); }
    __device__ __forceinline__ bf16* KWB() const { return (bf16*)(ws() + WS_KWB); }
    __device__ __forceinline__ bf16* MIX() const { return (bf16*)(ws() + WS_MIX); }
    __device__ __forceinline__ bf16* X1B() const { return (bf16*)(ws() + WS_X1B); }
    __device__ __forceinline__ bf16* H() const { return (bf16*)(ws() + WS_H); }
    __device__ __forceinline__ float* Z() const { return (float*)(ws() + WS_Z); }
    __device__ __forceinline__ float* XBC() const { return (float*)(ws() + WS_XBC); }
    __device__ __forceinline__ float* GD() const { return (float*)(ws() + WS_GD); }
    __device__ __forceinline__ float* XBCA() const { return (float*)(ws() + WS_XBCA); }
    __device__ __forceinline__ float* DT() const { return (float*)(ws() + WS_DT); }
    __device__ __forceinline__ float* KCMPP() const { return (float*)(ws() + WS_KCMPP); }
    __device__ __forceinline__ float* KCMPS() const { return (float*)(ws() + WS_KCMPS); }
    __device__ __forceinline__ float* OWIN() const { return (float*)(ws() + WS_OWIN); }
    __device__ __forceinline__ float* OCMP() const { return (float*)(ws() + WS_OCMP); }
    __device__ __forceinline__ float* YSSD() const { return (float*)(ws() + WS_YSSD); }
    __device__ __forceinline__ float* X1() const { return (float*)(ws() + WS_X1); }
    __device__ __forceinline__ float* SS1() const { return (float*)(ws() + WS_SS1); }
    __device__ __forceinline__ float* X2() const { return (float*)(ws() + WS_X2); }
    __device__ __forceinline__ float* SS2() const { return (float*)(ws() + WS_SS2); }
    __device__ __forceinline__ int* SELIDX() const { return (int*)(ws() + WS_SELIDX); }
    __device__ __forceinline__ unsigned long long* SELMASK() const { return (unsigned long long*)(ws() + WS_SELMASK); }
    __device__ __forceinline__ bf16* W1T() const { return (bf16*)(ws() + WS_W1T); }
    __device__ __forceinline__ float* PEB() const { return (float*)(ws() + WS_PEB); }
    __device__ __forceinline__ bf16* XBCA16() const { return (bf16*)(ws() + WS_XBCA16); }
    __device__ __forceinline__ float* ST() const { return (float*)(ws() + WS_ST); }
    __device__ __forceinline__ float* DEC() const { return (float*)(ws() + WS_DEC); }
    __device__ __forceinline__ float* ACS() const { return (float*)(ws() + WS_ACS); }
    __device__ __forceinline__ float* SS1S() const { return (float*)(ws() + WS_SS1S); }
    __device__ __forceinline__ float* SS2S() const { return (float*)(ws() + WS_SS2S); }
    __device__ __forceinline__ bf16* SIN() const { return (bf16*)(ws() + WS_SIN); }
};
__device__ __forceinline__ float bf2f(bf16 x) { return __uint_as_float((unsigned)x << 16); }
__device__ __forceinline__ float wave_sum(float v) {
#pragma unroll
    for (int o = 1; o < 64; o <<= 1) v += __shfl_xor(v, o);
    return v;
}
__device__ __forceinline__ float wave_max(float v) {
#pragma unroll
    for (int o = 1; o < 64; o <<= 1) v = fmaxf(v, __shfl_xor(v, o));
    return v;
}
__device__ __forceinline__ float wave_reduce_t64(float (&a)[64], int lane) {
#pragma unroll
    for (int i = 0; i < 32; ++i) { const bool up = (lane & 32) != 0; const float keep = up ? a[i + 32] : a[i], send = up ? a[i] : a[i + 32]; a[i] = keep + __shfl_xor(send, 32); }
#pragma unroll
    for (int i = 0; i < 16; ++i) { const bool up = (lane & 16) != 0; const float keep = up ? a[i + 16] : a[i], send = up ? a[i] : a[i + 16]; a[i] = keep + __shfl_xor(send, 16); }
#pragma unroll
    for (int i = 0; i < 8; ++i) { const bool up = (lane & 8) != 0; const float keep = up ? a[i + 8] : a[i], send = up ? a[i] : a[i + 8]; a[i] = keep + __shfl_xor(send, 8); }
#pragma unroll
    for (int i = 0; i < 4; ++i) { const bool up = (lane & 4) != 0; const float keep = up ? a[i + 4] : a[i], send = up ? a[i] : a[i + 4]; a[i] = keep + __shfl_xor(send, 4); }
#pragma unroll
    for (int i = 0; i < 2; ++i) { const bool up = (lane & 2) != 0; const float keep = up ? a[i + 2] : a[i], send = up ? a[i] : a[i + 2]; a[i] = keep + __shfl_xor(send, 2); }
    { const bool up = (lane & 1) != 0; const float keep = up ? a[1] : a[0], send = up ? a[0] : a[1]; a[0] = keep + __shfl_xor(send, 1); }
    return a[0];
}
__device__ __forceinline__ float siluf_(float x) { return x / (1.0f + __expf(-x)); }
__device__ __forceinline__ float rdlane(float v, int l) { return __int_as_float(__builtin_amdgcn_readlane(__float_as_int(v), l)); }

__device__ __forceinline__ int win_oldcol(int n) { return n < 2560 ? n : (n < 5120 ? n + 48 : (n < 5168 ? n - 2560 : (n < NCOLS_IN ? n : -1))); }
template <int MODE  >
__device__ __forceinline__ void p0_transpose_item(const float* W, int K, int Nsrc, int Ndst, bf16* WT, const float* rowscale, LAS float* scr, int item, int lane) {
    const int nblk = Ndst / 32, kb = item / nblk, nb = item % nblk, k0 = 64 * kb, n0 = 32 * nb;
    const int ncol = MODE == 1 ? win_oldcol(n0 + (lane & 31)) : n0 + (lane & 31);
    float tv[32];
#pragma unroll
    for (int i = 0; i < 32; ++i) { const int kk = 2 * i + (lane >> 5); float v = 0.f; if (ncol >= 0) v = W[(size_t)(k0 + kk) * Nsrc + ncol]; tv[i] = v; }
#pragma unroll
    for (int i = 0; i < 32; ++i) { const int kk = 2 * i + (lane >> 5); float v = tv[i]; if (rowscale) v *= rowscale[k0 + kk]; scr[kk * 33 + (lane & 31)] = v; }
    LDS_WAIT(); asm volatile("" ::: "memory");
    const int c = lane & 7;
#pragma unroll
    for (int j = 0; j < 4; ++j) { const int n = (lane >> 3) + 8 * j; const LAS float* s = scr + (8 * c) * 33 + n;
        v4u o; o.x = pk2(s[0 * 33], s[1 * 33]); o.y = pk2(s[2 * 33], s[3 * 33]); o.z = pk2(s[4 * 33], s[5 * 33]); o.w = pk2(s[6 * 33], s[7 * 33]);
        *(GAS v4u*)(WT + (size_t)(n0 + n) * K + k0 + 8 * c) = o; }
    LDS_WAIT(); asm volatile("" ::: "memory");
}
__device__ __forceinline__ void p0_prologue(const Ctx& F) {
    LAS float* scr = (LAS float*)(F.lds + RING_OFF + F.wave * 16384);
    const int gw = F.vcu * NWAVES + F.wave, NGW = F.G * NWAVES;
    constexpr int I_IN = (DM / 64) * (NIN / 32);
    for (int it = gw; it < I_IN; it += NGW) p0_transpose_item<1>(F.w_in(), DM, NCOLS_IN, NIN, F.WIN(), nullptr, scr, it, F.lane);
    for (int it = gw; it < 2 * 128; it += NGW) { const int c = it >> 7; p0_transpose_item<0>(F.cmp_w1() + (size_t)c * 2048 * 128, 2048, 128, 128, F.W1T() + (size_t)c * 128 * 2048, nullptr, scr, it & 127, F.lane); }
    for (int it = gw; it < 64; it += NGW) { const int c = it >> 5, fh = (it >> 4) & 1, kc = it & 15, f = fh * 64 + F.lane; const float* w = F.cmp_w1() + ((size_t)c * 2048 + kc * 128) * 128 + f; const float* pe = F.cmp_pe() + c * 2048 + kc * 128; float acc = 0.f;
#pragma unroll 16
        for (int k = 0; k < 128; ++k) acc += pe[k] * w[(size_t)k * 128];
        F.PEB()[(c * 16 + kc) * 128 + f] = acc; }
    for (int m = gw; m < MP; m += NGW) {
        GAS unsigned long long* o8 = (GAS unsigned long long*)(F.XN() + (size_t)m * DM) + F.lane;
        if (m >= MROWS) { GAS unsigned long long* z8 = (GAS unsigned long long*)(F.MIX() + (size_t)m * DM) + F.lane;
#pragma unroll
            for (int j = 0; j < 8; ++j) { o8[64 * j] = 0ull; z8[64 * j] = 0ull; }
            continue; }
        const float* xrow = m < MPROMPT ? F.x_prompt() + (size_t)m * DM : F.x_sample() + (size_t)(m - MPROMPT) * DM;
        const GAS f32x4* xr = (const GAS f32x4*)xrow + F.lane; const GAS f32x4* wr = (const GAS f32x4*)F.ln_mix() + F.lane;
        f32x4 v[8]; float s = 0.f;
#pragma unroll
        for (int j = 0; j < 8; ++j) { v[j] = xr[64 * j]; s += (v[j].x * v[j].x + v[j].y * v[j].y) + (v[j].z * v[j].z + v[j].w * v[j].w); }
        const float rstd = 1.0f / sqrtf(wave_sum(s) * (1.0f / DM) + NORM_EPS);
#pragma unroll
        for (int j = 0; j < 8; ++j) { const f32x4 w = wr[64 * j]; o8[64 * j] = (unsigned long long)pk2(v[j].x * rstd * w.x, v[j].y * rstd * w.y) | ((unsigned long long)pk2(v[j].z * rstd * w.z, v[j].w * rstd * w.w) << 32); }
    }
}
constexpr int W_ITEMS = (DM / 64) * (DM / 32) + (DM / 64) * (DFF / 32) + (DFF / 64) * (DM / 32), W_ITEMS_P1 = 7680;
__device__ __forceinline__ void weight_items(const Ctx& F, int it0, int it1, int wv, int nw) {
    LAS float* scr = (LAS float*)(F.lds + RING_OFF + F.wave * 16384);
    constexpr int I_OUT = (DM / 64) * (DM / 32), I_UP = (DM / 64) * (DFF / 32);
    for (int it = it0 + wv; it < it1; it += nw) {
        int r = it;
        if (r < I_OUT) { p0_transpose_item<0>(F.w_out(), DM, DM, DM, F.WOUT(), nullptr, scr, r, F.lane); continue; } r -= I_OUT;
        if (r < I_UP) { p0_transpose_item<0>(F.w_up(), DM, DFF, DFF, F.WUP(), F.ln_mlp(), scr, r, F.lane); continue; } r -= I_UP;
        p0_transpose_item<0>(F.w_down(), DFF, DM, DM, F.WDN(), nullptr, scr, r, F.lane);
    }
}
__device__ __forceinline__ void winbuf_copy(const Ctx& F) {
    { const int gt = F.vcu * (NWAVES * 64) + F.tid, NGT = F.G * NWAVES * 64; constexpr int TOT = DECB * 511 * 128;
      for (int i = gt; i < TOT; i += NGT) { const int b = i / (511 * 128), r = i % (511 * 128), row = r >> 7, c4 = r & 127;
          *(f32x4*)(F.out() + O_KWS + ((size_t)(b * 512 + row) * 512) + c4 * 4) = *(const f32x4*)(F.st_win() + ((size_t)(b * 512 + row + 1) * 512) + c4 * 4); } }
}

struct KeyRef { const void* k; const void* v; int f32; int valid; };
template <int NCH, class KF>
__device__ __forceinline__ void naive_attn2(const bf16* q2, const KF& kf, LAS float* qs, LAS float* sc, LAS float* ps, bool use_ps, int lane, float& o0, float& o1) {
    qs[lane] = bf2f(q2[lane]) * 0.125f; qs[64 + lane] = bf2f(q2[64 + lane]) * 0.125f;
    for (int c = 0; c < NCH; ++c) {
        const KeyRef kr = kf(c, lane);
        float s0 = -INFINITY, s1 = -INFINITY;
        if (kr.valid) {
            float k[64];
            if (kr.f32) { const f32x4* p = (const f32x4*)kr.k;
#pragma unroll
                for (int i = 0; i < 16; ++i) { const f32x4 t = p[i]; k[4 * i] = t.x; k[4 * i + 1] = t.y; k[4 * i + 2] = t.z; k[4 * i + 3] = t.w; } }
            else { const v4u* p = (const v4u*)kr.k;
#pragma unroll
                for (int i = 0; i < 8; ++i) { const v4u t = p[i]; k[8 * i] = __uint_as_float(t.x << 16); k[8 * i + 1] = __uint_as_float(t.x & 0xffff0000u); k[8 * i + 2] = __uint_as_float(t.y << 16); k[8 * i + 3] = __uint_as_float(t.y & 0xffff0000u);
                    k[8 * i + 4] = __uint_as_float(t.z << 16); k[8 * i + 5] = __uint_as_float(t.z & 0xffff0000u); k[8 * i + 6] = __uint_as_float(t.w << 16); k[8 * i + 7] = __uint_as_float(t.w & 0xffff0000u); } }
            s0 = 0.f; s1 = 0.f;
#pragma unroll
            for (int d = 0; d < 64; ++d) { s0 += qs[d] * k[d]; s1 += qs[64 + d] * k[d]; }
        }
        sc[c * 64 + lane] = s0; sc[NCH * 64 + c * 64 + lane] = s1;
    }
#pragma unroll
    for (int hh = 0; hh < 2; ++hh) { LAS float* s = sc + hh * NCH * 64; float m = -INFINITY;
        for (int c = 0; c < NCH; ++c) m = fmaxf(m, s[c * 64 + lane]);
        m = wave_max(m); if (m == -INFINITY) m = 0.f;
        float sum = 0.f;
        for (int c = 0; c < NCH; ++c) { const float e = __expf(s[c * 64 + lane] - m); s[c * 64 + lane] = e; sum += e; }
        sum = wave_sum(sum); const float inv = 1.0f / fmaxf(sum, 1e-30f);
        for (int c = 0; c < NCH; ++c) { const float p = s[c * 64 + lane] * inv; s[c * 64 + lane] = p; if (use_ps) ps[1 + c * 64 + lane] += p; } }
    o0 = 0.f; o1 = 0.f;
#pragma unroll
    for (int hh = 0; hh < 2; ++hh) {
        float a0[64];
#pragma unroll
        for (int d = 0; d < 64; ++d) a0[d] = 0.f;
        for (int c = 0; c < NCH; ++c) {
            const KeyRef kr = kf(c, lane);
            if (kr.valid) {
                const float p0 = sc[hh * NCH * 64 + c * 64 + lane];
                if (kr.f32) { const f32x4* p = (const f32x4*)kr.v;
#pragma unroll
                    for (int i = 0; i < 16; ++i) { const f32x4 t = p[i]; a0[4 * i] += p0 * t.x; a0[4 * i + 1] += p0 * t.y; a0[4 * i + 2] += p0 * t.z; a0[4 * i + 3] += p0 * t.w; } }
                else { const v4u* p = (const v4u*)kr.v;
#pragma unroll
                    for (int i = 0; i < 8; ++i) { const v4u t = p[i]; a0[8 * i] += p0 * __uint_as_float(t.x << 16); a0[8 * i + 1] += p0 * __uint_as_float(t.x & 0xffff0000u); a0[8 * i + 2] += p0 * __uint_as_float(t.y << 16); a0[8 * i + 3] += p0 * __uint_as_float(t.y & 0xffff0000u);
                        a0[8 * i + 4] += p0 * __uint_as_float(t.z << 16); a0[8 * i + 5] += p0 * __uint_as_float(t.z & 0xffff0000u); a0[8 * i + 6] += p0 * __uint_as_float(t.w << 16); a0[8 * i + 7] += p0 * __uint_as_float(t.w & 0xffff0000u); } }
            }
        }
        const float s0 = wave_reduce_t64(a0, lane); if (hh == 0) o0 = s0; else o1 = s0;
    }
}
struct CmpKeys { const float* base; int g, ncmp, qpos;
    __device__ __forceinline__ KeyRef operator()(int c, int l) const { const int n = c * 64 + l; KeyRef r; r.valid = (n < ncmp) && (16 * n + 31 <= qpos); r.f32 = 1; r.k = base + (size_t)(r.valid ? n : 0) * 512 + g * 64; r.v = (const float*)r.k + 256; return r; } };
struct WinKeysP { const bf16* kw; int g, t;
    __device__ __forceinline__ KeyRef operator()(int c, int l) const { const int pos = t - 511 + c * 64 + l; KeyRef r; r.valid = pos >= 0; r.f32 = 0; r.k = kw + (size_t)(r.valid ? pos : 0) * 512 + g * 64; r.v = (const bf16*)r.k + 256; return r; } };
struct WinKeysS { const float* st; const bf16* nw; int g;
    __device__ __forceinline__ KeyRef operator()(int c, int l) const { const int i = 1 + c * 64 + l; KeyRef r; r.valid = 1;
        if (i < 512) { r.f32 = 1; r.k = st + (size_t)i * 512 + g * 64; r.v = (const float*)r.k + 256; } else { r.f32 = 0; r.k = nw + g * 64; r.v = nw + 256 + g * 64; } return r; } };
struct SelKeysP { const int* idx; const bf16* ks; int g, qpos;
    __device__ __forceinline__ KeyRef operator()(int c, int l) const { const int pos = idx[c] * 64 + l; KeyRef r; r.valid = pos <= qpos; r.f32 = 0; r.k = ks + (size_t)(r.valid ? pos : 0) * 512 + g * 64; r.v = (const bf16*)r.k + 256; return r; } };
struct SelKeysS { const int* idx; const int* pt; const float* cache; const bf16* nw; int g;
    __device__ __forceinline__ KeyRef operator()(int c, int l) const { const int pos = idx[c] * 64 + l; KeyRef r; r.valid = pos <= PAST;
        if (pos < PAST) { const int page = pt[pos >> 7]; r.f32 = 1; r.k = cache + ((size_t)page * 128 + (pos & 127)) * 512 + g * 64; r.v = (const float*)r.k + 256; } else { r.f32 = 0; r.k = nw + g * 64; r.v = nw + 256 + g * 64; } return r; } };

constexpr int NA_WAVE_LDS = 14336;
__device__ __forceinline__ void na_ptrs(const Ctx& F, LAS float*& qs, LAS float*& sc, LAS float*& ps, LAS float*& imp) {
    LAS unsigned char* b = F.lds + RING_OFF + F.wave * NA_WAVE_LDS; qs = (LAS float*)b; sc = (LAS float*)(b + 512); ps = (LAS float*)(b + 8704); imp = (LAS float*)(b + 10880); }

template <bool CHK>
__device__ __forceinline__ void compress_task(const Ctx& F, int task, int lane) {
    constexpr int NT_P = NB * NCMP_P * 2;
    const bool dec = task >= NT_P; const int tt = dec ? task - NT_P : task, ncmp = dec ? NCMP_S : NCMP_P, bb = tt / (ncmp * 2), rr = tt % (ncmp * 2), n = rr >> 1, c = rr & 1;
    float h0[4] = {0.f, 0.f, 0.f, 0.f}, h1[4] = {0.f, 0.f, 0.f, 0.f};
    const float* w1 = F.cmp_w1() + (size_t)c * 2048 * 128; const float* pe = F.cmp_pe() + c * 2048;
    for (int l = 0; l < 32; ++l) {
        const int pos = 16 * n + l; const float* row;
        if (!dec) row = F.out() + O_KCP + (size_t)(bb * SEQ + pos) * 512; else { const int page = F.page_table()[bb * 64 + (pos >> 7)]; row = F.cache_cmp() + ((size_t)page * 128 + (pos & 127)) * 512; }
        const float pv = pe[l * 64 + lane]; float xg[4];
#pragma unroll
        for (int g = 0; g < 4; ++g) xg[g] = row[c * 256 + g * 64 + lane] + pv;
        const float* wl = w1 + (size_t)l * 64 * 128;
#pragma unroll 8
        for (int d = 0; d < 64; ++d) { const float wa = wl[d * 128 + lane], wb = wl[d * 128 + 64 + lane];
#pragma unroll
            for (int g = 0; g < 4; ++g) { const float xv = rdlane(xg[g], d); h0[g] += xv * wa; h1[g] += xv * wb; } }
    }
    const float ba = F.cmp_b1()[c * 128 + lane], bb1 = F.cmp_b1()[c * 128 + 64 + lane];
#pragma unroll
    for (int g = 0; g < 4; ++g) { h0[g] = siluf_(h0[g] + ba); h1[g] = siluf_(h1[g] + bb1); }
    const float* w2 = F.cmp_w2() + (size_t)c * 128 * 64; const float b2 = F.cmp_b2()[c * 64 + lane];
    float o[4] = {b2, b2, b2, b2};
    for (int f = 0; f < 64; ++f) { const float wa = w2[f * 64 + lane], wb = w2[(64 + f) * 64 + lane];
#pragma unroll
        for (int g = 0; g < 4; ++g) o[g] += rdlane(h0[g], f) * wa + rdlane(h1[g], f) * wb; }
    float* dst = (dec ? F.KCMPS() : F.KCMPP()) + ((size_t)(bb * ncmp + n) * 2 + c) * 256;
#pragma unroll
    for (int g = 0; g < 4; ++g) { if (CHK) { const float df = fabsf(o[g] - dst[g * 64 + lane]);
            if (!(df <= 0.02f + 0.02f * fabsf(o[g]))) __hip_atomic_fetch_or((unsigned*)F.ctl + CW_CHK + (!dec ? 0 : ((n & 127) == 127 ? 1 : 2)), 1u, RLX_AGENT);
            if (!(df <= 0.2f)) __hip_atomic_fetch_or((unsigned*)F.ctl + CW_CHK + 3, 1u, RLX_AGENT); } else dst[g * 64 + lane] = o[g]; }
}
__device__ __forceinline__ void compress_ref_check(const Ctx& F, int task, int g, int lane, int dbgslot) {
    constexpr int NT_P = NB * NCMP_P * 2;
    const bool dec = task >= NT_P; const int tt = dec ? task - NT_P : task, ncmp = dec ? NCMP_S : NCMP_P, bb = tt / (ncmp * 2), rr = tt % (ncmp * 2), n = rr >> 1, c = rr & 1;
    LAS float* hl = (LAS float*)(F.lds + RING_OFF + F.wave * NA_WAVE_LDS);
    float ha = 0.f, hb2 = 0.f;
    for (int k = 0; k < 2048; ++k) { const int l = k >> 6, d = k & 63, pos = 16 * n + l; const float* row;
        if (!dec) row = F.out() + O_KCP + (size_t)(bb * SEQ + pos) * 512; else { const int page = F.page_table()[bb * 64 + (pos >> 7)]; row = F.cache_cmp() + ((size_t)page * 128 + (pos & 127)) * 512; }
        const float x = row[c * 256 + g * 64 + d] + F.cmp_pe()[c * 2048 + k]; const float* w = F.cmp_w1() + ((size_t)c * 2048 + k) * 128;
        ha += x * w[lane]; hb2 += x * w[64 + lane]; }
    if (dbgslot >= 0) { const float* HD = (const float*)F.H() + (size_t)dbgslot * 512 * 128 + (size_t)(((n & 127) << 2) + g) * 128; float pa = 0.f, pb = 0.f; for (int kc = 0; kc < 16; ++kc) { pa += F.PEB()[(c * 16 + kc) * 128 + lane]; pb += F.PEB()[(c * 16 + kc) * 128 + 64 + lane]; }
        if (!(fabsf(HD[lane] + pa - ha) <= 0.05f + 0.05f * fabsf(ha)) || !(fabsf(HD[64 + lane] + pb - hb2) <= 0.05f + 0.05f * fabsf(hb2))) __hip_atomic_fetch_or((unsigned*)F.ctl + CW_CHK + 5 + dbgslot, 1u, RLX_AGENT); }
    ha += F.cmp_b1()[c * 128 + lane]; hb2 += F.cmp_b1()[c * 128 + 64 + lane];
    hl[lane] = ha / (1.0f + __expf(-ha)); hl[64 + lane] = hb2 / (1.0f + __expf(-hb2));
    float o = F.cmp_b2()[c * 64 + lane];
    for (int f = 0; f < 128; ++f) o += hl[f] * F.cmp_w2()[((size_t)c * 128 + f) * 64 + lane];
    const float got = (dec ? F.KCMPS() : F.KCMPP())[((size_t)(bb * ncmp + n) * 2 + c) * 256 + g * 64 + lane];
    if (!(fabsf(o - got) <= 0.05f + 0.05f * fabsf(o))) __hip_atomic_fetch_or((unsigned*)F.ctl + CW_CHK + 4, 1u, RLX_AGENT);
}
__device__ __forceinline__ void conv_prepass(const Ctx& F) {
    const int gt = F.vcu * (NWAVES * 64) + F.tid, NGT = F.G * NWAVES * 64;
    constexpr int TOTP = (MPROMPT / 8) * (CONV_DIM / 4);
    for (int i = gt; i < TOTP; i += NGT) {
        const int rb = i / (CONV_DIM / 4), c4 = i % (CONV_DIM / 4), col = c4 * 4, m0 = rb * 8, t0 = m0 & (SEQ - 1), b = m0 >> 12;
        f32x4 xr[11];
#pragma unroll
        for (int k = 0; k < 11; ++k) xr[k] = (t0 - 3 + k >= 0) ? *(const f32x4*)(F.XBC() + (size_t)(m0 - 3 + k) * CONV_DIM + col) : (f32x4){0.f, 0.f, 0.f, 0.f};
        const f32x4 bias = *(const f32x4*)(F.conv_b() + col), w0 = *(const f32x4*)(F.conv_w() + col), w1 = *(const f32x4*)(F.conv_w() + CONV_DIM + col), w2 = *(const f32x4*)(F.conv_w() + 2 * CONV_DIM + col), w3 = *(const f32x4*)(F.conv_w() + 3 * CONV_DIM + col);
#pragma unroll
        for (int r = 0; r < 8; ++r) { const f32x4 acc = bias + xr[r] * w0 + xr[r + 1] * w1 + xr[r + 2] * w2 + xr[r + 3] * w3;
            typedef unsigned u32x2v __attribute__((ext_vector_type(2))); u32x2v w; w.x = pk2(siluf_(acc.x), siluf_(acc.y)); w.y = pk2(siluf_(acc.z), siluf_(acc.w)); *(u32x2v*)(F.XBCA16() + (size_t)(m0 + r) * CONV_DIM + col) = w;
            if (t0 + r >= SEQ - 3) *(f32x4*)(F.out() + O_CVP + (size_t)(b * 3 + (t0 + r - (SEQ - 3))) * CONV_DIM + col) = xr[r + 3]; }
        if (c4 < 4) {
#pragma unroll
            for (int r = 0; r < 8; ++r)
#pragma unroll
                for (int e = 0; e < 4; ++e) { const int h = c4 * 4 + e; const float x = F.GD()[(size_t)(m0 + r) * 64 + 48 + h] + F.dt_bias()[h]; F.DT()[(size_t)(m0 + r) * 16 + h] = x > 20.f ? x : log1pf(__expf(x)); } }
    }
    constexpr int TOTS = DECB * (CONV_DIM / 4);
    for (int i = gt; i < TOTS; i += NGT) {
        const int b = i / (CONV_DIM / 4), c4 = i % (CONV_DIM / 4), col = c4 * 4; const size_t m = (size_t)MPROMPT + b;
        f32x4 acc = *(const f32x4*)(F.conv_b() + col);
#pragma unroll
        for (int w = 0; w < 3; ++w) acc += *(const f32x4*)(F.st_conv() + (size_t)(b * 3 + w) * CONV_DIM + col) * *(const f32x4*)(F.conv_w() + (size_t)w * CONV_DIM + col);
        const f32x4 xcur = *(const f32x4*)(F.XBC() + m * CONV_DIM + col); acc += xcur * *(const f32x4*)(F.conv_w() + (size_t)3 * CONV_DIM + col);
        f32x4 a; a.x = siluf_(acc.x); a.y = siluf_(acc.y); a.z = siluf_(acc.z); a.w = siluf_(acc.w);
        *(f32x4*)(F.XBCA() + m * CONV_DIM + col) = a;
        { typedef unsigned u32x2v __attribute__((ext_vector_type(2))); u32x2v w; w.x = pk2(a.x, a.y); w.y = pk2(a.z, a.w); *(u32x2v*)(F.XBCA16() + m * CONV_DIM + col) = w; }
        *(f32x4*)(F.out() + O_CVS + (size_t)(b * 3 + 0) * CONV_DIM + col) = *(const f32x4*)(F.st_conv() + (size_t)(b * 3 + 1) * CONV_DIM + col);
        *(f32x4*)(F.out() + O_CVS + (size_t)(b * 3 + 1) * CONV_DIM + col) = *(const f32x4*)(F.st_conv() + (size_t)(b * 3 + 2) * CONV_DIM + col);
        *(f32x4*)(F.out() + O_CVS + (size_t)(b * 3 + 2) * CONV_DIM + col) = xcur;
        if (c4 < 4) {
#pragma unroll
            for (int e = 0; e < 4; ++e) { const int h = c4 * 4 + e; const float x = F.GD()[m * 64 + 48 + h] + F.dt_bias()[h]; F.DT()[m * 16 + h] = x > 20.f ? x : log1pf(__expf(x)); } }
    }
}
template <bool CHK>
__device__ __forceinline__ void win_task(const Ctx& F, int task, int lane) {
    LAS float *qs, *sc, *ps, *imp; na_ptrs(F, qs, sc, ps, imp);
    const int m = task >> 2, g = task & 3; const bool dec = m >= MPROMPT; const int b = dec ? m - MPROMPT : m >> 12, t = m & (SEQ - 1);
#pragma unroll
    for (int pr = 0; pr < 2; ++pr) { float o0, o1; const bf16* q2 = F.QB() + (size_t)m * 1024 + g * 256 + pr * 128;
        if (!dec) { const WinKeysP kf{F.KWB() + (size_t)b * SEQ * 512, g, t}; naive_attn2<8>(q2, kf, qs, sc, ps, false, lane, o0, o1); }
        else { const WinKeysS kf{F.st_win() + (size_t)b * 512 * 512, F.KWB() + (size_t)m * 512, g}; naive_attn2<8>(q2, kf, qs, sc, ps, false, lane, o0, o1); }
        float* d0 = F.OWIN() + (size_t)m * 1024 + (g * 4 + pr * 2) * 64 + lane;
        if (CHK) { if (!(fabsf(o0 - d0[0]) <= 2e-3f) || !(fabsf(o1 - d0[64]) <= 2e-3f)) __hip_atomic_fetch_or((unsigned*)F.ctl + CW_CHK + 0, 1u, RLX_AGENT); }
        else { d0[0] = o0; d0[64] = o1; } }
}
template <bool CHK>
__device__ __forceinline__ void cmp_task(const Ctx& F, int task, int lane) {
    LAS float *qs, *sc, *ps, *imp; na_ptrs(F, qs, sc, ps, imp);
    const int m = task >> 2, g = task & 3; const bool dec = m >= MPROMPT; const int b = dec ? m - MPROMPT : m >> 12, t = m & (SEQ - 1);
    const int qpos = dec ? PAST : t, ncmp = dec ? NCMP_S : NCMP_P, nslc = dec ? NSLC_S : NSLC_P, jt = qpos >> 6;
    for (int i = lane; i < 544; i += 64) ps[i] = 0.f;
    const CmpKeys kf{dec ? F.KCMPS() + (size_t)b * NCMP_S * 512 : F.KCMPP() + (size_t)b * NCMP_P * 512, g, ncmp, qpos};
#pragma unroll
    for (int pr = 0; pr < 2; ++pr) { float o0, o1; naive_attn2<8>(F.QB() + (size_t)m * 1024 + g * 256 + pr * 128, kf, qs, sc, ps, true, lane, o0, o1);
        float* d0 = F.OCMP() + (size_t)m * 1024 + (g * 4 + pr * 2) * 64 + lane;
        if (CHK) { if (!(fabsf(o0 - d0[0]) <= 5e-3f + 0.02f * fabsf(o0)) || !(fabsf(o1 - d0[64]) <= 5e-3f + 0.02f * fabsf(o1))) __hip_atomic_fetch_or((unsigned*)F.ctl + CW_CHK + 0, 1u, RLX_AGENT);
                   if (!(fabsf(o0 - d0[0]) <= 0.05f) || !(fabsf(o1 - d0[64]) <= 0.05f)) __hip_atomic_fetch_or((unsigned*)F.ctl + CW_CHK + 3, 1u, RLX_AGENT); }
        else { d0[0] = o0; d0[64] = o1; } }
    float mine[3]; int cnt[3];
#pragma unroll
    for (int jj = 0; jj < 3; ++jj) { const int j = jj * 64 + lane; float v = 0.f; cnt[jj] = 0;
        if (j < nslc) { v = ps[4 * j] + 2.0f * (ps[4 * j + 1] + ps[4 * j + 2] + ps[4 * j + 3]) + ps[4 * j + 4]; if (j == 0 || j == jt || j == jt - 1) v = 1.0e4f; if (j > jt) v = -1.0e4f; imp[j] = v; }
        mine[jj] = v; }
    for (int k = 0; k < nslc; ++k) { const float v = imp[k];
#pragma unroll
        for (int jj = 0; jj < 3; ++jj) { const int j = jj * 64 + lane; cnt[jj] += ((v > mine[jj]) || (v == mine[jj] && k < j)) ? 1 : 0; } }
    int base = 0;
#pragma unroll
    for (int jj = 0; jj < 3; ++jj) { const int j = jj * 64 + lane; const bool sel = (j < nslc) && (cnt[jj] < 16); const unsigned long long bal = __ballot(sel);
        if (CHK && dec) { bool stored = false; for (int i = 0; i < 16; ++i) stored = stored || (F.SELIDX()[(size_t)task * 16 + i] == j);
            if (__ballot((j < nslc) && (stored != sel)) != 0ull && lane == 0) __hip_atomic_fetch_or((unsigned*)F.ctl + CW_CHK + 2, 1u, RLX_AGENT); }
        else if (CHK) { if (jj == 0 && lane == 0 && F.SELMASK()[task] != bal) { if (__hip_atomic_fetch_add((unsigned*)F.ctl + CW_CHK + 8, 1u, RLX_AGENT) >= 100u) __hip_atomic_fetch_or((unsigned*)F.ctl + CW_CHK + 1, 1u, RLX_AGENT); if (__popcll(F.SELMASK()[task] ^ bal) > 2) __hip_atomic_fetch_or((unsigned*)F.ctl + CW_CHK + 2, 1u, RLX_AGENT); } }
        else { if (sel) F.SELIDX()[(size_t)task * 16 + base + __popcll(bal & ((1ull << lane) - 1ull))] = j;
        if (!dec && jj == 0 && lane == 0) F.SELMASK()[task] = bal; }
        base += __popcll(bal); }
}
template <bool CHK>
__device__ __forceinline__ void sel_task(const Ctx& F, int task, int lane) {
    LAS float *qs, *sc, *ps, *imp; na_ptrs(F, qs, sc, ps, imp);
    const int m = task >> 2, g = task & 3; const bool dec = m >= MPROMPT; const int b = dec ? m - MPROMPT : m >> 12, t = m & (SEQ - 1);
#pragma unroll
    for (int pr = 0; pr < 2; ++pr) { float o0, o1; const bf16* q2 = F.QB() + (size_t)m * 1024 + g * 256 + pr * 128;
        if (!dec) { LAS int* il = (LAS int*)imp;
            const unsigned long long mk = F.SELMASK()[task]; if ((mk >> lane) & 1ull) il[__popcll(mk & ((1ull << lane) - 1ull))] = lane;
            const SelKeysP kf{(const int*)il, F.KSB() + (size_t)b * SEQ * 512, g, t}; naive_attn2<16>(q2, kf, qs, sc, ps, false, lane, o0, o1); }
        else { const SelKeysS kf{F.SELIDX() + (size_t)task * 16, F.page_table() + b * 64, F.cache_sel(), F.KSB() + (size_t)m * 512, g}; naive_attn2<16>(q2, kf, qs, sc, ps, false, lane, o0, o1); }
#pragma unroll
        for (int e = 0; e < 2; ++e) { const int hd = g * 4 + pr * 2 + e; const float* gt = F.GD() + (size_t)m * 64 + hd * 3; const size_t oi = (size_t)m * 1024 + hd * 64 + lane;
            const float a = gt[0] * F.OCMP()[oi] + gt[1] * (e ? o1 : o0) + gt[2] * F.OWIN()[oi]; bf16* dm = F.MIX() + (size_t)m * DM + hd * 64 + lane;
            if (CHK) { if (!(fabsf(a - bf2f(*dm)) <= 2e-3f + 0.01f * fabsf(a))) __hip_atomic_fetch_or((unsigned*)F.ctl + CW_CHK + 1, 1u, RLX_AGENT); } else *dm = (bf16)f2bf(a); } }
}
template <int U>
__device__ __forceinline__ void ssd_chain(const Ctx& F, int rowbase, int L, int h, int p, const float* s0, float* sfin, int lane) {
    const int grp = h >> 3; float h0 = 0.f, h1 = 0.f; if (s0) { h0 = s0[lane]; h1 = s0[64 + lane]; }
    const float A = -__expf(F.a_log()[h]), Dk = F.d_skip()[h];
    for (int t0 = 0; t0 < L; t0 += U) {
        float dt[U], x[U], B0[U], B1[U], C0[U], C1[U];
#pragma unroll
        for (int u = 0; u < U; ++u) { const size_t m = (size_t)(rowbase + t0 + u); dt[u] = F.DT()[m * 16 + h]; const float* r = F.XBCA() + m * CONV_DIM; x[u] = r[h * 64 + p];
            B0[u] = r[1024 + grp * 128 + lane]; B1[u] = r[1024 + grp * 128 + 64 + lane]; C0[u] = r[1280 + grp * 128 + lane]; C1[u] = r[1280 + grp * 128 + 64 + lane]; }
        float y[U];
#pragma unroll
        for (int u = 0; u < U; ++u) { const float dA = __expf(dt[u] * A), xd = dt[u] * x[u]; h0 = h0 * dA + xd * B0[u]; h1 = h1 * dA + xd * B1[u]; y[u] = wave_sum(C0[u] * h0 + C1[u] * h1) + Dk * x[u]; }
        if (lane == 0) {
#pragma unroll
            for (int u = 0; u < U; ++u) F.YSSD()[(size_t)(rowbase + t0 + u) * 1024 + h * 64 + p] = y[u]; }
    }
    sfin[lane] = h0; sfin[64 + lane] = h1;
}
__device__ __forceinline__ void ssd_task(const Ctx& F, int task, int lane) {
    if (task < NB * 16 * 64) { const int b = task >> 10, h = (task >> 6) & 15, p = task & 63; ssd_chain<4>(F, b * SEQ, SEQ, h, p, nullptr, F.out() + O_SSP + (size_t)task * 128, lane); }
    else { const int tk = task - NB * 16 * 64, b = tk >> 10, h = (tk >> 6) & 15, p = tk & 63; ssd_chain<1>(F, MPROMPT + b, 1, h, p, F.st_ssm() + (size_t)tk * 128, F.out() + O_SSS + (size_t)tk * 128, lane); }
}
__device__ __forceinline__ void ssd_decode_task(const Ctx& F, int task, int lane) {
    const int pg = task & 7, h = (task >> 3) & 15, b = task >> 7, grp = h >> 3; const size_t m = (size_t)MPROMPT + b;
    const float* r = F.XBCA() + m * CONV_DIM; const float dt = F.DT()[m * 16 + h], A = -__expf(F.a_log()[h]), Dk = F.d_skip()[h], dA = __expf(dt * A);
    const float B0 = r[1024 + grp * 128 + lane], B1 = r[1024 + grp * 128 + 64 + lane], C0 = r[1280 + grp * 128 + lane], C1 = r[1280 + grp * 128 + 64 + lane];
    const size_t sb = ((size_t)(b * 16 + h) * 64 + pg * 8) * 128;
    float h0[8], h1[8], x[8];
#pragma unroll
    for (int i = 0; i < 8; ++i) { h0[i] = F.st_ssm()[sb + i * 128 + lane]; h1[i] = F.st_ssm()[sb + i * 128 + 64 + lane]; x[i] = r[h * 64 + pg * 8 + i]; }
#pragma unroll
    for (int i = 0; i < 8; ++i) { const float xd = dt * x[i]; h0[i] = h0[i] * dA + xd * B0; h1[i] = h1[i] * dA + xd * B1;
        F.out()[O_SSS + sb + i * 128 + lane] = h0[i]; F.out()[O_SSS + sb + i * 128 + 64 + lane] = h1[i];
        const float y = wave_sum(C0 * h0[i] + C1 * h1[i]) + Dk * x[i]; if (lane == 0) F.YSSD()[m * 1024 + h * 64 + pg * 8 + i] = y; }
}
__device__ __forceinline__ void ssd_gate_task(const Ctx& F, int task, int lane) {
    const int m = task >> 1, grp = task & 1; const size_t o = (size_t)m * 1024 + grp * 512 + lane * 8;
    const f32x4 y0 = *(const f32x4*)(F.YSSD() + o), y1 = *(const f32x4*)(F.YSSD() + o + 4), z0 = *(const f32x4*)(F.Z() + o), z1 = *(const f32x4*)(F.Z() + o + 4);
    float v[8] = {y0.x * siluf_(z0.x), y0.y * siluf_(z0.y), y0.z * siluf_(z0.z), y0.w * siluf_(z0.w), y1.x * siluf_(z1.x), y1.y * siluf_(z1.y), y1.z * siluf_(z1.z), y1.w * siluf_(z1.w)};
    float ss = 0.f;
#pragma unroll
    for (int e = 0; e < 8; ++e) ss += v[e] * v[e];
    const float rstd = 1.0f / sqrtf(wave_sum(ss) * (1.0f / 512.0f) + NORM_EPS);
    const float* w = F.ssm_norm() + grp * 512 + lane * 8;
    v4u ow; ow.x = pk2(v[0] * rstd * w[0], v[1] * rstd * w[1]); ow.y = pk2(v[2] * rstd * w[2], v[3] * rstd * w[3]); ow.z = pk2(v[4] * rstd * w[4], v[5] * rstd * w[5]); ow.w = pk2(v[6] * rstd * w[6], v[7] * rstd * w[7]);
    *(v4u*)(F.MIX() + (size_t)m * DM + 1024 + grp * 512 + lane * 8) = ow;
}
__device__ __forceinline__ void final_norm_row(const Ctx& F, int m, int lane) {
    float s = m < MPROMPT ? (lane < 32 ? F.SS2()[(size_t)m * 32 + lane] : 0.f) : F.SS2S()[(size_t)(m - MPROMPT) * 64 + lane]; s = wave_sum(s);
    const float rstd = 1.0f / sqrtf(s * (1.0f / DM) + NORM_EPS);
    const f32x4* xr = (const f32x4*)(F.X2() + (size_t)m * DM) + lane; const f32x4* wr = (const f32x4*)F.ln_final() + lane;
    f32x4* o = (f32x4*)(m < MPROMPT ? F.out() + O_YP + (size_t)m * DM : F.out() + O_YS + (size_t)(m - MPROMPT) * DM) + lane;
#pragma unroll
    for (int j = 0; j < 8; ++j) o[64 * j] = xr[64 * j] * rstd * wr[64 * j];
}

namespace fa {
typedef short bf16x8 __attribute__((ext_vector_type(8)));
typedef short s16x4 __attribute__((ext_vector_type(4)));
typedef float f32x16 __attribute__((ext_vector_type(16)));
constexpr float C2 = 0.125f * 1.4426950408889634f, MASKV = -1.0e30f;
constexpr int LK = 0, LV = 16384, LWS = 32768, LDS_BYTES_FA = 34816;
__device__ __forceinline__ int crow(int r, int hi) { return (r & 3) + 8 * (r >> 2) + 4 * hi; }
__device__ __forceinline__ float max3f(float a, float b, float c) { float r; asm("v_max3_f32 %0, %1, %2, %3" : "=v"(r) : "v"(a), "v"(b), "v"(c)); return r; }
typedef float f32x2_t __attribute__((ext_vector_type(2))); typedef __bf16 bf16x2_t __attribute__((ext_vector_type(2)));
__device__ __forceinline__ unsigned cvtpk(float lo, float hi) { f32x2_t v = {lo, hi}; bf16x2_t b = __builtin_convertvector(v, bf16x2_t); return __builtin_bit_cast(unsigned, b); }
__device__ __forceinline__ float xmax(float v) { auto rr = __builtin_amdgcn_permlane32_swap(__float_as_uint(v), __float_as_uint(v), false, false); return fmaxf(__uint_as_float(rr[0]), __uint_as_float(rr[1])); }
__device__ __forceinline__ float xsum(float v) { auto rr = __builtin_amdgcn_permlane32_swap(__float_as_uint(v), __float_as_uint(v), false, false); return __uint_as_float(rr[0]) + __uint_as_float(rr[1]); }
__device__ __forceinline__ void qkt(f32x16& p0, f32x16& p1, const LAS unsigned char* Kt, const bf16x8* qr, int r32, int hi) {
    const LAS unsigned char* kb = Kt + hi * 1024 + r32 * 16;
    p0 = f32x16{}; p1 = f32x16{};
#pragma unroll
    for (int d0 = 0; d0 < 4; ++d0) {
        const bf16x8 b0 = *(const LAS bf16x8*)(kb + d0 * 2048), b1 = *(const LAS bf16x8*)(kb + d0 * 2048 + 512);
        p0 = __builtin_amdgcn_mfma_f32_32x32x16_bf16(b0, qr[d0], p0, 0, 0, 0); p1 = __builtin_amdgcn_mfma_f32_32x32x16_bf16(b1, qr[d0], p1, 0, 0, 0); }
}
__device__ __forceinline__ void pv(f32x16* o, unsigned vb, bf16x8 pa0, bf16x8 pa1, bf16x8 pa2, bf16x8 pa3) {
#pragma unroll
    for (int d0 = 0; d0 < 2; ++d0) { s16x4 lo[4], hi[4];
#pragma unroll
        for (int ks = 0; ks < 4; ++ks) {
            asm volatile("ds_read_b64_tr_b16 %0,%1 offset:%c2" : "=&v"(lo[ks]) : "v"(vb), "i"(d0 * 4096 + ks * 1024) : "memory");
            asm volatile("ds_read_b64_tr_b16 %0,%1 offset:%c2" : "=&v"(hi[ks]) : "v"(vb), "i"(d0 * 4096 + ks * 1024 + 512) : "memory"); }
        asm volatile("s_waitcnt lgkmcnt(0)" ::: "memory"); __builtin_amdgcn_sched_barrier(0);
#define FA_PK(k) (bf16x8){lo[k][0], lo[k][1], lo[k][2], lo[k][3], hi[k][0], hi[k][1], hi[k][2], hi[k][3]}
        o[d0] = __builtin_amdgcn_mfma_f32_32x32x16_bf16(pa0, FA_PK(0), o[d0], 0, 0, 0);
        o[d0] = __builtin_amdgcn_mfma_f32_32x32x16_bf16(pa1, FA_PK(1), o[d0], 0, 0, 0);
        o[d0] = __builtin_amdgcn_mfma_f32_32x32x16_bf16(pa2, FA_PK(2), o[d0], 0, 0, 0);
        o[d0] = __builtin_amdgcn_mfma_f32_32x32x16_bf16(pa3, FA_PK(3), o[d0], 0, 0, 0);
#undef FA_PK
    }
}
__device__ __forceinline__ float rowmax(const f32x16& p0, const f32x16& p1) {
    float a = max3f(p0[0], p0[1], p1[0]), b = max3f(p0[2], p0[3], p1[1]); a = max3f(a, p1[2], p1[3]);
#pragma unroll
    for (int r = 4; r < 16; r += 4) { a = max3f(a, p0[r], p0[r + 1]); b = max3f(b, p0[r + 2], p0[r + 3]); a = max3f(a, p1[r], p1[r + 1]); b = max3f(b, p1[r + 2], p1[r + 3]); }
    const float m = fmaxf(a, b);
    return xmax(m);
}
#define FA_BAR() asm volatile("s_waitcnt vmcnt(0) lgkmcnt(0)\n\ts_barrier" ::: "memory")

template <int MODE>
__device__ __forceinline__ void attn_unit(const Ctx& F, LAS unsigned char* shm, int b, int g, int qb) {
    const int tid = threadIdx.x, lane = tid & 63, r32 = lane & 31, hi = lane >> 5; const int wid = __builtin_amdgcn_readfirstlane(tid >> 6);
    const int hd = 4 * g + (wid & 3), th = wid >> 2, trel = 32 * th + r32; const size_t m = (size_t)b * SEQ + 64 * qb + trel;
    const int j_lo = MODE == 0 ? 0 : (qb > 8 ? qb - 8 : 0), j_hi = qb;
    const bf16* KV = (MODE == 0 ? F.KSB() : F.KWB()) + (size_t)b * SEQ * 512 + g * 64;
    const unsigned long long smask = MODE == 0 ? F.SELMASK()[m * 4 + g] : ~0ull;
    bf16x8 qr[4];
    { const bf16* Qp = F.QB() + m * 1024 + hd * 64 + hi * 8;
#pragma unroll
      for (int d0 = 0; d0 < 4; ++d0) qr[d0] = *(const bf16x8*)(Qp + 16 * d0); }
    const bf16* ksrc = KV + (size_t)lane * 512 + wid * 8;
    const bf16* vsrc = KV + 256 + (size_t)(16 * (wid & 3) + (lane >> 2)) * 512 + (wid >> 2) * 32 + (lane & 3) * 8;
    LAS unsigned char* kdst = shm + LK + wid * 1024 + lane * 16; LAS unsigned char* vdst = shm + LV + wid * 1024 + lane * 16;
    const unsigned vb0 = (unsigned)(uintptr_t)(shm + LV) + ((lane >> 4) & 1) * 32 + (lane & 3) * 8 + (4 * hi + ((lane & 15) >> 2)) * 64;
    LAS float* wsf = (LAS float*)(shm + LWS) + wid * 64;
    v4u kreg = *(const v4u*)(ksrc + (size_t)j_lo * 64 * 512), vreg = *(const v4u*)(vsrc + (size_t)j_lo * 64 * 512);
    *(LAS v4u*)kdst = kreg; *(LAS v4u*)vdst = vreg;
    FA_BAR();
    float mref = MASKV, lsum = 0.f; f32x16 o[2]; o[0] = f32x16{}; o[1] = f32x16{};
#define FA_TILE(DIAG) do { \
        const int buf = (j - j_lo) & 1; \
        if (!(DIAG)) { kreg = *(const v4u*)(ksrc + (size_t)(j + 1) * 64 * 512); vreg = *(const v4u*)(vsrc + (size_t)(j + 1) * 64 * 512); } \
        f32x16 p0, p1; \
        qkt(p0, p1, shm + LK + buf * 8192, qr, r32, hi); \
        if (DIAG) { _Pragma("unroll") for (int r = 0; r < 16; ++r) { const int kv = crow(r, hi); if (kv > trel) p0[r] = MASKV; if (kv + 32 > trel) p1[r] = MASKV; } } \
        if (MODE == 1 && qb >= 8 && j == j_lo) { _Pragma("unroll") for (int r = 0; r < 16; ++r) { const int kv = crow(r, hi); if (kv <= trel) p0[r] = MASKV; if (kv + 32 <= trel) p1[r] = MASKV; } } \
        const bool blocked = MODE == 0 && !((smask >> j) & 1ull); \
        float mt = rowmax(p0, p1); mt = (blocked || mt < -1.0e29f) ? MASKV : mt * C2; \
        const bool need = mt > mref + 8.0f; \
        if (__any(need)) { \
            const float mnew = need ? mt : mref, f = __builtin_amdgcn_exp2f(mref - mnew); lsum *= f; mref = mnew; \
            if (hi == 0) wsf[r32] = f; \
            asm volatile("s_waitcnt lgkmcnt(0)" ::: "memory"); \
            _Pragma("unroll") for (int r = 0; r < 16; ++r) { const float fr = wsf[crow(r, hi)]; o[0][r] *= fr; o[1][r] *= fr; } \
        } \
        const float nref = blocked ? -1.0e30f : (mref < -1.0e29f ? 0.f : -mref); float sacc = 0.f;        \
        _Pragma("unroll") for (int r = 0; r < 16; ++r) { p0[r] = __builtin_amdgcn_exp2f(__builtin_fmaf(p0[r], C2, nref)); p1[r] = __builtin_amdgcn_exp2f(__builtin_fmaf(p1[r], C2, nref)); sacc += p0[r] + p1[r]; } \
        lsum += sacc; \
        v4u pw0, pw1, pw2, pw3; \
        pw0.x = cvtpk(p0[0], p0[1]); pw0.y = cvtpk(p0[2], p0[3]); pw0.z = cvtpk(p0[4], p0[5]); pw0.w = cvtpk(p0[6], p0[7]); \
        pw1.x = cvtpk(p0[8], p0[9]); pw1.y = cvtpk(p0[10], p0[11]); pw1.z = cvtpk(p0[12], p0[13]); pw1.w = cvtpk(p0[14], p0[15]); \
        pw2.x = cvtpk(p1[0], p1[1]); pw2.y = cvtpk(p1[2], p1[3]); pw2.z = cvtpk(p1[4], p1[5]); pw2.w = cvtpk(p1[6], p1[7]); \
        pw3.x = cvtpk(p1[8], p1[9]); pw3.y = cvtpk(p1[10], p1[11]); pw3.z = cvtpk(p1[12], p1[13]); pw3.w = cvtpk(p1[14], p1[15]); \
        pv(o, vb0 + buf * 8192, __builtin_bit_cast(bf16x8, pw0), __builtin_bit_cast(bf16x8, pw1), __builtin_bit_cast(bf16x8, pw2), __builtin_bit_cast(bf16x8, pw3)); \
        if (!(DIAG)) { *(LAS v4u*)(kdst + (buf ^ 1) * 8192) = kreg; *(LAS v4u*)(vdst + (buf ^ 1) * 8192) = vreg; } \
        FA_BAR(); } while (0)
    int j = j_lo;
    for (; j < j_hi; ++j) FA_TILE(false);
    FA_TILE(true);
#undef FA_TILE
    lsum = xsum(lsum);
    if (hi == 0) wsf[32 + r32] = lsum;
    asm volatile("s_waitcnt lgkmcnt(0)" ::: "memory");
#pragma unroll
    for (int r = 0; r < 16; ++r) {
        const int q = crow(r, hi); const float rl = 1.0f / wsf[32 + q]; const size_t mm = (size_t)b * SEQ + 64 * qb + 32 * th + q; const size_t oi = mm * 1024 + hd * 64 + r32;
        if (MODE == 1) { F.OWIN()[oi] = o[0][r] * rl; F.OWIN()[oi + 32] = o[1][r] * rl; }
        else { const float* gt = F.GD() + mm * 64 + hd * 3; const float gc = gt[0], gs = gt[1], gw = gt[2];
            const float a0 = gc * F.OCMP()[oi] + gs * (o[0][r] * rl) + gw * F.OWIN()[oi], a1 = gc * F.OCMP()[oi + 32] + gs * (o[1][r] * rl) + gw * F.OWIN()[oi + 32];
            F.MIX()[mm * DM + hd * 64 + r32] = (bf16)f2bf(a0); F.MIX()[mm * DM + hd * 64 + 32 + r32] = (bf16)f2bf(a1); }
    }
    FA_BAR();
}
__device__ __forceinline__ void sel_phase(const Ctx& F, LAS unsigned char* shm) {
    for (int p = blockIdx.x; p < NB * 4 * 32; p += gridDim.x) { const int bg = p >> 5, s = p & 31; attn_unit<0>(F, shm, bg >> 2, bg & 3, 63 - s); attn_unit<0>(F, shm, bg >> 2, bg & 3, s); }
}
__device__ __forceinline__ void win_phase(const Ctx& F, LAS unsigned char* shm) {
    for (int u = blockIdx.x; u < NB * 4 * 64; u += gridDim.x) { const int bg = u >> 6, qb = u & 63; attn_unit<1>(F, shm, bg >> 2, bg & 3, qb); }
}
}
namespace cmpg {
typedef short bf16x8 __attribute__((ext_vector_type(8)));
typedef short s16x4 __attribute__((ext_vector_type(4)));
typedef float f32x16 __attribute__((ext_vector_type(16)));
constexpr int A_CH = 516 * 16, A_BYTES = 4 * A_CH, B_BYTES = 16384, STG = A_BYTES + B_BYTES, L_W2 = 2 * STG, L_BIAS = L_W2 + 16384, LDS_BYTES_CMP = L_BIAS + 512;
static_assert(LDS_BYTES_CMP <= RING_BYTES, "compress LDS");
typedef float f32x2_t __attribute__((ext_vector_type(2))); typedef __bf16 bf16x2_t __attribute__((ext_vector_type(2)));
__device__ __forceinline__ unsigned cvtpk(float lo, float hi) { f32x2_t v = {lo, hi}; bf16x2_t b = __builtin_convertvector(v, bf16x2_t); return __builtin_bit_cast(unsigned, b); }
__device__ __forceinline__ void unit(const Ctx& F, LAS unsigned char* shm, int unit_id) {
    const int tid = threadIdx.x, lane = tid & 63, r32 = lane & 31, hi = lane >> 5; const int wid = __builtin_amdgcn_readfirstlane(tid >> 6);
    const bool dec = unit_id < 256; const int uu = dec ? unit_id : unit_id - 256;
    const int b = dec ? uu >> 3 : uu >> 2, c = dec ? (uu >> 2) & 1 : (uu >> 1) & 1, q = dec ? uu & 3 : uu & 1, n0 = 128 * q, ncmp = dec ? NCMP_S : NCMP_P, maxpos = dec ? PAST - 1 : SEQ - 1;
    const float* src0 = dec ? F.cache_cmp() : F.out() + O_KCP + (size_t)b * SEQ * 512; const int* pt = F.page_table() + b * 64;
    const bf16* W1T = F.W1T() + (size_t)c * 128 * 2048;
    const int ai = tid >> 2, ag = tid & 3;
    const int xg = tid >> 3, xf = tid & 7;
    const int bu = tid >> 8, bf_ = (tid >> 1) & 127, bh = tid & 1;
    f32x4 ar[8]; f32x4 xr = (f32x4){0.f, 0.f, 0.f, 0.f}; v4u br[2];
#define CG_BASE(blk) ({ int pos_ = 16 * (n0 + (blk)); pos_ = pos_ > maxpos - 15 ? maxpos - 15 : pos_; \
        const float* p_ = dec ? src0 + ((size_t)pt[pos_ >> 7] * 128 + (pos_ & 127)) * 512 : src0 + (size_t)pos_ * 512; p_ + c * 256; })
    const float* abase = CG_BASE(ai) + ag * 64; const float* xbase = CG_BASE(128) + xg * 64 + 4 * xf;
#define CG_LOAD(s) do { const int l_ = (s) >> 1, dh_ = (s) & 1; const float* rp_ = abase + (size_t)l_ * 512 + dh_ * 32; \
        _Pragma("unroll") for (int e_ = 0; e_ < 8; ++e_) ar[e_] = *(const f32x4*)(rp_ + 4 * e_); \
        if (tid < 32) { xr = *(const f32x4*)(xbase + (size_t)l_ * 512 + dh_ * 32); } \
        const bf16* bp_ = W1T + (size_t)bf_ * 2048 + (l_ + 16 * bu) * 64 + dh_ * 32 + bh * 16; br[0] = *(const v4u*)bp_; br[1] = *(const v4u*)(bp_ + 8); } while (0)
#define CG_STORE(bufoff) do { LAS unsigned char* a_ = shm + (bufoff) + (4 * ai + ag) * 16; \
        _Pragma("unroll") for (int ch_ = 0; ch_ < 4; ++ch_) { v4u w_; w_.x = cvtpk(ar[2 * ch_].x, ar[2 * ch_].y); w_.y = cvtpk(ar[2 * ch_].z, ar[2 * ch_].w); w_.z = cvtpk(ar[2 * ch_ + 1].x, ar[2 * ch_ + 1].y); w_.w = cvtpk(ar[2 * ch_ + 1].z, ar[2 * ch_ + 1].w); *(LAS v4u*)(a_ + ch_ * A_CH) = w_; } \
        if (tid < 32) { typedef unsigned u32x2v_ __attribute__((ext_vector_type(2))); u32x2v_ w2_; w2_.x = cvtpk(xr.x, xr.y); w2_.y = cvtpk(xr.z, xr.w); *(LAS u32x2v_*)(shm + (bufoff) + (xf >> 1) * A_CH + (512 + xg) * 16 + (xf & 1) * 8) = w2_; } \
        LAS unsigned char* b_ = shm + (bufoff) + A_BYTES + bu * 8192 + (2 * bh) * 2048 + bf_ * 16; *(LAS v4u*)b_ = br[0]; *(LAS v4u*)(b_ + 2048) = br[1]; } while (0)
    { const int f = tid >> 2, d0 = (tid & 3) * 16; const float* wp = F.cmp_w2() + ((size_t)c * 128 + f) * 64 + d0;
      const f32x4 w0 = *(const f32x4*)wp, w1 = *(const f32x4*)(wp + 4), w2 = *(const f32x4*)(wp + 8), w3 = *(const f32x4*)(wp + 12);
      v4u o0, o1; o0.x = cvtpk(w0.x, w0.y); o0.y = cvtpk(w0.z, w0.w); o0.z = cvtpk(w1.x, w1.y); o0.w = cvtpk(w1.z, w1.w); o1.x = cvtpk(w2.x, w2.y); o1.y = cvtpk(w2.z, w2.w); o1.z = cvtpk(w3.x, w3.y); o1.w = cvtpk(w3.z, w3.w);
      LAS unsigned char* wd = shm + L_W2 + ((d0 >> 5) * 8 + (f >> 4)) * 1024 + (f & 15) * 64 + (d0 & 31) * 2; *(LAS v4u*)wd = o0; *(LAS v4u*)(wd + 16) = o1;
      if (tid < 128) { float pe = 0.f;
#pragma unroll
          for (int kc = 0; kc < 16; ++kc) pe += F.PEB()[(c * 16 + kc) * 128 + tid];
          ((LAS float*)(shm + L_BIAS))[tid] = F.cmp_b1()[c * 128 + tid] + pe; } }
    f32x16 acc[2][4];
#pragma unroll
    for (int rb = 0; rb < 2; ++rb)
#pragma unroll
        for (int fb = 0; fb < 4; ++fb) acc[rb][fb] = f32x16{};
    CG_LOAD(0); CG_STORE(0);
    asm volatile("s_waitcnt vmcnt(0) lgkmcnt(0)\n\ts_barrier" ::: "memory");
    for (int s = 0; s < 32; ++s) {
        const int boff = (s & 1) * STG;
        if (s < 31) CG_LOAD(s + 1);
#pragma unroll
        for (int u = 0; u < 2; ++u)
#pragma unroll
            for (int kk = 0; kk < 2; ++kk) {
                bf16x8 xfr[2], wfr[4];
#pragma unroll
                for (int rb = 0; rb < 2; ++rb) xfr[rb] = *(const LAS bf16x8*)(shm + boff + (2 * kk + hi) * A_CH + (64 * wid + 32 * rb + r32 + 4 * u) * 16);
#pragma unroll
                for (int fb = 0; fb < 4; ++fb) wfr[fb] = *(const LAS bf16x8*)(shm + boff + A_BYTES + u * 8192 + (2 * kk + hi) * 2048 + (32 * fb + r32) * 16);
#pragma unroll
                for (int rb = 0; rb < 2; ++rb)
#pragma unroll
                    for (int fb = 0; fb < 4; ++fb) acc[rb][fb] = __builtin_amdgcn_mfma_f32_32x32x16_bf16(wfr[fb], xfr[rb], acc[rb][fb], 0, 0, 0);
            }
        if (s < 31) CG_STORE(((s + 1) & 1) * STG);
        asm volatile("s_waitcnt vmcnt(0) lgkmcnt(0)\n\ts_barrier" ::: "memory");
    }
#ifdef CHK_CMP
    if (unit_id == 5 || unit_id == 256) { float* HD = (float*)F.H() + (size_t)(unit_id == 5 ? 0 : 1) * 512 * 128;
#pragma unroll
        for (int rb = 0; rb < 2; ++rb)
#pragma unroll
            for (int fb = 0; fb < 4; ++fb)
#pragma unroll
                for (int r = 0; r < 16; ++r) HD[(size_t)(64 * wid + 32 * rb + r32) * 128 + 32 * fb + (r & 3) + 8 * (r >> 2) + 4 * hi] = acc[rb][fb][r]; }
#endif
    const LAS float* hb = (const LAS float*)(shm + L_BIAS);
    const unsigned vb = (unsigned)(uintptr_t)(shm + L_W2) + ((lane >> 4) & 1) * 32 + (lane & 3) * 8 + (4 * hi + ((lane & 15) >> 2)) * 64;
    float* dstb = (dec ? F.KCMPS() : F.KCMPP()) + (size_t)b * ncmp * 512 + c * 256;
    const float b2a = F.cmp_b2()[c * 64 + r32], b2b = F.cmp_b2()[c * 64 + 32 + r32];
#pragma unroll
    for (int rb = 0; rb < 2; ++rb) {
        f32x16 o[2]; o[0] = f32x16{}; o[1] = f32x16{};
#pragma unroll
        for (int fb = 0; fb < 4; ++fb) {
            float h[16];
#pragma unroll
            for (int r = 0; r < 16; ++r) { const float x = acc[rb][fb][r] + hb[32 * fb + (r & 3) + 8 * (r >> 2) + 4 * hi]; h[r] = x / (1.0f + __expf(-x)); }
#pragma unroll
            for (int s2 = 0; s2 < 2; ++s2) {
                v4u pw; pw.x = cvtpk(h[8 * s2], h[8 * s2 + 1]); pw.y = cvtpk(h[8 * s2 + 2], h[8 * s2 + 3]); pw.z = cvtpk(h[8 * s2 + 4], h[8 * s2 + 5]); pw.w = cvtpk(h[8 * s2 + 6], h[8 * s2 + 7]);
                const int ks = 2 * fb + s2;
#pragma unroll
                for (int d0 = 0; d0 < 2; ++d0) { s16x4 lo, hi4;
                    asm volatile("ds_read_b64_tr_b16 %0,%1 offset:%c2" : "=&v"(lo) : "v"(vb), "i"(d0 * 8192 + ks * 1024) : "memory");
                    asm volatile("ds_read_b64_tr_b16 %0,%1 offset:%c2" : "=&v"(hi4) : "v"(vb), "i"(d0 * 8192 + ks * 1024 + 512) : "memory");
                    asm volatile("s_waitcnt lgkmcnt(0)" ::: "memory"); __builtin_amdgcn_sched_barrier(0);
                    const bf16x8 wf = (bf16x8){lo[0], lo[1], lo[2], lo[3], hi4[0], hi4[1], hi4[2], hi4[3]};
                    o[d0] = __builtin_amdgcn_mfma_f32_32x32x16_bf16(__builtin_bit_cast(bf16x8, pw), wf, o[d0], 0, 0, 0); }
            }
        }
#pragma unroll
        for (int r = 0; r < 16; ++r) { const int R = 64 * wid + 32 * rb + (r & 3) + 8 * (r >> 2) + 4 * hi, n = n0 + (R >> 2), g = R & 3;
            if (n < ncmp) { float* d = dstb + (size_t)n * 512 + g * 64; d[r32] = o[0][r] + b2a; d[32 + r32] = o[1][r] + b2b; } }
    }
    asm volatile("s_waitcnt vmcnt(0) lgkmcnt(0)\n\ts_barrier" ::: "memory");
#undef CG_BASE
#undef CG_LOAD
#undef CG_STORE
}

__device__ __forceinline__ void small_unit(const Ctx& F, LAS unsigned char* shm, int u) {
    const int tid = threadIdx.x, lane = tid & 63, r32 = lane & 31, hi = lane >> 5; const int wid = __builtin_amdgcn_readfirstlane(tid >> 6);
    const int b = u >> 6, c = (u >> 5) & 1, n0 = 8 * (u & 31), fb = wid & 3, lh = wid >> 2;
    constexpr int L_W2S = 0, L_BS = 16384, L_PA = 20480, L_PO = 36864;
    { const int f = tid >> 2, d0 = (tid & 3) * 16; const float* wp = F.cmp_w2() + ((size_t)c * 128 + f) * 64 + d0;
      const f32x4 w0 = *(const f32x4*)wp, w1 = *(const f32x4*)(wp + 4), w2 = *(const f32x4*)(wp + 8), w3 = *(const f32x4*)(wp + 12);
      v4u o0, o1; o0.x = cvtpk(w0.x, w0.y); o0.y = cvtpk(w0.z, w0.w); o0.z = cvtpk(w1.x, w1.y); o0.w = cvtpk(w1.z, w1.w); o1.x = cvtpk(w2.x, w2.y); o1.y = cvtpk(w2.z, w2.w); o1.z = cvtpk(w3.x, w3.y); o1.w = cvtpk(w3.z, w3.w);
      LAS unsigned char* wd = shm + L_W2S + ((d0 >> 5) * 8 + (f >> 4)) * 1024 + (f & 15) * 64 + (d0 & 31) * 2; *(LAS v4u*)wd = o0; *(LAS v4u*)(wd + 16) = o1;
      if (tid < 128) { float pe = 0.f;
#pragma unroll
          for (int kc = 0; kc < 16; ++kc) pe += F.PEB()[(c * 16 + kc) * 128 + tid];
          ((LAS float*)(shm + L_BS))[tid] = F.cmp_b1()[c * 128 + tid] + pe; } }
    const int bi = r32 >> 2, g = r32 & 3;
    const float* xb = F.out() + O_KCP + (size_t)b * SEQ * 512 + c * 256 + g * 64 + hi * 8;
    const bf16* wb = F.W1T() + (size_t)c * 128 * 2048 + (size_t)(32 * fb + r32) * 2048 + hi * 8;
    f32x16 acc = f32x16{};
    for (int li = 0; li < 8; ++li) { const int l = 2 * li + lh;
#pragma unroll
        for (int uu = 0; uu < 2; ++uu) { int pos = 16 * (n0 + bi + uu) + l; pos = pos > SEQ - 1 ? SEQ - 1 : pos; const float* xr = xb + (size_t)pos * 512; const bf16* wr = wb + (l + 16 * uu) * 64;
#pragma unroll
            for (int kk = 0; kk < 4; ++kk) { const f32x4 x0 = *(const f32x4*)(xr + 16 * kk), x1 = *(const f32x4*)(xr + 16 * kk + 4);
                v4u xw; xw.x = cvtpk(x0.x, x0.y); xw.y = cvtpk(x0.z, x0.w); xw.z = cvtpk(x1.x, x1.y); xw.w = cvtpk(x1.z, x1.w);
                acc = __builtin_amdgcn_mfma_f32_32x32x16_bf16(*(const bf16x8*)(wr + 16 * kk), __builtin_bit_cast(bf16x8, xw), acc, 0, 0, 0); } } }
    LAS float* pa = (LAS float*)(shm + L_PA) + fb * 1024;
    if (lh == 1) {
#pragma unroll
        for (int r = 0; r < 16; ++r) pa[r * 64 + lane] = acc[r]; }
    asm volatile("s_waitcnt vmcnt(0) lgkmcnt(0)\n\ts_barrier" ::: "memory");
    LAS float* po = (LAS float*)(shm + L_PO) + fb * 2048;
    if (lh == 0) {
        const LAS float* hb = (const LAS float*)(shm + L_BS);
        const unsigned vb = (unsigned)(uintptr_t)(shm + L_W2S) + ((lane >> 4) & 1) * 32 + (lane & 3) * 8 + (4 * hi + ((lane & 15) >> 2)) * 64 + fb * 2048;
        float h[16];
#pragma unroll
        for (int r = 0; r < 16; ++r) { const float x = acc[r] + pa[r * 64 + lane] + hb[32 * fb + (r & 3) + 8 * (r >> 2) + 4 * hi]; h[r] = x / (1.0f + __expf(-x)); }
        f32x16 o[2]; o[0] = f32x16{}; o[1] = f32x16{};
#pragma unroll
        for (int s2 = 0; s2 < 2; ++s2) {
            v4u pw; pw.x = cvtpk(h[8 * s2], h[8 * s2 + 1]); pw.y = cvtpk(h[8 * s2 + 2], h[8 * s2 + 3]); pw.z = cvtpk(h[8 * s2 + 4], h[8 * s2 + 5]); pw.w = cvtpk(h[8 * s2 + 6], h[8 * s2 + 7]);
#pragma unroll
            for (int d0 = 0; d0 < 2; ++d0) { s16x4 lo, hi4;
                asm volatile("ds_read_b64_tr_b16 %0,%1 offset:%c2" : "=&v"(lo) : "v"(vb), "i"(d0 * 8192 + s2 * 1024) : "memory");
                asm volatile("ds_read_b64_tr_b16 %0,%1 offset:%c2" : "=&v"(hi4) : "v"(vb), "i"(d0 * 8192 + s2 * 1024 + 512) : "memory");
                asm volatile("s_waitcnt lgkmcnt(0)" ::: "memory"); __builtin_amdgcn_sched_barrier(0);
                const bf16x8 wf = (bf16x8){lo[0], lo[1], lo[2], lo[3], hi4[0], hi4[1], hi4[2], hi4[3]};
                o[d0] = __builtin_amdgcn_mfma_f32_32x32x16_bf16(__builtin_bit_cast(bf16x8, pw), wf, o[d0], 0, 0, 0); } }
#pragma unroll
        for (int r = 0; r < 16; ++r) { po[r * 64 + lane] = o[0][r]; po[1024 + r * 64 + lane] = o[1][r]; }
    }
    asm volatile("s_waitcnt vmcnt(0) lgkmcnt(0)\n\ts_barrier" ::: "memory");
#pragma unroll
    for (int e = 0; e < 4; ++e) { const int idx = e * 512 + tid, d0 = idx >> 10, r = (idx >> 6) & 15, ln = idx & 63; const LAS float* pp = (const LAS float*)(shm + L_PO) + d0 * 1024 + r * 64 + ln;
        const float v = (pp[0] + pp[2048]) + (pp[4096] + pp[6144]);
        const int R = (r & 3) + 8 * (r >> 2) + 4 * (ln >> 5), n = n0 + (R >> 2), gg = R & 3, d = 32 * d0 + (ln & 31);
        if (n < NCMP_P) F.KCMPP()[((size_t)(b * NCMP_P + n) * 2 + c) * 256 + gg * 64 + d] = v + F.cmp_b2()[c * 64 + d]; }
    asm volatile("s_waitcnt vmcnt(0) lgkmcnt(0)\n\ts_barrier" ::: "memory");
}
}
namespace ssd {
typedef short bf16x8 __attribute__((ext_vector_type(8)));
typedef short s16x4 __attribute__((ext_vector_type(4)));
typedef float f32x16 __attribute__((ext_vector_type(16)));
typedef float f32x2_t __attribute__((ext_vector_type(2))); typedef __bf16 bf16x2_t __attribute__((ext_vector_type(2)));
__device__ __forceinline__ unsigned cvtpk(float lo, float hi) { f32x2_t v = {lo, hi}; bf16x2_t b = __builtin_convertvector(v, bf16x2_t); return __builtin_bit_cast(unsigned, b); }
constexpr int L_B = 0, L_X = 65536, L_ACS = 98304, L_E = 99328, LDS_BYTES_SSD = 100352;
__device__ __forceinline__ int crow(int r, int hi) { return (r & 3) + 8 * (r >> 2) + 4 * hi; }
#define SSD_BAR() asm volatile("s_waitcnt vmcnt(0) lgkmcnt(0)\n\ts_barrier" ::: "memory")
__device__ __forceinline__ void local_unit(const Ctx& F, LAS unsigned char* shm, int u) {
    const int tid = threadIdx.x, lane = tid & 63, r32 = lane & 31, hi = lane >> 5; const int wid = __builtin_amdgcn_readfirstlane(tid >> 6);
    const int b = u >> 8, c = (u >> 4) & 15, h = u & 15, grp = h >> 3; const size_t m0 = (size_t)b * SEQ + c * 256;
    const bf16* XA = F.XBCA16() + m0 * CONV_DIM; const float* DTp = F.DT() + m0 * 16 + h;
    LAS float* acs = (LAS float*)(shm + L_ACS); LAS float* et = (LAS float*)(shm + L_E);
    const float A = -__expf(F.a_log()[h]);
    if (wid == 0) { float a[4], tot = 0.f;
#pragma unroll
        for (int e = 0; e < 4; ++e) { tot += DTp[(size_t)(4 * lane + e) * 16] * A; a[e] = tot; }
        float x = tot;
#pragma unroll
        for (int o = 1; o < 64; o <<= 1) { const float y = __shfl_up(x, o); if (lane >= o) x += y; }
        const float excl = x - tot;
#pragma unroll
        for (int e = 0; e < 4; ++e) { acs[4 * lane + e] = excl + a[e]; F.ACS()[(m0 + 4 * lane + e) * 16 + h] = excl + a[e]; }
        if (lane == 63) F.DEC()[(b * 16 + c) * 16 + h] = __expf(x); }
    { const int s = tid >> 1, hf = tid & 1; const bf16* br = XA + (size_t)s * CONV_DIM + 1024 + grp * 128 + hf * 64;
#pragma unroll
      for (int i = 0; i < 8; ++i) *(LAS v4u*)(shm + L_B + (hf * 8 + i) * 4096 + s * 16) = *(const v4u*)(br + 8 * i);
      const bf16* xr = XA + (size_t)s * CONV_DIM + h * 64 + hf * 32; const float dt = DTp[(size_t)s * 16];
      LAS unsigned char* xd = shm + L_X + (hf * 16 + (s >> 4)) * 1024 + (s & 15) * 64;
#pragma unroll
      for (int i = 0; i < 4; ++i) { const v4u t = *(const v4u*)(xr + 8 * i); v4u o;
          o.x = cvtpk(__uint_as_float(t.x << 16) * dt, __uint_as_float(t.x & 0xffff0000u) * dt); o.y = cvtpk(__uint_as_float(t.y << 16) * dt, __uint_as_float(t.y & 0xffff0000u) * dt);
          o.z = cvtpk(__uint_as_float(t.z << 16) * dt, __uint_as_float(t.z & 0xffff0000u) * dt); o.w = cvtpk(__uint_as_float(t.w << 16) * dt, __uint_as_float(t.w & 0xffff0000u) * dt);
          *(LAS v4u*)(xd + i * 16) = o; } }
    bf16x8 cf[8];
    { const bf16* cr = XA + (size_t)(32 * wid + r32) * CONV_DIM + 1280 + grp * 128 + hi * 8;
#pragma unroll
      for (int kk = 0; kk < 8; ++kk) cf[kk] = *(const bf16x8*)(cr + 16 * kk); }
    SSD_BAR();
    if (tid < 256) et[tid] = __expf(acs[255] - acs[tid]);
    const float acl = acs[32 * wid + r32];
    f32x16 o[2]; o[0] = f32x16{}; o[1] = f32x16{};
    const int jmax = (32 * wid + 31) >> 6, lrel = 32 * wid + r32;
    const unsigned vbx = (unsigned)(uintptr_t)(shm + L_X) + ((lane >> 4) & 1) * 32 + (lane & 3) * 8 + (4 * hi + ((lane & 15) >> 2)) * 64;
    for (int j = 0; j <= jmax; ++j) {
        f32x16 p0 = f32x16{}, p1 = f32x16{};
        const LAS unsigned char* kb = shm + L_B + hi * 4096 + (64 * j + r32) * 16;
#pragma unroll
        for (int kk = 0; kk < 8; ++kk) { const bf16x8 b0 = *(const LAS bf16x8*)(kb + kk * 8192), b1 = *(const LAS bf16x8*)(kb + kk * 8192 + 512);
            p0 = __builtin_amdgcn_mfma_f32_32x32x16_bf16(b0, cf[kk], p0, 0, 0, 0); p1 = __builtin_amdgcn_mfma_f32_32x32x16_bf16(b1, cf[kk], p1, 0, 0, 0); }
#pragma unroll
        for (int q = 0; q < 4; ++q) { const f32x4 a0 = *(const LAS f32x4*)(acs + 64 * j + 8 * q + 4 * hi), a1 = *(const LAS f32x4*)(acs + 64 * j + 32 + 8 * q + 4 * hi);
#pragma unroll
            for (int e = 0; e < 4; ++e) { const int r = 4 * q + e, s0 = 64 * j + 8 * q + 4 * hi + e;
                p0[r] = (s0 <= lrel) ? p0[r] * __expf(acl - a0[e]) : 0.f; p1[r] = (s0 + 32 <= lrel) ? p1[r] * __expf(acl - a1[e]) : 0.f; } }
        v4u pw0, pw1, pw2, pw3;
        pw0.x = cvtpk(p0[0], p0[1]); pw0.y = cvtpk(p0[2], p0[3]); pw0.z = cvtpk(p0[4], p0[5]); pw0.w = cvtpk(p0[6], p0[7]);
        pw1.x = cvtpk(p0[8], p0[9]); pw1.y = cvtpk(p0[10], p0[11]); pw1.z = cvtpk(p0[12], p0[13]); pw1.w = cvtpk(p0[14], p0[15]);
        pw2.x = cvtpk(p1[0], p1[1]); pw2.y = cvtpk(p1[2], p1[3]); pw2.z = cvtpk(p1[4], p1[5]); pw2.w = cvtpk(p1[6], p1[7]);
        pw3.x = cvtpk(p1[8], p1[9]); pw3.y = cvtpk(p1[10], p1[11]); pw3.z = cvtpk(p1[12], p1[13]); pw3.w = cvtpk(p1[14], p1[15]);
        const unsigned vb = vbx + j * 4096;
#pragma unroll
        for (int d0 = 0; d0 < 2; ++d0) { s16x4 lo[4], hi4[4];
#pragma unroll
            for (int ks = 0; ks < 4; ++ks) {
                asm volatile("ds_read_b64_tr_b16 %0,%1 offset:%c2" : "=&v"(lo[ks]) : "v"(vb), "i"(d0 * 16384 + ks * 1024) : "memory");
                asm volatile("ds_read_b64_tr_b16 %0,%1 offset:%c2" : "=&v"(hi4[ks]) : "v"(vb), "i"(d0 * 16384 + ks * 1024 + 512) : "memory"); }
            asm volatile("s_waitcnt lgkmcnt(0)" ::: "memory"); __builtin_amdgcn_sched_barrier(0);
#define SSD_PK(k) (bf16x8){lo[k][0], lo[k][1], lo[k][2], lo[k][3], hi4[k][0], hi4[k][1], hi4[k][2], hi4[k][3]}
            o[d0] = __builtin_amdgcn_mfma_f32_32x32x16_bf16(__builtin_bit_cast(bf16x8, pw0), SSD_PK(0), o[d0], 0, 0, 0);
            o[d0] = __builtin_amdgcn_mfma_f32_32x32x16_bf16(__builtin_bit_cast(bf16x8, pw1), SSD_PK(1), o[d0], 0, 0, 0);
            o[d0] = __builtin_amdgcn_mfma_f32_32x32x16_bf16(__builtin_bit_cast(bf16x8, pw2), SSD_PK(2), o[d0], 0, 0, 0);
            o[d0] = __builtin_amdgcn_mfma_f32_32x32x16_bf16(__builtin_bit_cast(bf16x8, pw3), SSD_PK(3), o[d0], 0, 0, 0);
#undef SSD_PK
        }
    }
#pragma unroll
    for (int r = 0; r < 16; ++r) { float* yp = F.YSSD() + (m0 + 32 * wid + crow(r, hi)) * 1024 + h * 64 + r32; yp[0] = o[0][r]; yp[32] = o[1][r]; }
    { const int pb = wid & 1, nb = wid >> 1; f32x16 st = f32x16{};
      const int li = lane & 15, g16 = (lane >> 4) & 1, c4 = li & 3;
      const unsigned vbB = (unsigned)(uintptr_t)(shm + L_B) + (4 * nb + 2 * g16 + (c4 >> 1)) * 4096 + (4 * hi + (li >> 2)) * 16 + (c4 & 1) * 8;
      const unsigned vbA = vbx + pb * 16384;
      SSD_BAR();
      for (int ks = 0; ks < 16; ++ks) { s16x4 xl, xh, bl, bh;
          asm volatile("ds_read_b64_tr_b16 %0,%1" : "=&v"(xl) : "v"(vbA + ks * 1024) : "memory");
          asm volatile("ds_read_b64_tr_b16 %0,%1 offset:512" : "=&v"(xh) : "v"(vbA + ks * 1024) : "memory");
          asm volatile("ds_read_b64_tr_b16 %0,%1" : "=&v"(bl) : "v"(vbB + ks * 256) : "memory");
          asm volatile("ds_read_b64_tr_b16 %0,%1 offset:128" : "=&v"(bh) : "v"(vbB + ks * 256) : "memory");
          const f32x4 e0 = *(const LAS f32x4*)(et + 16 * ks + 4 * hi), e1 = *(const LAS f32x4*)(et + 16 * ks + 8 + 4 * hi);
          asm volatile("s_waitcnt lgkmcnt(0)" ::: "memory"); __builtin_amdgcn_sched_barrier(0);
          v4u xa;
          xa.x = cvtpk(__uint_as_float((unsigned)(unsigned short)xl[0] << 16) * e0[0], __uint_as_float((unsigned)(unsigned short)xl[1] << 16) * e0[1]);
          xa.y = cvtpk(__uint_as_float((unsigned)(unsigned short)xl[2] << 16) * e0[2], __uint_as_float((unsigned)(unsigned short)xl[3] << 16) * e0[3]);
          xa.z = cvtpk(__uint_as_float((unsigned)(unsigned short)xh[0] << 16) * e1[0], __uint_as_float((unsigned)(unsigned short)xh[1] << 16) * e1[1]);
          xa.w = cvtpk(__uint_as_float((unsigned)(unsigned short)xh[2] << 16) * e1[2], __uint_as_float((unsigned)(unsigned short)xh[3] << 16) * e1[3]);
          const bf16x8 bfr = (bf16x8){bl[0], bl[1], bl[2], bl[3], bh[0], bh[1], bh[2], bh[3]};
          st = __builtin_amdgcn_mfma_f32_32x32x16_bf16(__builtin_bit_cast(bf16x8, xa), bfr, st, 0, 0, 0); }
      float* sp = F.ST() + ((size_t)((b * 16 + c) * 16 + h)) * 8192 + 32 * nb + r32;
#pragma unroll
      for (int r = 0; r < 16; ++r) sp[(size_t)(32 * pb + crow(r, hi)) * 128] = st[r]; }
    SSD_BAR();
}

__device__ __forceinline__ void final_unit(const Ctx& F, LAS unsigned char* shm, int u) {
    const int tid = threadIdx.x, lane = tid & 63, r32 = lane & 31, hi = lane >> 5; const int wid = __builtin_amdgcn_readfirstlane(tid >> 6);
    const int qq = u & 3, grp = (u >> 2) & 1, c = (u >> 3) & 15, b = u >> 7, h = 8 * grp + wid; const size_t m0 = (size_t)b * SEQ + c * 256 + qq * 64;
    f32x16 acc[2][2];
#pragma unroll
    for (int pb = 0; pb < 2; ++pb) {
        bf16x8 sfr[8];
        { int lane_o = lane; asm volatile("" : "+v"(lane_o));
          const bf16* sp = F.SIN() + ((size_t)((b * 16 + c) * 16 + h) * 16 + pb * 8) * 512 + lane_o * 8;
#pragma unroll
          for (int kk = 0; kk < 8; ++kk) sfr[kk] = *(const bf16x8*)(sp + kk * 512); }
#pragma unroll
        for (int lb = 0; lb < 2; ++lb) { const bf16* cr = F.XBCA16() + (m0 + 32 * lb + r32) * CONV_DIM + 1280 + grp * 128 + hi * 8; f32x16 a = f32x16{};
#pragma unroll
            for (int kk = 0; kk < 8; ++kk) a = __builtin_amdgcn_mfma_f32_32x32x16_bf16(*(const bf16x8*)(cr + 16 * kk), sfr[kk], a, 0, 0, 0);
            acc[lb][pb] = a; }
    }
    LAS float* yt = (LAS float*)shm;
#pragma unroll
    for (int lb = 0; lb < 2; ++lb)
#pragma unroll
        for (int r = 0; r < 16; ++r) { LAS float* yp = yt + (32 * lb + crow(r, hi)) * 512 + wid * 64 + r32; yp[0] = acc[lb][0][r]; yp[32] = acc[lb][1][r]; }
    SSD_BAR();
    { const int hl = lane >> 3, hh = 8 * grp + hl, ch = hh * 64 + 8 * (lane & 7);
      const float Dk = F.d_skip()[hh]; const f32x4 n0 = *(const f32x4*)(F.ssm_norm() + ch), n1 = *(const f32x4*)(F.ssm_norm() + ch + 4);
#pragma unroll
      for (int half = 0; half < 2; ++half) {
          f32x4 yd[4][2], zz[4][2]; v4u xx[4]; float ea[4];
#pragma unroll
          for (int i = 0; i < 4; ++i) { const size_t mm = m0 + 8 * wid + 4 * half + i;
              yd[i][0] = *(const f32x4*)(F.YSSD() + mm * 1024 + ch); yd[i][1] = *(const f32x4*)(F.YSSD() + mm * 1024 + ch + 4); zz[i][0] = *(const f32x4*)(F.Z() + mm * 1024 + ch); zz[i][1] = *(const f32x4*)(F.Z() + mm * 1024 + ch + 4);
              xx[i] = *(const v4u*)(F.XBCA16() + mm * CONV_DIM + ch); ea[i] = __expf(F.ACS()[mm * 16 + hh]); }
#pragma unroll
          for (int i = 0; i < 4; ++i) { const int row = 8 * wid + 4 * half + i; const size_t mm = m0 + row;
              const f32x4 a0 = *(const LAS f32x4*)(yt + row * 512 + hl * 64 + 8 * (lane & 7)), a1 = *(const LAS f32x4*)(yt + row * 512 + hl * 64 + 8 * (lane & 7) + 4);
              float v[8] = {a0.x, a0.y, a0.z, a0.w, a1.x, a1.y, a1.z, a1.w};
              const float xv[8] = {__uint_as_float(xx[i].x << 16), __uint_as_float(xx[i].x & 0xffff0000u), __uint_as_float(xx[i].y << 16), __uint_as_float(xx[i].y & 0xffff0000u), __uint_as_float(xx[i].z << 16), __uint_as_float(xx[i].z & 0xffff0000u), __uint_as_float(xx[i].w << 16), __uint_as_float(xx[i].w & 0xffff0000u)};
              const float yv[8] = {yd[i][0].x, yd[i][0].y, yd[i][0].z, yd[i][0].w, yd[i][1].x, yd[i][1].y, yd[i][1].z, yd[i][1].w}, zv[8] = {zz[i][0].x, zz[i][0].y, zz[i][0].z, zz[i][0].w, zz[i][1].x, zz[i][1].y, zz[i][1].z, zz[i][1].w};
              float ss = 0.f;
#pragma unroll
              for (int e = 0; e < 8; ++e) { float y = v[e] * ea[i] + yv[e] + Dk * xv[e]; y *= zv[e] / (1.0f + __expf(-zv[e])); v[e] = y; ss += y * y; }
              const float rstd = 1.0f / sqrtf(wave_sum(ss) * (1.0f / 512.0f) + NORM_EPS);
              v4u w; w.x = cvtpk(v[0] * rstd * n0.x, v[1] * rstd * n0.y); w.y = cvtpk(v[2] * rstd * n0.z, v[3] * rstd * n0.w); w.z = cvtpk(v[4] * rstd * n1.x, v[5] * rstd * n1.y); w.w = cvtpk(v[6] * rstd * n1.z, v[7] * rstd * n1.w);
              *(v4u*)(F.MIX() + mm * DM + 1024 + ch) = w; } } }
    SSD_BAR();
}


__device__ __forceinline__ void carry_phase(const Ctx& F) {
    const int gt = blockIdx.x * (NWAVES * 64) + threadIdx.x, NGT = gridDim.x * NWAVES * 64;
    for (int i = gt; i < NB * 16 * 64 * 16; i += NGT) { const int n8 = i & 15, p = (i >> 4) & 63, h = (i >> 10) & 15, b = i >> 14;
        const int pb = p >> 5, kk = n8 >> 1, ln = (n8 & 1) * 32 + (p & 31);
        float sv[8] = {0.f, 0.f, 0.f, 0.f, 0.f, 0.f, 0.f, 0.f};
        for (int c = 0; c < 16; ++c) { const size_t ci = (size_t)(b * 16 + c) * 16 + h;
            v4u w; w.x = cvtpk(sv[0], sv[1]); w.y = cvtpk(sv[2], sv[3]); w.z = cvtpk(sv[4], sv[5]); w.w = cvtpk(sv[6], sv[7]);
            *(v4u*)(F.SIN() + ((ci * 16 + pb * 8 + kk) * 64 + ln) * 8) = w;
            const float dec = F.DEC()[ci]; const float* sp = F.ST() + ci * 8192 + (size_t)p * 128 + n8 * 8; const f32x4 a = *(const f32x4*)sp, d = *(const f32x4*)(sp + 4);
            sv[0] = sv[0] * dec + a.x; sv[1] = sv[1] * dec + a.y; sv[2] = sv[2] * dec + a.z; sv[3] = sv[3] * dec + a.w; sv[4] = sv[4] * dec + d.x; sv[5] = sv[5] * dec + d.y; sv[6] = sv[6] * dec + d.z; sv[7] = sv[7] * dec + d.w; }
        float* op = F.out() + O_SSP + ((size_t)(b * 16 + h) * 64 + p) * 128 + n8 * 8;
        *(f32x4*)op = (f32x4){sv[0], sv[1], sv[2], sv[3]}; *(f32x4*)(op + 4) = (f32x4){sv[4], sv[5], sv[6], sv[7]}; }
}
}
namespace cmpa {
using fa::bf16x8; using fa::f32x16;
constexpr int LK = 0, LV = 32768, LPS = 65536, PS_W = 8 * 264 * 4, IMP_W = 8 * 64 * 4, WAVE_B = PS_W + IMP_W;
static_assert(LPS + 8 * WAVE_B <= RING_BYTES, "cmpa LDS");
__device__ __forceinline__ float quad_sum(float v) {
    v += __int_as_float(__builtin_amdgcn_mov_dpp(__float_as_int(v), 0xB1, 0xF, 0xF, true));
    v += __int_as_float(__builtin_amdgcn_mov_dpp(__float_as_int(v), 0x4E, 0xF, 0xF, true));
    return v; }
__device__ __forceinline__ void unit(const Ctx& F, LAS unsigned char* shm, int b, int g, int qb) {
    const int tid = threadIdx.x, lane = tid & 63, r32 = lane & 31, hi = lane >> 5; const int wid = __builtin_amdgcn_readfirstlane(tid >> 6);
    const int ntile = (4 * qb + 3 + 63) >> 6;
    const float* KC = F.KCMPP() + (size_t)b * NCMP_P * 512 + g * 64;
    { f32x4 ka[4], kb2[4], va[4], vb2[4];
#pragma unroll
      for (int t = 0; t < 4; ++t) if (t < ntile) {
          int nk = 64 * t + lane; nk = nk > NCMP_P - 1 ? NCMP_P - 1 : nk; const float* kp = KC + (size_t)nk * 512 + wid * 8; ka[t] = *(const f32x4*)kp; kb2[t] = *(const f32x4*)(kp + 4);
          int nv = 64 * t + 16 * (wid & 3) + (lane >> 2); nv = nv > NCMP_P - 1 ? NCMP_P - 1 : nv; const float* vp = KC + 256 + (size_t)nv * 512 + (wid >> 2) * 32 + (lane & 3) * 8; va[t] = *(const f32x4*)vp; vb2[t] = *(const f32x4*)(vp + 4); }
#pragma unroll
      for (int t = 0; t < 4; ++t) if (t < ntile) {
          v4u kw; kw.x = fa::cvtpk(ka[t].x, ka[t].y); kw.y = fa::cvtpk(ka[t].z, ka[t].w); kw.z = fa::cvtpk(kb2[t].x, kb2[t].y); kw.w = fa::cvtpk(kb2[t].z, kb2[t].w);
          *(LAS v4u*)(shm + LK + t * 8192 + wid * 1024 + lane * 16) = kw;
          v4u vw; vw.x = fa::cvtpk(va[t].x, va[t].y); vw.y = fa::cvtpk(va[t].z, va[t].w); vw.z = fa::cvtpk(vb2[t].x, vb2[t].y); vw.w = fa::cvtpk(vb2[t].z, vb2[t].w);
          *(LAS v4u*)(shm + LV + t * 8192 + wid * 1024 + lane * 16) = vw; } }
    const int tl = r32 >> 2, hd = 4 * g + (r32 & 3), t = 64 * qb + 8 * wid + tl; const size_t m = (size_t)b * SEQ + t;
    bf16x8 qr[4];
    { const bf16* Qp = F.QB() + m * 1024 + hd * 64 + hi * 8;
#pragma unroll
      for (int d0 = 0; d0 < 4; ++d0) qr[d0] = *(const bf16x8*)(Qp + 16 * d0); }
    FA_BAR();
    const int nvis = t >= 31 ? ((t - 31) >> 4) + 1 : 0;
    float mx = fa::MASKV, lsum = 0.f;
    for (int tt = 0; tt < ntile; ++tt) { f32x16 p0, p1; fa::qkt(p0, p1, shm + LK + tt * 8192, qr, r32, hi);
#pragma unroll
        for (int r = 0; r < 16; ++r) { const int n0 = 64 * tt + fa::crow(r, hi); p0[r] = n0 < nvis ? p0[r] * fa::C2 : fa::MASKV; p1[r] = n0 + 32 < nvis ? p1[r] * fa::C2 : fa::MASKV; }
        const float mn = fmaxf(mx, fa::rowmax(p0, p1)); float acc = 0.f;
#pragma unroll
        for (int r = 0; r < 16; ++r) { const int n0 = 64 * tt + fa::crow(r, hi); acc += (n0 < nvis ? __builtin_amdgcn_exp2f(p0[r] - mn) : 0.f) + (n0 + 32 < nvis ? __builtin_amdgcn_exp2f(p1[r] - mn) : 0.f); }
        lsum = lsum * __builtin_amdgcn_exp2f(mx - mn) + acc; mx = mn; }
    lsum = fa::xsum(lsum); const float inv = 1.0f / fmaxf(lsum, 1e-30f);
    LAS float* ps = (LAS float*)(shm + LPS + wid * WAVE_B); LAS float* impl = (LAS float*)(shm + LPS + wid * WAVE_B + PS_W);
    for (int i = lane; i < 8 * 264; i += 64) ps[i] = 0.f;
    asm volatile("s_waitcnt lgkmcnt(0)" ::: "memory");
    f32x16 o[2]; o[0] = f32x16{}; o[1] = f32x16{};
    const unsigned vb0 = (unsigned)(uintptr_t)(shm + LV) + ((lane >> 4) & 1) * 32 + (lane & 3) * 8 + (4 * hi + ((lane & 15) >> 2)) * 64;
    for (int tt = 0; tt < ntile; ++tt) { f32x16 p0, p1; fa::qkt(p0, p1, shm + LK + tt * 8192, qr, r32, hi);
#pragma unroll
        for (int r = 0; r < 16; ++r) { const int n0 = 64 * tt + fa::crow(r, hi); p0[r] = n0 < nvis ? __builtin_amdgcn_exp2f(p0[r] * fa::C2 - mx) * inv : 0.f; p1[r] = n0 + 32 < nvis ? __builtin_amdgcn_exp2f(p1[r] * fa::C2 - mx) * inv : 0.f; }
        v4u pw0, pw1, pw2, pw3;
        pw0.x = fa::cvtpk(p0[0], p0[1]); pw0.y = fa::cvtpk(p0[2], p0[3]); pw0.z = fa::cvtpk(p0[4], p0[5]); pw0.w = fa::cvtpk(p0[6], p0[7]);
        pw1.x = fa::cvtpk(p0[8], p0[9]); pw1.y = fa::cvtpk(p0[10], p0[11]); pw1.z = fa::cvtpk(p0[12], p0[13]); pw1.w = fa::cvtpk(p0[14], p0[15]);
        pw2.x = fa::cvtpk(p1[0], p1[1]); pw2.y = fa::cvtpk(p1[2], p1[3]); pw2.z = fa::cvtpk(p1[4], p1[5]); pw2.w = fa::cvtpk(p1[6], p1[7]);
        pw3.x = fa::cvtpk(p1[8], p1[9]); pw3.y = fa::cvtpk(p1[10], p1[11]); pw3.z = fa::cvtpk(p1[12], p1[13]); pw3.w = fa::cvtpk(p1[14], p1[15]);
        fa::pv(o, vb0 + tt * 8192, __builtin_bit_cast(bf16x8, pw0), __builtin_bit_cast(bf16x8, pw1), __builtin_bit_cast(bf16x8, pw2), __builtin_bit_cast(bf16x8, pw3));
#pragma unroll
        for (int r = 0; r < 16; ++r) { const float s0 = quad_sum(p0[r]), s1 = quad_sum(p1[r]);
            if ((r32 & 3) == (tt & 3)) { const int n0 = 64 * tt + fa::crow(r, hi); ps[tl * 264 + 1 + n0] = s0; ps[tl * 264 + 1 + n0 + 32] = s1; } } }
#pragma unroll
    for (int r = 0; r < 16; ++r) { const int q = fa::crow(r, hi); float* op = F.OCMP() + ((size_t)b * SEQ + 64 * qb + 8 * wid + (q >> 2)) * 1024 + (4 * g + (q & 3)) * 64 + r32; op[0] = o[0][r]; op[32] = o[1][r]; }
    asm volatile("s_waitcnt lgkmcnt(0)" ::: "memory");
    const int tk = lane >> 3, jsub = lane & 7; float mine[8];
#pragma unroll
    for (int k = 0; k < 8; ++k) { const int j = jsub + 8 * k; const LAS float* pp = ps + tk * 264 + 4 * j;
        float v = pp[0] + 2.0f * (pp[1] + pp[2] + pp[3]) + pp[4];
        if (j == 0 || j == qb || j == qb - 1) v = 1.0e4f; if (j > qb) v = -1.0e4f;
        mine[k] = v; impl[tk * 64 + j] = v; }
    asm volatile("s_waitcnt lgkmcnt(0)" ::: "memory");
    int cnt[8];
#pragma unroll
    for (int k = 0; k < 8; ++k) cnt[k] = 0;
    for (int i4 = 0; i4 < 16; ++i4) { const f32x4 vv = *(const LAS f32x4*)(impl + tk * 64 + 4 * i4);
#pragma unroll
        for (int e = 0; e < 4; ++e) { const float v = vv[e]; const int kk = 4 * i4 + e;
#pragma unroll
            for (int k = 0; k < 8; ++k) { const int j = jsub + 8 * k; cnt[k] += ((v > mine[k]) || (v == mine[k] && kk < j)) ? 1 : 0; } } }
    unsigned mlo = 0u, mhi = 0u;
#pragma unroll
    for (int k = 0; k < 8; ++k) { if (cnt[k] < 16) { const int j = jsub + 8 * k; if (j < 32) mlo |= 1u << j; else mhi |= 1u << (j - 32); } }
#pragma unroll
    for (int o2 = 1; o2 < 8; o2 <<= 1) { mlo |= (unsigned)__shfl_xor((int)mlo, o2); mhi |= (unsigned)__shfl_xor((int)mhi, o2); }
    if (jsub == 0) F.SELMASK()[((size_t)b * SEQ + 64 * qb + 8 * wid + tk) * 4 + g] = ((unsigned long long)mhi << 32) | mlo;
    FA_BAR();
}
__device__ __forceinline__ void phase(const Ctx& F, LAS unsigned char* shm) {
    for (int u = blockIdx.x; u < NB * 4 * 64; u += gridDim.x) { const int bg = u >> 6; int qb = u & 63; qb = (u >= 256) ? 63 - qb : qb; unit(F, shm, bg >> 2, bg & 3, qb); }
}
}
namespace sk {
typedef short bf16x8 __attribute__((ext_vector_type(8)));
typedef float f32x16 __attribute__((ext_vector_type(16)));
__device__ __forceinline__ int crow(int r, int hi) { return (r & 3) + 8 * (r >> 2) + 4 * hi; }
__device__ __forceinline__ float half_sum(float v) {
#pragma unroll
    for (int o = 1; o < 32; o <<= 1) v += __shfl_xor(v, o);
    return v; }
#define SK_BAR() asm volatile("s_waitcnt vmcnt(0) lgkmcnt(0)\n\ts_barrier" ::: "memory")
template <class Epi>
__device__ __forceinline__ void phase(LAS unsigned char* shm, const bf16* A, const bf16* Bt, int N, int K, int wg_rel, int nwg, const Epi& E) {
    const int tid = threadIdx.x, lane = tid & 63, r32 = lane & 31, hi = lane >> 5; const int wid = __builtin_amdgcn_readfirstlane(tid >> 6);
    const int ks = K >> 3; LAS float* red = (LAS float*)shm;
    for (int blk = wg_rel; blk < (N >> 5); blk += nwg) {
        const bf16* ap = A + (size_t)r32 * K + wid * ks + hi * 8; const bf16* bp = Bt + (size_t)(blk * 32 + r32) * K + wid * ks + hi * 8;
        f32x16 acc = f32x16{};
        for (int k = 0; k < ks; k += 256) { bf16x8 a[16], b[16];
#pragma unroll
            for (int i = 0; i < 16; ++i) { a[i] = *(const bf16x8*)(ap + k + 16 * i); b[i] = *(const bf16x8*)(bp + k + 16 * i); }
#pragma unroll
            for (int i = 0; i < 16; ++i) acc = __builtin_amdgcn_mfma_f32_32x32x16_bf16(a[i], b[i], acc, 0, 0, 0); }
#pragma unroll
        for (int r = 0; r < 16; ++r) red[(wid * 16 + r) * 64 + lane] = acc[r];
        SK_BAR();
        float v0 = 0.f, v1 = 0.f;
#pragma unroll
        for (int w = 0; w < 8; ++w) { v0 += red[(w * 16 + 2 * wid) * 64 + lane]; v1 += red[(w * 16 + 2 * wid + 1) * 64 + lane]; }
        E(blk, blk * 32 + r32, crow(2 * wid, hi), v0, crow(2 * wid + 1, hi), v1, r32);
        SK_BAR();
    }
}
struct EpiInS { bf16 *QB, *KVB; size_t kvstride; float *Z, *XBC, *GD, *out;
    __device__ __forceinline__ void one(int cp, int row, float v) const { const size_t m = (size_t)MPROMPT + row;
        if (cp < 1024) QB[m * 1024 + cp] = (bf16)f2bf(v);
        else if (cp < 2560) { const int which = (cp - 1024) >> 9, cc = (cp - 1024) & 511; KVB[(size_t)which * kvstride + m * 512 + cc] = (bf16)f2bf(v);
            float* fo = which == 0 ? out + O_KCS + (size_t)row * 512 : (which == 1 ? out + O_KSS + (size_t)row * 512 : out + O_KWS + (size_t)(row * 512 + 511) * 512); fo[cc] = v; }
        else if (cp < 3584) Z[m * 1024 + cp - 2560] = v;
        else if (cp < 5120) XBC[m * CONV_DIM + cp - 3584] = v;
        else if (cp < 5168) GD[m * 64 + cp - 5120] = 1.0f / (1.0f + __expf(-v));
        else if (cp < NCOLS_IN) GD[m * 64 + cp - 5120] = v; }
    __device__ __forceinline__ void operator()(int, int col, int r0, float v0, int r1, float v1, int) const { one(col, r0, v0); one(col, r1, v1); } };
struct EpiResS { const float* xres; float* X1; bf16* X1B; float* SS;
    __device__ __forceinline__ void operator()(int blk, int col, int r0, float v0, int r1, float v1, int r32) const {
        v0 += xres[(size_t)r0 * DM + col]; v1 += xres[(size_t)r1 * DM + col]; X1[(size_t)r0 * DM + col] = v0; X1[(size_t)r1 * DM + col] = v1;
        if (X1B) { X1B[(size_t)r0 * DM + col] = (bf16)f2bf(v0); X1B[(size_t)r1 * DM + col] = (bf16)f2bf(v1); }
        const float s0 = half_sum(v0 * v0), s1 = half_sum(v1 * v1); if (r32 == 0) { SS[r0 * 64 + blk] = s0; SS[r1 * 64 + blk] = s1; } } };
struct EpiUpS { bf16* H; const LAS float* rs;
    __device__ __forceinline__ void operator()(int, int col, int r0, float v0, int r1, float v1, int) const {
        float a = fmaxf(v0 * rs[r0], 0.f), b = fmaxf(v1 * rs[r1], 0.f); H[(size_t)r0 * DFF + col] = (bf16)f2bf(a * a); H[(size_t)r1 * DFF + col] = (bf16)f2bf(b * b); } };
}
namespace deca {
constexpr int L_QS = 0, L_SC = 1024, L_PART = 17408, L_PS = 25600, L_IMP = 27776;
#define DA_BAR() asm volatile("s_waitcnt vmcnt(0) lgkmcnt(0)\n\ts_barrier" ::: "memory")
__device__ __forceinline__ void load_row(const KeyRef& kr, const void* p, float (&k)[64]) {
    if (kr.f32) { const f32x4* q = (const f32x4*)p;
#pragma unroll
        for (int i = 0; i < 16; ++i) { const f32x4 t = q[i]; k[4 * i] = t.x; k[4 * i + 1] = t.y; k[4 * i + 2] = t.z; k[4 * i + 3] = t.w; } }
    else { const v4u* q = (const v4u*)p;
#pragma unroll
        for (int i = 0; i < 8; ++i) { const v4u t = q[i]; k[8 * i] = __uint_as_float(t.x << 16); k[8 * i + 1] = __uint_as_float(t.x & 0xffff0000u); k[8 * i + 2] = __uint_as_float(t.y << 16); k[8 * i + 3] = __uint_as_float(t.y & 0xffff0000u);
            k[8 * i + 4] = __uint_as_float(t.z << 16); k[8 * i + 5] = __uint_as_float(t.z & 0xffff0000u); k[8 * i + 6] = __uint_as_float(t.w << 16); k[8 * i + 7] = __uint_as_float(t.w & 0xffff0000u); } }
}
template <int NCH, int MODE, class KF>
__device__ __forceinline__ void unit(const Ctx& F, LAS unsigned char* shm, int m, int g, const KF& kf) {
    const int tid = threadIdx.x, lane = tid & 63; const int wid = __builtin_amdgcn_readfirstlane(tid >> 6);
    LAS float* qs = (LAS float*)(shm + L_QS); LAS float* sc = (LAS float*)(shm + L_SC); LAS float* part = (LAS float*)(shm + L_PART);
    constexpr int NK = NCH * 64, CPW = NCH / 8;
    if (tid < 256) qs[tid] = bf2f(F.QB()[(size_t)m * 1024 + g * 256 + tid]) * 0.125f;
    DA_BAR();
#pragma unroll
    for (int i = 0; i < CPW; ++i) { const int c = wid + 8 * i; const KeyRef kr = kf(c, lane); float s[4] = {-INFINITY, -INFINITY, -INFINITY, -INFINITY};
        if (kr.valid) { float k[64]; load_row(kr, kr.k, k);
#pragma unroll
            for (int h = 0; h < 4; ++h) { float a = 0.f;
#pragma unroll
                for (int d4 = 0; d4 < 16; ++d4) { const f32x4 q4 = *(const LAS f32x4*)(qs + h * 64 + 4 * d4); a += q4.x * k[4 * d4] + q4.y * k[4 * d4 + 1] + q4.z * k[4 * d4 + 2] + q4.w * k[4 * d4 + 3]; }
                s[h] = a; } }
#pragma unroll
        for (int h = 0; h < 4; ++h) sc[h * NK + c * 64 + lane] = s[h]; }
    DA_BAR();
    float mh[4], ih[4];
#pragma unroll
    for (int h = 0; h < 4; ++h) { float mx = -INFINITY;
        for (int c = 0; c < NCH; ++c) mx = fmaxf(mx, sc[h * NK + c * 64 + lane]);
        mx = wave_max(mx); if (mx == -INFINITY) mx = 0.f;
        float sm = 0.f;
        for (int c = 0; c < NCH; ++c) sm += __expf(sc[h * NK + c * 64 + lane] - mx);
        sm = wave_sum(sm); mh[h] = mx; ih[h] = 1.0f / fmaxf(sm, 1e-30f); }
    DA_BAR();
#pragma unroll
    for (int i = 0; i < CPW; ++i) { const int c = wid + 8 * i;
#pragma unroll
        for (int h = 0; h < 4; ++h) sc[h * NK + c * 64 + lane] = __expf(sc[h * NK + c * 64 + lane] - mh[h]) * ih[h]; }
#pragma unroll
    for (int h = 0; h < 4; ++h) { float a0[64];
#pragma unroll
        for (int d = 0; d < 64; ++d) a0[d] = 0.f;
#pragma unroll
        for (int i = 0; i < CPW; ++i) { const int c = wid + 8 * i; const KeyRef kr = kf(c, lane);
            if (kr.valid) { const float p0 = sc[h * NK + c * 64 + lane];
                if (kr.f32) { const f32x4* p = (const f32x4*)kr.v;
#pragma unroll
                    for (int j = 0; j < 16; ++j) { const f32x4 t = p[j]; a0[4 * j] += p0 * t.x; a0[4 * j + 1] += p0 * t.y; a0[4 * j + 2] += p0 * t.z; a0[4 * j + 3] += p0 * t.w; } }
                else { const v4u* p = (const v4u*)kr.v;
#pragma unroll
                    for (int j = 0; j < 8; ++j) { const v4u t = p[j]; a0[8 * j] += p0 * __uint_as_float(t.x << 16); a0[8 * j + 1] += p0 * __uint_as_float(t.x & 0xffff0000u); a0[8 * j + 2] += p0 * __uint_as_float(t.y << 16); a0[8 * j + 3] += p0 * __uint_as_float(t.y & 0xffff0000u);
                        a0[8 * j + 4] += p0 * __uint_as_float(t.z << 16); a0[8 * j + 5] += p0 * __uint_as_float(t.z & 0xffff0000u); a0[8 * j + 6] += p0 * __uint_as_float(t.w << 16); a0[8 * j + 7] += p0 * __uint_as_float(t.w & 0xffff0000u); } } } }
        part[(wid * 4 + h) * 64 + lane] = wave_reduce_t64(a0, lane); }
    DA_BAR();
    if (tid < 256) { const int h = tid >> 6, d = tid & 63; float o = 0.f;
#pragma unroll
        for (int w = 0; w < 8; ++w) o += part[(w * 4 + h) * 64 + d];
        const int hd = g * 4 + h; const size_t oi = (size_t)m * 1024 + hd * 64 + d;
        if (MODE == 0) F.OCMP()[oi] = o;
        else if (MODE == 1) F.OWIN()[oi] = o;
        else { const float* gt = F.GD() + (size_t)m * 64 + hd * 3; F.MIX()[(size_t)m * DM + hd * 64 + d] = (bf16)f2bf(gt[0] * F.OCMP()[oi] + gt[1] * o + gt[2] * F.OWIN()[oi]); } }
    if (MODE == 0 && wid == 0) {
        LAS float* ps = (LAS float*)(shm + L_PS); LAS float* imp = (LAS float*)(shm + L_IMP);
        for (int i = lane; i < 544; i += 64) ps[i] = 0.f;
        for (int c = 0; c < NCH; ++c) ps[1 + c * 64 + lane] = (sc[c * 64 + lane] + sc[NK + c * 64 + lane]) + (sc[2 * NK + c * 64 + lane] + sc[3 * NK + c * 64 + lane]);
        constexpr int nslc = NSLC_S, jt = PAST >> 6; float mine[3]; int cnt[3];
#pragma unroll
        for (int jj = 0; jj < 3; ++jj) { const int j = jj * 64 + lane; float v = 0.f; cnt[jj] = 0;
            if (j < nslc) { v = ps[4 * j] + 2.0f * (ps[4 * j + 1] + ps[4 * j + 2] + ps[4 * j + 3]) + ps[4 * j + 4]; if (j == 0 || j == jt || j == jt - 1) v = 1.0e4f; if (j > jt) v = -1.0e4f; imp[j] = v; }
            mine[jj] = v; }
        for (int k = 0; k < nslc; ++k) { const float v = imp[k];
#pragma unroll
            for (int jj = 0; jj < 3; ++jj) { const int j = jj * 64 + lane; cnt[jj] += ((v > mine[jj]) || (v == mine[jj] && k < j)) ? 1 : 0; } }
        int base = 0; const size_t task = (size_t)m * 4 + g;
#pragma unroll
        for (int jj = 0; jj < 3; ++jj) { const int j = jj * 64 + lane; const bool sel = (j < nslc) && (cnt[jj] < 16); const unsigned long long bal = __ballot(sel);
            if (sel) F.SELIDX()[task * 16 + base + __popcll(bal & ((1ull << lane) - 1ull))] = j;
            base += __popcll(bal); } }
    DA_BAR();
}
}
struct Args { const void* in[26]; float* out; unsigned char* ws; int ph_lo, ph_hi, li, pad; };
__global__ void __launch_bounds__(NWAVES * 64, 2) fwd_kernel(Args args) {
    extern __shared__ __attribute__((aligned(16))) unsigned char lds[];
    Ctx F;
    F.lds = (LAS unsigned char*)lds; F.MISC = (volatile LAS unsigned*)(F.lds + MISC_OFF);
    F.tid = threadIdx.x; F.lane = F.tid & 63; F.wave = __builtin_amdgcn_readfirstlane(F.tid >> 6);
    F.G = gridDim.x; { const int bx = blockIdx.x; F.vcu = (F.G % 8 == 0) ? (bx % 8) * (F.G / 8) + bx / 8 : bx; }
    F.ka = (const __attribute__((address_space(4))) unsigned long long*)__builtin_amdgcn_kernarg_segment_ptr();
    F.ctl = (gu32*)(F.ws() + WS_CTL);
    for (int u = F.tid; u < (LDS_BYTES - LDSCTL_OFF) / 4; u += NWAVES * 64) ((LAS unsigned*)(F.lds + LDSCTL_OFF))[u] = 0u;
    __syncthreads();
    XcdBarrier bar; bar.bar = (unsigned*)(F.ctl + CW_BAR); bar.x = 0; bar.st = nullptr;
    if (N_LAUNCHES == 1) bar = xcd_barrier_post((unsigned*)(F.ctl + CW_BAR), F.MISC + 8);
#ifdef PROBE_DBLBAR
#define PROBE_EXTRA_BAR xcd_barrier(bar);
#else
#define PROBE_EXTRA_BAR
#endif
#define GRID_BAR(seam) do { if (N_LAUNCHES != 1) { if (F.tid == 0) __hip_atomic_store(F.ctl + CW_TMO, 0xBADBA0u | (unsigned)(seam), RLX_AGENT); } else { xcd_barrier(bar); PROBE_EXTRA_BAR } } while (0)
    const int lo = args.ph_lo, hi = args.ph_hi;
#define IN(k) (lo <= (k) && (k) < hi)
#define BOTH(k) (IN(k) && IN((k) + 1))
    const int gw = F.vcu * NWAVES + F.wave, NGW = F.G * NWAVES;

    if (IN(0)) { p0_prologue(F); if (BOTH(0)) GRID_BAR(0); }
    if (IN(1)) {
        pg8::Gemm g{F.XN(), F.WIN(), MPROMPT, NIN, DM}; pg8::StaticOrder S; S.init(MPROMPT, NIN, F.G, (int)blockIdx.x);
        static_assert(WS_KSB - WS_KCB == WS_KWB - WS_KSB, "kv copies equally spaced");
        pg8::EpiInProj E{F.QB(), F.KCB(), (WS_KSB - WS_KCB) / 2, F.Z(), F.XBC(), F.GD(), F.out()};
        pg8::gemm_phase<pg8::EpiInProj, pg8::StaticOrder, true, true>(F.lds + RING_OFF, g, S, E);
        {
          const int rel = (F.G == 256) ? (int)blockIdx.x - 160 : (int)blockIdx.x, nw = (F.G == 256) ? 96 : F.G;
          if (rel >= 0) { const sk::EpiInS ES{F.QB(), F.KCB(), (WS_KSB - WS_KCB) / 2, F.Z(), F.XBC(), F.GD(), F.out()};
              sk::phase(F.lds + RING_OFF, F.XN() + (size_t)MPROMPT * DM, F.WIN(), NCOLS_IN, DM, rel, nw, ES); } }
        if (F.G == 256 && blockIdx.x >= 160) { __syncthreads(); weight_items(F, 0, W_ITEMS_P1, ((int)blockIdx.x - 160) * NWAVES + F.wave, 96 * NWAVES); }
        if (BOTH(1)) GRID_BAR(1);
    }
    if (IN(2)) {
        constexpr int NT_C = NB * NCMP_P * 2 + DECB * NCMP_S * 2;
        for (int u = blockIdx.x; u < 256; u += gridDim.x) cmpg::unit(F, F.lds + RING_OFF, u);
        for (int u = blockIdx.x; u < NB * 2 * 32; u += gridDim.x) cmpg::small_unit(F, F.lds + RING_OFF, u);
        __syncthreads();
        conv_prepass(F);
        fa::win_phase(F, F.lds + RING_OFF); __syncthreads();
        for (int u = F.G - 1 - (int)blockIdx.x; u < DECB * 4; u += F.G) { const int b = u >> 2, g = u & 3, m = MPROMPT + b;
            const WinKeysS kf{F.st_win() + (size_t)b * 512 * 512, F.KWB() + (size_t)m * 512, g}; deca::unit<8, 1>(F, F.lds + RING_OFF, m, g, kf); }
        if (BOTH(2)) GRID_BAR(2);
    }
    if (IN(3)) {
        constexpr int NT_S = NB * 16 * 64 + DECB * 16 * 64;
#ifdef CHK_DEC
        for (int it = MPROMPT * 4 + gw; it < MROWS * 4; it += NGW) win_task<true>(F, it, F.lane);
        __syncthreads();
#endif
#ifdef CHK_CMP
        { constexpr int NT_C2 = NB * NCMP_P * 2 + DECB * NCMP_S * 2; for (int it = gw; it < 200; it += NGW) compress_ref_check(F, (int)(((long)it * 168 + 7) % NT_C2), it & 3, F.lane, -1); }
        { constexpr int NT_C = NB * NCMP_P * 2 + DECB * NCMP_S * 2; for (int it = gw; it < 600; it += NGW) compress_task<true>(F, (int)(((long)it * 56 + 7) % NT_C), F.lane); }
        __syncthreads();
#endif
#ifdef CHK_ATT
        for (int it = gw; it < 135 * 4; it += NGW) win_task<true>(F, (it >> 2) * 61 * 4 + (it & 3), F.lane);
        __syncthreads();
#endif
#ifdef SSD_NAIVE
        for (int it = gw; it < NT_S; it += NGW) ssd_task(F, it, F.lane);
#else
#ifdef REP_LOC
        for (int rep = 0; rep <= args.pad; ++rep)
#endif
        for (int u = blockIdx.x; u < NB * 16 * 16; u += gridDim.x) ssd::local_unit(F, F.lds + RING_OFF, u);
        __syncthreads();
        if (F.G == 256) { if (blockIdx.x < 128) for (int it = (int)blockIdx.x * NWAVES + F.wave; it < DECB * 16 * 8; it += 128 * NWAVES) ssd_decode_task(F, it, F.lane); }
        else for (int it = gw; it < DECB * 16 * 8; it += NGW) ssd_decode_task(F, it, F.lane);
#endif
        __syncthreads();
#ifdef REP_CMPA
        for (int rep = 0; rep <= args.pad; ++rep)
#endif
        { cmpa::phase(F, F.lds + RING_OFF); __syncthreads(); }
        for (int u = F.G - 1 - (int)blockIdx.x; u < DECB * 4; u += F.G) { const int b = u >> 2, g = u & 3, m = MPROMPT + b;
            const CmpKeys kf{F.KCMPS() + (size_t)b * NCMP_S * 512, g, NCMP_S, PAST}; deca::unit<8, 0>(F, F.lds + RING_OFF, m, g, kf); }
        if (BOTH(3)) GRID_BAR(3);
    }
    if (IN(4)) {
#ifdef REP_DECA
        for (int rep = 0; rep <= args.pad; ++rep)
#endif
        for (int u = F.G - 1 - (int)blockIdx.x; u < DECB * 4; u += F.G) { const int b = u >> 2, g = u & 3, m = MPROMPT + b;
            const SelKeysS kf{F.SELIDX() + ((size_t)m * 4 + g) * 16, F.page_table() + b * 64, F.cache_sel(), F.KSB() + (size_t)m * 512, g}; deca::unit<16, 2>(F, F.lds + RING_OFF, m, g, kf); }
        __syncthreads();
        ssd::carry_phase(F); winbuf_copy(F);
        if (F.G == 256) { if (blockIdx.x < 128) weight_items(F, W_ITEMS_P1, W_ITEMS, (int)blockIdx.x * NWAVES + F.wave, 128 * NWAVES); }
        else weight_items(F, 0, W_ITEMS, gw, NGW);
        if (BOTH(4)) GRID_BAR(4); }
    if (IN(5)) {
#ifdef CHK_DEC
        for (int it = MPROMPT * 4 + gw; it < MROWS * 4; it += NGW) cmp_task<true>(F, it, F.lane);
        __syncthreads();
#endif
#ifdef CHK_CMPA
        for (int it = gw; it < 135 * 4; it += NGW) cmp_task<true>(F, (it >> 2) * 61 * 4 + (it & 3), F.lane);
        __syncthreads();
#endif
        fa::sel_phase(F, F.lds + RING_OFF); __syncthreads();
#ifdef REP_SEL
        fa::sel_phase(F, F.lds + RING_OFF); __syncthreads();
#endif
#ifdef DRY_SEL
        fa::sel_phase_dry<DRY_SEL>(F, F.lds + RING_OFF); __syncthreads();
#endif
#ifdef SSD_NAIVE
        for (int it = gw; it < MROWS * 2; it += NGW) ssd_gate_task(F, it, F.lane);
#else
        __syncthreads();
#ifdef REP_FIN
        for (int rep = 0; rep <= args.pad; ++rep)
#endif
        for (int u = blockIdx.x; u < NB * 16 * 2 * 4; u += gridDim.x) ssd::final_unit(F, F.lds + RING_OFF, u);
        for (int it = MPROMPT * 2 + gw; it < MROWS * 2; it += NGW) ssd_gate_task(F, it, F.lane);
#endif
        if (BOTH(5)) GRID_BAR(5);
    }
    if (IN(6)) {
#ifdef CHK_DEC
        for (int it = MPROMPT * 4 + gw; it < MROWS * 4; it += NGW) sel_task<true>(F, it, F.lane);
        __syncthreads();
#endif
#ifdef CHK_ATT
        for (int it = gw; it < 135 * 4; it += NGW) sel_task<true>(F, (it >> 2) * 61 * 4 + (it & 3), F.lane);
        __syncthreads();
#endif
        pg8::Gemm g{F.MIX(), F.WOUT(), MPROMPT, DM, DM}; pg8::StaticOrder S; S.init(MPROMPT, DM, F.G, (int)blockIdx.x);
        pg8::EpiResid E{F.x_prompt(), F.x_sample(), DM, F.X1(), F.X1B(), F.SS1()};
        pg8::gemm_phase<pg8::EpiResid, pg8::StaticOrder, true, true>(F.lds + RING_OFF, g, S, E);
        { const sk::EpiResS ES{F.x_sample(), F.X1() + (size_t)MPROMPT * DM, F.X1B() + (size_t)MPROMPT * DM, F.SS1S()};
          sk::phase(F.lds + RING_OFF, F.MIX() + (size_t)MPROMPT * DM, F.WOUT(), DM, DM, (int)blockIdx.x, F.G, ES); }
        if (BOTH(6)) GRID_BAR(6);
    }
    if (IN(7)) {
        pg8::Gemm g{F.X1B(), F.WUP(), MPROMPT, DFF, DM}; pg8::StaticOrder S; S.init(MPROMPT, DFF, F.G, (int)blockIdx.x);
        pg8::EpiUp E{F.H(), F.SS1()};
        pg8::gemm_phase<pg8::EpiUp, pg8::StaticOrder, true, true>(F.lds + RING_OFF, g, S, E);
        { LAS float* rs = (LAS float*)(F.lds + RING_OFF + 32768);
          if (F.tid < 32) { float t = 0.f; for (int i = 0; i < 64; ++i) t += F.SS1S()[F.tid * 64 + i]; rs[F.tid] = 1.0f / sqrtf(t * (1.0f / DM) + NORM_EPS); }
          __syncthreads();
          const sk::EpiUpS ES{F.H() + (size_t)MPROMPT * DFF, rs};
          sk::phase(F.lds + RING_OFF, F.X1B() + (size_t)MPROMPT * DM, F.WUP(), DFF, DM, (int)blockIdx.x, F.G, ES); }
        if (BOTH(7)) GRID_BAR(7);
    }
    if (IN(8)) {
        pg8::Gemm g{F.H(), F.WDN(), MPROMPT, DM, DFF}; pg8::StaticOrder S; S.init(MPROMPT, DM, F.G, (int)blockIdx.x);
        pg8::EpiResid E{F.X1(), F.X1() + (size_t)MPROMPT * DM, DM, F.X2(), nullptr, F.SS2()};
        pg8::gemm_phase<pg8::EpiResid, pg8::StaticOrder, true, true>(F.lds + RING_OFF, g, S, E);
        { const sk::EpiResS ES{F.X1() + (size_t)MPROMPT * DM, F.X2() + (size_t)MPROMPT * DM, nullptr, F.SS2S()};
          sk::phase(F.lds + RING_OFF, F.H() + (size_t)MPROMPT * DFF, F.WDN(), DM, DFF, (int)blockIdx.x, F.G, ES); }
        if (BOTH(8)) GRID_BAR(8);
    }
    if (IN(9)) { for (int m = gw; m < MROWS; m += NGW) final_norm_row(F, m, F.lane);
#if defined(CHK_ATT) || defined(CHK_CMP) || defined(CHK_CMPA) || defined(CHK_DEC) || defined(CHK_ANY)
        if (blockIdx.x == 0 && F.tid == 0) { unsigned mask = 0u;
            for (int k = 0; k < 8; ++k) if (__hip_atomic_load((unsigned*)F.ctl + CW_CHK + k, RLX_AGENT)) mask |= 1u << k;
            if (mask & 31u) F.out()[O_KCS] = 1.0e6f * (float)(1u + (mask & 31u));
            if (mask >> 5) F.out()[O_KSS] = 1.0e9f * (float)(1u + (mask >> 5)); }
#endif
    }
#undef IN
#undef BOTH
}

extern "C" void kernel_launch(void* const* d_in, const int* in_sizes, int n_in, void* d_out, int out_size, void* d_ws, size_t ws_size, hipStream_t stream) {
    static int grid = 0;
    if (grid == 0) {
        if (n_in != 26 || (size_t)out_size != O_END || ws_size < WS_END) { fprintf(stderr, "kernel_launch: unexpected shapes: n_in %d out %d ws %zu (need %zu)\n", n_in, out_size, ws_size, (size_t)WS_END); grid = -1; return; }
        int dev = 0, cus = 0, per_cu = 0;
        if (hipGetDevice(&dev) != hipSuccess || hipDeviceGetAttribute(&cus, hipDeviceAttributeMultiprocessorCount, dev) != hipSuccess) { grid = -1; return; }
        if (hipFuncSetAttribute((const void*)fwd_kernel, hipFuncAttributeMaxDynamicSharedMemorySize, LDS_BYTES) != hipSuccess) { fprintf(stderr, "kernel_launch: hipFuncSetAttribute failed\n"); grid = -1; return; }
        if (hipOccupancyMaxActiveBlocksPerMultiprocessor(&per_cu, (const void*)fwd_kernel, NWAVES * 64, LDS_BYTES) != hipSuccess || per_cu < 1) fprintf(stderr, "kernel_launch: occupancy query reports %d\n", per_cu);
        (void)hipGetLastError();
        grid = cus;
    }
    if (grid < 0) return;
    if (hipMemsetAsync((char*)d_ws + WS_CTL, 0, CTL_ZERO_BYTES, stream) != hipSuccess) return;
    Args a{};
    for (int i = 0; i < 26; ++i) a.in[i] = d_in[i];
    a.out = (float*)d_out; a.ws = (unsigned char*)d_ws;
    for (int li = 0; li < N_LAUNCHES; ++li) {
        a.ph_lo = (N_LAUNCHES == 1) ? 0 : li; a.ph_hi = (N_LAUNCHES == 1) ? N_PHASES : li + 1; a.li = li; a.pad = 0;
#if defined(REP_CMPG) || defined(REP_FIN) || defined(REP_LOC) || defined(REP_DECA) || defined(REP_CMPA)
        a.pad = 1;
#endif
        hipLaunchKernelGGL(fwd_kernel, dim3(grid), dim3(NWAVES * 64), LDS_BYTES, stream, a);
        if (hipPeekAtLastError() != hipSuccess) { fprintf(stderr, "kernel_launch: launch %d failed\n", li); break; }
    }
}
```

```cpp
#include <hip/hip_runtime.h>
#include <cstdio>
#include <cstdint>

constexpr int DM = 2048, SEQ = 4096, NB = 2, MPROMPT = NB * SEQ, DECB = 32, PAST = 8192, MROWS = MPROMPT + DECB, MP = 8448;
constexpr int NCOLS_IN = 5184, NIN = 5376;
constexpr int DFF = 8192, CONV_DIM = 1536, DIN = 1024;
constexpr int NCMP_P = 255, NCMP_S = 511, NSLC_P = 64, NSLC_S = 129;
constexpr float NORM_EPS = 1e-5f;
constexpr size_t O_YP = 0, O_YS = O_YP + (size_t)MPROMPT * DM, O_KCP = O_YS + (size_t)DECB * DM, O_KSP = O_KCP + (size_t)MPROMPT * 512, O_KWP = O_KSP + (size_t)MPROMPT * 512,
                 O_CVP = O_KWP + (size_t)NB * 512 * 512, O_SSP = O_CVP + (size_t)NB * 3 * CONV_DIM, O_KCS = O_SSP + (size_t)NB * 16 * 64 * 128, O_KSS = O_KCS + (size_t)DECB * 512,
                 O_KWS = O_KSS + (size_t)DECB * 512, O_CVS = O_KWS + (size_t)DECB * 512 * 512, O_SSS = O_CVS + (size_t)DECB * 3 * CONV_DIM, O_END = O_SSS + (size_t)DECB * 16 * 64 * 128;
static_assert(O_END == 38790144, "d_out size");
namespace pg8 {
#define PG8_LAS __attribute__((address_space(3)))
typedef unsigned short bf16_t;
typedef short bf16x8 __attribute__((ext_vector_type(8)));
typedef float f32x4 __attribute__((ext_vector_type(4)));
typedef unsigned u32x4 __attribute__((ext_vector_type(4)));
constexpr int BM = 256, BK = 64, HALF = 128, HTB = HALF * BK * 2  , STAGE_BYTES = 8 * HTB, NXCD = 8, WGM = 8;

__host__ __device__ __forceinline__ int lds_byte(int r, int c) { const int st = (r >> 4) * 2 + (c >> 5), rr = r & 15, cc = c & 31, ob = rr * 64 + cc * 2; return st * 1024 + (ob ^ (((ob >> 9) & 1) << 5)); }
__host__ __device__ __forceinline__ void stage_rc(int b, int& R, int& C) { const int st = b / 1024, sb = b % 1024, swz = sb ^ (((sb >> 9) & 1) << 5); R = (st >> 1) * 16 + swz / 64; C = (st & 1) * 32 + (swz % 64) / 2; }
__host__ __device__ __forceinline__ int perm32(int rho) { const int n = rho >> 4, i = rho & 15; return 8 * (i >> 2) + 4 * n + (i & 3); }

struct Unit { int pm, pn; };
struct Gemm { const bf16_t* A; const bf16_t* Bt; int M, N, K; };

struct StaticOrder {
    int nM, nN, nwg, G, c;
    __host__ __device__ void init(int M, int N, int G_, int c_) { nM = M / BM; nN = N / BM; nwg = nM * nN; G = G_; c = c_; }
    __host__ __device__ bool next(int i, Unit& u) const {
        const long L = (long)i * G + c; if (L >= nwg) return false;
        int wgid = (int)L; { const int q = nwg / NXCD, r = nwg % NXCD, xcd = wgid % NXCD, off = wgid / NXCD; wgid = (xcd < r ? xcd * (q + 1) : r * (q + 1) + (xcd - r) * q) + off; }
        const int nig = WGM * nN, gid = wgid / nig, fm = gid * WGM, gsz = (nM - fm) < WGM ? (nM - fm) : WGM;
        u.pm = fm + ((wgid % nig) % gsz); u.pn = (wgid % nig) / gsz; return true;
    }
    __device__ __forceinline__ void a_ready(const Unit&) const {}
    __device__ __forceinline__ void done(const Unit&) const {}
};

__device__ __forceinline__ unsigned cvt_pk_bf16(float lo, float hi) { unsigned r; asm volatile("v_cvt_pk_bf16_f32 %0, %1, %2" : "=v"(r) : "v"(lo), "v"(hi)); return r; }
typedef float f32x2 __attribute__((ext_vector_type(2)));
__device__ __forceinline__ void st_bf16x4(bf16_t* p, const f32x4 v) { typedef unsigned u32x2v __attribute__((ext_vector_type(2))); u32x2v w; w.x = cvt_pk_bf16(v[0], v[1]); w.y = cvt_pk_bf16(v[2], v[3]); *(u32x2v*)p = w; }
__device__ __forceinline__ float sigmoidf_(float x) { return 1.0f / (1.0f + __expf(-x)); }
struct EpiInProj {
    static constexpr bool PERM = false, AFTER_DRAIN = false;
    bf16_t *QB, *KVB; size_t kvstride; float *Z, *XBC, *GD, *out;
    __device__ __forceinline__ void operator()(const f32x4 (&acc)[2][2][4][2], const Unit& u, int wr, int wc, int fr, int fq) const {
        const int pn = u.pn, rbase = u.pm * BM + wr * 64 + fr, cl = wc * 32 + 4 * fq;
        if (pn < 4) {
#pragma unroll
            for (int ai = 0; ai < 2; ++ai)
#pragma unroll
                for (int m = 0; m < 4; ++m) { const int row = rbase + ai * HALF + m * 16; if (row < MROWS) { bf16_t* p = QB + (size_t)row * 1024 + pn * 256 + cl;
#pragma unroll
                    for (int bj = 0; bj < 2; ++bj)
#pragma unroll
                        for (int n = 0; n < 2; ++n) st_bf16x4(p + bj * HALF + n * 16, acc[ai][bj][m][n]); } }
        } else if (pn < 10) {
            const int which = (pn - 4) >> 1, cb = ((pn - 4) & 1) * 256 + cl; bf16_t* B = KVB + (size_t)which * kvstride;
#pragma unroll
            for (int ai = 0; ai < 2; ++ai)
#pragma unroll
                for (int m = 0; m < 4; ++m) { const int row = rbase + ai * HALF + m * 16; if (row < MROWS) {
                    float* fo = nullptr;
                    if (row < MPROMPT) { if (which == 0) fo = out + O_KCP + (size_t)row * 512; else if (which == 1) fo = out + O_KSP + (size_t)row * 512; else { const int t = row & (SEQ - 1); if (t >= SEQ - 512) fo = out + O_KWP + (size_t)((row >> 12) * 512 + t - (SEQ - 512)) * 512; } }
                    else { const int s = row - MPROMPT; fo = which == 0 ? out + O_KCS + (size_t)s * 512 : (which == 1 ? out + O_KSS + (size_t)s * 512 : out + O_KWS + (size_t)(s * 512 + 511) * 512); }
                    bf16_t* p = B + (size_t)row * 512 + cb;
#pragma unroll
                    for (int bj = 0; bj < 2; ++bj)
#pragma unroll
                        for (int n = 0; n < 2; ++n) { const f32x4 v = acc[ai][bj][m][n]; st_bf16x4(p + bj * HALF + n * 16, v); if (fo) *(f32x4*)(fo + cb + bj * HALF + n * 16) = v; } } }
        } else if (pn < 20) {
            float* base = pn < 14 ? Z : XBC; const int ld = pn < 14 ? 1024 : CONV_DIM, cb = (pn < 14 ? (pn - 10) : (pn - 14)) * 256 + cl;
#pragma unroll
            for (int ai = 0; ai < 2; ++ai)
#pragma unroll
                for (int m = 0; m < 4; ++m) { const int row = rbase + ai * HALF + m * 16; if (row < MROWS) { float* p = base + (size_t)row * ld + cb;
#pragma unroll
                    for (int bj = 0; bj < 2; ++bj)
#pragma unroll
                        for (int n = 0; n < 2; ++n) *(f32x4*)(p + bj * HALF + n * 16) = acc[ai][bj][m][n]; } }
        } else {
#pragma unroll
            for (int ai = 0; ai < 2; ++ai)
#pragma unroll
                for (int m = 0; m < 4; ++m) { const int row = rbase + ai * HALF + m * 16; if (row < MROWS) {
#pragma unroll
                    for (int n = 0; n < 2; ++n) { const int col = cl + n * 16; if (col < 64) { f32x4 v = acc[ai][0][m][n]; if (col < 48) { v[0] = sigmoidf_(v[0]); v[1] = sigmoidf_(v[1]); v[2] = sigmoidf_(v[2]); v[3] = sigmoidf_(v[3]); } *(f32x4*)(GD + (size_t)row * 64 + col) = v; } } } }
        }
    }
};
struct EpiResid {
    static constexpr bool PERM = false, AFTER_DRAIN = false;
    const float* xp; const float* xs; int ldx; float* X1; bf16_t* X1B; float* SS;
    __device__ __forceinline__ void operator()(const f32x4 (&acc)[2][2][4][2], const Unit& u, int wr, int wc, int fr, int fq) const {
        const int pn = u.pn, rbase = u.pm * BM + wr * 64 + fr, cb = pn * 256 + wc * 32 + 4 * fq;
#pragma unroll
        for (int ai = 0; ai < 2; ++ai) {
            f32x4 pre[4][2][2];
#pragma unroll
            for (int m = 0; m < 4; ++m) { const int row = rbase + ai * HALF + m * 16; const float* xr = row < MPROMPT ? xp + (size_t)row * ldx : xs + (size_t)(row - MPROMPT) * ldx;
#pragma unroll
                for (int bj = 0; bj < 2; ++bj)
#pragma unroll
                    for (int n = 0; n < 2; ++n) pre[m][bj][n] = row < MROWS ? *(const f32x4*)(xr + cb + bj * HALF + n * 16) : (f32x4){0.f, 0.f, 0.f, 0.f}; }
            asm volatile("" ::: "memory");
#pragma unroll
            for (int m = 0; m < 4; ++m) { const int row = rbase + ai * HALF + m * 16; const bool ok = row < MROWS; float ss = 0.f;
#pragma unroll
                for (int bj = 0; bj < 2; ++bj)
#pragma unroll
                    for (int n = 0; n < 2; ++n) { const int col = cb + bj * HALF + n * 16; const f32x4 v = acc[ai][bj][m][n] + pre[m][bj][n];
                        if (ok) { *(f32x4*)(X1 + (size_t)row * DM + col) = v; if (X1B) st_bf16x4(X1B + (size_t)row * DM + col, v); }
                        ss += (v[0] * v[0] + v[1] * v[1]) + (v[2] * v[2] + v[3] * v[3]); }
                ss += __shfl_xor(ss, 16); ss += __shfl_xor(ss, 32);
                if (ok && fq == 0) SS[(size_t)row * 32 + pn * 4 + wc] = ss; }
        }
    }
};
struct EpiUp {
    static constexpr bool PERM = false, AFTER_DRAIN = false;
    bf16_t* H; const float* SS;
    __device__ __forceinline__ void operator()(const f32x4 (&acc)[2][2][4][2], const Unit& u, int wr, int wc, int fr, int fq) const {
        const int pn = u.pn, rbase = u.pm * BM + wr * 64 + fr, cb = pn * 256 + wc * 32 + 4 * fq;
#pragma unroll
        for (int ai = 0; ai < 2; ++ai)
#pragma unroll
            for (int m = 0; m < 4; ++m) { const int row = rbase + ai * HALF + m * 16; const bool ok = row < MROWS;
                float t = 0.f; if (ok) { const f32x4 a = *(const f32x4*)(SS + (size_t)row * 32 + fq * 8), b = *(const f32x4*)(SS + (size_t)row * 32 + fq * 8 + 4); t = ((a[0] + a[1]) + (a[2] + a[3])) + ((b[0] + b[1]) + (b[2] + b[3])); }
                t += __shfl_xor(t, 16); t += __shfl_xor(t, 32);
                const float rstd = 1.0f / sqrtf(t * (1.0f / DM) + NORM_EPS);
                if (ok) { bf16_t* p = H + (size_t)row * DFF + cb;
#pragma unroll
                    for (int bj = 0; bj < 2; ++bj)
#pragma unroll
                        for (int n = 0; n < 2; ++n) { f32x4 v = acc[ai][bj][m][n] * rstd; v[0] = fmaxf(v[0], 0.f); v[1] = fmaxf(v[1], 0.f); v[2] = fmaxf(v[2], 0.f); v[3] = fmaxf(v[3], 0.f); v = v * v; st_bf16x4(p + bj * HALF + n * 16, v); } } }
    }
};
template <class Epi, class Sched, bool ALIGN_EPI = false, bool SP2 = false>
__device__ __forceinline__ void gemm_phase(PG8_LAS unsigned char* lds, const Gemm g, const Sched& S, const Epi& E) {
    const int tid = threadIdx.x, wid = __builtin_amdgcn_readfirstlane(tid >> 6), lane = tid & 63, wr = wid >> 2, wc = wid & 3, fr = lane & 15, fq = lane >> 4;
    const int K = g.K, nt = K / BK;
    unsigned voffA[2], voffB[2];
#pragma unroll
    for (int i = 0; i < 2; ++i) { int R, C; stage_rc(tid * 16 + i * 8192, R, C); const int Rb = Epi::PERM ? ((R & ~31) + perm32(R & 31)) : R;
        voffA[i] = (unsigned)(R * K + C) * 2u; voffB[i] = (unsigned)(Rb * K + C) * 2u; }
    const size_t kstep = (size_t)(BK * 2);
    const size_t hstep = (size_t)HALF * K * 2;
    const size_t tstep = 2 * hstep;
    const unsigned ldsw = (unsigned)wid * 1024u;
    const int aoff = lds_byte(wr * 64 + fr, fq * 8), boff = lds_byte(wc * 32 + fr, fq * 8);
#define PG8_SA(b, h) (((b) * 2 + (h)) * HTB)
#define PG8_SB(b, h) ((4 + (b) * 2 + (h)) * HTB)
#define PG8_STAGE(bufoff, gbase, voff) do { _Pragma("unroll") for (int _i = 0; _i < 2; ++_i) \
        __builtin_amdgcn_global_load_lds((const unsigned*)((const char*)(gbase) + (voff)[_i]), (PG8_LAS unsigned*)(lds + (bufoff) + ldsw + _i * 8192), 16, 0, 0); } while (0)
#define PG8_LDA(dst, b, h) do { _Pragma("unroll") for (int m = 0; m < 4; ++m) _Pragma("unroll") for (int k = 0; k < 2; ++k) dst[m][k] = *(const PG8_LAS bf16x8*)(lds + PG8_SA(b, h) + aoff + m * 2048 + k * 1024); } while (0)
#define PG8_LDB(dst, b, h) do { _Pragma("unroll") for (int n = 0; n < 2; ++n) _Pragma("unroll") for (int k = 0; k < 2; ++k) dst[n][k] = *(const PG8_LAS bf16x8*)(lds + PG8_SB(b, h) + boff + n * 2048 + k * 1024); } while (0)
#define PG8_MMA(ai, bj, At, Bt) do { __builtin_amdgcn_s_setprio(1); _Pragma("unroll") for (int m = 0; m < 4; ++m) _Pragma("unroll") for (int n = 0; n < 2; ++n) _Pragma("unroll") for (int k = 0; k < 2; ++k) \
        acc[ai][bj][m][n] = __builtin_amdgcn_mfma_f32_16x16x32_bf16(Bt[n][k], At[m][k], acc[ai][bj][m][n], 0, 0, 0); __builtin_amdgcn_s_setprio(0); } while (0)
#define PG8_WAIT_V(n) asm volatile("s_waitcnt vmcnt(" #n ")" ::: "memory")
#define PG8_WAIT_L(n) asm volatile("s_waitcnt lgkmcnt(" #n ")" ::: "memory")
#define PG8_BAR __builtin_amdgcn_s_barrier()
#define PG8_SCHED __builtin_amdgcn_sched_barrier(0)
    Unit cur, nxt; int ui = 0;
    if (!S.next(0, cur)) return;
    f32x4 acc[2][2][4][2];
#pragma unroll
    for (int a = 0; a < 2; ++a)
#pragma unroll
        for (int b = 0; b < 2; ++b)
#pragma unroll
            for (int m = 0; m < 4; ++m)
#pragma unroll
                for (int n = 0; n < 2; ++n) acc[a][b][m][n] = (f32x4){0.f, 0.f, 0.f, 0.f};
    bf16x8 At[4][2], B0[2][2], B1[2][2];
    const char* cA = (const char*)g.A + (size_t)cur.pm * tstep; const char* cB = (const char*)g.Bt + (size_t)cur.pn * tstep;
    S.a_ready(cur);
    if constexpr (SP2) {
        PG8_STAGE(PG8_SB(0, 0), cB, voffB); PG8_STAGE(PG8_SB(0, 1), cB + hstep, voffB); PG8_STAGE(PG8_SA(0, 0), cA, voffA); PG8_STAGE(PG8_SA(0, 1), cA + hstep, voffA);
        if (wr == 1) PG8_BAR;
        PG8_WAIT_V(2); PG8_BAR;
        PG8_STAGE(PG8_SB(1, 0), cB + kstep, voffB); PG8_STAGE(PG8_SA(1, 0), cA + kstep, voffA); PG8_STAGE(PG8_SB(1, 1), cB + hstep + kstep, voffB);
        PG8_WAIT_V(6); PG8_BAR;
    } else {
        PG8_STAGE(PG8_SB(0, 0), cB, voffB); PG8_STAGE(PG8_SA(0, 0), cA, voffA); PG8_STAGE(PG8_SB(0, 1), cB + hstep, voffB); PG8_STAGE(PG8_SA(0, 1), cA + hstep, voffA);
        if (wr == 1) PG8_BAR;
        PG8_WAIT_V(4); PG8_BAR;
        PG8_STAGE(PG8_SB(1, 0), cB + kstep, voffB); PG8_STAGE(PG8_SA(1, 0), cA + kstep, voffA); PG8_STAGE(PG8_SB(1, 1), cB + hstep + kstep, voffB);
        PG8_WAIT_V(6); PG8_BAR;
    }
    for (;;) {
        const bool has_next = S.next(ui + 1, nxt);
        const char* nA = has_next ? (const char*)g.A + (size_t)nxt.pm * tstep : cA; const char* nB = has_next ? (const char*)g.Bt + (size_t)nxt.pn * tstep : cB;
        for (int t = 0; t < nt; t += 2) {
            const bool last = (t == nt - 2);
            const char* a1 = cA + (size_t)(t + 1) * kstep;
            const char* a2 = last ? nA : cA + (size_t)(t + 2) * kstep; const char* b2 = last ? nB : cB + (size_t)(t + 2) * kstep;
            const char* a3 = a2 + kstep; const char* b3 = b2 + kstep;
            if (last && has_next) S.a_ready(nxt);
            if constexpr (SP2) {
            PG8_LDB(B0, 0, 0); PG8_LDB(B1, 0, 1); PG8_SCHED; PG8_LDA(At, 0, 0); PG8_STAGE(PG8_SA(1, 1), a1 + hstep, voffA);
            PG8_WAIT_V(8); PG8_WAIT_L(0); PG8_BAR; PG8_MMA(0, 0, At, B0); PG8_MMA(0, 1, At, B1); PG8_BAR; PG8_SCHED;
            PG8_LDA(At, 0, 1); PG8_STAGE(PG8_SB(0, 0), b2, voffB); PG8_STAGE(PG8_SB(0, 1), b2 + hstep, voffB); PG8_STAGE(PG8_SA(0, 0), a2, voffA);
            PG8_WAIT_V(8); PG8_WAIT_L(0); PG8_BAR; PG8_MMA(1, 0, At, B0); PG8_MMA(1, 1, At, B1); PG8_BAR; PG8_SCHED;
            PG8_LDB(B0, 1, 0); PG8_LDB(B1, 1, 1); PG8_SCHED; PG8_LDA(At, 1, 0); PG8_STAGE(PG8_SA(0, 1), a2 + hstep, voffA);
            PG8_WAIT_V(8); PG8_WAIT_L(0); PG8_BAR; PG8_MMA(0, 0, At, B0); PG8_MMA(0, 1, At, B1); PG8_BAR; PG8_SCHED;
            PG8_LDA(At, 1, 1); PG8_STAGE(PG8_SB(1, 0), b3, voffB); PG8_STAGE(PG8_SB(1, 1), b3 + hstep, voffB); PG8_STAGE(PG8_SA(1, 0), a3, voffA);
            PG8_WAIT_V(8); PG8_WAIT_L(0); PG8_BAR; PG8_MMA(1, 0, At, B0); PG8_MMA(1, 1, At, B1); PG8_BAR; PG8_SCHED;
            } else {
            PG8_LDB(B0, 0, 0); PG8_SCHED; PG8_LDA(At, 0, 0); PG8_STAGE(PG8_SA(1, 1), a1 + hstep, voffA);
            PG8_WAIT_L(8); PG8_BAR; PG8_WAIT_L(0); PG8_MMA(0, 0, At, B0); PG8_BAR; PG8_SCHED;
            PG8_LDB(B1, 0, 1); PG8_STAGE(PG8_SB(0, 0), b2, voffB);
            PG8_BAR; PG8_WAIT_L(0); PG8_MMA(0, 1, At, B1); PG8_BAR;
            PG8_LDA(At, 0, 1); PG8_STAGE(PG8_SA(0, 0), a2, voffA);
            PG8_BAR; PG8_WAIT_L(0); PG8_MMA(1, 0, At, B0); PG8_BAR; PG8_SCHED;
            PG8_STAGE(PG8_SB(0, 1), b2 + hstep, voffB);
            PG8_WAIT_V(6); PG8_BAR; PG8_MMA(1, 1, At, B1); PG8_BAR;
            PG8_LDB(B0, 1, 0); PG8_SCHED; PG8_LDA(At, 1, 0); PG8_STAGE(PG8_SA(0, 1), a2 + hstep, voffA);
            PG8_WAIT_L(8); PG8_BAR; PG8_WAIT_L(0); PG8_MMA(0, 0, At, B0); PG8_BAR; PG8_SCHED;
            PG8_LDB(B1, 1, 1); PG8_STAGE(PG8_SB(1, 0), b3, voffB);
            PG8_BAR; PG8_WAIT_L(0); PG8_MMA(0, 1, At, B1); PG8_BAR;
            PG8_LDA(At, 1, 1); PG8_STAGE(PG8_SA(1, 0), a3, voffA);
            PG8_BAR; PG8_WAIT_L(0); PG8_MMA(1, 0, At, B0); PG8_BAR; PG8_SCHED;
            PG8_STAGE(PG8_SB(1, 1), b3 + hstep, voffB);
            PG8_WAIT_V(6); PG8_BAR; PG8_MMA(1, 1, At, B1); PG8_BAR;
            }
        }
        if constexpr (ALIGN_EPI) { if (wr == 0) PG8_BAR; }
        if constexpr (!Epi::AFTER_DRAIN) { E(acc, cur, wr, wc, fr, fq); S.done(cur); }
        if (!has_next) break;
#pragma unroll
        for (int a = 0; a < 2; ++a)
#pragma unroll
            for (int b = 0; b < 2; ++b)
#pragma unroll
                for (int m = 0; m < 4; ++m)
#pragma unroll
                    for (int n = 0; n < 2; ++n) acc[a][b][m][n] = (f32x4){0.f, 0.f, 0.f, 0.f};
        cur = nxt; cA = nA; cB = nB; ++ui;
        if constexpr (ALIGN_EPI) { if (wr == 1) PG8_BAR; }
    }
    PG8_WAIT_V(0);
    if constexpr (!ALIGN_EPI) { if (wr == 0) PG8_BAR; }
    PG8_BAR;
    if constexpr (Epi::AFTER_DRAIN) { E.fused(acc, cur, wr, wc, fr, fq, lds, wid, lane); S.done(cur); }
#undef PG8_SA
#undef PG8_SB
#undef PG8_STAGE
#undef PG8_LDA
#undef PG8_LDB
#undef PG8_MMA
#undef PG8_WAIT_V
#undef PG8_WAIT_L
#undef PG8_BAR
#undef PG8_SCHED
}
}
#define GAS __attribute__((address_space(1)))
#define LAS __attribute__((address_space(3)))
typedef unsigned short bf16;
typedef unsigned v4u __attribute__((ext_vector_type(4)));
typedef float f32x4 __attribute__((ext_vector_type(4)));
typedef short bf16x8 __attribute__((ext_vector_type(8)));
typedef GAS unsigned gu32;
typedef GAS unsigned long long gu64;
#define RLX_AGENT __ATOMIC_RELAXED, __HIP_MEMORY_SCOPE_AGENT
#define LDS_WAIT() asm volatile("s_waitcnt lgkmcnt(0)" ::: "memory")
#define VM_WAIT() asm volatile("s_waitcnt vmcnt(0)" ::: "memory")
__device__ __forceinline__ unsigned long long rt() { return __builtin_amdgcn_s_memrealtime(); }
__device__ __forceinline__ unsigned f2bf(float f) { unsigned u = __builtin_bit_cast(unsigned, f); return (u + 0x7fffu + ((u >> 16) & 1u)) >> 16; }
__device__ __forceinline__ unsigned pk2(float lo, float hi) { return f2bf(lo) | (f2bf(hi) << 16); }

#define XB_TMO      128
#define XB_XCNT(j)  (256  + 64 * (j))
#define XB_XSUB(j)  (1280 + 64 * (j))
#define XB_XGEN(j)  (2304 + 64 * (j))
#define XB_TOP      3328
#define XB_TOPGEN   3392
#define XCD_BAR_WORDS 3456
#define XB_SPIN_CAP (1u << 18)

__device__ __forceinline__ unsigned xb_ld(unsigned* p)              { return __hip_atomic_load(p, __ATOMIC_RELAXED, __HIP_MEMORY_SCOPE_AGENT); }
__device__ __forceinline__ unsigned xb_add(unsigned* p, unsigned v) { return __hip_atomic_fetch_add(p, v, __ATOMIC_RELAXED, __HIP_MEMORY_SCOPE_AGENT); }
__device__ __forceinline__ unsigned xb_xcc_id() { return (unsigned)__builtin_amdgcn_s_getreg((3 << 11) | 20) & 0xFu; }
#define XB_SPIN(cond, bar) do { unsigned _sp = 0; while (cond) { __builtin_amdgcn_s_sleep(1); \
    if ((++_sp & 255u) == 0u) { if (xb_ld(&(bar)[XB_TMO])) break; if (_sp > XB_SPIN_CAP) { atomicAdd(&(bar)[XB_TMO], 1u); break; } } } } while (0)

struct XcdBarrier {
    unsigned* bar; unsigned x;
    volatile LAS unsigned* st;
};

__device__ __forceinline__ XcdBarrier xcd_barrier_post(unsigned* bar, volatile LAS unsigned* st) {
    XcdBarrier b; b.bar = bar; b.x = xb_xcc_id(); b.st = st;
    if (threadIdx.x == 0) (void)xb_add(&bar[XB_XCNT(b.x)], 1u);
    return b;
}
__device__ __forceinline__ void xcd_barrier_complete(unsigned* bar, unsigned x, unsigned& nloc, unsigned& nx) {
    const unsigned G = gridDim.x * gridDim.y * gridDim.z;
    unsigned sum, cnt, mine, sp = 0u;
    for (;;) {
        sum = 0u; cnt = 0u; mine = 0u;
#pragma unroll
        for (unsigned j = 0; j < 16; ++j) { const unsigned c = xb_ld(&bar[XB_XCNT(j)]); sum += c; cnt += (c > 0u) ? 1u : 0u; mine = (j == x) ? c : mine; }
        if (sum == G) break;
        __builtin_amdgcn_s_sleep(1);
        if ((++sp & 255u) == 0u) { if (xb_ld(&bar[XB_TMO])) break; if (sp > XB_SPIN_CAP) { atomicAdd(&bar[XB_TMO], 1u); break; } }
    }
    nloc = mine > 0u ? mine : 1u; nx = cnt > 0u ? cnt : 1u;
}

__device__ __forceinline__ void xcd_barrier(const XcdBarrier& b) {
    asm volatile("s_waitcnt vmcnt(0)" ::: "memory");
    __syncthreads();
    if (threadIdx.x == 0) {
        unsigned* bar = b.bar;
        __builtin_amdgcn_s_waitcnt(0);
        unsigned nloc = b.st[0], nx = b.st[1];
        if (nloc == 0u) { xcd_barrier_complete(bar, b.x, nloc, nx); b.st[0] = nloc; b.st[1] = nx; }
        const unsigned old = xb_add(&bar[XB_XSUB(b.x)], 1u);
        const unsigned gen = old / nloc;
        if (old + 1u == (gen + 1u) * nloc) {
            __builtin_amdgcn_fence(__ATOMIC_RELEASE, "agent");
            asm volatile("s_waitcnt vmcnt(0)" ::: "memory");
            const unsigned og = xb_add(&bar[XB_TOP], 1u);
            const unsigned tg = og / nx;
            if (og + 1u == (tg + 1u) * nx) xb_add(&bar[XB_TOPGEN], 1u);
            else XB_SPIN(xb_ld(&bar[XB_TOPGEN]) == tg, bar);
            __builtin_amdgcn_fence(__ATOMIC_ACQUIRE, "agent");
            xb_add(&bar[XB_XGEN(b.x)], 1u);
            asm volatile("s_waitcnt vmcnt(0)" ::: "memory");
        } else {
            XB_SPIN(xb_ld(&bar[XB_XGEN(b.x)]) == gen, bar);
            __builtin_amdgcn_fence(__ATOMIC_ACQUIRE, "agent");
            asm volatile("s_waitcnt vmcnt(0)" ::: "memory");
        }
    }
    __syncthreads();
}

constexpr int NWAVES = 8;
#ifndef MK_N_LAUNCHES
#define MK_N_LAUNCHES 1
#endif
constexpr int N_PHASES = 10;
constexpr int N_LAUNCHES = MK_N_LAUNCHES;
static_assert(N_LAUNCHES == 1 || N_LAUNCHES == N_PHASES, "MK_N_LAUNCHES is 1 or 10");

constexpr size_t MiB = 1u << 20;
constexpr size_t al(size_t x) { return (x + MiB - 1) / MiB * MiB; }
constexpr size_t WS_CTL = 0, CTL_ZERO_BYTES = 32768;
constexpr size_t WS_WIN = 2 * MiB;
constexpr size_t WS_WOUT = WS_WIN + al((size_t)NIN * DM * 2);
constexpr size_t WS_WUP = WS_WOUT + al((size_t)DM * DM * 2);
constexpr size_t WS_WDN = WS_WUP + al((size_t)DFF * DM * 2);
constexpr size_t WS_XN = WS_WDN + al((size_t)DM * DFF * 2);
constexpr size_t WS_QB = WS_XN + al((size_t)MP * DM * 2);
constexpr size_t WS_KCB = WS_QB + al((size_t)MP * 1024 * 2);
constexpr size_t WS_KSB = WS_KCB + al((size_t)MP * 512 * 2);
constexpr size_t WS_KWB = WS_KSB + al((size_t)MP * 512 * 2);
constexpr size_t WS_Z = WS_KWB + al((size_t)MP * 512 * 2);
constexpr size_t WS_XBC = WS_Z + al((size_t)MP * 1024 * 4);
constexpr size_t WS_GD = WS_XBC + al((size_t)MP * CONV_DIM * 4);
constexpr size_t WS_XBCA = WS_GD + al((size_t)MP * 64 * 4);
constexpr size_t WS_DT = WS_XBCA + al((size_t)MP * CONV_DIM * 4);
constexpr size_t WS_KCMPP = WS_DT + al((size_t)MP * 16 * 4);
constexpr size_t WS_KCMPS = WS_KCMPP + al((size_t)NB * NCMP_P * 512 * 4);
constexpr size_t WS_OWIN = WS_KCMPS + al((size_t)DECB * NCMP_S * 512 * 4);
constexpr size_t WS_OCMP = WS_OWIN + al((size_t)MP * 1024 * 4);
constexpr size_t WS_SELIDX = WS_OCMP + al((size_t)MP * 1024 * 4);
constexpr size_t WS_SELMASK = WS_SELIDX + al((size_t)MP * 64 * 4);
constexpr size_t WS_YSSD = WS_SELMASK + al((size_t)MPROMPT * 4 * 8);
constexpr size_t WS_MIX = WS_YSSD + al((size_t)MP * 1024 * 4);
constexpr size_t WS_X1 = WS_MIX + al((size_t)MP * DM * 2);
constexpr size_t WS_X1B = WS_X1 + al((size_t)MP * DM * 4);
constexpr size_t WS_SS1 = WS_X1B + al((size_t)MP * DM * 2);
constexpr size_t WS_H = WS_SS1 + al((size_t)MP * 32 * 4);
constexpr size_t WS_X2 = WS_H + al((size_t)MP * DFF * 2);
constexpr size_t WS_SS2 = WS_X2 + al((size_t)MP * DM * 4);
constexpr size_t WS_W1T = WS_SS2 + al((size_t)MP * 32 * 4);
constexpr size_t WS_PEB = WS_W1T + al((size_t)2 * 128 * 2048 * 2);
constexpr size_t WS_XBCA16 = WS_PEB + MiB;
constexpr size_t WS_ST = WS_XBCA16 + al((size_t)MP * CONV_DIM * 2);
constexpr size_t WS_DEC = WS_ST + al((size_t)NB * 16 * 16 * 8192 * 4);
constexpr size_t WS_ACS = WS_DEC + MiB;
constexpr size_t WS_SS1S = WS_ACS + al((size_t)MPROMPT * 16 * 4);
constexpr size_t WS_SS2S = WS_SS1S + MiB;
constexpr size_t WS_SIN = WS_SS2S + MiB;
constexpr size_t WS_END = WS_SIN + al((size_t)NB * 16 * 16 * 8192 * 2);
constexpr int CW_TMO = 0, CW_CODE = 1, CW_CHK = 8, CW_BAR = 4096;

constexpr int RING_OFF = 0, RING_BYTES = 155648;
constexpr int LDSCTL_OFF = RING_BYTES, MISC_OFF = LDSCTL_OFF + 320;
constexpr int LDS_BYTES = 156160;
static_assert(MISC_OFF + 128 <= LDS_BYTES, "LDS map");

struct Ctx {
    LAS unsigned char* lds; volatile LAS unsigned* MISC; gu32* ctl;
    int tid, lane, wave, vcu, G;
    const __attribute__((address_space(4))) unsigned long long* ka;
    __device__ __forceinline__ const float* x_prompt() const { return (const float*)ka[0]; }
    __device__ __forceinline__ const float* x_sample() const { return (const float*)ka[1]; }
    __device__ __forceinline__ const float* cache_cmp() const { return (const float*)ka[2]; }
    __device__ __forceinline__ const float* cache_sel() const { return (const float*)ka[3]; }
    __device__ __forceinline__ const float* st_win() const { return (const float*)ka[4]; }
    __device__ __forceinline__ const float* st_conv() const { return (const float*)ka[5]; }
    __device__ __forceinline__ const float* st_ssm() const { return (const float*)ka[6]; }
    __device__ __forceinline__ const int* page_table() const { return (const int*)ka[7]; }
    __device__ __forceinline__ const float* ln_mix() const { return (const float*)ka[8]; }
    __device__ __forceinline__ const float* w_in() const { return (const float*)ka[9]; }
    __device__ __forceinline__ const float* cmp_pe() const { return (const float*)ka[10]; }
    __device__ __forceinline__ const float* cmp_w1() const { return (const float*)ka[11]; }
    __device__ __forceinline__ const float* cmp_b1() const { return (const float*)ka[12]; }
    __device__ __forceinline__ const float* cmp_w2() const { return (const float*)ka[13]; }
    __device__ __forceinline__ const float* cmp_b2() const { return (const float*)ka[14]; }
    __device__ __forceinline__ const float* conv_w() const { return (const float*)ka[15]; }
    __device__ __forceinline__ const float* conv_b() const { return (const float*)ka[16]; }
    __device__ __forceinline__ const float* dt_bias() const { return (const float*)ka[17]; }
    __device__ __forceinline__ const float* a_log() const { return (const float*)ka[18]; }
    __device__ __forceinline__ const float* d_skip() const { return (const float*)ka[19]; }
    __device__ __forceinline__ const float* ssm_norm() const { return (const float*)ka[20]; }
    __device__ __forceinline__ const float* w_out() const { return (const float*)ka[21]; }
    __device__ __forceinline__ const float* ln_mlp() const { return (const float*)ka[22]; }
    __device__ __forceinline__ const float* w_up() const { return (const float*)ka[23]; }
    __device__ __forceinline__ const float* w_down() const { return (const float*)ka[24]; }
    __device__ __forceinline__ const float* ln_final() const { return (const float*)ka[25]; }
    __device__ __forceinline__ float* out() const { return (float*)ka[26]; }
    __device__ __forceinline__ unsigned char* ws() const { return (unsigned char*)ka[27]; }
    __device__ __forceinline__ bf16* WIN() const { return (bf16*)(ws() + WS_WIN); }
    __device__ __forceinline__ bf16* WOUT() const { return (bf16*)(ws() + WS_WOUT); }
    __device__ __forceinline__ bf16* WUP() const { return (bf16*)(ws() + WS_WUP); }
    __device__ __forceinline__ bf16* WDN() const { return (bf16*)(ws() + WS_WDN); }
    __device__ __forceinline__ bf16* XN() const { return (bf16*)(ws() + WS_XN); }
    __device__ __forceinline__ bf16* QB() const { return (bf16*)(ws() + WS_QB); }
    __device__ __forceinline__ bf16* KCB() const { return (bf16*)(ws() + WS_KCB); }
    __device__ __forceinline__ bf16* KSB() const { return (bf16*)(ws() + WS_KSB); }
    __device__ __forceinline__ bf16* KWB() const { return (bf16*)(ws() + WS_KWB); }
    __device__ __forceinline__ bf16* MIX() const { return (bf16*)(ws() + WS_MIX); }
    __device__ __forceinline__ bf16* X1B() const { return (bf16*)(ws() + WS_X1B); }
    __device__ __forceinline__ bf16* H() const { return (bf16*)(ws() + WS_H); }
    __device__ __forceinline__ float* Z() const { return (float*)(ws() + WS_Z); }
    __device__ __forceinline__ float* XBC() const { return (float*)(ws() + WS_XBC); }
    __device__ __forceinline__ float* GD() const { return (float*)(ws() + WS_GD); }
    __device__ __forceinline__ float* XBCA() const { return (float*)(ws() + WS_XBCA); }
    __device__ __forceinline__ float* DT() const { return (float*)(ws() + WS_DT); }
    __device__ __forceinline__ float* KCMPP() const { return (float*)(ws() + WS_KCMPP); }
    __device__ __forceinline__ float* KCMPS() const { return (float*)(ws() + WS_KCMPS); }
    __device__ __forceinline__ float* OWIN() const { return (float*)(ws() + WS_OWIN); }
    __device__ __forceinline__ float* OCMP() const { return (float*)(ws() + WS_OCMP); }
    __device__ __forceinline__ float* YSSD() const { return (float*)(ws() + WS_YSSD); }
    __device__ __forceinline__ float* X1() const { return (float*)(ws() + WS_X1); }
    __device__ __forceinline__ float* SS1() const { return (float*)(ws() + WS_SS1); }
    __device__ __forceinline__ float* X2() const { return (float*)(ws() + WS_X2); }
    __device__ __forceinline__ float* SS2() const { return (float*)(ws() + WS_SS2); }
    __device__ __forceinline__ int* SELIDX() const { return (int*)(ws() + WS_SELIDX); }
    __device__ __forceinline__ unsigned long long* SELMASK() const { return (unsigned long long*)(ws() + WS_SELMASK); }
    __device__ __forceinline__ bf16* W1T() const { return (bf16*)(ws() + WS_W1T); }
    __device__ __forceinline__ float* PEB() const { return (float*)(ws() + WS_PEB); }
    __device__ __forceinline__ bf16* XBCA16() const { return (bf16*)(ws() + WS_XBCA16); }
    __device__ __forceinline__ float* ST() const { return (float*)(ws() + WS_ST); }
    __device__ __forceinline__ float* DEC() const { return (float*)(ws() + WS_DEC); }
    __device__ __forceinline__ float* ACS() const { return (float*)(ws() + WS_ACS); }
    __device__ __forceinline__ float* SS1S() const { return (float*)(ws() + WS_SS1S); }
    __device__ __forceinline__ float* SS2S() const { return (float*)(ws() + WS_SS2S); }
    __device__ __forceinline__ bf16* SIN() const { return (bf16*)(ws() + WS_SIN); }
};
__device__ __forceinline__ float bf2f(bf16 x) { return __uint_as_float((unsigned)x << 16); }
__device__ __forceinline__ float wave_sum(float v) {
#pragma unroll
    for (int o = 1; o < 64; o <<= 1) v += __shfl_xor(v, o);
    return v;
}
__device__ __forceinline__ float wave_max(float v) {
#pragma unroll
    for (int o = 1; o < 64; o <<= 1) v = fmaxf(v, __shfl_xor(v, o));
    return v;
}
__device__ __forceinline__ float wave_reduce_t64(float (&a)[64], int lane) {
#pragma unroll
    for (int i = 0; i < 32; ++i) { const bool up = (lane & 32) != 0; const float keep = up ? a[i + 32] : a[i], send = up ? a[i] : a[i + 32]; a[i] = keep + __shfl_xor(send, 32); }
#pragma unroll
    for (int i = 0; i < 16; ++i) { const bool up = (lane & 16) != 0; const float keep = up ? a[i + 16] : a[i], send = up ? a[i] : a[i + 16]; a[i] = keep + __shfl_xor(send, 16); }
#pragma unroll
    for (int i = 0; i < 8; ++i) { const bool up = (lane & 8) != 0; const float keep = up ? a[i + 8] : a[i], send = up ? a[i] : a[i + 8]; a[i] = keep + __shfl_xor(send, 8); }
#pragma unroll
    for (int i = 0; i < 4; ++i) { const bool up = (lane & 4) != 0; const float keep = up ? a[i + 4] : a[i], send = up ? a[i] : a[i + 4]; a[i] = keep + __shfl_xor(send, 4); }
#pragma unroll
    for (int i = 0; i < 2; ++i) { const bool up = (lane & 2) != 0; const float keep = up ? a[i + 2] : a[i], send = up ? a[i] : a[i + 2]; a[i] = keep + __shfl_xor(send, 2); }
    { const bool up = (lane & 1) != 0; const float keep = up ? a[1] : a[0], send = up ? a[0] : a[1]; a[0] = keep + __shfl_xor(send, 1); }
    return a[0];
}
__device__ __forceinline__ float siluf_(float x) { return x / (1.0f + __expf(-x)); }
__device__ __forceinline__ float rdlane(float v, int l) { return __int_as_float(__builtin_amdgcn_readlane(__float_as_int(v), l)); }

__device__ __forceinline__ int win_oldcol(int n) { return n < 2560 ? n : (n < 5120 ? n + 48 : (n < 5168 ? n - 2560 : (n < NCOLS_IN ? n : -1))); }
template <int MODE  >
__device__ __forceinline__ void p0_transpose_item(const float* W, int K, int Nsrc, int Ndst, bf16* WT, const float* rowscale, LAS float* scr, int item, int lane) {
    const int nblk = Ndst / 32, kb = item / nblk, nb = item % nblk, k0 = 64 * kb, n0 = 32 * nb;
    const int ncol = MODE == 1 ? win_oldcol(n0 + (lane & 31)) : n0 + (lane & 31);
    float tv[32];
#pragma unroll
    for (int i = 0; i < 32; ++i) { const int kk = 2 * i + (lane >> 5); float v = 0.f; if (ncol >= 0) v = W[(size_t)(k0 + kk) * Nsrc + ncol]; tv[i] = v; }
#pragma unroll
    for (int i = 0; i < 32; ++i) { const int kk = 2 * i + (lane >> 5); float v = tv[i]; if (rowscale) v *= rowscale[k0 + kk]; scr[kk * 33 + (lane & 31)] = v; }
    LDS_WAIT(); asm volatile("" ::: "memory");
    const int c = lane & 7;
#pragma unroll
    for (int j = 0; j < 4; ++j) { const int n = (lane >> 3) + 8 * j; const LAS float* s = scr + (8 * c) * 33 + n;
        v4u o; o.x = pk2(s[0 * 33], s[1 * 33]); o.y = pk2(s[2 * 33], s[3 * 33]); o.z = pk2(s[4 * 33], s[5 * 33]); o.w = pk2(s[6 * 33], s[7 * 33]);
        *(GAS v4u*)(WT + (size_t)(n0 + n) * K + k0 + 8 * c) = o; }
    LDS_WAIT(); asm volatile("" ::: "memory");
}
__device__ __forceinline__ void p0_prologue(const Ctx& F) {
    LAS float* scr = (LAS float*)(F.lds + RING_OFF + F.wave * 16384);
    const int gw = F.vcu * NWAVES + F.wave, NGW = F.G * NWAVES;
    constexpr int I_IN = (DM / 64) * (NIN / 32);
    for (int it = gw; it < I_IN; it += NGW) p0_transpose_item<1>(F.w_in(), DM, NCOLS_IN, NIN, F.WIN(), nullptr, scr, it, F.lane);
    for (int it = gw; it < 2 * 128; it += NGW) { const int c = it >> 7; p0_transpose_item<0>(F.cmp_w1() + (size_t)c * 2048 * 128, 2048, 128, 128, F.W1T() + (size_t)c * 128 * 2048, nullptr, scr, it & 127, F.lane); }
    for (int it = gw; it < 64; it += NGW) { const int c = it >> 5, fh = (it >> 4) & 1, kc = it & 15, f = fh * 64 + F.lane; const float* w = F.cmp_w1() + ((size_t)c * 2048 + kc * 128) * 128 + f; const float* pe = F.cmp_pe() + c * 2048 + kc * 128; float acc = 0.f;
#pragma unroll 16
        for (int k = 0; k < 128; ++k) acc += pe[k] * w[(size_t)k * 128];
        F.PEB()[(c * 16 + kc) * 128 + f] = acc; }
    for (int m = gw; m < MP; m += NGW) {
        GAS unsigned long long* o8 = (GAS unsigned long long*)(F.XN() + (size_t)m * DM) + F.lane;
        if (m >= MROWS) { GAS unsigned long long* z8 = (GAS unsigned long long*)(F.MIX() + (size_t)m * DM) + F.lane;
#pragma unroll
            for (int j = 0; j < 8; ++j) { o8[64 * j] = 0ull; z8[64 * j] = 0ull; }
            continue; }
        const float* xrow = m < MPROMPT ? F.x_prompt() + (size_t)m * DM : F.x_sample() + (size_t)(m - MPROMPT) * DM;
        const GAS f32x4* xr = (const GAS f32x4*)xrow + F.lane; const GAS f32x4* wr = (const GAS f32x4*)F.ln_mix() + F.lane;
        f32x4 v[8]; float s = 0.f;
#pragma unroll
        for (int j = 0; j < 8; ++j) { v[j] = xr[64 * j]; s += (v[j].x * v[j].x + v[j].y * v[j].y) + (v[j].z * v[j].z + v[j].w * v[j].w); }
        const float rstd = 1.0f / sqrtf(wave_sum(s) * (1.0f / DM) + NORM_EPS);
#pragma unroll
        for (int j = 0; j < 8; ++j) { const f32x4 w = wr[64 * j]; o8[64 * j] = (unsigned long long)pk2(v[j].x * rstd * w.x, v[j].y * rstd * w.y) | ((unsigned long long)pk2(v[j].z * rstd * w.z, v[j].w * rstd * w.w) << 32); }
    }
}
constexpr int W_ITEMS = (DM / 64) * (DM / 32) + (DM / 64) * (DFF / 32) + (DFF / 64) * (DM / 32), W_ITEMS_P1 = 7680;
__device__ __forceinline__ void weight_items(const Ctx& F, int it0, int it1, int wv, int nw) {
    LAS float* scr = (LAS float*)(F.lds + RING_OFF + F.wave * 16384);
    constexpr int I_OUT = (DM / 64) * (DM / 32), I_UP = (DM / 64) * (DFF / 32);
    for (int it = it0 + wv; it < it1; it += nw) {
        int r = it;
        if (r < I_OUT) { p0_transpose_item<0>(F.w_out(), DM, DM, DM, F.WOUT(), nullptr, scr, r, F.lane); continue; } r -= I_OUT;
        if (r < I_UP) { p0_transpose_item<0>(F.w_up(), DM, DFF, DFF, F.WUP(), F.ln_mlp(), scr, r, F.lane); continue; } r -= I_UP;
        p0_transpose_item<0>(F.w_down(), DFF, DM, DM, F.WDN(), nullptr, scr, r, F.lane);
    }
}
__device__ __forceinline__ void winbuf_copy(const Ctx& F) {
    { const int gt = F.vcu * (NWAVES * 64) + F.tid, NGT = F.G * NWAVES * 64; constexpr int TOT = DECB * 511 * 128;
      for (int i = gt; i < TOT; i += NGT) { const int b = i / (511 * 128), r = i % (511 * 128), row = r >> 7, c4 = r & 127;
          *(f32x4*)(F.out() + O_KWS + ((size_t)(b * 512 + row) * 512) + c4 * 4) = *(const f32x4*)(F.st_win() + ((size_t)(b * 512 + row + 1) * 512) + c4 * 4); } }
}

struct KeyRef { const void* k; const void* v; int f32; int valid; };
template <int NCH, class KF>
__device__ __forceinline__ void naive_attn2(const bf16* q2, const KF& kf, LAS float* qs, LAS float* sc, LAS float* ps, bool use_ps, int lane, float& o0, float& o1) {
    qs[lane] = bf2f(q2[lane]) * 0.125f; qs[64 + lane] = bf2f(q2[64 + lane]) * 0.125f;
    for (int c = 0; c < NCH; ++c) {
        const KeyRef kr = kf(c, lane);
        float s0 = -INFINITY, s1 = -INFINITY;
        if (kr.valid) {
            float k[64];
            if (kr.f32) { const f32x4* p = (const f32x4*)kr.k;
#pragma unroll
                for (int i = 0; i < 16; ++i) { const f32x4 t = p[i]; k[4 * i] = t.x; k[4 * i + 1] = t.y; k[4 * i + 2] = t.z; k[4 * i + 3] = t.w; } }
            else { const v4u* p = (const v4u*)kr.k;
#pragma unroll
                for (int i = 0; i < 8; ++i) { const v4u t = p[i]; k[8 * i] = __uint_as_float(t.x << 16); k[8 * i + 1] = __uint_as_float(t.x & 0xffff0000u); k[8 * i + 2] = __uint_as_float(t.y << 16); k[8 * i + 3] = __uint_as_float(t.y & 0xffff0000u);
                    k[8 * i + 4] = __uint_as_float(t.z << 16); k[8 * i + 5] = __uint_as_float(t.z & 0xffff0000u); k[8 * i + 6] = __uint_as_float(t.w << 16); k[8 * i + 7] = __uint_as_float(t.w & 0xffff0000u); } }
            s0 = 0.f; s1 = 0.f;
#pragma unroll
            for (int d = 0; d < 64; ++d) { s0 += qs[d] * k[d]; s1 += qs[64 + d] * k[d]; }
        }
        sc[c * 64 + lane] = s0; sc[NCH * 64 + c * 64 + lane] = s1;
    }
#pragma unroll
    for (int hh = 0; hh < 2; ++hh) { LAS float* s = sc + hh * NCH * 64; float m = -INFINITY;
        for (int c = 0; c < NCH; ++c) m = fmaxf(m, s[c * 64 + lane]);
        m = wave_max(m); if (m == -INFINITY) m = 0.f;
        float sum = 0.f;
        for (int c = 0; c < NCH; ++c) { const float e = __expf(s[c * 64 + lane] - m); s[c * 64 + lane] = e; sum += e; }
        sum = wave_sum(sum); const float inv = 1.0f / fmaxf(sum, 1e-30f);
        for (int c = 0; c < NCH; ++c) { const float p = s[c * 64 + lane] * inv; s[c * 64 + lane] = p; if (use_ps) ps[1 + c * 64 + lane] += p; } }
    o0 = 0.f; o1 = 0.f;
#pragma unroll
    for (int hh = 0; hh < 2; ++hh) {
        float a0[64];
#pragma unroll
        for (int d = 0; d < 64; ++d) a0[d] = 0.f;
        for (int c = 0; c < NCH; ++c) {
            const KeyRef kr = kf(c, lane);
            if (kr.valid) {
                const float p0 = sc[hh * NCH * 64 + c * 64 + lane];
                if (kr.f32) { const f32x4* p = (const f32x4*)kr.v;
#pragma unroll
                    for (int i = 0; i < 16; ++i) { const f32x4 t = p[i]; a0[4 * i] += p0 * t.x; a0[4 * i + 1] += p0 * t.y; a0[4 * i + 2] += p0 * t.z; a0[4 * i + 3] += p0 * t.w; } }
                else { const v4u* p = (const v4u*)kr.v;
#pragma unroll
                    for (int i = 0; i < 8; ++i) { const v4u t = p[i]; a0[8 * i] += p0 * __uint_as_float(t.x << 16); a0[8 * i + 1] += p0 * __uint_as_float(t.x & 0xffff0000u); a0[8 * i + 2] += p0 * __uint_as_float(t.y << 16); a0[8 * i + 3] += p0 * __uint_as_float(t.y & 0xffff0000u);
                        a0[8 * i + 4] += p0 * __uint_as_float(t.z << 16); a0[8 * i + 5] += p0 * __uint_as_float(t.z & 0xffff0000u); a0[8 * i + 6] += p0 * __uint_as_float(t.w << 16); a0[8 * i + 7] += p0 * __uint_as_float(t.w & 0xffff0000u); } }
            }
        }
        const float s0 = wave_reduce_t64(a0, lane); if (hh == 0) o0 = s0; else o1 = s0;
    }
}
struct CmpKeys { const float* base; int g, ncmp, qpos;
    __device__ __forceinline__ KeyRef operator()(int c, int l) const { const int n = c * 64 + l; KeyRef r; r.valid = (n < ncmp) && (16 * n + 31 <= qpos); r.f32 = 1; r.k = base + (size_t)(r.valid ? n : 0) * 512 + g * 64; r.v = (const float*)r.k + 256; return r; } };
struct WinKeysP { const bf16* kw; int g, t;
    __device__ __forceinline__ KeyRef operator()(int c, int l) const { const int pos = t - 511 + c * 64 + l; KeyRef r; r.valid = pos >= 0; r.f32 = 0; r.k = kw + (size_t)(r.valid ? pos : 0) * 512 + g * 64; r.v = (const bf16*)r.k + 256; return r; } };
struct WinKeysS { const float* st; const bf16* nw; int g;
    __device__ __forceinline__ KeyRef operator()(int c, int l) const { const int i = 1 + c * 64 + l; KeyRef r; r.valid = 1;
        if (i < 512) { r.f32 = 1; r.k = st + (size_t)i * 512 + g * 64; r.v = (const float*)r.k + 256; } else { r.f32 = 0; r.k = nw + g * 64; r.v = nw + 256 + g * 64; } return r; } };
struct SelKeysP { const int* idx; const bf16* ks; int g, qpos;
    __device__ __forceinline__ KeyRef operator()(int c, int l) const { const int pos = idx[c] * 64 + l; KeyRef r; r.valid = pos <= qpos; r.f32 = 0; r.k = ks + (size_t)(r.valid ? pos : 0) * 512 + g * 64; r.v = (const bf16*)r.k + 256; return r; } };
struct SelKeysS { const int* idx; const int* pt; const float* cache; const bf16* nw; int g;
    __device__ __forceinline__ KeyRef operator()(int c, int l) const { const int pos = idx[c] * 64 + l; KeyRef r; r.valid = pos <= PAST;
        if (pos < PAST) { const int page = pt[pos >> 7]; r.f32 = 1; r.k = cache + ((size_t)page * 128 + (pos & 127)) * 512 + g * 64; r.v = (const float*)r.k + 256; } else { r.f32 = 0; r.k = nw + g * 64; r.v = nw + 256 + g * 64; } return r; } };

constexpr int NA_WAVE_LDS = 14336;
__device__ __forceinline__ void na_ptrs(const Ctx& F, LAS float*& qs, LAS float*& sc, LAS float*& ps, LAS float*& imp) {
    LAS unsigned char* b = F.lds + RING_OFF + F.wave * NA_WAVE_LDS; qs = (LAS float*)b; sc = (LAS float*)(b + 512); ps = (LAS float*)(b + 8704); imp = (LAS float*)(b + 10880); }

template <bool CHK>
__device__ __forceinline__ void compress_task(const Ctx& F, int task, int lane) {
    constexpr int NT_P = NB * NCMP_P * 2;
    const bool dec = task >= NT_P; const int tt = dec ? task - NT_P : task, ncmp = dec ? NCMP_S : NCMP_P, bb = tt / (ncmp * 2), rr = tt % (ncmp * 2), n = rr >> 1, c = rr & 1;
    float h0[4] = {0.f, 0.f, 0.f, 0.f}, h1[4] = {0.f, 0.f, 0.f, 0.f};
    const float* w1 = F.cmp_w1() + (size_t)c * 2048 * 128; const float* pe = F.cmp_pe() + c * 2048;
    for (int l = 0; l < 32; ++l) {
        const int pos = 16 * n + l; const float* row;
        if (!dec) row = F.out() + O_KCP + (size_t)(bb * SEQ + pos) * 512; else { const int page = F.page_table()[bb * 64 + (pos >> 7)]; row = F.cache_cmp() + ((size_t)page * 128 + (pos & 127)) * 512; }
        const float pv = pe[l * 64 + lane]; float xg[4];
#pragma unroll
        for (int g = 0; g < 4; ++g) xg[g] = row[c * 256 + g * 64 + lane] + pv;
        const float* wl = w1 + (size_t)l * 64 * 128;
#pragma unroll 8
        for (int d = 0; d < 64; ++d) { const float wa = wl[d * 128 + lane], wb = wl[d * 128 + 64 + lane];
#pragma unroll
            for (int g = 0; g < 4; ++g) { const float xv = rdlane(xg[g], d); h0[g] += xv * wa; h1[g] += xv * wb; } }
    }
    const float ba = F.cmp_b1()[c * 128 + lane], bb1 = F.cmp_b1()[c * 128 + 64 + lane];
#pragma unroll
    for (int g = 0; g < 4; ++g) { h0[g] = siluf_(h0[g] + ba); h1[g] = siluf_(h1[g] + bb1); }
    const float* w2 = F.cmp_w2() + (size_t)c * 128 * 64; const float b2 = F.cmp_b2()[c * 64 + lane];
    float o[4] = {b2, b2, b2, b2};
    for (int f = 0; f < 64; ++f) { const float wa = w2[f * 64 + lane], wb = w2[(64 + f) * 64 + lane];
#pragma unroll
        for (int g = 0; g < 4; ++g) o[g] += rdlane(h0[g], f) * wa + rdlane(h1[g], f) * wb; }
    float* dst = (dec ? F.KCMPS() : F.KCMPP()) + ((size_t)(bb * ncmp + n) * 2 + c) * 256;
#pragma unroll
    for (int g = 0; g < 4; ++g) { if (CHK) { const float df = fabsf(o[g] - dst[g * 64 + lane]);
            if (!(df <= 0.02f + 0.02f * fabsf(o[g]))) __hip_atomic_fetch_or((unsigned*)F.ctl + CW_CHK + (!dec ? 0 : ((n & 127) == 127 ? 1 : 2)), 1u, RLX_AGENT);
            if (!(df <= 0.2f)) __hip_atomic_fetch_or((unsigned*)F.ctl + CW_CHK + 3, 1u, RLX_AGENT); } else dst[g * 64 + lane] = o[g]; }
}
__device__ __forceinline__ void compress_ref_check(const Ctx& F, int task, int g, int lane, int dbgslot) {
    constexpr int NT_P = NB * NCMP_P * 2;
    const bool dec = task >= NT_P; const int tt = dec ? task - NT_P : task, ncmp = dec ? NCMP_S : NCMP_P, bb = tt / (ncmp * 2), rr = tt % (ncmp * 2), n = rr >> 1, c = rr & 1;
    LAS float* hl = (LAS float*)(F.lds + RING_OFF + F.wave * NA_WAVE_LDS);
    float ha = 0.f, hb2 = 0.f;
    for (int k = 0; k < 2048; ++k) { const int l = k >> 6, d = k & 63, pos = 16 * n + l; const float* row;
        if (!dec) row = F.out() + O_KCP + (size_t)(bb * SEQ + pos) * 512; else { const int page = F.page_table()[bb * 64 + (pos >> 7)]; row = F.cache_cmp() + ((size_t)page * 128 + (pos & 127)) * 512; }
        const float x = row[c * 256 + g * 64 + d] + F.cmp_pe()[c * 2048 + k]; const float* w = F.cmp_w1() + ((size_t)c * 2048 + k) * 128;
        ha += x * w[lane]; hb2 += x * w[64 + lane]; }
    if (dbgslot >= 0) { const float* HD = (const float*)F.H() + (size_t)dbgslot * 512 * 128 + (size_t)(((n & 127) << 2) + g) * 128; float pa = 0.f, pb = 0.f; for (int kc = 0; kc < 16; ++kc) { pa += F.PEB()[(c * 16 + kc) * 128 + lane]; pb += F.PEB()[(c * 16 + kc) * 128 + 64 + lane]; }
        if (!(fabsf(HD[lane] + pa - ha) <= 0.05f + 0.05f * fabsf(ha)) || !(fabsf(HD[64 + lane] + pb - hb2) <= 0.05f + 0.05f * fabsf(hb2))) __hip_atomic_fetch_or((unsigned*)F.ctl + CW_CHK + 5 + dbgslot, 1u, RLX_AGENT); }
    ha += F.cmp_b1()[c * 128 + lane]; hb2 += F.cmp_b1()[c * 128 + 64 + lane];
    hl[lane] = ha / (1.0f + __expf(-ha)); hl[64 + lane] = hb2 / (1.0f + __expf(-hb2));
    float o = F.cmp_b2()[c * 64 + lane];
    for (int f = 0; f < 128; ++f) o += hl[f] * F.cmp_w2()[((size_t)c * 128 + f) * 64 + lane];
    const float got = (dec ? F.KCMPS() : F.KCMPP())[((size_t)(bb * ncmp + n) * 2 + c) * 256 + g * 64 + lane];
    if (!(fabsf(o - got) <= 0.05f + 0.05f * fabsf(o))) __hip_atomic_fetch_or((unsigned*)F.ctl + CW_CHK + 4, 1u, RLX_AGENT);
}
__device__ __forceinline__ void conv_prepass(const Ctx& F) {
    const int gt = F.vcu * (NWAVES * 64) + F.tid, NGT = F.G * NWAVES * 64;
    constexpr int TOTP = (MPROMPT / 8) * (CONV_DIM / 4);
    for (int i = gt; i < TOTP; i += NGT) {
        const int rb = i / (CONV_DIM / 4), c4 = i % (CONV_DIM / 4), col = c4 * 4, m0 = rb * 8, t0 = m0 & (SEQ - 1), b = m0 >> 12;
        f32x4 xr[11];
#pragma unroll
        for (int k = 0; k < 11; ++k) xr[k] = (t0 - 3 + k >= 0) ? *(const f32x4*)(F.XBC() + (size_t)(m0 - 3 + k) * CONV_DIM + col) : (f32x4){0.f, 0.f, 0.f, 0.f};
        const f32x4 bias = *(const f32x4*)(F.conv_b() + col), w0 = *(const f32x4*)(F.conv_w() + col), w1 = *(const f32x4*)(F.conv_w() + CONV_DIM + col), w2 = *(const f32x4*)(F.conv_w() + 2 * CONV_DIM + col), w3 = *(const f32x4*)(F.conv_w() + 3 * CONV_DIM + col);
#pragma unroll
        for (int r = 0; r < 8; ++r) { const f32x4 acc = bias + xr[r] * w0 + xr[r + 1] * w1 + xr[r + 2] * w2 + xr[r + 3] * w3;
            typedef unsigned u32x2v __attribute__((ext_vector_type(2))); u32x2v w; w.x = pk2(siluf_(acc.x), siluf_(acc.y)); w.y = pk2(siluf_(acc.z), siluf_(acc.w)); *(u32x2v*)(F.XBCA16() + (size_t)(m0 + r) * CONV_DIM + col) = w;
            if (t0 + r >= SEQ - 3) *(f32x4*)(F.out() + O_CVP + (size_t)(b * 3 + (t0 + r - (SEQ - 3))) * CONV_DIM + col) = xr[r + 3]; }
        if (c4 < 4) {
#pragma unroll
            for (int r = 0; r < 8; ++r)
#pragma unroll
                for (int e = 0; e < 4; ++e) { const int h = c4 * 4 + e; const float x = F.GD()[(size_t)(m0 + r) * 64 + 48 + h] + F.dt_bias()[h]; F.DT()[(size_t)(m0 + r) * 16 + h] = x > 20.f ? x : log1pf(__expf(x)); } }
    }
    constexpr int TOTS = DECB * (CONV_DIM / 4);
    for (int i = gt; i < TOTS; i += NGT) {
        const int b = i / (CONV_DIM / 4), c4 = i % (CONV_DIM / 4), col = c4 * 4; const size_t m = (size_t)MPROMPT + b;
        f32x4 acc = *(const f32x4*)(F.conv_b() + col);
#pragma unroll
        for (int w = 0; w < 3; ++w) acc += *(const f32x4*)(F.st_conv() + (size_t)(b * 3 + w) * CONV_DIM + col) * *(const f32x4*)(F.conv_w() + (size_t)w * CONV_DIM + col);
        const f32x4 xcur = *(const f32x4*)(F.XBC() + m * CONV_DIM + col); acc += xcur * *(const f32x4*)(F.conv_w() + (size_t)3 * CONV_DIM + col);
        f32x4 a; a.x = siluf_(acc.x); a.y = siluf_(acc.y); a.z = siluf_(acc.z); a.w = siluf_(acc.w);
        *(f32x4*)(F.XBCA() + m * CONV_DIM + col) = a;
        { typedef unsigned u32x2v __attribute__((ext_vector_type(2))); u32x2v w; w.x = pk2(a.x, a.y); w.y = pk2(a.z, a.w); *(u32x2v*)(F.XBCA16() + m * CONV_DIM + col) = w; }
        *(f32x4*)(F.out() + O_CVS + (size_t)(b * 3 + 0) * CONV_DIM + col) = *(const f32x4*)(F.st_conv() + (size_t)(b * 3 + 1) * CONV_DIM + col);
        *(f32x4*)(F.out() + O_CVS + (size_t)(b * 3 + 1) * CONV_DIM + col) = *(const f32x4*)(F.st_conv() + (size_t)(b * 3 + 2) * CONV_DIM + col);
        *(f32x4*)(F.out() + O_CVS + (size_t)(b * 3 + 2) * CONV_DIM + col) = xcur;
        if (c4 < 4) {
#pragma unroll
            for (int e = 0; e < 4; ++e) { const int h = c4 * 4 + e; const float x = F.GD()[m * 64 + 48 + h] + F.dt_bias()[h]; F.DT()[m * 16 + h] = x > 20.f ? x : log1pf(__expf(x)); } }
    }
}
template <bool CHK>
__device__ __forceinline__ void win_task(const Ctx& F, int task, int lane) {
    LAS float *qs, *sc, *ps, *imp; na_ptrs(F, qs, sc, ps, imp);
    const int m = task >> 2, g = task & 3; const bool dec = m >= MPROMPT; const int b = dec ? m - MPROMPT : m >> 12, t = m & (SEQ - 1);
#pragma unroll
    for (int pr = 0; pr < 2; ++pr) { float o0, o1; const bf16* q2 = F.QB() + (size_t)m * 1024 + g * 256 + pr * 128;
        if (!dec) { const WinKeysP kf{F.KWB() + (size_t)b * SEQ * 512, g, t}; naive_attn2<8>(q2, kf, qs, sc, ps, false, lane, o0, o1); }
        else { const WinKeysS kf{F.st_win() + (size_t)b * 512 * 512, F.KWB() + (size_t)m * 512, g}; naive_attn2<8>(q2, kf, qs, sc, ps, false, lane, o0, o1); }
        float* d0 = F.OWIN() + (size_t)m * 1024 + (g * 4 + pr * 2) * 64 + lane;
        if (CHK) { if (!(fabsf(o0 - d0[0]) <= 2e-3f) || !(fabsf(o1 - d0[64]) <= 2e-3f)) __hip_atomic_fetch_or((unsigned*)F.ctl + CW_CHK + 0, 1u, RLX_AGENT); }
        else { d0[0] = o0; d0[64] = o1; } }
}
template <bool CHK>
__device__ __forceinline__ void cmp_task(const Ctx& F, int task, int lane) {
    LAS float *qs, *sc, *ps, *imp; na_ptrs(F, qs, sc, ps, imp);
    const int m = task >> 2, g = task & 3; const bool dec = m >= MPROMPT; const int b = dec ? m - MPROMPT : m >> 12, t = m & (SEQ - 1);
    const int qpos = dec ? PAST : t, ncmp = dec ? NCMP_S : NCMP_P, nslc = dec ? NSLC_S : NSLC_P, jt = qpos >> 6;
    for (int i = lane; i < 544; i += 64) ps[i] = 0.f;
    const CmpKeys kf{dec ? F.KCMPS() + (size_t)b * NCMP_S * 512 : F.KCMPP() + (size_t)b * NCMP_P * 512, g, ncmp, qpos};
#pragma unroll
    for (int pr = 0; pr < 2; ++pr) { float o0, o1; naive_attn2<8>(F.QB() + (size_t)m * 1024 + g * 256 + pr * 128, kf, qs, sc, ps, true, lane, o0, o1);
        float* d0 = F.OCMP() + (size_t)m * 1024 + (g * 4 + pr * 2) * 64 + lane;
        if (CHK) { if (!(fabsf(o0 - d0[0]) <= 5e-3f + 0.02f * fabsf(o0)) || !(fabsf(o1 - d0[64]) <= 5e-3f + 0.02f * fabsf(o1))) __hip_atomic_fetch_or((unsigned*)F.ctl + CW_CHK + 0, 1u, RLX_AGENT);
                   if (!(fabsf(o0 - d0[0]) <= 0.05f) || !(fabsf(o1 - d0[64]) <= 0.05f)) __hip_atomic_fetch_or((unsigned*)F.ctl + CW_CHK + 3, 1u, RLX_AGENT); }
        else { d0[0] = o0; d0[64] = o1; } }
    float mine[3]; int cnt[3];
#pragma unroll
    for (int jj = 0; jj < 3; ++jj) { const int j = jj * 64 + lane; float v = 0.f; cnt[jj] = 0;
        if (j < nslc) { v = ps[4 * j] + 2.0f * (ps[4 * j + 1] + ps[4 * j + 2] + ps[4 * j + 3]) + ps[4 * j + 4]; if (j == 0 || j == jt || j == jt - 1) v = 1.0e4f; if (j > jt) v = -1.0e4f; imp[j] = v; }
        mine[jj] = v; }
    for (int k = 0; k < nslc; ++k) { const float v = imp[k];
#pragma unroll
        for (int jj = 0; jj < 3; ++jj) { const int j = jj * 64 + lane; cnt[jj] += ((v > mine[jj]) || (v == mine[jj] && k < j)) ? 1 : 0; } }
    int base = 0;
#pragma unroll
    for (int jj = 0; jj < 3; ++jj) { const int j = jj * 64 + lane; const bool sel = (j < nslc) && (cnt[jj] < 16); const unsigned long long bal = __ballot(sel);
        if (CHK && dec) { bool stored = false; for (int i = 0; i < 16; ++i) stored = stored || (F.SELIDX()[(size_t)task * 16 + i] == j);
            if (__ballot((j < nslc) && (stored != sel)) != 0ull && lane == 0) __hip_atomic_fetch_or((unsigned*)F.ctl + CW_CHK + 2, 1u, RLX_AGENT); }
        else if (CHK) { if (jj == 0 && lane == 0 && F.SELMASK()[task] != bal) { if (__hip_atomic_fetch_add((unsigned*)F.ctl + CW_CHK + 8, 1u, RLX_AGENT) >= 100u) __hip_atomic_fetch_or((unsigned*)F.ctl + CW_CHK + 1, 1u, RLX_AGENT); if (__popcll(F.SELMASK()[task] ^ bal) > 2) __hip_atomic_fetch_or((unsigned*)F.ctl + CW_CHK + 2, 1u, RLX_AGENT); } }
        else { if (sel) F.SELIDX()[(size_t)task * 16 + base + __popcll(bal & ((1ull << lane) - 1ull))] = j;
        if (!dec && jj == 0 && lane == 0) F.SELMASK()[task] = bal; }
        base += __popcll(bal); }
}
template <bool CHK>
__device__ __forceinline__ void sel_task(const Ctx& F, int task, int lane) {
    LAS float *qs, *sc, *ps, *imp; na_ptrs(F, qs, sc, ps, imp);
    const int m = task >> 2, g = task & 3; const bool dec = m >= MPROMPT; const int b = dec ? m - MPROMPT : m >> 12, t = m & (SEQ - 1);
#pragma unroll
    for (int pr = 0; pr < 2; ++pr) { float o0, o1; const bf16* q2 = F.QB() + (size_t)m * 1024 + g * 256 + pr * 128;
        if (!dec) { LAS int* il = (LAS int*)imp;
            const unsigned long long mk = F.SELMASK()[task]; if ((mk >> lane) & 1ull) il[__popcll(mk & ((1ull << lane) - 1ull))] = lane;
            const SelKeysP kf{(const int*)il, F.KSB() + (size_t)b * SEQ * 512, g, t}; naive_attn2<16>(q2, kf, qs, sc, ps, false, lane, o0, o1); }
        else { const SelKeysS kf{F.SELIDX() + (size_t)task * 16, F.page_table() + b * 64, F.cache_sel(), F.KSB() + (size_t)m * 512, g}; naive_attn2<16>(q2, kf, qs, sc, ps, false, lane, o0, o1); }
#pragma unroll
        for (int e = 0; e < 2; ++e) { const int hd = g * 4 + pr * 2 + e; const float* gt = F.GD() + (size_t)m * 64 + hd * 3; const size_t oi = (size_t)m * 1024 + hd * 64 + lane;
            const float a = gt[0] * F.OCMP()[oi] + gt[1] * (e ? o1 : o0) + gt[2] * F.OWIN()[oi]; bf16* dm = F.MIX() + (size_t)m * DM + hd * 64 + lane;
            if (CHK) { if (!(fabsf(a - bf2f(*dm)) <= 2e-3f + 0.01f * fabsf(a))) __hip_atomic_fetch_or((unsigned*)F.ctl + CW_CHK + 1, 1u, RLX_AGENT); } else *dm = (bf16)f2bf(a); } }
}
template <int U>
__device__ __forceinline__ void ssd_chain(const Ctx& F, int rowbase, int L, int h, int p, const float* s0, float* sfin, int lane) {
    const int grp = h >> 3; float h0 = 0.f, h1 = 0.f; if (s0) { h0 = s0[lane]; h1 = s0[64 + lane]; }
    const float A = -__expf(F.a_log()[h]), Dk = F.d_skip()[h];
    for (int t0 = 0; t0 < L; t0 += U) {
        float dt[U], x[U], B0[U], B1[U], C0[U], C1[U];
#pragma unroll
        for (int u = 0; u < U; ++u) { const size_t m = (size_t)(rowbase + t0 + u); dt[u] = F.DT()[m * 16 + h]; const float* r = F.XBCA() + m * CONV_DIM; x[u] = r[h * 64 + p];
            B0[u] = r[1024 + grp * 128 + lane]; B1[u] = r[1024 + grp * 128 + 64 + lane]; C0[u] = r[1280 + grp * 128 + lane]; C1[u] = r[1280 + grp * 128 + 64 + lane]; }
        float y[U];
#pragma unroll
        for (int u = 0; u < U; ++u) { const float dA = __expf(dt[u] * A), xd = dt[u] * x[u]; h0 = h0 * dA + xd * B0[u]; h1 = h1 * dA + xd * B1[u]; y[u] = wave_sum(C0[u] * h0 + C1[u] * h1) + Dk * x[u]; }
        if (lane == 0) {
#pragma unroll
            for (int u = 0; u < U; ++u) F.YSSD()[(size_t)(rowbase + t0 + u) * 1024 + h * 64 + p] = y[u]; }
    }
    sfin[lane] = h0; sfin[64 + lane] = h1;
}
__device__ __forceinline__ void ssd_task(const Ctx& F, int task, int lane) {
    if (task < NB * 16 * 64) { const int b = task >> 10, h = (task >> 6) & 15, p = task & 63; ssd_chain<4>(F, b * SEQ, SEQ, h, p, nullptr, F.out() + O_SSP + (size_t)task * 128, lane); }
    else { const int tk = task - NB * 16 * 64, b = tk >> 10, h = (tk >> 6) & 15, p = tk & 63; ssd_chain<1>(F, MPROMPT + b, 1, h, p, F.st_ssm() + (size_t)tk * 128, F.out() + O_SSS + (size_t)tk * 128, lane); }
}
__device__ __forceinline__ void ssd_decode_task(const Ctx& F, int task, int lane) {
    const int pg = task & 7, h = (task >> 3) & 15, b = task >> 7, grp = h >> 3; const size_t m = (size_t)MPROMPT + b;
    const float* r = F.XBCA() + m * CONV_DIM; const float dt = F.DT()[m * 16 + h], A = -__expf(F.a_log()[h]), Dk = F.d_skip()[h], dA = __expf(dt * A);
    const float B0 = r[1024 + grp * 128 + lane], B1 = r[1024 + grp * 128 + 64 + lane], C0 = r[1280 + grp * 128 + lane], C1 = r[1280 + grp * 128 + 64 + lane];
    const size_t sb = ((size_t)(b * 16 + h) * 64 + pg * 8) * 128;
    float h0[8], h1[8], x[8];
#pragma unroll
    for (int i = 0; i < 8; ++i) { h0[i] = F.st_ssm()[sb + i * 128 + lane]; h1[i] = F.st_ssm()[sb + i * 128 + 64 + lane]; x[i] = r[h * 64 + pg * 8 + i]; }
#pragma unroll
    for (int i = 0; i < 8; ++i) { const float xd = dt * x[i]; h0[i] = h0[i] * dA + xd * B0; h1[i] = h1[i] * dA + xd * B1;
        F.out()[O_SSS + sb + i * 128 + lane] = h0[i]; F.out()[O_SSS + sb + i * 128 + 64 + lane] = h1[i];
        const float y = wave_sum(C0 * h0[i] + C1 * h1[i]) + Dk * x[i]; if (lane == 0) F.YSSD()[m * 1024 + h * 64 + pg * 8 + i] = y; }
}
__device__ __forceinline__ void ssd_gate_task(const Ctx& F, int task, int lane) {
    const int m = task >> 1, grp = task & 1; const size_t o = (size_t)m * 1024 + grp * 512 + lane * 8;
    const f32x4 y0 = *(const f32x4*)(F.YSSD() + o), y1 = *(const f32x4*)(F.YSSD() + o + 4), z0 = *(const f32x4*)(F.Z() + o), z1 = *(const f32x4*)(F.Z() + o + 4);
    float v[8] = {y0.x * siluf_(z0.x), y0.y * siluf_(z0.y), y0.z * siluf_(z0.z), y0.w * siluf_(z0.w), y1.x * siluf_(z1.x), y1.y * siluf_(z1.y), y1.z * siluf_(z1.z), y1.w * siluf_(z1.w)};
    float ss = 0.f;
#pragma unroll
    for (int e = 0; e < 8; ++e) ss += v[e] * v[e];
    const float rstd = 1.0f / sqrtf(wave_sum(ss) * (1.0f / 512.0f) + NORM_EPS);
    const float* w = F.ssm_norm() + grp * 512 + lane * 8;
    v4u ow; ow.x = pk2(v[0] * rstd * w[0], v[1] * rstd * w[1]); ow.y = pk2(v[2] * rstd * w[2], v[3] * rstd * w[3]); ow.z = pk2(v[4] * rstd * w[4], v[5] * rstd * w[5]); ow.w = pk2(v[6] * rstd * w[6], v[7] * rstd * w[7]);
    *(v4u*)(F.MIX() + (size_t)m * DM + 1024 + grp * 512 + lane * 8) = ow;
}
__device__ __forceinline__ void final_norm_row(const Ctx& F, int m, int lane) {
    float s = m < MPROMPT ? (lane < 32 ? F.SS2()[(size_t)m * 32 + lane] : 0.f) : F.SS2S()[(size_t)(m - MPROMPT) * 64 + lane]; s = wave_sum(s);
    const float rstd = 1.0f / sqrtf(s * (1.0f / DM) + NORM_EPS);
    const f32x4* xr = (const f32x4*)(F.X2() + (size_t)m * DM) + lane; const f32x4* wr = (const f32x4*)F.ln_final() + lane;
    f32x4* o = (f32x4*)(m < MPROMPT ? F.out() + O_YP + (size_t)m * DM : F.out() + O_YS + (size_t)(m - MPROMPT) * DM) + lane;
#pragma unroll
    for (int j = 0; j < 8; ++j) o[64 * j] = xr[64 * j] * rstd * wr[64 * j];
}

namespace fa {
typedef short bf16x8 __attribute__((ext_vector_type(8)));
typedef short s16x4 __attribute__((ext_vector_type(4)));
typedef float f32x16 __attribute__((ext_vector_type(16)));
constexpr float C2 = 0.125f * 1.4426950408889634f, MASKV = -1.0e30f;
constexpr int LK = 0, LV = 16384, LWS = 32768, LDS_BYTES_FA = 34816;
__device__ __forceinline__ int crow(int r, int hi) { return (r & 3) + 8 * (r >> 2) + 4 * hi; }
__device__ __forceinline__ float max3f(float a, float b, float c) { float r; asm("v_max3_f32 %0, %1, %2, %3" : "=v"(r) : "v"(a), "v"(b), "v"(c)); return r; }
typedef float f32x2_t __attribute__((ext_vector_type(2))); typedef __bf16 bf16x2_t __attribute__((ext_vector_type(2)));
__device__ __forceinline__ unsigned cvtpk(float lo, float hi) { f32x2_t v = {lo, hi}; bf16x2_t b = __builtin_convertvector(v, bf16x2_t); return __builtin_bit_cast(unsigned, b); }
__device__ __forceinline__ float xmax(float v) { auto rr = __builtin_amdgcn_permlane32_swap(__float_as_uint(v), __float_as_uint(v), false, false); return fmaxf(__uint_as_float(rr[0]), __uint_as_float(rr[1])); }
__device__ __forceinline__ float xsum(float v) { auto rr = __builtin_amdgcn_permlane32_swap(__float_as_uint(v), __float_as_uint(v), false, false); return __uint_as_float(rr[0]) + __uint_as_float(rr[1]); }
__device__ __forceinline__ void qkt(f32x16& p0, f32x16& p1, const LAS unsigned char* Kt, const bf16x8* qr, int r32, int hi) {
    const LAS unsigned char* kb = Kt + hi * 1024 + r32 * 16;
    p0 = f32x16{}; p1 = f32x16{};
#pragma unroll
    for (int d0 = 0; d0 < 4; ++d0) {
        const bf16x8 b0 = *(const LAS bf16x8*)(kb + d0 * 2048), b1 = *(const LAS bf16x8*)(kb + d0 * 2048 + 512);
        p0 = __builtin_amdgcn_mfma_f32_32x32x16_bf16(b0, qr[d0], p0, 0, 0, 0); p1 = __builtin_amdgcn_mfma_f32_32x32x16_bf16(b1, qr[d0], p1, 0, 0, 0); }
}
__device__ __forceinline__ void pv(f32x16* o, unsigned vb, bf16x8 pa0, bf16x8 pa1, bf16x8 pa2, bf16x8 pa3) {
#pragma unroll
    for (int d0 = 0; d0 < 2; ++d0) { s16x4 lo[4], hi[4];
#pragma unroll
        for (int ks = 0; ks < 4; ++ks) {
            asm volatile("ds_read_b64_tr_b16 %0,%1 offset:%c2" : "=&v"(lo[ks]) : "v"(vb), "i"(d0 * 4096 + ks * 1024) : "memory");
            asm volatile("ds_read_b64_tr_b16 %0,%1 offset:%c2" : "=&v"(hi[ks]) : "v"(vb), "i"(d0 * 4096 + ks * 1024 + 512) : "memory"); }
        asm volatile("s_waitcnt lgkmcnt(0)" ::: "memory"); __builtin_amdgcn_sched_barrier(0);
#define FA_PK(k) (bf16x8){lo[k][0], lo[k][1], lo[k][2], lo[k][3], hi[k][0], hi[k][1], hi[k][2], hi[k][3]}
        o[d0] = __builtin_amdgcn_mfma_f32_32x32x16_bf16(pa0, FA_PK(0), o[d0], 0, 0, 0);
        o[d0] = __builtin_amdgcn_mfma_f32_32x32x16_bf16(pa1, FA_PK(1), o[d0], 0, 0, 0);
        o[d0] = __builtin_amdgcn_mfma_f32_32x32x16_bf16(pa2, FA_PK(2), o[d0], 0, 0, 0);
        o[d0] = __builtin_amdgcn_mfma_f32_32x32x16_bf16(pa3, FA_PK(3), o[d0], 0, 0, 0);
#undef FA_PK
    }
}
__device__ __forceinline__ float rowmax(const f32x16& p0, const f32x16& p1) {
    float a = max3f(p0[0], p0[1], p1[0]), b = max3f(p0[2], p0[3], p1[1]); a = max3f(a, p1[2], p1[3]);
#pragma unroll
    for (int r = 4; r < 16; r += 4) { a = max3f(a, p0[r], p0[r + 1]); b = max3f(b, p0[r + 2], p0[r + 3]); a = max3f(a, p1[r], p1[r + 1]); b = max3f(b, p1[r + 2], p1[r + 3]); }
    const float m = fmaxf(a, b);
    return xmax(m);
}
#define FA_BAR() asm volatile("s_waitcnt vmcnt(0) lgkmcnt(0)\n\ts_barrier" ::: "memory")

template <int MODE>
__device__ __forceinline__ void attn_unit(const Ctx& F, LAS unsigned char* shm, int b, int g, int qb) {
    const int tid = threadIdx.x, lane = tid & 63, r32 = lane & 31, hi = lane >> 5; const int wid = __builtin_amdgcn_readfirstlane(tid >> 6);
    const int hd = 4 * g + (wid & 3), th = wid >> 2, trel = 32 * th + r32; const size_t m = (size_t)b * SEQ + 64 * qb + trel;
    const int j_lo = MODE == 0 ? 0 : (qb > 8 ? qb - 8 : 0), j_hi = qb;
    const bf16* KV = (MODE == 0 ? F.KSB() : F.KWB()) + (size_t)b * SEQ * 512 + g * 64;
    const unsigned long long smask = MODE == 0 ? F.SELMASK()[m * 4 + g] : ~0ull;
    bf16x8 qr[4];
    { const bf16* Qp = F.QB() + m * 1024 + hd * 64 + hi * 8;
#pragma unroll
      for (int d0 = 0; d0 < 4; ++d0) qr[d0] = *(const bf16x8*)(Qp + 16 * d0); }
    const bf16* ksrc = KV + (size_t)lane * 512 + wid * 8;
    const bf16* vsrc = KV + 256 + (size_t)(16 * (wid & 3) + (lane >> 2)) * 512 + (wid >> 2) * 32 + (lane & 3) * 8;
    LAS unsigned char* kdst = shm + LK + wid * 1024 + lane * 16; LAS unsigned char* vdst = shm + LV + wid * 1024 + lane * 16;
    const unsigned vb0 = (unsigned)(uintptr_t)(shm + LV) + ((lane >> 4) & 1) * 32 + (lane & 3) * 8 + (4 * hi + ((lane & 15) >> 2)) * 64;
    LAS float* wsf = (LAS float*)(shm + LWS) + wid * 64;
    v4u kreg = *(const v4u*)(ksrc + (size_t)j_lo * 64 * 512), vreg = *(const v4u*)(vsrc + (size_t)j_lo * 64 * 512);
    *(LAS v4u*)kdst = kreg; *(LAS v4u*)vdst = vreg;
    FA_BAR();
    float mref = MASKV, lsum = 0.f; f32x16 o[2]; o[0] = f32x16{}; o[1] = f32x16{};
#define FA_TILE(DIAG) do { \
        const int buf = (j - j_lo) & 1; \
        if (!(DIAG)) { kreg = *(const v4u*)(ksrc + (size_t)(j + 1) * 64 * 512); vreg = *(const v4u*)(vsrc + (size_t)(j + 1) * 64 * 512); } \
        f32x16 p0, p1; \
        qkt(p0, p1, shm + LK + buf * 8192, qr, r32, hi); \
        if (DIAG) { _Pragma("unroll") for (int r = 0; r < 16; ++r) { const int kv = crow(r, hi); if (kv > trel) p0[r] = MASKV; if (kv + 32 > trel) p1[r] = MASKV; } } \
        if (MODE == 1 && qb >= 8 && j == j_lo) { _Pragma("unroll") for (int r = 0; r < 16; ++r) { const int kv = crow(r, hi); if (kv <= trel) p0[r] = MASKV; if (kv + 32 <= trel) p1[r] = MASKV; } } \
        const bool blocked = MODE == 0 && !((smask >> j) & 1ull); \
        float mt = rowmax(p0, p1); mt = (blocked || mt < -1.0e29f) ? MASKV : mt * C2; \
        const bool need = mt > mref + 8.0f; \
        if (__any(need)) { \
            const float mnew = need ? mt : mref, f = __builtin_amdgcn_exp2f(mref - mnew); lsum *= f; mref = mnew; \
            if (hi == 0) wsf[r32] = f; \
            asm volatile("s_waitcnt lgkmcnt(0)" ::: "memory"); \
            _Pragma("unroll") for (int r = 0; r < 16; ++r) { const float fr = wsf[crow(r, hi)]; o[0][r] *= fr; o[1][r] *= fr; } \
        } \
        const float nref = blocked ? -1.0e30f : (mref < -1.0e29f ? 0.f : -mref); float sacc = 0.f;        \
        _Pragma("unroll") for (int r = 0; r < 16; ++r) { p0[r] = __builtin_amdgcn_exp2f(__builtin_fmaf(p0[r], C2, nref)); p1[r] = __builtin_amdgcn_exp2f(__builtin_fmaf(p1[r], C2, nref)); sacc += p0[r] + p1[r]; } \
        lsum += sacc; \
        v4u pw0, pw1, pw2, pw3; \
        pw0.x = cvtpk(p0[0], p0[1]); pw0.y = cvtpk(p0[2], p0[3]); pw0.z = cvtpk(p0[4], p0[5]); pw0.w = cvtpk(p0[6], p0[7]); \
        pw1.x = cvtpk(p0[8], p0[9]); pw1.y = cvtpk(p0[10], p0[11]); pw1.z = cvtpk(p0[12], p0[13]); pw1.w = cvtpk(p0[14], p0[15]); \
        pw2.x = cvtpk(p1[0], p1[1]); pw2.y = cvtpk(p1[2], p1[3]); pw2.z = cvtpk(p1[4], p1[5]); pw2.w = cvtpk(p1[6], p1[7]); \
        pw3.x = cvtpk(p1[8], p1[9]); pw3.y = cvtpk(p1[10], p1[11]); pw3.z = cvtpk(p1[12], p1[13]); pw3.w = cvtpk(p1[14], p1[15]); \
        pv(o, vb0 + buf * 8192, __builtin_bit_cast(bf16x8, pw0), __builtin_bit_cast(bf16x8, pw1), __builtin_bit_cast(bf16x8, pw2), __builtin_bit_cast(bf16x8, pw3)); \
        if (!(DIAG)) { *(LAS v4u*)(kdst + (buf ^ 1) * 8192) = kreg; *(LAS v4u*)(vdst + (buf ^ 1) * 8192) = vreg; } \
        FA_BAR(); } while (0)
    int j = j_lo;
    for (; j < j_hi; ++j) FA_TILE(false);
    FA_TILE(true);
#undef FA_TILE
    lsum = xsum(lsum);
    if (hi == 0) wsf[32 + r32] = lsum;
    asm volatile("s_waitcnt lgkmcnt(0)" ::: "memory");
#pragma unroll
    for (int r = 0; r < 16; ++r) {
        const int q = crow(r, hi); const float rl = 1.0f / wsf[32 + q]; const size_t mm = (size_t)b * SEQ + 64 * qb + 32 * th + q; const size_t oi = mm * 1024 + hd * 64 + r32;
        if (MODE == 1) { F.OWIN()[oi] = o[0][r] * rl; F.OWIN()[oi + 32] = o[1][r] * rl; }
        else { const float* gt = F.GD() + mm * 64 + hd * 3; const float gc = gt[0], gs = gt[1], gw = gt[2];
            const float a0 = gc * F.OCMP()[oi] + gs * (o[0][r] * rl) + gw * F.OWIN()[oi], a1 = gc * F.OCMP()[oi + 32] + gs * (o[1][r] * rl) + gw * F.OWIN()[oi + 32];
            F.MIX()[mm * DM + hd * 64 + r32] = (bf16)f2bf(a0); F.MIX()[mm * DM + hd * 64 + 32 + r32] = (bf16)f2bf(a1); }
    }
    FA_BAR();
}
__device__ __forceinline__ void sel_phase(const Ctx& F, LAS unsigned char* shm) {
    for (int p = blockIdx.x; p < NB * 4 * 32; p += gridDim.x) { const int bg = p >> 5, s = p & 31; attn_unit<0>(F, shm, bg >> 2, bg & 3, 63 - s); attn_unit<0>(F, shm, bg >> 2, bg & 3, s); }
}
__device__ __forceinline__ void win_phase(const Ctx& F, LAS unsigned char* shm) {
    for (int u = blockIdx.x; u < NB * 4 * 64; u += gridDim.x) { const int bg = u >> 6, qb = u & 63; attn_unit<1>(F, shm, bg >> 2, bg & 3, qb); }
}
}
namespace cmpg {
typedef short bf16x8 __attribute__((ext_vector_type(8)));
typedef short s16x4 __attribute__((ext_vector_type(4)));
typedef float f32x16 __attribute__((ext_vector_type(16)));
typedef float f32x2_t __attribute__((ext_vector_type(2))); typedef __bf16 bf16x2_t __attribute__((ext_vector_type(2)));
__device__ __forceinline__ unsigned cvtpk(float lo, float hi) { f32x2_t v = {lo, hi}; bf16x2_t b = __builtin_convertvector(v, bf16x2_t); return __builtin_bit_cast(unsigned, b); }
__device__ __forceinline__ void glds16(const void* gsrc, unsigned lds_dst) { unsigned keep;
    asm volatile("s_mov_b32 %0, m0\n\ts_mov_b32 m0, %2\n\ts_nop 0\n\tglobal_load_lds_dwordx4 %1, off\n\ts_mov_b32 m0, %0" : "=&s"(keep) : "v"(gsrc), "s"(lds_dst) : "memory"); }
constexpr int A_CH = 516 * 16, A_BYTES = 8 * A_CH, B_BYTES = 32768, L_W2 = A_BYTES + 2 * B_BYTES, L_BIAS = L_W2 + 16384, LDS_BYTES_CMP = L_BIAS + 512;
static_assert(LDS_BYTES_CMP <= RING_BYTES, "compress LDS");
__device__ __forceinline__ void unit(const Ctx& F, LAS unsigned char* shm, int unit_id) {
    int tid_o = threadIdx.x; asm volatile("" : "+v"(tid_o));
    const int tid = tid_o, lane = tid & 63, r32 = lane & 31, hi = lane >> 5; const int wid = __builtin_amdgcn_readfirstlane(tid >> 6);
    const bool dec = unit_id < 256; const int uu = dec ? unit_id : unit_id - 256;
    const int b = dec ? uu >> 3 : uu >> 2, c = dec ? (uu >> 2) & 1 : (uu >> 1) & 1, q = dec ? uu & 3 : uu & 1, n0 = 128 * q, ncmp = dec ? NCMP_S : NCMP_P, maxpos = dec ? PAST - 1 : SEQ - 1;
    const float* src0 = dec ? F.cache_cmp() : F.out() + O_KCP + (size_t)b * SEQ * 512; const int* pt = F.page_table() + b * 64;
    const bf16* W1T = F.W1T() + (size_t)c * 128 * 2048;
    f32x4 ar[16]; f32x4 xr = (f32x4){0.f, 0.f, 0.f, 0.f};
    const bf16* pb0 = W1T + (size_t)lane * 2048 + (wid >> 2) * 16 * 64 + ((2 * wid) & 7) * 8;
    const unsigned ldsb = (unsigned)(uintptr_t)(shm + A_BYTES);
#define CG_BASE(blk) ({ int pos_ = 16 * (n0 + (blk)); pos_ = pos_ > maxpos - 15 ? maxpos - 15 : pos_; \
        const unsigned o_ = dec ? ((unsigned)pt[pos_ >> 7] * 128u + (unsigned)(pos_ & 127)) * 512u : (unsigned)pos_ * 512u; (unsigned)__builtin_amdgcn_readfirstlane((int)(o_ + (unsigned)c * 256u)); })
    unsigned bs[16];
#pragma unroll
    for (int e_ = 0; e_ < 16; ++e_) bs[e_] = CG_BASE(16 * wid + e_);
    const unsigned bsx = CG_BASE(128);
    const int lg = lane >> 4, lch = (lane & 15) >> 1, lhalf = lane & 1;
#define CG_LOAD(l_) do { \
        _Pragma("unroll") for (int e_ = 0; e_ < 16; ++e_) ar[e_] = *(const f32x4*)(src0 + (size_t)(bs[e_] + (unsigned)(l_) * 512u) + 4 * lane); \
        if (wid == 0) xr = *(const f32x4*)(src0 + (size_t)(bsx + (unsigned)(l_) * 512u) + 4 * lane); \
        _Pragma("unroll") for (int j_ = 0; j_ < 4; ++j_) glds16(pb0 + (j_ & 1) * 64 * 2048 + (j_ >> 1) * 8 + (l_) * 64, (unsigned)__builtin_amdgcn_readfirstlane(ldsb + ((l_) & 1) * B_BYTES + (4 * wid + j_) * 1024)); } while (0)
#define CG_STORE() do { typedef unsigned u32x2v_ __attribute__((ext_vector_type(2))); LAS unsigned char* a_ = shm + lch * A_CH + (4 * 16 * wid + lg) * 16 + lhalf * 8; \
        _Pragma("unroll") for (int e_ = 0; e_ < 16; ++e_) { u32x2v_ w_; w_.x = cvtpk(ar[e_].x, ar[e_].y); w_.y = cvtpk(ar[e_].z, ar[e_].w); *(LAS u32x2v_*)(a_ + e_ * 64) = w_; } \
        if (wid == 0) { u32x2v_ w2_; w2_.x = cvtpk(xr.x, xr.y); w2_.y = cvtpk(xr.z, xr.w); *(LAS u32x2v_*)(shm + lch * A_CH + (512 + lg) * 16 + lhalf * 8) = w2_; } } while (0)
    { const int f = tid >> 2, d0 = (tid & 3) * 16; const float* wp = F.cmp_w2() + ((size_t)c * 128 + f) * 64 + d0;
      const f32x4 w0 = *(const f32x4*)wp, w1 = *(const f32x4*)(wp + 4), w2 = *(const f32x4*)(wp + 8), w3 = *(const f32x4*)(wp + 12);
      v4u o0, o1; o0.x = cvtpk(w0.x, w0.y); o0.y = cvtpk(w0.z, w0.w); o0.z = cvtpk(w1.x, w1.y); o0.w = cvtpk(w1.z, w1.w); o1.x = cvtpk(w2.x, w2.y); o1.y = cvtpk(w2.z, w2.w); o1.z = cvtpk(w3.x, w3.y); o1.w = cvtpk(w3.z, w3.w);
      LAS unsigned char* wd = shm + L_W2 + ((d0 >> 5) * 8 + (f >> 4)) * 1024 + (f & 15) * 64 + (d0 & 31) * 2; *(LAS v4u*)wd = o0; *(LAS v4u*)(wd + 16) = o1;
      if (tid < 128) { float pe = 0.f;
#pragma unroll
          for (int kc = 0; kc < 16; ++kc) pe += F.PEB()[(c * 16 + kc) * 128 + tid];
          ((LAS float*)(shm + L_BIAS))[tid] = F.cmp_b1()[c * 128 + tid] + pe; } }
    f32x16 acc[2][4];
#pragma unroll
    for (int rb = 0; rb < 2; ++rb)
#pragma unroll
        for (int fb = 0; fb < 4; ++fb) acc[rb][fb] = f32x16{};
    CG_LOAD(0); CG_STORE();
    asm volatile("s_waitcnt vmcnt(0) lgkmcnt(0)\n\ts_barrier" ::: "memory");
    for (int l = 0; l < 16; ++l) {
        if (l < 15) CG_LOAD(l + 1);
#pragma nounroll
        for (int u = 0; u < 2; ++u)
#pragma nounroll
            for (int kk = 0; kk < 4; ++kk) {
                bf16x8 xfr[2];
#pragma unroll
                for (int rb = 0; rb < 2; ++rb) xfr[rb] = *(const LAS bf16x8*)(shm + (2 * kk + hi) * A_CH + (64 * wid + 32 * rb + r32 + 4 * u) * 16);
#pragma unroll
                for (int fb = 0; fb < 4; ++fb) { const bf16x8 wf = *(const LAS bf16x8*)(shm + A_BYTES + (l & 1) * B_BYTES + u * 16384 + (2 * kk + hi) * 2048 + (32 * fb + r32) * 16);
                    acc[0][fb] = __builtin_amdgcn_mfma_f32_32x32x16_bf16(wf, xfr[0], acc[0][fb], 0, 0, 0); acc[1][fb] = __builtin_amdgcn_mfma_f32_32x32x16_bf16(wf, xfr[1], acc[1][fb], 0, 0, 0); }
            }
        asm volatile("s_waitcnt lgkmcnt(0)\n\ts_barrier" ::: "memory");
        if (l < 15) CG_STORE();
        asm volatile("s_waitcnt vmcnt(0) lgkmcnt(0)\n\ts_barrier" ::: "memory");
    }
    const LAS float* hb = (const LAS float*)(shm + L_BIAS);
    const unsigned vb = (unsigned)(uintptr_t)(shm + L_W2) + ((lane >> 4) & 1) * 32 + (lane & 3) * 8 + (4 * hi + ((lane & 15) >> 2)) * 64;
    float* dstb = (dec ? F.KCMPS() : F.KCMPP()) + (size_t)b * ncmp * 512 + c * 256;
    const float b2a = F.cmp_b2()[c * 64 + r32], b2b = F.cmp_b2()[c * 64 + 32 + r32];
#pragma unroll
    for (int rb = 0; rb < 2; ++rb) {
        f32x16 o[2]; o[0] = f32x16{}; o[1] = f32x16{};
#pragma unroll
        for (int fb = 0; fb < 4; ++fb) {
            float h[16];
#pragma unroll
            for (int r = 0; r < 16; ++r) { const float x = acc[rb][fb][r] + hb[32 * fb + (r & 3) + 8 * (r >> 2) + 4 * hi]; h[r] = x / (1.0f + __expf(-x)); }
#pragma unroll
            for (int s2 = 0; s2 < 2; ++s2) {
                v4u pw; pw.x = cvtpk(h[8 * s2], h[8 * s2 + 1]); pw.y = cvtpk(h[8 * s2 + 2], h[8 * s2 + 3]); pw.z = cvtpk(h[8 * s2 + 4], h[8 * s2 + 5]); pw.w = cvtpk(h[8 * s2 + 6], h[8 * s2 + 7]);
                const int ks = 2 * fb + s2;
#pragma unroll
                for (int d0 = 0; d0 < 2; ++d0) { s16x4 lo, hi4;
                    asm volatile("ds_read_b64_tr_b16 %0,%1 offset:%c2" : "=&v"(lo) : "v"(vb), "i"(d0 * 8192 + ks * 1024) : "memory");
                    asm volatile("ds_read_b64_tr_b16 %0,%1 offset:%c2" : "=&v"(hi4) : "v"(vb), "i"(d0 * 8192 + ks * 1024 + 512) : "memory");
                    asm volatile("s_waitcnt lgkmcnt(0)" ::: "memory"); __builtin_amdgcn_sched_barrier(0);
                    const bf16x8 wf = (bf16x8){lo[0], lo[1], lo[2], lo[3], hi4[0], hi4[1], hi4[2], hi4[3]};
                    o[d0] = __builtin_amdgcn_mfma_f32_32x32x16_bf16(__builtin_bit_cast(bf16x8, pw), wf, o[d0], 0, 0, 0); }
            }
        }
#pragma unroll
        for (int r = 0; r < 16; ++r) { const int R = 64 * wid + 32 * rb + (r & 3) + 8 * (r >> 2) + 4 * hi, n = n0 + (R >> 2), g = R & 3;
            if (n < ncmp) { float* d = dstb + (size_t)n * 512 + g * 64; d[r32] = o[0][r] + b2a; d[32 + r32] = o[1][r] + b2b; } }
    }
    asm volatile("s_waitcnt vmcnt(0) lgkmcnt(0)\n\ts_barrier" ::: "memory");
#undef CG_BASE
#undef CG_LOAD
#undef CG_STORE
}

__device__ __forceinline__ void small_unit(const Ctx& F, LAS unsigned char* shm, int u) {
    const int tid = threadIdx.x, lane = tid & 63, r32 = lane & 31, hi = lane >> 5; const int wid = __builtin_amdgcn_readfirstlane(tid >> 6);
    const int b = u >> 6, c = (u >> 5) & 1, n0 = 8 * (u & 31), fb = wid & 3, lh = wid >> 2;
    constexpr int L_W2S = 0, L_BS = 16384, L_PA = 20480, L_PO = 36864;
    { const int f = tid >> 2, d0 = (tid & 3) * 16; const float* wp = F.cmp_w2() + ((size_t)c * 128 + f) * 64 + d0;
      const f32x4 w0 = *(const f32x4*)wp, w1 = *(const f32x4*)(wp + 4), w2 = *(const f32x4*)(wp + 8), w3 = *(const f32x4*)(wp + 12);
      v4u o0, o1; o0.x = cvtpk(w0.x, w0.y); o0.y = cvtpk(w0.z, w0.w); o0.z = cvtpk(w1.x, w1.y); o0.w = cvtpk(w1.z, w1.w); o1.x = cvtpk(w2.x, w2.y); o1.y = cvtpk(w2.z, w2.w); o1.z = cvtpk(w3.x, w3.y); o1.w = cvtpk(w3.z, w3.w);
      LAS unsigned char* wd = shm + L_W2S + ((d0 >> 5) * 8 + (f >> 4)) * 1024 + (f & 15) * 64 + (d0 & 31) * 2; *(LAS v4u*)wd = o0; *(LAS v4u*)(wd + 16) = o1;
      if (tid < 128) { float pe = 0.f;
#pragma unroll
          for (int kc = 0; kc < 16; ++kc) pe += F.PEB()[(c * 16 + kc) * 128 + tid];
          ((LAS float*)(shm + L_BS))[tid] = F.cmp_b1()[c * 128 + tid] + pe; } }
    const int bi = r32 >> 2, g = r32 & 3;
    const float* xb = F.out() + O_KCP + (size_t)b * SEQ * 512 + c * 256 + g * 64 + hi * 8;
    const bf16* wb = F.W1T() + (size_t)c * 128 * 2048 + (size_t)(32 * fb + r32) * 2048 + hi * 8;
    f32x16 acc = f32x16{};
    for (int li = 0; li < 8; ++li) { const int l = 2 * li + lh;
#pragma unroll
        for (int uu = 0; uu < 2; ++uu) { int pos = 16 * (n0 + bi + uu) + l; pos = pos > SEQ - 1 ? SEQ - 1 : pos; const float* xr = xb + (size_t)pos * 512; const bf16* wr = wb + (l + 16 * uu) * 64;
#pragma unroll
            for (int kk = 0; kk < 4; ++kk) { const f32x4 x0 = *(const f32x4*)(xr + 16 * kk), x1 = *(const f32x4*)(xr + 16 * kk + 4);
                v4u xw; xw.x = cvtpk(x0.x, x0.y); xw.y = cvtpk(x0.z, x0.w); xw.z = cvtpk(x1.x, x1.y); xw.w = cvtpk(x1.z, x1.w);
                acc = __builtin_amdgcn_mfma_f32_32x32x16_bf16(*(const bf16x8*)(wr + 16 * kk), __builtin_bit_cast(bf16x8, xw), acc, 0, 0, 0); } } }
    LAS float* pa = (LAS float*)(shm + L_PA) + fb * 1024;
    if (lh == 1) {
#pragma unroll
        for (int r = 0; r < 16; ++r) pa[r * 64 + lane] = acc[r]; }
    asm volatile("s_waitcnt vmcnt(0) lgkmcnt(0)\n\ts_barrier" ::: "memory");
    LAS float* po = (LAS float*)(shm + L_PO) + fb * 2048;
    if (lh == 0) {
        const LAS float* hb = (const LAS float*)(shm + L_BS);
        const unsigned vb = (unsigned)(uintptr_t)(shm + L_W2S) + ((lane >> 4) & 1) * 32 + (lane & 3) * 8 + (4 * hi + ((lane & 15) >> 2)) * 64 + fb * 2048;
        float h[16];
#pragma unroll
        for (int r = 0; r < 16; ++r) { const float x = acc[r] + pa[r * 64 + lane] + hb[32 * fb + (r & 3) + 8 * (r >> 2) + 4 * hi]; h[r] = x / (1.0f + __expf(-x)); }
        f32x16 o[2]; o[0] = f32x16{}; o[1] = f32x16{};
#pragma unroll
        for (int s2 = 0; s2 < 2; ++s2) {
            v4u pw; pw.x = cvtpk(h[8 * s2], h[8 * s2 + 1]); pw.y = cvtpk(h[8 * s2 + 2], h[8 * s2 + 3]); pw.z = cvtpk(h[8 * s2 + 4], h[8 * s2 + 5]); pw.w = cvtpk(h[8 * s2 + 6], h[8 * s2 + 7]);
#pragma unroll
            for (int d0 = 0; d0 < 2; ++d0) { s16x4 lo, hi4;
                asm volatile("ds_read_b64_tr_b16 %0,%1 offset:%c2" : "=&v"(lo) : "v"(vb), "i"(d0 * 8192 + s2 * 1024) : "memory");
                asm volatile("ds_read_b64_tr_b16 %0,%1 offset:%c2" : "=&v"(hi4) : "v"(vb), "i"(d0 * 8192 + s2 * 1024 + 512) : "memory");
                asm volatile("s_waitcnt lgkmcnt(0)" ::: "memory"); __builtin_amdgcn_sched_barrier(0);
                const bf16x8 wf = (bf16x8){lo[0], lo[1], lo[2], lo[3], hi4[0], hi4[1], hi4[2], hi4[3]};
                o[d0] = __builtin_amdgcn_mfma_f32_32x32x16_bf16(__builtin_bit_cast(bf16x8, pw), wf, o[d0], 0, 0, 0); } }
#pragma unroll
        for (int r = 0; r < 16; ++r) { po[r * 64 + lane] = o[0][r]; po[1024 + r * 64 + lane] = o[1][r]; }
    }
    asm volatile("s_waitcnt vmcnt(0) lgkmcnt(0)\n\ts_barrier" ::: "memory");
#pragma unroll
    for (int e = 0; e < 4; ++e) { const int idx = e * 512 + tid, d0 = idx >> 10, r = (idx >> 6) & 15, ln = idx & 63; const LAS float* pp = (const LAS float*)(shm + L_PO) + d0 * 1024 + r * 64 + ln;
        const float v = (pp[0] + pp[2048]) + (pp[4096] + pp[6144]);
        const int R = (r & 3) + 8 * (r >> 2) + 4 * (ln >> 5), n = n0 + (R >> 2), gg = R & 3, d = 32 * d0 + (ln & 31);
        if (n < NCMP_P) F.KCMPP()[((size_t)(b * NCMP_P + n) * 2 + c) * 256 + gg * 64 + d] = v + F.cmp_b2()[c * 64 + d]; }
    asm volatile("s_waitcnt vmcnt(0) lgkmcnt(0)\n\ts_barrier" ::: "memory");
}
}
namespace ssd {
typedef short bf16x8 __attribute__((ext_vector_type(8)));
typedef short s16x4 __attribute__((ext_vector_type(4)));
typedef float f32x16 __attribute__((ext_vector_type(16)));
typedef float f32x2_t __attribute__((ext_vector_type(2))); typedef __bf16 bf16x2_t __attribute__((ext_vector_type(2)));
__device__ __forceinline__ unsigned cvtpk(float lo, float hi) { f32x2_t v = {lo, hi}; bf16x2_t b = __builtin_convertvector(v, bf16x2_t); return __builtin_bit_cast(unsigned, b); }
constexpr int L_B = 0, L_X = 65536, L_ACS = 98304, L_E = 99328, LDS_BYTES_SSD = 100352;
__device__ __forceinline__ int crow(int r, int hi) { return (r & 3) + 8 * (r >> 2) + 4 * hi; }
#define SSD_BAR() asm volatile("s_waitcnt vmcnt(0) lgkmcnt(0)\n\ts_barrier" ::: "memory")
__device__ __forceinline__ void local_unit(const Ctx& F, LAS unsigned char* shm, int u) {
    const int tid = threadIdx.x, lane = tid & 63, r32 = lane & 31, hi = lane >> 5; const int wid = __builtin_amdgcn_readfirstlane(tid >> 6);
    const int b = u >> 8, c = (u >> 4) & 15, h = u & 15, grp = h >> 3; const size_t m0 = (size_t)b * SEQ + c * 256;
    const bf16* XA = F.XBCA16() + m0 * CONV_DIM; const float* DTp = F.DT() + m0 * 16 + h;
    LAS float* acs = (LAS float*)(shm + L_ACS); LAS float* et = (LAS float*)(shm + L_E);
    const float A = -__expf(F.a_log()[h]);
    if (wid == 0) { float a[4], tot = 0.f;
#pragma unroll
        for (int e = 0; e < 4; ++e) { tot += DTp[(size_t)(4 * lane + e) * 16] * A; a[e] = tot; }
        float x = tot;
#pragma unroll
        for (int o = 1; o < 64; o <<= 1) { const float y = __shfl_up(x, o); if (lane >= o) x += y; }
        const float excl = x - tot;
#pragma unroll
        for (int e = 0; e < 4; ++e) { acs[4 * lane + e] = excl + a[e]; F.ACS()[(m0 + 4 * lane + e) * 16 + h] = excl + a[e]; }
        if (lane == 63) F.DEC()[(b * 16 + c) * 16 + h] = __expf(x); }
    { const int s = tid >> 1, hf = tid & 1; const bf16* br = XA + (size_t)s * CONV_DIM + 1024 + grp * 128 + hf * 64;
#pragma unroll
      for (int i = 0; i < 8; ++i) *(LAS v4u*)(shm + L_B + (hf * 8 + i) * 4096 + s * 16) = *(const v4u*)(br + 8 * i);
      const bf16* xr = XA + (size_t)s * CONV_DIM + h * 64 + hf * 32; const float dt = DTp[(size_t)s * 16];
      LAS unsigned char* xd = shm + L_X + (hf * 16 + (s >> 4)) * 1024 + (s & 15) * 64;
#pragma unroll
      for (int i = 0; i < 4; ++i) { const v4u t = *(const v4u*)(xr + 8 * i); v4u o;
          o.x = cvtpk(__uint_as_float(t.x << 16) * dt, __uint_as_float(t.x & 0xffff0000u) * dt); o.y = cvtpk(__uint_as_float(t.y << 16) * dt, __uint_as_float(t.y & 0xffff0000u) * dt);
          o.z = cvtpk(__uint_as_float(t.z << 16) * dt, __uint_as_float(t.z & 0xffff0000u) * dt); o.w = cvtpk(__uint_as_float(t.w << 16) * dt, __uint_as_float(t.w & 0xffff0000u) * dt);
          *(LAS v4u*)(xd + i * 16) = o; } }
    bf16x8 cf[8];
    { const bf16* cr = XA + (size_t)(32 * wid + r32) * CONV_DIM + 1280 + grp * 128 + hi * 8;
#pragma unroll
      for (int kk = 0; kk < 8; ++kk) cf[kk] = *(const bf16x8*)(cr + 16 * kk); }
    SSD_BAR();
    if (tid < 256) et[tid] = __expf(acs[255] - acs[tid]);
    const float acl = acs[32 * wid + r32];
    f32x16 o[2]; o[0] = f32x16{}; o[1] = f32x16{};
    const int jmax = (32 * wid + 31) >> 6, lrel = 32 * wid + r32;
    const unsigned vbx = (unsigned)(uintptr_t)(shm + L_X) + ((lane >> 4) & 1) * 32 + (lane & 3) * 8 + (4 * hi + ((lane & 15) >> 2)) * 64;
    for (int j = 0; j <= jmax; ++j) {
        f32x16 p0 = f32x16{}, p1 = f32x16{};
        const LAS unsigned char* kb = shm + L_B + hi * 4096 + (64 * j + r32) * 16;
#pragma unroll
        for (int kk = 0; kk < 8; ++kk) { const bf16x8 b0 = *(const LAS bf16x8*)(kb + kk * 8192), b1 = *(const LAS bf16x8*)(kb + kk * 8192 + 512);
            p0 = __builtin_amdgcn_mfma_f32_32x32x16_bf16(b0, cf[kk], p0, 0, 0, 0); p1 = __builtin_amdgcn_mfma_f32_32x32x16_bf16(b1, cf[kk], p1, 0, 0, 0); }
#pragma unroll
        for (int q = 0; q < 4; ++q) { const f32x4 a0 = *(const LAS f32x4*)(acs + 64 * j + 8 * q + 4 * hi), a1 = *(const LAS f32x4*)(acs + 64 * j + 32 + 8 * q + 4 * hi);
#pragma unroll
            for (int e = 0; e < 4; ++e) { const int r = 4 * q + e, s0 = 64 * j + 8 * q + 4 * hi + e;
                p0[r] = (s0 <= lrel) ? p0[r] * __expf(acl - a0[e]) : 0.f; p1[r] = (s0 + 32 <= lrel) ? p1[r] * __expf(acl - a1[e]) : 0.f; } }
        v4u pw0, pw1, pw2, pw3;
        pw0.x = cvtpk(p0[0], p0[1]); pw0.y = cvtpk(p0[2], p0[3]); pw0.z = cvtpk(p0[4], p0[5]); pw0.w = cvtpk(p0[6], p0[7]);
        pw1.x = cvtpk(p0[8], p0[9]); pw1.y = cvtpk(p0[10], p0[11]); pw1.z = cvtpk(p0[12], p0[13]); pw1.w = cvtpk(p0[14], p0[15]);
        pw2.x = cvtpk(p1[0], p1[1]); pw2.y = cvtpk(p1[2], p1[3]); pw2.z = cvtpk(p1[4], p1[5]); pw2.w = cvtpk(p1[6], p1[7]);
        pw3.x = cvtpk(p1[8], p1[9]); pw3.y = cvtpk(p1[10], p1[11]); pw3.z = cvtpk(p1[12], p1[13]); pw3.w = cvtpk(p1[14], p1[15]);
        const unsigned vb = vbx + j * 4096;
#pragma unroll
        for (int d0 = 0; d0 < 2; ++d0) { s16x4 lo[4], hi4[4];
#pragma unroll
            for (int ks = 0; ks < 4; ++ks) {
                asm volatile("ds_read_b64_tr_b16 %0,%1 offset:%c2" : "=&v"(lo[ks]) : "v"(vb), "i"(d0 * 16384 + ks * 1024) : "memory");
                asm volatile("ds_read_b64_tr_b16 %0,%1 offset:%c2" : "=&v"(hi4[ks]) : "v"(vb), "i"(d0 * 16384 + ks * 1024 + 512) : "memory"); }
            asm volatile("s_waitcnt lgkmcnt(0)" ::: "memory"); __builtin_amdgcn_sched_barrier(0);
#define SSD_PK(k) (bf16x8){lo[k][0], lo[k][1], lo[k][2], lo[k][3], hi4[k][0], hi4[k][1], hi4[k][2], hi4[k][3]}
            o[d0] = __builtin_amdgcn_mfma_f32_32x32x16_bf16(__builtin_bit_cast(bf16x8, pw0), SSD_PK(0), o[d0], 0, 0, 0);
            o[d0] = __builtin_amdgcn_mfma_f32_32x32x16_bf16(__builtin_bit_cast(bf16x8, pw1), SSD_PK(1), o[d0], 0, 0, 0);
            o[d0] = __builtin_amdgcn_mfma_f32_32x32x16_bf16(__builtin_bit_cast(bf16x8, pw2), SSD_PK(2), o[d0], 0, 0, 0);
            o[d0] = __builtin_amdgcn_mfma_f32_32x32x16_bf16(__builtin_bit_cast(bf16x8, pw3), SSD_PK(3), o[d0], 0, 0, 0);
#undef SSD_PK
        }
    }
#pragma unroll
    for (int r = 0; r < 16; ++r) { float* yp = F.YSSD() + (m0 + 32 * wid + crow(r, hi)) * 1024 + h * 64 + r32; yp[0] = o[0][r]; yp[32] = o[1][r]; }
    { const int pb = wid & 1, nb = wid >> 1; f32x16 st = f32x16{};
      const int li = lane & 15, g16 = (lane >> 4) & 1, c4 = li & 3;
      const unsigned vbB = (unsigned)(uintptr_t)(shm + L_B) + (4 * nb + 2 * g16 + (c4 >> 1)) * 4096 + (4 * hi + (li >> 2)) * 16 + (c4 & 1) * 8;
      const unsigned vbA = vbx + pb * 16384;
      SSD_BAR();
      for (int ks = 0; ks < 16; ++ks) { s16x4 xl, xh, bl, bh;
          asm volatile("ds_read_b64_tr_b16 %0,%1" : "=&v"(xl) : "v"(vbA + ks * 1024) : "memory");
          asm volatile("ds_read_b64_tr_b16 %0,%1 offset:512" : "=&v"(xh) : "v"(vbA + ks * 1024) : "memory");
          asm volatile("ds_read_b64_tr_b16 %0,%1" : "=&v"(bl) : "v"(vbB + ks * 256) : "memory");
          asm volatile("ds_read_b64_tr_b16 %0,%1 offset:128" : "=&v"(bh) : "v"(vbB + ks * 256) : "memory");
          const f32x4 e0 = *(const LAS f32x4*)(et + 16 * ks + 4 * hi), e1 = *(const LAS f32x4*)(et + 16 * ks + 8 + 4 * hi);
          asm volatile("s_waitcnt lgkmcnt(0)" ::: "memory"); __builtin_amdgcn_sched_barrier(0);
          v4u xa;
          xa.x = cvtpk(__uint_as_float((unsigned)(unsigned short)xl[0] << 16) * e0[0], __uint_as_float((unsigned)(unsigned short)xl[1] << 16) * e0[1]);
          xa.y = cvtpk(__uint_as_float((unsigned)(unsigned short)xl[2] << 16) * e0[2], __uint_as_float((unsigned)(unsigned short)xl[3] << 16) * e0[3]);
          xa.z = cvtpk(__uint_as_float((unsigned)(unsigned short)xh[0] << 16) * e1[0], __uint_as_float((unsigned)(unsigned short)xh[1] << 16) * e1[1]);
          xa.w = cvtpk(__uint_as_float((unsigned)(unsigned short)xh[2] << 16) * e1[2], __uint_as_float((unsigned)(unsigned short)xh[3] << 16) * e1[3]);
          const bf16x8 bfr = (bf16x8){bl[0], bl[1], bl[2], bl[3], bh[0], bh[1], bh[2], bh[3]};
          st = __builtin_amdgcn_mfma_f32_32x32x16_bf16(__builtin_bit_cast(bf16x8, xa), bfr, st, 0, 0, 0); }
      float* sp = F.ST() + ((size_t)((b * 16 + c) * 16 + h)) * 8192 + 32 * nb + r32;
#pragma unroll
      for (int r = 0; r < 16; ++r) sp[(size_t)(32 * pb + crow(r, hi)) * 128] = st[r]; }
    SSD_BAR();
}

__device__ __forceinline__ void final_unit(const Ctx& F, LAS unsigned char* shm, int u) {
    const int tid = threadIdx.x, lane = tid & 63, r32 = lane & 31, hi = lane >> 5; const int wid = __builtin_amdgcn_readfirstlane(tid >> 6);
    const int qq = u & 3, grp = (u >> 2) & 1, c = (u >> 3) & 15, b = u >> 7, h = 8 * grp + wid; const size_t m0 = (size_t)b * SEQ + c * 256 + qq * 64;
    f32x16 acc[2][2];
#pragma unroll
    for (int pb = 0; pb < 2; ++pb) {
        bf16x8 sfr[8];
        { int lane_o = lane; asm volatile("" : "+v"(lane_o));
          const bf16* sp = F.SIN() + ((size_t)((b * 16 + c) * 16 + h) * 16 + pb * 8) * 512 + lane_o * 8;
#pragma unroll
          for (int kk = 0; kk < 8; ++kk) sfr[kk] = *(const bf16x8*)(sp + kk * 512); }
#pragma unroll
        for (int lb = 0; lb < 2; ++lb) { const bf16* cr = F.XBCA16() + (m0 + 32 * lb + r32) * CONV_DIM + 1280 + grp * 128 + hi * 8; f32x16 a = f32x16{};
#pragma unroll
            for (int kk = 0; kk < 8; ++kk) a = __builtin_amdgcn_mfma_f32_32x32x16_bf16(*(const bf16x8*)(cr + 16 * kk), sfr[kk], a, 0, 0, 0);
            acc[lb][pb] = a; }
    }
    LAS float* yt = (LAS float*)shm;
#pragma unroll
    for (int lb = 0; lb < 2; ++lb)
#pragma unroll
        for (int r = 0; r < 16; ++r) { LAS float* yp = yt + (32 * lb + crow(r, hi)) * 512 + wid * 64 + r32; yp[0] = acc[lb][0][r]; yp[32] = acc[lb][1][r]; }
    SSD_BAR();
    { const int hl = lane >> 3, hh = 8 * grp + hl, ch = hh * 64 + 8 * (lane & 7);
      const float Dk = F.d_skip()[hh]; const f32x4 n0 = *(const f32x4*)(F.ssm_norm() + ch), n1 = *(const f32x4*)(F.ssm_norm() + ch + 4);
#pragma unroll
      for (int half = 0; half < 2; ++half) {
          f32x4 yd[4][2], zz[4][2]; v4u xx[4]; float ea[4];
#pragma unroll
          for (int i = 0; i < 4; ++i) { const size_t mm = m0 + 8 * wid + 4 * half + i;
              yd[i][0] = *(const f32x4*)(F.YSSD() + mm * 1024 + ch); yd[i][1] = *(const f32x4*)(F.YSSD() + mm * 1024 + ch + 4); zz[i][0] = *(const f32x4*)(F.Z() + mm * 1024 + ch); zz[i][1] = *(const f32x4*)(F.Z() + mm * 1024 + ch + 4);
              xx[i] = *(const v4u*)(F.XBCA16() + mm * CONV_DIM + ch); ea[i] = __expf(F.ACS()[mm * 16 + hh]); }
#pragma unroll
          for (int i = 0; i < 4; ++i) { const int row = 8 * wid + 4 * half + i; const size_t mm = m0 + row;
              const f32x4 a0 = *(const LAS f32x4*)(yt + row * 512 + hl * 64 + 8 * (lane & 7)), a1 = *(const LAS f32x4*)(yt + row * 512 + hl * 64 + 8 * (lane & 7) + 4);
              float v[8] = {a0.x, a0.y, a0.z, a0.w, a1.x, a1.y, a1.z, a1.w};
              const float xv[8] = {__uint_as_float(xx[i].x << 16), __uint_as_float(xx[i].x & 0xffff0000u), __uint_as_float(xx[i].y << 16), __uint_as_float(xx[i].y & 0xffff0000u), __uint_as_float(xx[i].z << 16), __uint_as_float(xx[i].z & 0xffff0000u), __uint_as_float(xx[i].w << 16), __uint_as_float(xx[i].w & 0xffff0000u)};
              const float yv[8] = {yd[i][0].x, yd[i][0].y, yd[i][0].z, yd[i][0].w, yd[i][1].x, yd[i][1].y, yd[i][1].z, yd[i][1].w}, zv[8] = {zz[i][0].x, zz[i][0].y, zz[i][0].z, zz[i][0].w, zz[i][1].x, zz[i][1].y, zz[i][1].z, zz[i][1].w};
              float ss = 0.f;
#pragma unroll
              for (int e = 0; e < 8; ++e) { float y = v[e] * ea[i] + yv[e] + Dk * xv[e]; y *= zv[e] / (1.0f + __expf(-zv[e])); v[e] = y; ss += y * y; }
              const float rstd = 1.0f / sqrtf(wave_sum(ss) * (1.0f / 512.0f) + NORM_EPS);
              v4u w; w.x = cvtpk(v[0] * rstd * n0.x, v[1] * rstd * n0.y); w.y = cvtpk(v[2] * rstd * n0.z, v[3] * rstd * n0.w); w.z = cvtpk(v[4] * rstd * n1.x, v[5] * rstd * n1.y); w.w = cvtpk(v[6] * rstd * n1.z, v[7] * rstd * n1.w);
              *(v4u*)(F.MIX() + mm * DM + 1024 + ch) = w; } } }
    SSD_BAR();
}


__device__ __forceinline__ void carry_phase(const Ctx& F) {
    const int gt = blockIdx.x * (NWAVES * 64) + threadIdx.x, NGT = gridDim.x * NWAVES * 64;
    for (int i = gt; i < NB * 16 * 64 * 16; i += NGT) { const int n8 = i & 15, p = (i >> 4) & 63, h = (i >> 10) & 15, b = i >> 14;
        const int pb = p >> 5, kk = n8 >> 1, ln = (n8 & 1) * 32 + (p & 31);
        float sv[8] = {0.f, 0.f, 0.f, 0.f, 0.f, 0.f, 0.f, 0.f};
        for (int c = 0; c < 16; ++c) { const size_t ci = (size_t)(b * 16 + c) * 16 + h;
            v4u w; w.x = cvtpk(sv[0], sv[1]); w.y = cvtpk(sv[2], sv[3]); w.z = cvtpk(sv[4], sv[5]); w.w = cvtpk(sv[6], sv[7]);
            *(v4u*)(F.SIN() + ((ci * 16 + pb * 8 + kk) * 64 + ln) * 8) = w;
            const float dec = F.DEC()[ci]; const float* sp = F.ST() + ci * 8192 + (size_t)p * 128 + n8 * 8; const f32x4 a = *(const f32x4*)sp, d = *(const f32x4*)(sp + 4);
            sv[0] = sv[0] * dec + a.x; sv[1] = sv[1] * dec + a.y; sv[2] = sv[2] * dec + a.z; sv[3] = sv[3] * dec + a.w; sv[4] = sv[4] * dec + d.x; sv[5] = sv[5] * dec + d.y; sv[6] = sv[6] * dec + d.z; sv[7] = sv[7] * dec + d.w; }
        float* op = F.out() + O_SSP + ((size_t)(b * 16 + h) * 64 + p) * 128 + n8 * 8;
        *(f32x4*)op = (f32x4){sv[0], sv[1], sv[2], sv[3]}; *(f32x4*)(op + 4) = (f32x4){sv[4], sv[5], sv[6], sv[7]}; }
}
}
namespace cmpa {
using fa::bf16x8; using fa::f32x16;
constexpr int LK = 0, LV = 32768, LPS = 65536, PS_W = 8 * 264 * 4, IMP_W = 8 * 64 * 4, WAVE_B = PS_W + IMP_W;
static_assert(LPS + 8 * WAVE_B <= RING_BYTES, "cmpa LDS");
__device__ __forceinline__ float quad_sum(float v) {
    v += __int_as_float(__builtin_amdgcn_mov_dpp(__float_as_int(v), 0xB1, 0xF, 0xF, true));
    v += __int_as_float(__builtin_amdgcn_mov_dpp(__float_as_int(v), 0x4E, 0xF, 0xF, true));
    return v; }
__device__ __forceinline__ void unit(const Ctx& F, LAS unsigned char* shm, int b, int g, int qb) {
    const int tid = threadIdx.x, lane = tid & 63, r32 = lane & 31, hi = lane >> 5; const int wid = __builtin_amdgcn_readfirstlane(tid >> 6);
    const int ntile = (4 * qb + 3 + 63) >> 6;
    const float* KC = F.KCMPP() + (size_t)b * NCMP_P * 512 + g * 64;
    for (int t = 0; t < ntile; ++t) {
        int nk = 64 * t + lane; nk = nk > NCMP_P - 1 ? NCMP_P - 1 : nk; const float* kp = KC + (size_t)nk * 512 + wid * 8; const f32x4 k0 = *(const f32x4*)kp, k1 = *(const f32x4*)(kp + 4);
        v4u kw; kw.x = fa::cvtpk(k0.x, k0.y); kw.y = fa::cvtpk(k0.z, k0.w); kw.z = fa::cvtpk(k1.x, k1.y); kw.w = fa::cvtpk(k1.z, k1.w);
        *(LAS v4u*)(shm + LK + t * 8192 + wid * 1024 + lane * 16) = kw;
        int nv = 64 * t + 16 * (wid & 3) + (lane >> 2); nv = nv > NCMP_P - 1 ? NCMP_P - 1 : nv; const float* vp = KC + 256 + (size_t)nv * 512 + (wid >> 2) * 32 + (lane & 3) * 8; const f32x4 v0 = *(const f32x4*)vp, v1 = *(const f32x4*)(vp + 4);
        v4u vw; vw.x = fa::cvtpk(v0.x, v0.y); vw.y = fa::cvtpk(v0.z, v0.w); vw.z = fa::cvtpk(v1.x, v1.y); vw.w = fa::cvtpk(v1.z, v1.w);
        *(LAS v4u*)(shm + LV + t * 8192 + wid * 1024 + lane * 16) = vw; }
    const int tl = r32 >> 2, hd = 4 * g + (r32 & 3), t = 64 * qb + 8 * wid + tl; const size_t m = (size_t)b * SEQ + t;
    bf16x8 qr[4];
    { const bf16* Qp = F.QB() + m * 1024 + hd * 64 + hi * 8;
#pragma unroll
      for (int d0 = 0; d0 < 4; ++d0) qr[d0] = *(const bf16x8*)(Qp + 16 * d0); }
    FA_BAR();
    const int nvis = t >= 31 ? ((t - 31) >> 4) + 1 : 0;
    float mx = fa::MASKV, lsum = 0.f;
    for (int tt = 0; tt < ntile; ++tt) { f32x16 p0, p1; fa::qkt(p0, p1, shm + LK + tt * 8192, qr, r32, hi);
#pragma unroll
        for (int r = 0; r < 16; ++r) { const int n0 = 64 * tt + fa::crow(r, hi); p0[r] = n0 < nvis ? p0[r] * fa::C2 : fa::MASKV; p1[r] = n0 + 32 < nvis ? p1[r] * fa::C2 : fa::MASKV; }
        const float mn = fmaxf(mx, fa::rowmax(p0, p1)); float acc = 0.f;
#pragma unroll
        for (int r = 0; r < 16; ++r) { const int n0 = 64 * tt + fa::crow(r, hi); acc += (n0 < nvis ? __builtin_amdgcn_exp2f(p0[r] - mn) : 0.f) + (n0 + 32 < nvis ? __builtin_amdgcn_exp2f(p1[r] - mn) : 0.f); }
        lsum = lsum * __builtin_amdgcn_exp2f(mx - mn) + acc; mx = mn; }
    lsum = fa::xsum(lsum); const float inv = 1.0f / fmaxf(lsum, 1e-30f);
    LAS float* ps = (LAS float*)(shm + LPS + wid * WAVE_B); LAS float* impl = (LAS float*)(shm + LPS + wid * WAVE_B + PS_W);
    for (int i = lane; i < 8 * 264; i += 64) ps[i] = 0.f;
    asm volatile("s_waitcnt lgkmcnt(0)" ::: "memory");
    f32x16 o[2]; o[0] = f32x16{}; o[1] = f32x16{};
    const unsigned vb0 = (unsigned)(uintptr_t)(shm + LV) + ((lane >> 4) & 1) * 32 + (lane & 3) * 8 + (4 * hi + ((lane & 15) >> 2)) * 64;
    for (int tt = 0; tt < ntile; ++tt) { f32x16 p0, p1; fa::qkt(p0, p1, shm + LK + tt * 8192, qr, r32, hi);
#pragma unroll
        for (int r = 0; r < 16; ++r) { const int n0 = 64 * tt + fa::crow(r, hi); p0[r] = n0 < nvis ? __builtin_amdgcn_exp2f(p0[r] * fa::C2 - mx) * inv : 0.f; p1[r] = n0 + 32 < nvis ? __builtin_amdgcn_exp2f(p1[r] * fa::C2 - mx) * inv : 0.f; }
        v4u pw0, pw1, pw2, pw3;
        pw0.x = fa::cvtpk(p0[0], p0[1]); pw0.y = fa::cvtpk(p0[2], p0[3]); pw0.z = fa::cvtpk(p0[4], p0[5]); pw0.w = fa::cvtpk(p0[6], p0[7]);
        pw1.x = fa::cvtpk(p0[8], p0[9]); pw1.y = fa::cvtpk(p0[10], p0[11]); pw1.z = fa::cvtpk(p0[12], p0[13]); pw1.w = fa::cvtpk(p0[14], p0[15]);
        pw2.x = fa::cvtpk(p1[0], p1[1]); pw2.y = fa::cvtpk(p1[2], p1[3]); pw2.z = fa::cvtpk(p1[4], p1[5]); pw2.w = fa::cvtpk(p1[6], p1[7]);
        pw3.x = fa::cvtpk(p1[8], p1[9]); pw3.y = fa::cvtpk(p1[10], p1[11]); pw3.z = fa::cvtpk(p1[12], p1[13]); pw3.w = fa::cvtpk(p1[14], p1[15]);
        fa::pv(o, vb0 + tt * 8192, __builtin_bit_cast(bf16x8, pw0), __builtin_bit_cast(bf16x8, pw1), __builtin_bit_cast(bf16x8, pw2), __builtin_bit_cast(bf16x8, pw3));
#pragma unroll
        for (int r = 0; r < 16; ++r) { const float s0 = quad_sum(p0[r]), s1 = quad_sum(p1[r]);
            if ((r32 & 3) == (tt & 3)) { const int n0 = 64 * tt + fa::crow(r, hi); ps[tl * 264 + 1 + n0] = s0; ps[tl * 264 + 1 + n0 + 32] = s1; } } }
#pragma unroll
    for (int r = 0; r < 16; ++r) { const int q = fa::crow(r, hi); float* op = F.OCMP() + ((size_t)b * SEQ + 64 * qb + 8 * wid + (q >> 2)) * 1024 + (4 * g + (q & 3)) * 64 + r32; op[0] = o[0][r]; op[32] = o[1][r]; }
    asm volatile("s_waitcnt lgkmcnt(0)" ::: "memory");
    const int tk = lane >> 3, jsub = lane & 7; float mine[8];
#pragma unroll
    for (int k = 0; k < 8; ++k) { const int j = jsub + 8 * k; const LAS float* pp = ps + tk * 264 + 4 * j;
        float v = pp[0] + 2.0f * (pp[1] + pp[2] + pp[3]) + pp[4];
        if (j == 0 || j == qb || j == qb - 1) v = 1.0e4f; if (j > qb) v = -1.0e4f;
        mine[k] = v; impl[tk * 64 + j] = v; }
    asm volatile("s_waitcnt lgkmcnt(0)" ::: "memory");
    int cnt[8];
#pragma unroll
    for (int k = 0; k < 8; ++k) cnt[k] = 0;
    for (int i4 = 0; i4 < 16; ++i4) { const f32x4 vv = *(const LAS f32x4*)(impl + tk * 64 + 4 * i4);
#pragma unroll
        for (int e = 0; e < 4; ++e) { const float v = vv[e]; const int kk = 4 * i4 + e;
#pragma unroll
            for (int k = 0; k < 8; ++k) { const int j = jsub + 8 * k; cnt[k] += ((v > mine[k]) || (v == mine[k] && kk < j)) ? 1 : 0; } } }
    unsigned mlo = 0u, mhi = 0u;
#pragma unroll
    for (int k = 0; k < 8; ++k) { if (cnt[k] < 16) { const int j = jsub + 8 * k; if (j < 32) mlo |= 1u << j; else mhi |= 1u << (j - 32); } }
#pragma unroll
    for (int o2 = 1; o2 < 8; o2 <<= 1) { mlo |= (unsigned)__shfl_xor((int)mlo, o2); mhi |= (unsigned)__shfl_xor((int)mhi, o2); }
    if (jsub == 0) F.SELMASK()[((size_t)b * SEQ + 64 * qb + 8 * wid + tk) * 4 + g] = ((unsigned long long)mhi << 32) | mlo;
    FA_BAR();
}
__device__ __forceinline__ void phase(const Ctx& F, LAS unsigned char* shm) {
    for (int u = blockIdx.x; u < NB * 4 * 64; u += gridDim.x) { const int bg = u >> 6; int qb = u & 63; qb = (u >= 256) ? 63 - qb : qb; unit(F, shm, bg >> 2, bg & 3, qb); }
}
}
namespace sk {
typedef short bf16x8 __attribute__((ext_vector_type(8)));
typedef float f32x16 __attribute__((ext_vector_type(16)));
__device__ __forceinline__ int crow(int r, int hi) { return (r & 3) + 8 * (r >> 2) + 4 * hi; }
__device__ __forceinline__ float half_sum(float v) {
#pragma unroll
    for (int o = 1; o < 32; o <<= 1) v += __shfl_xor(v, o);
    return v; }
#define SK_BAR() asm volatile("s_waitcnt vmcnt(0) lgkmcnt(0)\n\ts_barrier" ::: "memory")
template <class Epi>
__device__ __forceinline__ void phase(LAS unsigned char* shm, const bf16* A, const bf16* Bt, int N, int K, int wg_rel, int nwg, const Epi& E) {
    const int tid = threadIdx.x, lane = tid & 63, r32 = lane & 31, hi = lane >> 5; const int wid = __builtin_amdgcn_readfirstlane(tid >> 6);
    const int ks = K >> 3; LAS float* red = (LAS float*)shm;
    for (int blk = wg_rel; blk < (N >> 5); blk += nwg) {
        const bf16* ap = A + (size_t)r32 * K + wid * ks + hi * 8; const bf16* bp = Bt + (size_t)(blk * 32 + r32) * K + wid * ks + hi * 8;
        f32x16 acc = f32x16{};
        for (int k = 0; k < ks; k += 256) { bf16x8 a[16], b[16];
#pragma unroll
            for (int i = 0; i < 16; ++i) { a[i] = *(const bf16x8*)(ap + k + 16 * i); b[i] = *(const bf16x8*)(bp + k + 16 * i); }
#pragma unroll
            for (int i = 0; i < 16; ++i) acc = __builtin_amdgcn_mfma_f32_32x32x16_bf16(a[i], b[i], acc, 0, 0, 0); }
#pragma unroll
        for (int r = 0; r < 16; ++r) red[(wid * 16 + r) * 64 + lane] = acc[r];
        SK_BAR();
        float v0 = 0.f, v1 = 0.f;
#pragma unroll
        for (int w = 0; w < 8; ++w) { v0 += red[(w * 16 + 2 * wid) * 64 + lane]; v1 += red[(w * 16 + 2 * wid + 1) * 64 + lane]; }
        E(blk, blk * 32 + r32, crow(2 * wid, hi), v0, crow(2 * wid + 1, hi), v1, r32);
        SK_BAR();
    }
}
struct EpiInS { bf16 *QB, *KVB; size_t kvstride; float *Z, *XBC, *GD, *out;
    __device__ __forceinline__ void one(int cp, int row, float v) const { const size_t m = (size_t)MPROMPT + row;
        if (cp < 1024) QB[m * 1024 + cp] = (bf16)f2bf(v);
        else if (cp < 2560) { const int which = (cp - 1024) >> 9, cc = (cp - 1024) & 511; KVB[(size_t)which * kvstride + m * 512 + cc] = (bf16)f2bf(v);
            float* fo = which == 0 ? out + O_KCS + (size_t)row * 512 : (which == 1 ? out + O_KSS + (size_t)row * 512 : out + O_KWS + (size_t)(row * 512 + 511) * 512); fo[cc] = v; }
        else if (cp < 3584) Z[m * 1024 + cp - 2560] = v;
        else if (cp < 5120) XBC[m * CONV_DIM + cp - 3584] = v;
        else if (cp < 5168) GD[m * 64 + cp - 5120] = 1.0f / (1.0f + __expf(-v));
        else if (cp < NCOLS_IN) GD[m * 64 + cp - 5120] = v; }
    __device__ __forceinline__ void operator()(int, int col, int r0, float v0, int r1, float v1, int) const { one(col, r0, v0); one(col, r1, v1); } };
struct EpiResS { const float* xres; float* X1; bf16* X1B; float* SS;
    __device__ __forceinline__ void operator()(int blk, int col, int r0, float v0, int r1, float v1, int r32) const {
        v0 += xres[(size_t)r0 * DM + col]; v1 += xres[(size_t)r1 * DM + col]; X1[(size_t)r0 * DM + col] = v0; X1[(size_t)r1 * DM + col] = v1;
        if (X1B) { X1B[(size_t)r0 * DM + col] = (bf16)f2bf(v0); X1B[(size_t)r1 * DM + col] = (bf16)f2bf(v1); }
        const float s0 = half_sum(v0 * v0), s1 = half_sum(v1 * v1); if (r32 == 0) { SS[r0 * 64 + blk] = s0; SS[r1 * 64 + blk] = s1; } } };
struct EpiUpS { bf16* H; const LAS float* rs;
    __device__ __forceinline__ void operator()(int, int col, int r0, float v0, int r1, float v1, int) const {
        float a = fmaxf(v0 * rs[r0], 0.f), b = fmaxf(v1 * rs[r1], 0.f); H[(size_t)r0 * DFF + col] = (bf16)f2bf(a * a); H[(size_t)r1 * DFF + col] = (bf16)f2bf(b * b); } };
}
namespace deca {
constexpr int L_QS = 0, L_SC = 1024, L_PART = 17408, L_PS = 25600, L_IMP = 27776;
#define DA_BAR() asm volatile("s_waitcnt vmcnt(0) lgkmcnt(0)\n\ts_barrier" ::: "memory")
__device__ __forceinline__ void load_row(const KeyRef& kr, const void* p, float (&k)[64]) {
    if (kr.f32) { const f32x4* q = (const f32x4*)p;
#pragma unroll
        for (int i = 0; i < 16; ++i) { const f32x4 t = q[i]; k[4 * i] = t.x; k[4 * i + 1] = t.y; k[4 * i + 2] = t.z; k[4 * i + 3] = t.w; } }
    else { const v4u* q = (const v4u*)p;
#pragma unroll
        for (int i = 0; i < 8; ++i) { const v4u t = q[i]; k[8 * i] = __uint_as_float(t.x << 16); k[8 * i + 1] = __uint_as_float(t.x & 0xffff0000u); k[8 * i + 2] = __uint_as_float(t.y << 16); k[8 * i + 3] = __uint_as_float(t.y & 0xffff0000u);
            k[8 * i + 4] = __uint_as_float(t.z << 16); k[8 * i + 5] = __uint_as_float(t.z & 0xffff0000u); k[8 * i + 6] = __uint_as_float(t.w << 16); k[8 * i + 7] = __uint_as_float(t.w & 0xffff0000u); } }
}
template <int NCH, int MODE, class KF>
__device__ __forceinline__ void unit(const Ctx& F, LAS unsigned char* shm, int m, int g, const KF& kf) {
    const int tid = threadIdx.x, lane = tid & 63; const int wid = __builtin_amdgcn_readfirstlane(tid >> 6);
    LAS float* qs = (LAS float*)(shm + L_QS); LAS float* sc = (LAS float*)(shm + L_SC); LAS float* part = (LAS float*)(shm + L_PART);
    constexpr int NK = NCH * 64, CPW = NCH / 8;
    if (tid < 256) qs[tid] = bf2f(F.QB()[(size_t)m * 1024 + g * 256 + tid]) * 0.125f;
    DA_BAR();
#pragma unroll
    for (int i = 0; i < CPW; ++i) { const int c = wid + 8 * i; const KeyRef kr = kf(c, lane); float s[4] = {-INFINITY, -INFINITY, -INFINITY, -INFINITY};
        if (kr.valid) { float k[64]; load_row(kr, kr.k, k);
#pragma unroll
            for (int h = 0; h < 4; ++h) { float a = 0.f;
#pragma unroll
                for (int d4 = 0; d4 < 16; ++d4) { const f32x4 q4 = *(const LAS f32x4*)(qs + h * 64 + 4 * d4); a += q4.x * k[4 * d4] + q4.y * k[4 * d4 + 1] + q4.z * k[4 * d4 + 2] + q4.w * k[4 * d4 + 3]; }
                s[h] = a; } }
#pragma unroll
        for (int h = 0; h < 4; ++h) sc[h * NK + c * 64 + lane] = s[h]; }
    DA_BAR();
    float mh[4], ih[4];
#pragma unroll
    for (int h = 0; h < 4; ++h) { float mx = -INFINITY;
        for (int c = 0; c < NCH; ++c) mx = fmaxf(mx, sc[h * NK + c * 64 + lane]);
        mx = wave_max(mx); if (mx == -INFINITY) mx = 0.f;
        float sm = 0.f;
        for (int c = 0; c < NCH; ++c) sm += __expf(sc[h * NK + c * 64 + lane] - mx);
        sm = wave_sum(sm); mh[h] = mx; ih[h] = 1.0f / fmaxf(sm, 1e-30f); }
    DA_BAR();
#pragma unroll
    for (int i = 0; i < CPW; ++i) { const int c = wid + 8 * i;
#pragma unroll
        for (int h = 0; h < 4; ++h) sc[h * NK + c * 64 + lane] = __expf(sc[h * NK + c * 64 + lane] - mh[h]) * ih[h]; }
#pragma unroll
    for (int h = 0; h < 4; ++h) { float a0[64];
#pragma unroll
        for (int d = 0; d < 64; ++d) a0[d] = 0.f;
#pragma unroll
        for (int i = 0; i < CPW; ++i) { const int c = wid + 8 * i; const KeyRef kr = kf(c, lane);
            if (kr.valid) { const float p0 = sc[h * NK + c * 64 + lane];
                if (kr.f32) { const f32x4* p = (const f32x4*)kr.v;
#pragma unroll
                    for (int j = 0; j < 16; ++j) { const f32x4 t = p[j]; a0[4 * j] += p0 * t.x; a0[4 * j + 1] += p0 * t.y; a0[4 * j + 2] += p0 * t.z; a0[4 * j + 3] += p0 * t.w; } }
                else { const v4u* p = (const v4u*)kr.v;
#pragma unroll
                    for (int j = 0; j < 8; ++j) { const v4u t = p[j]; a0[8 * j] += p0 * __uint_as_float(t.x << 16); a0[8 * j + 1] += p0 * __uint_as_float(t.x & 0xffff0000u); a0[8 * j + 2] += p0 * __uint_as_float(t.y << 16); a0[8 * j + 3] += p0 * __uint_as_float(t.y & 0xffff0000u);
                        a0[8 * j + 4] += p0 * __uint_as_float(t.z << 16); a0[8 * j + 5] += p0 * __uint_as_float(t.z & 0xffff0000u); a0[8 * j + 6] += p0 * __uint_as_float(t.w << 16); a0[8 * j + 7] += p0 * __uint_as_float(t.w & 0xffff0000u); } } } }
        part[(wid * 4 + h) * 64 + lane] = wave_reduce_t64(a0, lane); }
    DA_BAR();
    if (tid < 256) { const int h = tid >> 6, d = tid & 63; float o = 0.f;
#pragma unroll
        for (int w = 0; w < 8; ++w) o += part[(w * 4 + h) * 64 + d];
        const int hd = g * 4 + h; const size_t oi = (size_t)m * 1024 + hd * 64 + d;
        if (MODE == 0) F.OCMP()[oi] = o;
        else if (MODE == 1) F.OWIN()[oi] = o;
        else { const float* gt = F.GD() + (size_t)m * 64 + hd * 3; F.MIX()[(size_t)m * DM + hd * 64 + d] = (bf16)f2bf(gt[0] * F.OCMP()[oi] + gt[1] * o + gt[2] * F.OWIN()[oi]); } }
    if (MODE == 0 && wid == 0) {
        LAS float* ps = (LAS float*)(shm + L_PS); LAS float* imp = (LAS float*)(shm + L_IMP);
        for (int i = lane; i < 544; i += 64) ps[i] = 0.f;
        for (int c = 0; c < NCH; ++c) ps[1 + c * 64 + lane] = (sc[c * 64 + lane] + sc[NK + c * 64 + lane]) + (sc[2 * NK + c * 64 + lane] + sc[3 * NK + c * 64 + lane]);
        constexpr int nslc = NSLC_S, jt = PAST >> 6; float mine[3]; int cnt[3];
#pragma unroll
        for (int jj = 0; jj < 3; ++jj) { const int j = jj * 64 + lane; float v = 0.f; cnt[jj] = 0;
            if (j < nslc) { v = ps[4 * j] + 2.0f * (ps[4 * j + 1] + ps[4 * j + 2] + ps[4 * j + 3]) + ps[4 * j + 4]; if (j == 0 || j == jt || j == jt - 1) v = 1.0e4f; if (j > jt) v = -1.0e4f; imp[j] = v; }
            mine[jj] = v; }
        for (int k = 0; k < nslc; ++k) { const float v = imp[k];
#pragma unroll
            for (int jj = 0; jj < 3; ++jj) { const int j = jj * 64 + lane; cnt[jj] += ((v > mine[jj]) || (v == mine[jj] && k < j)) ? 1 : 0; } }
        int base = 0; const size_t task = (size_t)m * 4 + g;
#pragma unroll
        for (int jj = 0; jj < 3; ++jj) { const int j = jj * 64 + lane; const bool sel = (j < nslc) && (cnt[jj] < 16); const unsigned long long bal = __ballot(sel);
            if (sel) F.SELIDX()[task * 16 + base + __popcll(bal & ((1ull << lane) - 1ull))] = j;
            base += __popcll(bal); } }
    DA_BAR();
}
}
struct Args { const void* in[26]; float* out; unsigned char* ws; int ph_lo, ph_hi, li, pad; };
__global__ void __launch_bounds__(NWAVES * 64, 2) fwd_kernel(Args args) {
    extern __shared__ __attribute__((aligned(16))) unsigned char lds[];
    Ctx F;
    F.lds = (LAS unsigned char*)lds; F.MISC = (volatile LAS unsigned*)(F.lds + MISC_OFF);
    F.tid = threadIdx.x; F.lane = F.tid & 63; F.wave = __builtin_amdgcn_readfirstlane(F.tid >> 6);
    F.G = gridDim.x; { const int bx = blockIdx.x; F.vcu = (F.G % 8 == 0) ? (bx % 8) * (F.G / 8) + bx / 8 : bx; }
    F.ka = (const __attribute__((address_space(4))) unsigned long long*)__builtin_amdgcn_kernarg_segment_ptr();
    F.ctl = (gu32*)(F.ws() + WS_CTL);
    for (int u = F.tid; u < (LDS_BYTES - LDSCTL_OFF) / 4; u += NWAVES * 64) ((LAS unsigned*)(F.lds + LDSCTL_OFF))[u] = 0u;
    __syncthreads();
    XcdBarrier bar; bar.bar = (unsigned*)(F.ctl + CW_BAR); bar.x = 0; bar.st = nullptr;
    if (N_LAUNCHES == 1) bar = xcd_barrier_post((unsigned*)(F.ctl + CW_BAR), F.MISC + 8);
#ifdef PROBE_DBLBAR
#define PROBE_EXTRA_BAR xcd_barrier(bar);
#else
#define PROBE_EXTRA_BAR
#endif
#define GRID_BAR(seam) do { if (N_LAUNCHES != 1) { if (F.tid == 0) __hip_atomic_store(F.ctl + CW_TMO, 0xBADBA0u | (unsigned)(seam), RLX_AGENT); } else { xcd_barrier(bar); PROBE_EXTRA_BAR } } while (0)
    const int lo = args.ph_lo, hi = args.ph_hi;
#define IN(k) (lo <= (k) && (k) < hi)
#define BOTH(k) (IN(k) && IN((k) + 1))
    const int gw = F.vcu * NWAVES + F.wave, NGW = F.G * NWAVES;

    if (IN(0)) { p0_prologue(F); if (BOTH(0)) GRID_BAR(0); }
    if (IN(1)) {
        pg8::Gemm g{F.XN(), F.WIN(), MPROMPT, NIN, DM}; pg8::StaticOrder S; S.init(MPROMPT, NIN, F.G, (int)blockIdx.x);
        static_assert(WS_KSB - WS_KCB == WS_KWB - WS_KSB, "kv copies equally spaced");
        pg8::EpiInProj E{F.QB(), F.KCB(), (WS_KSB - WS_KCB) / 2, F.Z(), F.XBC(), F.GD(), F.out()};
        pg8::gemm_phase<pg8::EpiInProj, pg8::StaticOrder, true, true>(F.lds + RING_OFF, g, S, E);
        {
          const int rel = (F.G == 256) ? (int)blockIdx.x - 160 : (int)blockIdx.x, nw = (F.G == 256) ? 96 : F.G;
          if (rel >= 0) { const sk::EpiInS ES{F.QB(), F.KCB(), (WS_KSB - WS_KCB) / 2, F.Z(), F.XBC(), F.GD(), F.out()};
              sk::phase(F.lds + RING_OFF, F.XN() + (size_t)MPROMPT * DM, F.WIN(), NCOLS_IN, DM, rel, nw, ES); } }
        if (F.G == 256 && blockIdx.x >= 160) { __syncthreads(); weight_items(F, 0, W_ITEMS_P1, ((int)blockIdx.x - 160) * NWAVES + F.wave, 96 * NWAVES); }
        if (BOTH(1)) GRID_BAR(1);
    }
    if (IN(2)) {
        constexpr int NT_C = NB * NCMP_P * 2 + DECB * NCMP_S * 2;
        for (int u = blockIdx.x; u < 256; u += gridDim.x) cmpg::unit(F, F.lds + RING_OFF, u);
        for (int u = blockIdx.x; u < NB * 2 * 32; u += gridDim.x) cmpg::small_unit(F, F.lds + RING_OFF, u);
        __syncthreads();
        conv_prepass(F);
        fa::win_phase(F, F.lds + RING_OFF); __syncthreads();
        for (int u = F.G - 1 - (int)blockIdx.x; u < DECB * 4; u += F.G) { const int b = u >> 2, g = u & 3, m = MPROMPT + b;
            const WinKeysS kf{F.st_win() + (size_t)b * 512 * 512, F.KWB() + (size_t)m * 512, g}; deca::unit<8, 1>(F, F.lds + RING_OFF, m, g, kf); }
        if (BOTH(2)) GRID_BAR(2);
    }
    if (IN(3)) {
        constexpr int NT_S = NB * 16 * 64 + DECB * 16 * 64;
#ifdef CHK_DEC
        for (int it = MPROMPT * 4 + gw; it < MROWS * 4; it += NGW) win_task<true>(F, it, F.lane);
        __syncthreads();
#endif
#ifdef CHK_CMP
        { constexpr int NT_C2 = NB * NCMP_P * 2 + DECB * NCMP_S * 2; for (int it = gw; it < 200; it += NGW) compress_ref_check(F, (int)(((long)it * 168 + 7) % NT_C2), it & 3, F.lane, -1); }
        { constexpr int NT_C = NB * NCMP_P * 2 + DECB * NCMP_S * 2; for (int it = gw; it < 600; it += NGW) compress_task<true>(F, (int)(((long)it * 56 + 7) % NT_C), F.lane); }
        __syncthreads();
#endif
#ifdef CHK_ATT
        for (int it = gw; it < 135 * 4; it += NGW) win_task<true>(F, (it >> 2) * 61 * 4 + (it & 3), F.lane);
        __syncthreads();
#endif
#ifdef SSD_NAIVE
        for (int it = gw; it < NT_S; it += NGW) ssd_task(F, it, F.lane);
#else
#ifdef REP_LOC
        for (int rep = 0; rep <= args.pad; ++rep)
#endif
        for (int u = blockIdx.x; u < NB * 16 * 16; u += gridDim.x) ssd::local_unit(F, F.lds + RING_OFF, u);
        __syncthreads();
        if (F.G == 256) { if (blockIdx.x < 128) for (int it = (int)blockIdx.x * NWAVES + F.wave; it < DECB * 16 * 8; it += 128 * NWAVES) ssd_decode_task(F, it, F.lane); }
        else for (int it = gw; it < DECB * 16 * 8; it += NGW) ssd_decode_task(F, it, F.lane);
#endif
        __syncthreads();
#ifdef REP_CMPA
        for (int rep = 0; rep <= args.pad; ++rep)
#endif
        { cmpa::phase(F, F.lds + RING_OFF); __syncthreads(); }
        for (int u = F.G - 1 - (int)blockIdx.x; u < DECB * 4; u += F.G) { const int b = u >> 2, g = u & 3, m = MPROMPT + b;
            const CmpKeys kf{F.KCMPS() + (size_t)b * NCMP_S * 512, g, NCMP_S, PAST}; deca::unit<8, 0>(F, F.lds + RING_OFF, m, g, kf); }
        if (BOTH(3)) GRID_BAR(3);
    }
    if (IN(4)) {
#ifdef REP_DECA
        for (int rep = 0; rep <= args.pad; ++rep)
#endif
        for (int u = F.G - 1 - (int)blockIdx.x; u < DECB * 4; u += F.G) { const int b = u >> 2, g = u & 3, m = MPROMPT + b;
            const SelKeysS kf{F.SELIDX() + ((size_t)m * 4 + g) * 16, F.page_table() + b * 64, F.cache_sel(), F.KSB() + (size_t)m * 512, g}; deca::unit<16, 2>(F, F.lds + RING_OFF, m, g, kf); }
        __syncthreads();
        ssd::carry_phase(F); winbuf_copy(F);
        if (F.G == 256) { if (blockIdx.x < 128) weight_items(F, W_ITEMS_P1, W_ITEMS, (int)blockIdx.x * NWAVES + F.wave, 128 * NWAVES); }
        else weight_items(F, 0, W_ITEMS, gw, NGW);
        if (BOTH(4)) GRID_BAR(4); }
    if (IN(5)) {
#ifdef CHK_DEC
        for (int it = MPROMPT * 4 + gw; it < MROWS * 4; it += NGW) cmp_task<true>(F, it, F.lane);
        __syncthreads();
#endif
#ifdef CHK_CMPA
        for (int it = gw; it < 135 * 4; it += NGW) cmp_task<true>(F, (it >> 2) * 61 * 4 + (it & 3), F.lane);
        __syncthreads();
#endif
        fa::sel_phase(F, F.lds + RING_OFF); __syncthreads();
#ifdef REP_SEL
        fa::sel_phase(F, F.lds + RING_OFF); __syncthreads();
#endif
#ifdef DRY_SEL
        fa::sel_phase_dry<DRY_SEL>(F, F.lds + RING_OFF); __syncthreads();
#endif
#ifdef SSD_NAIVE
        for (int it = gw; it < MROWS * 2; it += NGW) ssd_gate_task(F, it, F.lane);
#else
        __syncthreads();
#ifdef REP_FIN
        for (int rep = 0; rep <= args.pad; ++rep)
#endif
        for (int u = blockIdx.x; u < NB * 16 * 2 * 4; u += gridDim.x) ssd::final_unit(F, F.lds + RING_OFF, u);
        for (int it = MPROMPT * 2 + gw; it < MROWS * 2; it += NGW) ssd_gate_task(F, it, F.lane);
#endif
        if (BOTH(5)) GRID_BAR(5);
    }
    if (IN(6)) {
#ifdef CHK_DEC
        for (int it = MPROMPT * 4 + gw; it < MROWS * 4; it += NGW) sel_task<true>(F, it, F.lane);
        __syncthreads();
#endif
#ifdef CHK_ATT
        for (int it = gw; it < 135 * 4; it += NGW) sel_task<true>(F, (it >> 2) * 61 * 4 + (it & 3), F.lane);
        __syncthreads();
#endif
        pg8::Gemm g{F.MIX(), F.WOUT(), MPROMPT, DM, DM}; pg8::StaticOrder S; S.init(MPROMPT, DM, F.G, (int)blockIdx.x);
        pg8::EpiResid E{F.x_prompt(), F.x_sample(), DM, F.X1(), F.X1B(), F.SS1()};
        pg8::gemm_phase<pg8::EpiResid, pg8::StaticOrder, true, true>(F.lds + RING_OFF, g, S, E);
        { const sk::EpiResS ES{F.x_sample(), F.X1() + (size_t)MPROMPT * DM, F.X1B() + (size_t)MPROMPT * DM, F.SS1S()};
          sk::phase(F.lds + RING_OFF, F.MIX() + (size_t)MPROMPT * DM, F.WOUT(), DM, DM, (int)blockIdx.x, F.G, ES); }
        if (BOTH(6)) GRID_BAR(6);
    }
    if (IN(7)) {
        pg8::Gemm g{F.X1B(), F.WUP(), MPROMPT, DFF, DM}; pg8::StaticOrder S; S.init(MPROMPT, DFF, F.G, (int)blockIdx.x);
        pg8::EpiUp E{F.H(), F.SS1()};
        pg8::gemm_phase<pg8::EpiUp, pg8::StaticOrder, true, true>(F.lds + RING_OFF, g, S, E);
        { LAS float* rs = (LAS float*)(F.lds + RING_OFF + 32768);
          if (F.tid < 32) { float t = 0.f; for (int i = 0; i < 64; ++i) t += F.SS1S()[F.tid * 64 + i]; rs[F.tid] = 1.0f / sqrtf(t * (1.0f / DM) + NORM_EPS); }
          __syncthreads();
          const sk::EpiUpS ES{F.H() + (size_t)MPROMPT * DFF, rs};
          sk::phase(F.lds + RING_OFF, F.X1B() + (size_t)MPROMPT * DM, F.WUP(), DFF, DM, (int)blockIdx.x, F.G, ES); }
        if (BOTH(7)) GRID_BAR(7);
    }
    if (IN(8)) {
        pg8::Gemm g{F.H(), F.WDN(), MPROMPT, DM, DFF}; pg8::StaticOrder S; S.init(MPROMPT, DM, F.G, (int)blockIdx.x);
        pg8::EpiResid E{F.X1(), F.X1() + (size_t)MPROMPT * DM, DM, F.X2(), nullptr, F.SS2()};
        pg8::gemm_phase<pg8::EpiResid, pg8::StaticOrder, true, true>(F.lds + RING_OFF, g, S, E);
        { const sk::EpiResS ES{F.X1() + (size_t)MPROMPT * DM, F.X2() + (size_t)MPROMPT * DM, nullptr, F.SS2S()};
          sk::phase(F.lds + RING_OFF, F.H() + (size_t)MPROMPT * DFF, F.WDN(), DM, DFF, (int)blockIdx.x, F.G, ES); }
        if (BOTH(8)) GRID_BAR(8);
    }
    if (IN(9)) { for (int m = gw; m < MROWS; m += NGW) final_norm_row(F, m, F.lane);
#if defined(CHK_ATT) || defined(CHK_CMP) || defined(CHK_CMPA) || defined(CHK_DEC) || defined(CHK_ANY)
        if (blockIdx.x == 0 && F.tid == 0) { unsigned mask = 0u;
            for (int k = 0; k < 8; ++k) if (__hip_atomic_load((unsigned*)F.ctl + CW_CHK + k, RLX_AGENT)) mask |= 1u << k;
            if (mask & 31u) F.out()[O_KCS] = 1.0e6f * (float)(1u + (mask & 31u));
            if (mask >> 5) F.out()[O_KSS] = 1.0e9f * (float)(1u + (mask >> 5)); }
#endif
    }
#undef IN
#undef BOTH
}

extern "C" void kernel_launch(void* const* d_in, const int* in_sizes, int n_in, void* d_out, int out_size, void* d_ws, size_t ws_size, hipStream_t stream) {
    static int grid = 0;
    if (grid == 0) {
        if (n_in != 26 || (size_t)out_size != O_END || ws_size < WS_END) { fprintf(stderr, "kernel_launch: unexpected shapes: n_in %d out %d ws %zu (need %zu)\n", n_in, out_size, ws_size, (size_t)WS_END); grid = -1; return; }
        int dev = 0, cus = 0, per_cu = 0;
        if (hipGetDevice(&dev) != hipSuccess || hipDeviceGetAttribute(&cus, hipDeviceAttributeMultiprocessorCount, dev) != hipSuccess) { grid = -1; return; }
        if (hipFuncSetAttribute((const void*)fwd_kernel, hipFuncAttributeMaxDynamicSharedMemorySize, LDS_BYTES) != hipSuccess) { fprintf(stderr, "kernel_launch: hipFuncSetAttribute failed\n"); grid = -1; return; }
        if (hipOccupancyMaxActiveBlocksPerMultiprocessor(&per_cu, (const void*)fwd_kernel, NWAVES * 64, LDS_BYTES) != hipSuccess || per_cu < 1) fprintf(stderr, "kernel_launch: occupancy query reports %d\n", per_cu);
        (void)hipGetLastError();
        grid = cus;
    }
    if (grid < 0) return;
    if (hipMemsetAsync((char*)d_ws + WS_CTL, 0, CTL_ZERO_BYTES, stream) != hipSuccess) return;
    Args a{};
    for (int i = 0; i < 26; ++i) a.in[i] = d_in[i];
    a.out = (float*)d_out; a.ws = (unsigned char*)d_ws;
    for (int li = 0; li < N_LAUNCHES; ++li) {
        a.ph_lo = (N_LAUNCHES == 1) ? 0 : li; a.ph_hi = (N_LAUNCHES == 1) ? N_PHASES : li + 1; a.li = li; a.pad = 0;
#if defined(REP_CMPG) || defined(REP_FIN) || defined(REP_LOC) || defined(REP_DECA) || defined(REP_CMPA)
        a.pad = 1;
#endif
        hipLaunchKernelGGL(fwd_kernel, dim3(grid), dim3(NWAVES * 64), LDS_BYTES, stream, a);
        if (hipPeekAtLastError() != hipSuccess) { fprintf(stderr, "kernel_launch: launch %d failed\n", li); break; }
    }
}
```

```cpp
#include <hip/hip_runtime.h>
#include <cstdio>
#include <cstdint>

constexpr int DM = 2048, SEQ = 4096, NB = 2, MPROMPT = NB * SEQ, DECB = 32, PAST = 8192, MROWS = MPROMPT + DECB, MP = 8448;
constexpr int NCOLS_IN = 5184, NIN = 5376;
constexpr int DFF = 8192, CONV_DIM = 1536, DIN = 1024;
constexpr int NCMP_P = 255, NCMP_S = 511, NSLC_P = 64, NSLC_S = 129;
constexpr float NORM_EPS = 1e-5f;
constexpr size_t O_YP = 0, O_YS = O_YP + (size_t)MPROMPT * DM, O_KCP = O_YS + (size_t)DECB * DM, O_KSP = O_KCP + (size_t)MPROMPT * 512, O_KWP = O_KSP + (size_t)MPROMPT * 512,
                 O_CVP = O_KWP + (size_t)NB * 512 * 512, O_SSP = O_CVP + (size_t)NB * 3 * CONV_DIM, O_KCS = O_SSP + (size_t)NB * 16 * 64 * 128, O_KSS = O_KCS + (size_t)DECB * 512,
                 O_KWS = O_KSS + (size_t)DECB * 512, O_CVS = O_KWS + (size_t)DECB * 512 * 512, O_SSS = O_CVS + (size_t)DECB * 3 * CONV_DIM, O_END = O_SSS + (size_t)DECB * 16 * 64 * 128;
static_assert(O_END == 38790144, "d_out size");
namespace pg8 {
#define PG8_LAS __attribute__((address_space(3)))
typedef unsigned short bf16_t;
typedef short bf16x8 __attribute__((ext_vector_type(8)));
typedef float f32x4 __attribute__((ext_vector_type(4)));
typedef unsigned u32x4 __attribute__((ext_vector_type(4)));
constexpr int BM = 256, BK = 64, HALF = 128, HTB = HALF * BK * 2  , STAGE_BYTES = 8 * HTB, NXCD = 8, WGM = 8;

__host__ __device__ __forceinline__ int lds_byte(int r, int c) { const int st = (r >> 4) * 2 + (c >> 5), rr = r & 15, cc = c & 31, ob = rr * 64 + cc * 2; return st * 1024 + (ob ^ (((ob >> 9) & 1) << 5)); }
__host__ __device__ __forceinline__ void stage_rc(int b, int& R, int& C) { const int st = b / 1024, sb = b % 1024, swz = sb ^ (((sb >> 9) & 1) << 5); R = (st >> 1) * 16 + swz / 64; C = (st & 1) * 32 + (swz % 64) / 2; }
__host__ __device__ __forceinline__ int perm32(int rho) { const int n = rho >> 4, i = rho & 15; return 8 * (i >> 2) + 4 * n + (i & 3); }

struct Unit { int pm, pn; };
struct Gemm { const bf16_t* A; const bf16_t* Bt; int M, N, K; };

struct StaticOrder {
    int nM, nN, nwg, G, c;
    __host__ __device__ void init(int M, int N, int G_, int c_) { nM = M / BM; nN = N / BM; nwg = nM * nN; G = G_; c = c_; }
    __host__ __device__ bool next(int i, Unit& u) const {
        const long L = (long)i * G + c; if (L >= nwg) return false;
        int wgid = (int)L; { const int q = nwg / NXCD, r = nwg % NXCD, xcd = wgid % NXCD, off = wgid / NXCD; wgid = (xcd < r ? xcd * (q + 1) : r * (q + 1) + (xcd - r) * q) + off; }
        const int nig = WGM * nN, gid = wgid / nig, fm = gid * WGM, gsz = (nM - fm) < WGM ? (nM - fm) : WGM;
        u.pm = fm + ((wgid % nig) % gsz); u.pn = (wgid % nig) / gsz; return true;
    }
    __device__ __forceinline__ void a_ready(const Unit&) const {}
    __device__ __forceinline__ void done(const Unit&) const {}
};

__device__ __forceinline__ unsigned cvt_pk_bf16(float lo, float hi) { unsigned r; asm volatile("v_cvt_pk_bf16_f32 %0, %1, %2" : "=v"(r) : "v"(lo), "v"(hi)); return r; }
typedef float f32x2 __attribute__((ext_vector_type(2)));
__device__ __forceinline__ void st_bf16x4(bf16_t* p, const f32x4 v) { typedef unsigned u32x2v __attribute__((ext_vector_type(2))); u32x2v w; w.x = cvt_pk_bf16(v[0], v[1]); w.y = cvt_pk_bf16(v[2], v[3]); *(u32x2v*)p = w; }
__device__ __forceinline__ float sigmoidf_(float x) { return 1.0f / (1.0f + __expf(-x)); }
struct EpiInProj {
    static constexpr bool PERM = false, AFTER_DRAIN = false;
    bf16_t *QB, *KVB; size_t kvstride; float *Z, *XBC, *GD, *out;
    __device__ __forceinline__ void operator()(const f32x4 (&acc)[2][2][4][2], const Unit& u, int wr, int wc, int fr, int fq) const {
        const int pn = u.pn, rbase = u.pm * BM + wr * 64 + fr, cl = wc * 32 + 4 * fq;
        if (pn < 4) {
#pragma unroll
            for (int ai = 0; ai < 2; ++ai)
#pragma unroll
                for (int m = 0; m < 4; ++m) { const int row = rbase + ai * HALF + m * 16; if (row < MROWS) { bf16_t* p = QB + (size_t)row * 1024 + pn * 256 + cl;
#pragma unroll
                    for (int bj = 0; bj < 2; ++bj)
#pragma unroll
                        for (int n = 0; n < 2; ++n) st_bf16x4(p + bj * HALF + n * 16, acc[ai][bj][m][n]); } }
        } else if (pn < 10) {
            const int which = (pn - 4) >> 1, cb = ((pn - 4) & 1) * 256 + cl; bf16_t* B = KVB + (size_t)which * kvstride;
#pragma unroll
            for (int ai = 0; ai < 2; ++ai)
#pragma unroll
                for (int m = 0; m < 4; ++m) { const int row = rbase + ai * HALF + m * 16; if (row < MROWS) {
                    float* fo = nullptr;
                    if (row < MPROMPT) { if (which == 0) fo = out + O_KCP + (size_t)row * 512; else if (which == 1) fo = out + O_KSP + (size_t)row * 512; else { const int t = row & (SEQ - 1); if (t >= SEQ - 512) fo = out + O_KWP + (size_t)((row >> 12) * 512 + t - (SEQ - 512)) * 512; } }
                    else { const int s = row - MPROMPT; fo = which == 0 ? out + O_KCS + (size_t)s * 512 : (which == 1 ? out + O_KSS + (size_t)s * 512 : out + O_KWS + (size_t)(s * 512 + 511) * 512); }
                    bf16_t* p = B + (size_t)row * 512 + cb;
#pragma unroll
                    for (int bj = 0; bj < 2; ++bj)
#pragma unroll
                        for (int n = 0; n < 2; ++n) { const f32x4 v = acc[ai][bj][m][n]; st_bf16x4(p + bj * HALF + n * 16, v); if (fo) *(f32x4*)(fo + cb + bj * HALF + n * 16) = v; } } }
        } else if (pn < 20) {
            float* base = pn < 14 ? Z : XBC; const int ld = pn < 14 ? 1024 : CONV_DIM, cb = (pn < 14 ? (pn - 10) : (pn - 14)) * 256 + cl;
#pragma unroll
            for (int ai = 0; ai < 2; ++ai)
#pragma unroll
                for (int m = 0; m < 4; ++m) { const int row = rbase + ai * HALF + m * 16; if (row < MROWS) { float* p = base + (size_t)row * ld + cb;
#pragma unroll
                    for (int bj = 0; bj < 2; ++bj)
#pragma unroll
                        for (int n = 0; n < 2; ++n) *(f32x4*)(p + bj * HALF + n * 16) = acc[ai][bj][m][n]; } }
        } else {
#pragma unroll
            for (int ai = 0; ai < 2; ++ai)
#pragma unroll
                for (int m = 0; m < 4; ++m) { const int row = rbase + ai * HALF + m * 16; if (row < MROWS) {
#pragma unroll
                    for (int n = 0; n < 2; ++n) { const int col = cl + n * 16; if (col < 64) { f32x4 v = acc[ai][0][m][n]; if (col < 48) { v[0] = sigmoidf_(v[0]); v[1] = sigmoidf_(v[1]); v[2] = sigmoidf_(v[2]); v[3] = sigmoidf_(v[3]); } *(f32x4*)(GD + (size_t)row * 64 + col) = v; } } } }
        }
    }
};
struct EpiResid {
    static constexpr bool PERM = false, AFTER_DRAIN = false;
    const float* xp; const float* xs; int ldx; float* X1; bf16_t* X1B; float* SS;
    __device__ __forceinline__ void operator()(const f32x4 (&acc)[2][2][4][2], const Unit& u, int wr, int wc, int fr, int fq) const {
        const int pn = u.pn, rbase = u.pm * BM + wr * 64 + fr, cb = pn * 256 + wc * 32 + 4 * fq;
#pragma unroll
        for (int ai = 0; ai < 2; ++ai) {
            f32x4 pre[4][2][2];
#pragma unroll
            for (int m = 0; m < 4; ++m) { const int row = rbase + ai * HALF + m * 16; const float* xr = row < MPROMPT ? xp + (size_t)row * ldx : xs + (size_t)(row - MPROMPT) * ldx;
#pragma unroll
                for (int bj = 0; bj < 2; ++bj)
#pragma unroll
                    for (int n = 0; n < 2; ++n) pre[m][bj][n] = row < MROWS ? *(const f32x4*)(xr + cb + bj * HALF + n * 16) : (f32x4){0.f, 0.f, 0.f, 0.f}; }
            asm volatile("" ::: "memory");
#pragma unroll
            for (int m = 0; m < 4; ++m) { const int row = rbase + ai * HALF + m * 16; const bool ok = row < MROWS; float ss = 0.f;
#pragma unroll
                for (int bj = 0; bj < 2; ++bj)
#pragma unroll
                    for (int n = 0; n < 2; ++n) { const int col = cb + bj * HALF + n * 16; const f32x4 v = acc[ai][bj][m][n] + pre[m][bj][n];
                        if (ok) { *(f32x4*)(X1 + (size_t)row * DM + col) = v; if (X1B) st_bf16x4(X1B + (size_t)row * DM + col, v); }
                        ss += (v[0] * v[0] + v[1] * v[1]) + (v[2] * v[2] + v[3] * v[3]); }
                ss += __shfl_xor(ss, 16); ss += __shfl_xor(ss, 32);
                if (ok && fq == 0) SS[(size_t)row * 32 + pn * 4 + wc] = ss; }
        }
    }
};
struct EpiUp {
    static constexpr bool PERM = true, AFTER_DRAIN = false;
    bf16_t* H; const float* SS;
    __device__ __forceinline__ void operator()(const f32x4 (&acc)[2][2][4][2], const Unit& u, int wr, int wc, int fr, int fq) const {
        const int pn = u.pn, rbase = u.pm * BM + wr * 64 + fr, cb = pn * 256 + wc * 32 + 8 * fq;
#pragma unroll
        for (int ai = 0; ai < 2; ++ai)
#pragma unroll
            for (int m = 0; m < 4; ++m) { const int row = rbase + ai * HALF + m * 16; const bool ok = row < MROWS;
                float t = 0.f; if (ok) { const f32x4 a = *(const f32x4*)(SS + (size_t)row * 32 + fq * 8), b = *(const f32x4*)(SS + (size_t)row * 32 + fq * 8 + 4); t = ((a[0] + a[1]) + (a[2] + a[3])) + ((b[0] + b[1]) + (b[2] + b[3])); }
                t += __shfl_xor(t, 16); t += __shfl_xor(t, 32);
                const float rstd = 1.0f / sqrtf(t * (1.0f / DM) + NORM_EPS);
                if (ok) { bf16_t* p = H + (size_t)row * DFF + cb;
#pragma unroll
                    for (int bj = 0; bj < 2; ++bj) { f32x4 v0 = acc[ai][bj][m][0] * rstd, v1 = acc[ai][bj][m][1] * rstd;
                        v0[0] = fmaxf(v0[0], 0.f); v0[1] = fmaxf(v0[1], 0.f); v0[2] = fmaxf(v0[2], 0.f); v0[3] = fmaxf(v0[3], 0.f); v1[0] = fmaxf(v1[0], 0.f); v1[1] = fmaxf(v1[1], 0.f); v1[2] = fmaxf(v1[2], 0.f); v1[3] = fmaxf(v1[3], 0.f);
                        v0 = v0 * v0; v1 = v1 * v1;
                        u32x4 w; w.x = cvt_pk_bf16(v0[0], v0[1]); w.y = cvt_pk_bf16(v0[2], v0[3]); w.z = cvt_pk_bf16(v1[0], v1[1]); w.w = cvt_pk_bf16(v1[2], v1[3]);
                        *(u32x4*)(p + bj * HALF) = w; } } }
    }
};
template <class Epi, class Sched, bool ALIGN_EPI = false, bool SP2 = false>
__device__ __forceinline__ void gemm_phase(PG8_LAS unsigned char* lds, const Gemm g, const Sched& S, const Epi& E) {
    const int tid = threadIdx.x, wid = __builtin_amdgcn_readfirstlane(tid >> 6), lane = tid & 63, wr = wid >> 2, wc = wid & 3, fr = lane & 15, fq = lane >> 4;
    const int K = g.K, nt = K / BK;
    unsigned voffA[2], voffB[2];
#pragma unroll
    for (int i = 0; i < 2; ++i) { int R, C; stage_rc(tid * 16 + i * 8192, R, C); const int Rb = Epi::PERM ? ((R & ~31) + perm32(R & 31)) : R;
        voffA[i] = (unsigned)(R * K + C) * 2u; voffB[i] = (unsigned)(Rb * K + C) * 2u; }
    const size_t kstep = (size_t)(BK * 2);
    const size_t hstep = (size_t)HALF * K * 2;
    const size_t tstep = 2 * hstep;
    const unsigned ldsw = (unsigned)wid * 1024u;
    const int aoff = lds_byte(wr * 64 + fr, fq * 8), boff = lds_byte(wc * 32 + fr, fq * 8);
#define PG8_SA(b, h) (((b) * 2 + (h)) * HTB)
#define PG8_SB(b, h) ((4 + (b) * 2 + (h)) * HTB)
#define PG8_STAGE(bufoff, gbase, voff) do { _Pragma("unroll") for (int _i = 0; _i < 2; ++_i) \
        __builtin_amdgcn_global_load_lds((const unsigned*)((const char*)(gbase) + (voff)[_i]), (PG8_LAS unsigned*)(lds + (bufoff) + ldsw + _i * 8192), 16, 0, 0); } while (0)
#define PG8_LDA(dst, b, h) do { _Pragma("unroll") for (int m = 0; m < 4; ++m) _Pragma("unroll") for (int k = 0; k < 2; ++k) dst[m][k] = *(const PG8_LAS bf16x8*)(lds + PG8_SA(b, h) + aoff + m * 2048 + k * 1024); } while (0)
#define PG8_LDB(dst, b, h) do { _Pragma("unroll") for (int n = 0; n < 2; ++n) _Pragma("unroll") for (int k = 0; k < 2; ++k) dst[n][k] = *(const PG8_LAS bf16x8*)(lds + PG8_SB(b, h) + boff + n * 2048 + k * 1024); } while (0)
#define PG8_MMA(ai, bj, At, Bt) do { __builtin_amdgcn_s_setprio(1); _Pragma("unroll") for (int m = 0; m < 4; ++m) _Pragma("unroll") for (int n = 0; n < 2; ++n) _Pragma("unroll") for (int k = 0; k < 2; ++k) \
        acc[ai][bj][m][n] = __builtin_amdgcn_mfma_f32_16x16x32_bf16(Bt[n][k], At[m][k], acc[ai][bj][m][n], 0, 0, 0); __builtin_amdgcn_s_setprio(0); } while (0)
#define PG8_WAIT_V(n) asm volatile("s_waitcnt vmcnt(" #n ")" ::: "memory")
#define PG8_WAIT_L(n) asm volatile("s_waitcnt lgkmcnt(" #n ")" ::: "memory")
#define PG8_BAR __builtin_amdgcn_s_barrier()
#define PG8_SCHED __builtin_amdgcn_sched_barrier(0)
    Unit cur, nxt; int ui = 0;
    if (!S.next(0, cur)) return;
    f32x4 acc[2][2][4][2];
#pragma unroll
    for (int a = 0; a < 2; ++a)
#pragma unroll
        for (int b = 0; b < 2; ++b)
#pragma unroll
            for (int m = 0; m < 4; ++m)
#pragma unroll
                for (int n = 0; n < 2; ++n) acc[a][b][m][n] = (f32x4){0.f, 0.f, 0.f, 0.f};
    bf16x8 At[4][2], B0[2][2], B1[2][2];
    const char* cA = (const char*)g.A + (size_t)cur.pm * tstep; const char* cB = (const char*)g.Bt + (size_t)cur.pn * tstep;
    S.a_ready(cur);
    if constexpr (SP2) {
        PG8_STAGE(PG8_SB(0, 0), cB, voffB); PG8_STAGE(PG8_SB(0, 1), cB + hstep, voffB); PG8_STAGE(PG8_SA(0, 0), cA, voffA); PG8_STAGE(PG8_SA(0, 1), cA + hstep, voffA);
        if (wr == 1) PG8_BAR;
        PG8_WAIT_V(2); PG8_BAR;
        PG8_STAGE(PG8_SB(1, 0), cB + kstep, voffB); PG8_STAGE(PG8_SA(1, 0), cA + kstep, voffA); PG8_STAGE(PG8_SB(1, 1), cB + hstep + kstep, voffB);
        PG8_WAIT_V(6); PG8_BAR;
    } else {
        PG8_STAGE(PG8_SB(0, 0), cB, voffB); PG8_STAGE(PG8_SA(0, 0), cA, voffA); PG8_STAGE(PG8_SB(0, 1), cB + hstep, voffB); PG8_STAGE(PG8_SA(0, 1), cA + hstep, voffA);
        if (wr == 1) PG8_BAR;
        PG8_WAIT_V(4); PG8_BAR;
        PG8_STAGE(PG8_SB(1, 0), cB + kstep, voffB); PG8_STAGE(PG8_SA(1, 0), cA + kstep, voffA); PG8_STAGE(PG8_SB(1, 1), cB + hstep + kstep, voffB);
        PG8_WAIT_V(6); PG8_BAR;
    }
    for (;;) {
        const bool has_next = S.next(ui + 1, nxt);
        const char* nA = has_next ? (const char*)g.A + (size_t)nxt.pm * tstep : cA; const char* nB = has_next ? (const char*)g.Bt + (size_t)nxt.pn * tstep : cB;
        for (int t = 0; t < nt; t += 2) {
            const bool last = (t == nt - 2);
            const char* a1 = cA + (size_t)(t + 1) * kstep;
            const char* a2 = last ? nA : cA + (size_t)(t + 2) * kstep; const char* b2 = last ? nB : cB + (size_t)(t + 2) * kstep;
            const char* a3 = a2 + kstep; const char* b3 = b2 + kstep;
            if (last && has_next) S.a_ready(nxt);
            if constexpr (SP2) {
            PG8_LDB(B0, 0, 0); PG8_LDB(B1, 0, 1); PG8_SCHED; PG8_LDA(At, 0, 0); PG8_STAGE(PG8_SA(1, 1), a1 + hstep, voffA);
            PG8_WAIT_V(8); PG8_WAIT_L(0); PG8_BAR; PG8_MMA(0, 0, At, B0); PG8_MMA(0, 1, At, B1); PG8_BAR; PG8_SCHED;
            PG8_LDA(At, 0, 1); PG8_STAGE(PG8_SB(0, 0), b2, voffB); PG8_STAGE(PG8_SB(0, 1), b2 + hstep, voffB); PG8_STAGE(PG8_SA(0, 0), a2, voffA);
            PG8_WAIT_V(8); PG8_WAIT_L(0); PG8_BAR; PG8_MMA(1, 0, At, B0); PG8_MMA(1, 1, At, B1); PG8_BAR; PG8_SCHED;
            PG8_LDB(B0, 1, 0); PG8_LDB(B1, 1, 1); PG8_SCHED; PG8_LDA(At, 1, 0); PG8_STAGE(PG8_SA(0, 1), a2 + hstep, voffA);
            PG8_WAIT_V(8); PG8_WAIT_L(0); PG8_BAR; PG8_MMA(0, 0, At, B0); PG8_MMA(0, 1, At, B1); PG8_BAR; PG8_SCHED;
            PG8_LDA(At, 1, 1); PG8_STAGE(PG8_SB(1, 0), b3, voffB); PG8_STAGE(PG8_SB(1, 1), b3 + hstep, voffB); PG8_STAGE(PG8_SA(1, 0), a3, voffA);
            PG8_WAIT_V(8); PG8_WAIT_L(0); PG8_BAR; PG8_MMA(1, 0, At, B0); PG8_MMA(1, 1, At, B1); PG8_BAR; PG8_SCHED;
            } else {
            PG8_LDB(B0, 0, 0); PG8_SCHED; PG8_LDA(At, 0, 0); PG8_STAGE(PG8_SA(1, 1), a1 + hstep, voffA);
            PG8_WAIT_L(8); PG8_BAR; PG8_WAIT_L(0); PG8_MMA(0, 0, At, B0); PG8_BAR; PG8_SCHED;
            PG8_LDB(B1, 0, 1); PG8_STAGE(PG8_SB(0, 0), b2, voffB);
            PG8_BAR; PG8_WAIT_L(0); PG8_MMA(0, 1, At, B1); PG8_BAR;
            PG8_LDA(At, 0, 1); PG8_STAGE(PG8_SA(0, 0), a2, voffA);
            PG8_BAR; PG8_WAIT_L(0); PG8_MMA(1, 0, At, B0); PG8_BAR; PG8_SCHED;
            PG8_STAGE(PG8_SB(0, 1), b2 + hstep, voffB);
            PG8_WAIT_V(6); PG8_BAR; PG8_MMA(1, 1, At, B1); PG8_BAR;
            PG8_LDB(B0, 1, 0); PG8_SCHED; PG8_LDA(At, 1, 0); PG8_STAGE(PG8_SA(0, 1), a2 + hstep, voffA);
            PG8_WAIT_L(8); PG8_BAR; PG8_WAIT_L(0); PG8_MMA(0, 0, At, B0); PG8_BAR; PG8_SCHED;
            PG8_LDB(B1, 1, 1); PG8_STAGE(PG8_SB(1, 0), b3, voffB);
            PG8_BAR; PG8_WAIT_L(0); PG8_MMA(0, 1, At, B1); PG8_BAR;
            PG8_LDA(At, 1, 1); PG8_STAGE(PG8_SA(1, 0), a3, voffA);
            PG8_BAR; PG8_WAIT_L(0); PG8_MMA(1, 0, At, B0); PG8_BAR; PG8_SCHED;
            PG8_STAGE(PG8_SB(1, 1), b3 + hstep, voffB);
            PG8_WAIT_V(6); PG8_BAR; PG8_MMA(1, 1, At, B1); PG8_BAR;
            }
        }
        if constexpr (ALIGN_EPI) { if (wr == 0) PG8_BAR; }
        if constexpr (!Epi::AFTER_DRAIN) { E(acc, cur, wr, wc, fr, fq); S.done(cur); }
        if (!has_next) break;
#pragma unroll
        for (int a = 0; a < 2; ++a)
#pragma unroll
            for (int b = 0; b < 2; ++b)
#pragma unroll
                for (int m = 0; m < 4; ++m)
#pragma unroll
                    for (int n = 0; n < 2; ++n) acc[a][b][m][n] = (f32x4){0.f, 0.f, 0.f, 0.f};
        cur = nxt; cA = nA; cB = nB; ++ui;
        if constexpr (ALIGN_EPI) { if (wr == 1) PG8_BAR; }
    }
    PG8_WAIT_V(0);
    if constexpr (!ALIGN_EPI) { if (wr == 0) PG8_BAR; }
    PG8_BAR;
    if constexpr (Epi::AFTER_DRAIN) { E.fused(acc, cur, wr, wc, fr, fq, lds, wid, lane); S.done(cur); }
#undef PG8_SA
#undef PG8_SB
#undef PG8_STAGE
#undef PG8_LDA
#undef PG8_LDB
#undef PG8_MMA
#undef PG8_WAIT_V
#undef PG8_WAIT_L
#undef PG8_BAR
#undef PG8_SCHED
}
}
#define GAS __attribute__((address_space(1)))
#define LAS __attribute__((address_space(3)))
typedef unsigned short bf16;
typedef unsigned v4u __attribute__((ext_vector_type(4)));
typedef float f32x4 __attribute__((ext_vector_type(4)));
typedef short bf16x8 __attribute__((ext_vector_type(8)));
typedef GAS unsigned gu32;
typedef GAS unsigned long long gu64;
#define RLX_AGENT __ATOMIC_RELAXED, __HIP_MEMORY_SCOPE_AGENT
#define LDS_WAIT() asm volatile("s_waitcnt lgkmcnt(0)" ::: "memory")
#define VM_WAIT() asm volatile("s_waitcnt vmcnt(0)" ::: "memory")
__device__ __forceinline__ unsigned long long rt() { return __builtin_amdgcn_s_memrealtime(); }
__device__ __forceinline__ unsigned f2bf(float f) { unsigned u = __builtin_bit_cast(unsigned, f); return (u + 0x7fffu + ((u >> 16) & 1u)) >> 16; }
__device__ __forceinline__ unsigned pk2(float lo, float hi) { return f2bf(lo) | (f2bf(hi) << 16); }

#define XB_TMO      128
#define XB_XCNT(j)  (256  + 64 * (j))
#define XB_XSUB(j)  (1280 + 64 * (j))
#define XB_XGEN(j)  (2304 + 64 * (j))
#define XB_TOP      3328
#define XB_TOPGEN   3392
#define XCD_BAR_WORDS 3456
#define XB_SPIN_CAP (1u << 18)

__device__ __forceinline__ unsigned xb_ld(unsigned* p)              { return __hip_atomic_load(p, __ATOMIC_RELAXED, __HIP_MEMORY_SCOPE_AGENT); }
__device__ __forceinline__ unsigned xb_add(unsigned* p, unsigned v) { return __hip_atomic_fetch_add(p, v, __ATOMIC_RELAXED, __HIP_MEMORY_SCOPE_AGENT); }
__device__ __forceinline__ unsigned xb_xcc_id() { return (unsigned)__builtin_amdgcn_s_getreg((3 << 11) | 20) & 0xFu; }
#define XB_SPIN(cond, bar) do { unsigned _sp = 0; while (cond) { __builtin_amdgcn_s_sleep(1); \
    if ((++_sp & 255u) == 0u) { if (xb_ld(&(bar)[XB_TMO])) break; if (_sp > XB_SPIN_CAP) { atomicAdd(&(bar)[XB_TMO], 1u); break; } } } } while (0)

struct XcdBarrier {
    unsigned* bar; unsigned x;
    volatile LAS unsigned* st;
};

__device__ __forceinline__ XcdBarrier xcd_barrier_post(unsigned* bar, volatile LAS unsigned* st) {
    XcdBarrier b; b.bar = bar; b.x = xb_xcc_id(); b.st = st;
    if (threadIdx.x == 0) (void)xb_add(&bar[XB_XCNT(b.x)], 1u);
    return b;
}
__device__ __forceinline__ void xcd_barrier_complete(unsigned* bar, unsigned x, unsigned& nloc, unsigned& nx) {
    const unsigned G = gridDim.x * gridDim.y * gridDim.z;
    unsigned sum, cnt, mine, sp = 0u;
    for (;;) {
        sum = 0u; cnt = 0u; mine = 0u;
#pragma unroll
        for (unsigned j = 0; j < 16; ++j) { const unsigned c = xb_ld(&bar[XB_XCNT(j)]); sum += c; cnt += (c > 0u) ? 1u : 0u; mine = (j == x) ? c : mine; }
        if (sum == G) break;
        __builtin_amdgcn_s_sleep(1);
        if ((++sp & 255u) == 0u) { if (xb_ld(&bar[XB_TMO])) break; if (sp > XB_SPIN_CAP) { atomicAdd(&bar[XB_TMO], 1u); break; } }
    }
    nloc = mine > 0u ? mine : 1u; nx = cnt > 0u ? cnt : 1u;
}

__device__ __forceinline__ void xcd_barrier(const XcdBarrier& b) {
    asm volatile("s_waitcnt vmcnt(0)" ::: "memory");
    __syncthreads();
    if (threadIdx.x == 0) {
        unsigned* bar = b.bar;
        __builtin_amdgcn_s_waitcnt(0);
        unsigned nloc = b.st[0], nx = b.st[1];
        if (nloc == 0u) { xcd_barrier_complete(bar, b.x, nloc, nx); b.st[0] = nloc; b.st[1] = nx; }
        const unsigned old = xb_add(&bar[XB_XSUB(b.x)], 1u);
        const unsigned gen = old / nloc;
        if (old + 1u == (gen + 1u) * nloc) {
            __builtin_amdgcn_fence(__ATOMIC_RELEASE, "agent");
            asm volatile("s_waitcnt vmcnt(0)" ::: "memory");
            const unsigned og = xb_add(&bar[XB_TOP], 1u);
            const unsigned tg = og / nx;
            if (og + 1u == (tg + 1u) * nx) xb_add(&bar[XB_TOPGEN], 1u);
            else XB_SPIN(xb_ld(&bar[XB_TOPGEN]) == tg, bar);
            __builtin_amdgcn_fence(__ATOMIC_ACQUIRE, "agent");
            xb_add(&bar[XB_XGEN(b.x)], 1u);
            asm volatile("s_waitcnt vmcnt(0)" ::: "memory");
        } else {
            XB_SPIN(xb_ld(&bar[XB_XGEN(b.x)]) == gen, bar);
            __builtin_amdgcn_fence(__ATOMIC_ACQUIRE, "agent");
            asm volatile("s_waitcnt vmcnt(0)" ::: "memory");
        }
    }
    __syncthreads();
}

constexpr int NWAVES = 8;
#ifndef MK_N_LAUNCHES
#define MK_N_LAUNCHES 1
#endif
constexpr int N_PHASES = 10;
constexpr int N_LAUNCHES = MK_N_LAUNCHES;
static_assert(N_LAUNCHES == 1 || N_LAUNCHES == N_PHASES, "MK_N_LAUNCHES is 1 or 10");

constexpr size_t MiB = 1u << 20;
constexpr size_t al(size_t x) { return (x + MiB - 1) / MiB * MiB; }
constexpr size_t WS_CTL = 0, CTL_ZERO_BYTES = 32768;
constexpr size_t WS_WIN = 2 * MiB;
constexpr size_t WS_WOUT = WS_WIN + al((size_t)NIN * DM * 2);
constexpr size_t WS_WUP = WS_WOUT + al((size_t)DM * DM * 2);
constexpr size_t WS_WDN = WS_WUP + al((size_t)DFF * DM * 2);
constexpr size_t WS_XN = WS_WDN + al((size_t)DM * DFF * 2);
constexpr size_t WS_QB = WS_XN + al((size_t)MP * DM * 2);
constexpr size_t WS_KCB = WS_QB + al((size_t)MP * 1024 * 2);
constexpr size_t WS_KSB = WS_KCB + al((size_t)MP * 512 * 2);
constexpr size_t WS_KWB = WS_KSB + al((size_t)MP * 512 * 2);
constexpr size_t WS_Z = WS_KWB + al((size_t)MP * 512 * 2);
constexpr size_t WS_XBC = WS_Z + al((size_t)MP * 1024 * 4);
constexpr size_t WS_GD = WS_XBC + al((size_t)MP * CONV_DIM * 4);
constexpr size_t WS_XBCA = WS_GD + al((size_t)MP * 64 * 4);
constexpr size_t WS_DT = WS_XBCA + al((size_t)MP * CONV_DIM * 4);
constexpr size_t WS_KCMPP = WS_DT + al((size_t)MP * 16 * 4);
constexpr size_t WS_KCMPS = WS_KCMPP + al((size_t)NB * NCMP_P * 512 * 4);
constexpr size_t WS_OWIN = WS_KCMPS + al((size_t)DECB * NCMP_S * 512 * 4);
constexpr size_t WS_OCMP = WS_OWIN + al((size_t)MP * 1024 * 4);
constexpr size_t WS_SELIDX = WS_OCMP + al((size_t)MP * 1024 * 4);
constexpr size_t WS_SELMASK = WS_SELIDX + al((size_t)MP * 64 * 4);
constexpr size_t WS_YSSD = WS_SELMASK + al((size_t)MPROMPT * 4 * 8);
constexpr size_t WS_MIX = WS_YSSD + al((size_t)MP * 1024 * 4);
constexpr size_t WS_X1 = WS_MIX + al((size_t)MP * DM * 2);
constexpr size_t WS_X1B = WS_X1 + al((size_t)MP * DM * 4);
constexpr size_t WS_SS1 = WS_X1B + al((size_t)MP * DM * 2);
constexpr size_t WS_H = WS_SS1 + al((size_t)MP * 32 * 4);
constexpr size_t WS_X2 = WS_H + al((size_t)MP * DFF * 2);
constexpr size_t WS_SS2 = WS_X2 + al((size_t)MP * DM * 4);
constexpr size_t WS_W1T = WS_SS2 + al((size_t)MP * 32 * 4);
constexpr size_t WS_PEB = WS_W1T + al((size_t)2 * 128 * 2048 * 2);
constexpr size_t WS_XBCA16 = WS_PEB + MiB;
constexpr size_t WS_ST = WS_XBCA16 + al((size_t)MP * CONV_DIM * 2);
constexpr size_t WS_DEC = WS_ST + al((size_t)NB * 16 * 16 * 8192 * 4);
constexpr size_t WS_ACS = WS_DEC + MiB;
constexpr size_t WS_SS1S = WS_ACS + al((size_t)MPROMPT * 16 * 4);
constexpr size_t WS_SS2S = WS_SS1S + MiB;
constexpr size_t WS_SIN = WS_SS2S + MiB;
constexpr size_t WS_END = WS_SIN + al((size_t)NB * 16 * 16 * 8192 * 2);
constexpr int CW_TMO = 0, CW_CODE = 1, CW_CHK = 8, CW_BAR = 4096;

constexpr int RING_OFF = 0, RING_BYTES = 155648;
constexpr int LDSCTL_OFF = RING_BYTES, MISC_OFF = LDSCTL_OFF + 320;
constexpr int LDS_BYTES = 156160;
static_assert(MISC_OFF + 128 <= LDS_BYTES, "LDS map");

struct Ctx {
    LAS unsigned char* lds; volatile LAS unsigned* MISC; gu32* ctl;
    int tid, lane, wave, vcu, G;
    const __attribute__((address_space(4))) unsigned long long* ka;
    __device__ __forceinline__ const float* x_prompt() const { return (const float*)ka[0]; }
    __device__ __forceinline__ const float* x_sample() const { return (const float*)ka[1]; }
    __device__ __forceinline__ const float* cache_cmp() const { return (const float*)ka[2]; }
    __device__ __forceinline__ const float* cache_sel() const { return (const float*)ka[3]; }
    __device__ __forceinline__ const float* st_win() const { return (const float*)ka[4]; }
    __device__ __forceinline__ const float* st_conv() const { return (const float*)ka[5]; }
    __device__ __forceinline__ const float* st_ssm() const { return (const float*)ka[6]; }
    __device__ __forceinline__ const int* page_table() const { return (const int*)ka[7]; }
    __device__ __forceinline__ const float* ln_mix() const { return (const float*)ka[8]; }
    __device__ __forceinline__ const float* w_in() const { return (const float*)ka[9]; }
    __device__ __forceinline__ const float* cmp_pe() const { return (const float*)ka[10]; }
    __device__ __forceinline__ const float* cmp_w1() const { return (const float*)ka[11]; }
    __device__ __forceinline__ const float* cmp_b1() const { return (const float*)ka[12]; }
    __device__ __forceinline__ const float* cmp_w2() const { return (const float*)ka[13]; }
    __device__ __forceinline__ const float* cmp_b2() const { return (const float*)ka[14]; }
    __device__ __forceinline__ const float* conv_w() const { return (const float*)ka[15]; }
    __device__ __forceinline__ const float* conv_b() const { return (const float*)ka[16]; }
    __device__ __forceinline__ const float* dt_bias() const { return (const float*)ka[17]; }
    __device__ __forceinline__ const float* a_log() const { return (const float*)ka[18]; }
    __device__ __forceinline__ const float* d_skip() const { return (const float*)ka[19]; }
    __device__ __forceinline__ const float* ssm_norm() const { return (const float*)ka[20]; }
    __device__ __forceinline__ const float* w_out() const { return (const float*)ka[21]; }
    __device__ __forceinline__ const float* ln_mlp() const { return (const float*)ka[22]; }
    __device__ __forceinline__ const float* w_up() const { return (const float*)ka[23]; }
    __device__ __forceinline__ const float* w_down() const { return (const float*)ka[24]; }
    __device__ __forceinline__ const float* ln_final() const { return (const float*)ka[25]; }
    __device__ __forceinline__ float* out() const { return (float*)ka[26]; }
    __device__ __forceinline__ unsigned char* ws() const { return (unsigned char*)ka[27]; }
    __device__ __forceinline__ bf16* WIN() const { return (bf16*)(ws() + WS_WIN); }
    __device__ __forceinline__ bf16* WOUT() const { return (bf16*)(ws() + WS_WOUT); }
    __device__ __forceinline__ bf16* WUP() const { return (bf16*)(ws() + WS_WUP); }
    __device__ __forceinline__ bf16* WDN() const { return (bf16*)(ws() + WS_WDN); }
    __device__ __forceinline__ bf16* XN() const { return (bf16*)(ws() + WS_XN); }
    __device__ __forceinline__ bf16* QB() const { return (bf16*)(ws() + WS_QB); }
    __device__ __forceinline__ bf16* KCB() const { return (bf16*)(ws() + WS_KCB); }
    __device__ __forceinline__ bf16* KSB() const { return (bf16*)(ws() + WS_KSB); }
    __device__ __forceinline__ bf16* KWB() const { return (bf16*)(ws() + WS_KWB); }
    __device__ __forceinline__ bf16* MIX() const { return (bf16*)(ws() + WS_MIX); }
    __device__ __forceinline__ bf16* X1B() const { return (bf16*)(ws() + WS_X1B); }
    __device__ __forceinline__ bf16* H() const { return (bf16*)(ws() + WS_H); }
    __device__ __forceinline__ float* Z() const { return (float*)(ws() + WS_Z); }
    __device__ __forceinline__ float* XBC() const { return (float*)(ws() + WS_XBC); }
    __device__ __forceinline__ float* GD() const { return (float*)(ws() + WS_GD); }
    __device__ __forceinline__ float* XBCA() const { return (float*)(ws() + WS_XBCA); }
    __device__ __forceinline__ float* DT() const { return (float*)(ws() + WS_DT); }
    __device__ __forceinline__ float* KCMPP() const { return (float*)(ws() + WS_KCMPP); }
    __device__ __forceinline__ float* KCMPS() const { return (float*)(ws() + WS_KCMPS); }
    __device__ __forceinline__ float* OWIN() const { return (float*)(ws() + WS_OWIN); }
    __device__ __forceinline__ float* OCMP() const { return (float*)(ws() + WS_OCMP); }
    __device__ __forceinline__ float* YSSD() const { return (float*)(ws() + WS_YSSD); }
    __device__ __forceinline__ float* X1() const { return (float*)(ws() + WS_X1); }
    __device__ __forceinline__ float* SS1() const { return (float*)(ws() + WS_SS1); }
    __device__ __forceinline__ float* X2() const { return (float*)(ws() + WS_X2); }
    __device__ __forceinline__ float* SS2() const { return (float*)(ws() + WS_SS2); }
    __device__ __forceinline__ int* SELIDX() const { return (int*)(ws() + WS_SELIDX); }
    __device__ __forceinline__ unsigned long long* SELMASK() const { return (unsigned long long*)(ws() + WS_SELMASK); }
    __device__ __forceinline__ bf16* W1T() const { return (bf16*)(ws() + WS_W1T); }
    __device__ __forceinline__ float* PEB() const { return (float*)(ws() + WS_PEB); }
    __device__ __forceinline__ bf16* XBCA16() const { return (bf16*)(ws() + WS_XBCA16); }
    __device__ __forceinline__ float* ST() const { return (float*)(ws() + WS_ST); }
    __device__ __forceinline__ float* DEC() const { return (float*)(ws() + WS_DEC); }
    __device__ __forceinline__ float* ACS() const { return (float*)(ws() + WS_ACS); }
    __device__ __forceinline__ float* SS1S() const { return (float*)(ws() + WS_SS1S); }
    __device__ __forceinline__ float* SS2S() const { return (float*)(ws() + WS_SS2S); }
    __device__ __forceinline__ bf16* SIN() const { return (bf16*)(ws() + WS_SIN); }
};
__device__ __forceinline__ float bf2f(bf16 x) { return __uint_as_float((unsigned)x << 16); }
__device__ __forceinline__ float wave_sum(float v) {
#pragma unroll
    for (int o = 1; o < 64; o <<= 1) v += __shfl_xor(v, o);
    return v;
}
__device__ __forceinline__ float wave_max(float v) {
#pragma unroll
    for (int o = 1; o < 64; o <<= 1) v = fmaxf(v, __shfl_xor(v, o));
    return v;
}
__device__ __forceinline__ float wave_reduce_t64(float (&a)[64], int lane) {
#pragma unroll
    for (int i = 0; i < 32; ++i) { const bool up = (lane & 32) != 0; const float keep = up ? a[i + 32] : a[i], send = up ? a[i] : a[i + 32]; a[i] = keep + __shfl_xor(send, 32); }
#pragma unroll
    for (int i = 0; i < 16; ++i) { const bool up = (lane & 16) != 0; const float keep = up ? a[i + 16] : a[i], send = up ? a[i] : a[i + 16]; a[i] = keep + __shfl_xor(send, 16); }
#pragma unroll
    for (int i = 0; i < 8; ++i) { const bool up = (lane & 8) != 0; const float keep = up ? a[i + 8] : a[i], send = up ? a[i] : a[i + 8]; a[i] = keep + __shfl_xor(send, 8); }
#pragma unroll
    for (int i = 0; i < 4; ++i) { const bool up = (lane & 4) != 0; const float keep = up ? a[i + 4] : a[i], send = up ? a[i] : a[i + 4]; a[i] = keep + __shfl_xor(send, 4); }
#pragma unroll
    for (int i = 0; i < 2; ++i) { const bool up = (lane & 2) != 0; const float keep = up ? a[i + 2] : a[i], send = up ? a[i] : a[i + 2]; a[i] = keep + __shfl_xor(send, 2); }
    { const bool up = (lane & 1) != 0; const float keep = up ? a[1] : a[0], send = up ? a[0] : a[1]; a[0] = keep + __shfl_xor(send, 1); }
    return a[0];
}
__device__ __forceinline__ float siluf_(float x) { return x / (1.0f + __expf(-x)); }
__device__ __forceinline__ float rdlane(float v, int l) { return __int_as_float(__builtin_amdgcn_readlane(__float_as_int(v), l)); }

__device__ __forceinline__ int win_oldcol(int n) { return n < 2560 ? n : (n < 5120 ? n + 48 : (n < 5168 ? n - 2560 : (n < NCOLS_IN ? n : -1))); }
template <int MODE  >
__device__ __forceinline__ void p0_transpose_item(const float* W, int K, int Nsrc, int Ndst, bf16* WT, const float* rowscale, LAS float* scr, int item, int lane) {
    const int nblk = Ndst / 32, kb = item / nblk, nb = item % nblk, k0 = 64 * kb, n0 = 32 * nb;
    const int ncol = MODE == 1 ? win_oldcol(n0 + (lane & 31)) : n0 + (lane & 31);
    float tv[32];
#pragma unroll
    for (int i = 0; i < 32; ++i) { const int kk = 2 * i + (lane >> 5); float v = 0.f; if (ncol >= 0) v = W[(size_t)(k0 + kk) * Nsrc + ncol]; tv[i] = v; }
#pragma unroll
    for (int i = 0; i < 32; ++i) { const int kk = 2 * i + (lane >> 5); float v = tv[i]; if (rowscale) v *= rowscale[k0 + kk]; scr[kk * 33 + (lane & 31)] = v; }
    LDS_WAIT(); asm volatile("" ::: "memory");
    const int c = lane & 7;
#pragma unroll
    for (int j = 0; j < 4; ++j) { const int n = (lane >> 3) + 8 * j; const LAS float* s = scr + (8 * c) * 33 + n;
        v4u o; o.x = pk2(s[0 * 33], s[1 * 33]); o.y = pk2(s[2 * 33], s[3 * 33]); o.z = pk2(s[4 * 33], s[5 * 33]); o.w = pk2(s[6 * 33], s[7 * 33]);
        *(GAS v4u*)(WT + (size_t)(n0 + n) * K + k0 + 8 * c) = o; }
    LDS_WAIT(); asm volatile("" ::: "memory");
}
__device__ __forceinline__ void p0_prologue(const Ctx& F) {
    LAS float* scr = (LAS float*)(F.lds + RING_OFF + F.wave * 16384);
    const int gw = F.vcu * NWAVES + F.wave, NGW = F.G * NWAVES;
    constexpr int I_IN = (DM / 64) * (NIN / 32);
    for (int it = gw; it < I_IN; it += NGW) p0_transpose_item<1>(F.w_in(), DM, NCOLS_IN, NIN, F.WIN(), nullptr, scr, it, F.lane);
    for (int it = gw; it < 2 * 128; it += NGW) { const int c = it >> 7; p0_transpose_item<0>(F.cmp_w1() + (size_t)c * 2048 * 128, 2048, 128, 128, F.W1T() + (size_t)c * 128 * 2048, nullptr, scr, it & 127, F.lane); }
    for (int it = gw; it < 64; it += NGW) { const int c = it >> 5, fh = (it >> 4) & 1, kc = it & 15, f = fh * 64 + F.lane; const float* w = F.cmp_w1() + ((size_t)c * 2048 + kc * 128) * 128 + f; const float* pe = F.cmp_pe() + c * 2048 + kc * 128; float acc = 0.f;
#pragma unroll 16
        for (int k = 0; k < 128; ++k) acc += pe[k] * w[(size_t)k * 128];
        F.PEB()[(c * 16 + kc) * 128 + f] = acc; }
    for (int m = gw; m < MP; m += NGW) {
        GAS unsigned long long* o8 = (GAS unsigned long long*)(F.XN() + (size_t)m * DM) + F.lane;
        if (m >= MROWS) { GAS unsigned long long* z8 = (GAS unsigned long long*)(F.MIX() + (size_t)m * DM) + F.lane;
#pragma unroll
            for (int j = 0; j < 8; ++j) { o8[64 * j] = 0ull; z8[64 * j] = 0ull; }
            continue; }
        const float* xrow = m < MPROMPT ? F.x_prompt() + (size_t)m * DM : F.x_sample() + (size_t)(m - MPROMPT) * DM;
        const GAS f32x4* xr = (const GAS f32x4*)xrow + F.lane; const GAS f32x4* wr = (const GAS f32x4*)F.ln_mix() + F.lane;
        f32x4 v[8]; float s = 0.f;
#pragma unroll
        for (int j = 0; j < 8; ++j) { v[j] = xr[64 * j]; s += (v[j].x * v[j].x + v[j].y * v[j].y) + (v[j].z * v[j].z + v[j].w * v[j].w); }
        const float rstd = 1.0f / sqrtf(wave_sum(s) * (1.0f / DM) + NORM_EPS);
#pragma unroll
        for (int j = 0; j < 8; ++j) { const f32x4 w = wr[64 * j]; o8[64 * j] = (unsigned long long)pk2(v[j].x * rstd * w.x, v[j].y * rstd * w.y) | ((unsigned long long)pk2(v[j].z * rstd * w.z, v[j].w * rstd * w.w) << 32); }
    }
}
constexpr int W_ITEMS = (DM / 64) * (DM / 32) + (DM / 64) * (DFF / 32) + (DFF / 64) * (DM / 32), W_ITEMS_P1 = 7680;
__device__ __forceinline__ void weight_items(const Ctx& F, int it0, int it1, int wv, int nw) {
    LAS float* scr = (LAS float*)(F.lds + RING_OFF + F.wave * 16384);
    constexpr int I_OUT = (DM / 64) * (DM / 32), I_UP = (DM / 64) * (DFF / 32);
    for (int it = it0 + wv; it < it1; it += nw) {
        int r = it;
        if (r < I_OUT) { p0_transpose_item<0>(F.w_out(), DM, DM, DM, F.WOUT(), nullptr, scr, r, F.lane); continue; } r -= I_OUT;
        if (r < I_UP) { p0_transpose_item<0>(F.w_up(), DM, DFF, DFF, F.WUP(), F.ln_mlp(), scr, r, F.lane); continue; } r -= I_UP;
        p0_transpose_item<0>(F.w_down(), DFF, DM, DM, F.WDN(), nullptr, scr, r, F.lane);
    }
}
__device__ __forceinline__ void winbuf_copy(const Ctx& F) {
    { const int gt = F.vcu * (NWAVES * 64) + F.tid, NGT = F.G * NWAVES * 64; constexpr int TOT = DECB * 511 * 128;
      for (int i = gt; i < TOT; i += NGT) { const int b = i / (511 * 128), r = i % (511 * 128), row = r >> 7, c4 = r & 127;
          *(f32x4*)(F.out() + O_KWS + ((size_t)(b * 512 + row) * 512) + c4 * 4) = *(const f32x4*)(F.st_win() + ((size_t)(b * 512 + row + 1) * 512) + c4 * 4); } }
}

struct KeyRef { const void* k; const void* v; int f32; int valid; };
template <int NCH, class KF>
__device__ __forceinline__ void naive_attn2(const bf16* q2, const KF& kf, LAS float* qs, LAS float* sc, LAS float* ps, bool use_ps, int lane, float& o0, float& o1) {
    qs[lane] = bf2f(q2[lane]) * 0.125f; qs[64 + lane] = bf2f(q2[64 + lane]) * 0.125f;
    for (int c = 0; c < NCH; ++c) {
        const KeyRef kr = kf(c, lane);
        float s0 = -INFINITY, s1 = -INFINITY;
        if (kr.valid) {
            float k[64];
            if (kr.f32) { const f32x4* p = (const f32x4*)kr.k;
#pragma unroll
                for (int i = 0; i < 16; ++i) { const f32x4 t = p[i]; k[4 * i] = t.x; k[4 * i + 1] = t.y; k[4 * i + 2] = t.z; k[4 * i + 3] = t.w; } }
            else { const v4u* p = (const v4u*)kr.k;
#pragma unroll
                for (int i = 0; i < 8; ++i) { const v4u t = p[i]; k[8 * i] = __uint_as_float(t.x << 16); k[8 * i + 1] = __uint_as_float(t.x & 0xffff0000u); k[8 * i + 2] = __uint_as_float(t.y << 16); k[8 * i + 3] = __uint_as_float(t.y & 0xffff0000u);
                    k[8 * i + 4] = __uint_as_float(t.z << 16); k[8 * i + 5] = __uint_as_float(t.z & 0xffff0000u); k[8 * i + 6] = __uint_as_float(t.w << 16); k[8 * i + 7] = __uint_as_float(t.w & 0xffff0000u); } }
            s0 = 0.f; s1 = 0.f;
#pragma unroll
            for (int d = 0; d < 64; ++d) { s0 += qs[d] * k[d]; s1 += qs[64 + d] * k[d]; }
        }
        sc[c * 64 + lane] = s0; sc[NCH * 64 + c * 64 + lane] = s1;
    }
#pragma unroll
    for (int hh = 0; hh < 2; ++hh) { LAS float* s = sc + hh * NCH * 64; float m = -INFINITY;
        for (int c = 0; c < NCH; ++c) m = fmaxf(m, s[c * 64 + lane]);
        m = wave_max(m); if (m == -INFINITY) m = 0.f;
        float sum = 0.f;
        for (int c = 0; c < NCH; ++c) { const float e = __expf(s[c * 64 + lane] - m); s[c * 64 + lane] = e; sum += e; }
        sum = wave_sum(sum); const float inv = 1.0f / fmaxf(sum, 1e-30f);
        for (int c = 0; c < NCH; ++c) { const float p = s[c * 64 + lane] * inv; s[c * 64 + lane] = p; if (use_ps) ps[1 + c * 64 + lane] += p; } }
    o0 = 0.f; o1 = 0.f;
#pragma unroll
    for (int hh = 0; hh < 2; ++hh) {
        float a0[64];
#pragma unroll
        for (int d = 0; d < 64; ++d) a0[d] = 0.f;
        for (int c = 0; c < NCH; ++c) {
            const KeyRef kr = kf(c, lane);
            if (kr.valid) {
                const float p0 = sc[hh * NCH * 64 + c * 64 + lane];
                if (kr.f32) { const f32x4* p = (const f32x4*)kr.v;
#pragma unroll
                    for (int i = 0; i < 16; ++i) { const f32x4 t = p[i]; a0[4 * i] += p0 * t.x; a0[4 * i + 1] += p0 * t.y; a0[4 * i + 2] += p0 * t.z; a0[4 * i + 3] += p0 * t.w; } }
                else { const v4u* p = (const v4u*)kr.v;
#pragma unroll
                    for (int i = 0; i < 8; ++i) { const v4u t = p[i]; a0[8 * i] += p0 * __uint_as_float(t.x << 16); a0[8 * i + 1] += p0 * __uint_as_float(t.x & 0xffff0000u); a0[8 * i + 2] += p0 * __uint_as_float(t.y << 16); a0[8 * i + 3] += p0 * __uint_as_float(t.y & 0xffff0000u);
                        a0[8 * i + 4] += p0 * __uint_as_float(t.z << 16); a0[8 * i + 5] += p0 * __uint_as_float(t.z & 0xffff0000u); a0[8 * i + 6] += p0 * __uint_as_float(t.w << 16); a0[8 * i + 7] += p0 * __uint_as_float(t.w & 0xffff0000u); } }
            }
        }
        const float s0 = wave_reduce_t64(a0, lane); if (hh == 0) o0 = s0; else o1 = s0;
    }
}
struct CmpKeys { const float* base; int g, ncmp, qpos;
    __device__ __forceinline__ KeyRef operator()(int c, int l) const { const int n = c * 64 + l; KeyRef r; r.valid = (n < ncmp) && (16 * n + 31 <= qpos); r.f32 = 1; r.k = base + (size_t)(r.valid ? n : 0) * 512 + g * 64; r.v = (const float*)r.k + 256; return r; } };
struct WinKeysP { const bf16* kw; int g, t;
    __device__ __forceinline__ KeyRef operator()(int c, int l) const { const int pos = t - 511 + c * 64 + l; KeyRef r; r.valid = pos >= 0; r.f32 = 0; r.k = kw + (size_t)(r.valid ? pos : 0) * 512 + g * 64; r.v = (const bf16*)r.k + 256; return r; } };
struct WinKeysS { const float* st; const bf16* nw; int g;
    __device__ __forceinline__ KeyRef operator()(int c, int l) const { const int i = 1 + c * 64 + l; KeyRef r; r.valid = 1;
        if (i < 512) { r.f32 = 1; r.k = st + (size_t)i * 512 + g * 64; r.v = (const float*)r.k + 256; } else { r.f32 = 0; r.k = nw + g * 64; r.v = nw + 256 + g * 64; } return r; } };
struct SelKeysP { const int* idx; const bf16* ks; int g, qpos;
    __device__ __forceinline__ KeyRef operator()(int c, int l) const { const int pos = idx[c] * 64 + l; KeyRef r; r.valid = pos <= qpos; r.f32 = 0; r.k = ks + (size_t)(r.valid ? pos : 0) * 512 + g * 64; r.v = (const bf16*)r.k + 256; return r; } };
struct SelKeysS { const int* idx; const int* pt; const float* cache; const bf16* nw; int g;
    __device__ __forceinline__ KeyRef operator()(int c, int l) const { const int pos = idx[c] * 64 + l; KeyRef r; r.valid = pos <= PAST;
        if (pos < PAST) { const int page = pt[pos >> 7]; r.f32 = 1; r.k = cache + ((size_t)page * 128 + (pos & 127)) * 512 + g * 64; r.v = (const float*)r.k + 256; } else { r.f32 = 0; r.k = nw + g * 64; r.v = nw + 256 + g * 64; } return r; } };

constexpr int NA_WAVE_LDS = 14336;
__device__ __forceinline__ void na_ptrs(const Ctx& F, LAS float*& qs, LAS float*& sc, LAS float*& ps, LAS float*& imp) {
    LAS unsigned char* b = F.lds + RING_OFF + F.wave * NA_WAVE_LDS; qs = (LAS float*)b; sc = (LAS float*)(b + 512); ps = (LAS float*)(b + 8704); imp = (LAS float*)(b + 10880); }

template <bool CHK>
__device__ __forceinline__ void compress_task(const Ctx& F, int task, int lane) {
    constexpr int NT_P = NB * NCMP_P * 2;
    const bool dec = task >= NT_P; const int tt = dec ? task - NT_P : task, ncmp = dec ? NCMP_S : NCMP_P, bb = tt / (ncmp * 2), rr = tt % (ncmp * 2), n = rr >> 1, c = rr & 1;
    float h0[4] = {0.f, 0.f, 0.f, 0.f}, h1[4] = {0.f, 0.f, 0.f, 0.f};
    const float* w1 = F.cmp_w1() + (size_t)c * 2048 * 128; const float* pe = F.cmp_pe() + c * 2048;
    for (int l = 0; l < 32; ++l) {
        const int pos = 16 * n + l; const float* row;
        if (!dec) row = F.out() + O_KCP + (size_t)(bb * SEQ + pos) * 512; else { const int page = F.page_table()[bb * 64 + (pos >> 7)]; row = F.cache_cmp() + ((size_t)page * 128 + (pos & 127)) * 512; }
        const float pv = pe[l * 64 + lane]; float xg[4];
#pragma unroll
        for (int g = 0; g < 4; ++g) xg[g] = row[c * 256 + g * 64 + lane] + pv;
        const float* wl = w1 + (size_t)l * 64 * 128;
#pragma unroll 8
        for (int d = 0; d < 64; ++d) { const float wa = wl[d * 128 + lane], wb = wl[d * 128 + 64 + lane];
#pragma unroll
            for (int g = 0; g < 4; ++g) { const float xv = rdlane(xg[g], d); h0[g] += xv * wa; h1[g] += xv * wb; } }
    }
    const float ba = F.cmp_b1()[c * 128 + lane], bb1 = F.cmp_b1()[c * 128 + 64 + lane];
#pragma unroll
    for (int g = 0; g < 4; ++g) { h0[g] = siluf_(h0[g] + ba); h1[g] = siluf_(h1[g] + bb1); }
    const float* w2 = F.cmp_w2() + (size_t)c * 128 * 64; const float b2 = F.cmp_b2()[c * 64 + lane];
    float o[4] = {b2, b2, b2, b2};
    for (int f = 0; f < 64; ++f) { const float wa = w2[f * 64 + lane], wb = w2[(64 + f) * 64 + lane];
#pragma unroll
        for (int g = 0; g < 4; ++g) o[g] += rdlane(h0[g], f) * wa + rdlane(h1[g], f) * wb; }
    float* dst = (dec ? F.KCMPS() : F.KCMPP()) + ((size_t)(bb * ncmp + n) * 2 + c) * 256;
#pragma unroll
    for (int g = 0; g < 4; ++g) { if (CHK) { const float df = fabsf(o[g] - dst[g * 64 + lane]);
            if (!(df <= 0.02f + 0.02f * fabsf(o[g]))) __hip_atomic_fetch_or((unsigned*)F.ctl + CW_CHK + (!dec ? 0 : ((n & 127) == 127 ? 1 : 2)), 1u, RLX_AGENT);
            if (!(df <= 0.2f)) __hip_atomic_fetch_or((unsigned*)F.ctl + CW_CHK + 3, 1u, RLX_AGENT); } else dst[g * 64 + lane] = o[g]; }
}
__device__ __forceinline__ void compress_ref_check(const Ctx& F, int task, int g, int lane, int dbgslot) {
    constexpr int NT_P = NB * NCMP_P * 2;
    const bool dec = task >= NT_P; const int tt = dec ? task - NT_P : task, ncmp = dec ? NCMP_S : NCMP_P, bb = tt / (ncmp * 2), rr = tt % (ncmp * 2), n = rr >> 1, c = rr & 1;
    LAS float* hl = (LAS float*)(F.lds + RING_OFF + F.wave * NA_WAVE_LDS);
    float ha = 0.f, hb2 = 0.f;
    for (int k = 0; k < 2048; ++k) { const int l = k >> 6, d = k & 63, pos = 16 * n + l; const float* row;
        if (!dec) row = F.out() + O_KCP + (size_t)(bb * SEQ + pos) * 512; else { const int page = F.page_table()[bb * 64 + (pos >> 7)]; row = F.cache_cmp() + ((size_t)page * 128 + (pos & 127)) * 512; }
        const float x = row[c * 256 + g * 64 + d] + F.cmp_pe()[c * 2048 + k]; const float* w = F.cmp_w1() + ((size_t)c * 2048 + k) * 128;
        ha += x * w[lane]; hb2 += x * w[64 + lane]; }
    if (dbgslot >= 0) { const float* HD = (const float*)F.H() + (size_t)dbgslot * 512 * 128 + (size_t)(((n & 127) << 2) + g) * 128; float pa = 0.f, pb = 0.f; for (int kc = 0; kc < 16; ++kc) { pa += F.PEB()[(c * 16 + kc) * 128 + lane]; pb += F.PEB()[(c * 16 + kc) * 128 + 64 + lane]; }
        if (!(fabsf(HD[lane] + pa - ha) <= 0.05f + 0.05f * fabsf(ha)) || !(fabsf(HD[64 + lane] + pb - hb2) <= 0.05f + 0.05f * fabsf(hb2))) __hip_atomic_fetch_or((unsigned*)F.ctl + CW_CHK + 5 + dbgslot, 1u, RLX_AGENT); }
    ha += F.cmp_b1()[c * 128 + lane]; hb2 += F.cmp_b1()[c * 128 + 64 + lane];
    hl[lane] = ha / (1.0f + __expf(-ha)); hl[64 + lane] = hb2 / (1.0f + __expf(-hb2));
    float o = F.cmp_b2()[c * 64 + lane];
    for (int f = 0; f < 128; ++f) o += hl[f] * F.cmp_w2()[((size_t)c * 128 + f) * 64 + lane];
    const float got = (dec ? F.KCMPS() : F.KCMPP())[((size_t)(bb * ncmp + n) * 2 + c) * 256 + g * 64 + lane];
    if (!(fabsf(o - got) <= 0.05f + 0.05f * fabsf(o))) __hip_atomic_fetch_or((unsigned*)F.ctl + CW_CHK + 4, 1u, RLX_AGENT);
}
__device__ __forceinline__ void conv_prepass(const Ctx& F) {
    const int gt = F.vcu * (NWAVES * 64) + F.tid, NGT = F.G * NWAVES * 64;
    constexpr int TOTP = (MPROMPT / 8) * (CONV_DIM / 4);
    for (int i = gt; i < TOTP; i += NGT) {
        const int rb = i / (CONV_DIM / 4), c4 = i % (CONV_DIM / 4), col = c4 * 4, m0 = rb * 8, t0 = m0 & (SEQ - 1), b = m0 >> 12;
        f32x4 xr[11];
#pragma unroll
        for (int k = 0; k < 11; ++k) xr[k] = (t0 - 3 + k >= 0) ? *(const f32x4*)(F.XBC() + (size_t)(m0 - 3 + k) * CONV_DIM + col) : (f32x4){0.f, 0.f, 0.f, 0.f};
        const f32x4 bias = *(const f32x4*)(F.conv_b() + col), w0 = *(const f32x4*)(F.conv_w() + col), w1 = *(const f32x4*)(F.conv_w() + CONV_DIM + col), w2 = *(const f32x4*)(F.conv_w() + 2 * CONV_DIM + col), w3 = *(const f32x4*)(F.conv_w() + 3 * CONV_DIM + col);
#pragma unroll
        for (int r = 0; r < 8; ++r) { const f32x4 acc = bias + xr[r] * w0 + xr[r + 1] * w1 + xr[r + 2] * w2 + xr[r + 3] * w3;
            typedef unsigned u32x2v __attribute__((ext_vector_type(2))); u32x2v w; w.x = pk2(siluf_(acc.x), siluf_(acc.y)); w.y = pk2(siluf_(acc.z), siluf_(acc.w)); *(u32x2v*)(F.XBCA16() + (size_t)(m0 + r) * CONV_DIM + col) = w;
            if (t0 + r >= SEQ - 3) *(f32x4*)(F.out() + O_CVP + (size_t)(b * 3 + (t0 + r - (SEQ - 3))) * CONV_DIM + col) = xr[r + 3]; }
        if (c4 < 4) {
#pragma unroll
            for (int r = 0; r < 8; ++r)
#pragma unroll
                for (int e = 0; e < 4; ++e) { const int h = c4 * 4 + e; const float x = F.GD()[(size_t)(m0 + r) * 64 + 48 + h] + F.dt_bias()[h]; F.DT()[(size_t)(m0 + r) * 16 + h] = x > 20.f ? x : log1pf(__expf(x)); } }
    }
    constexpr int TOTS = DECB * (CONV_DIM / 4);
    for (int i = gt; i < TOTS; i += NGT) {
        const int b = i / (CONV_DIM / 4), c4 = i % (CONV_DIM / 4), col = c4 * 4; const size_t m = (size_t)MPROMPT + b;
        f32x4 acc = *(const f32x4*)(F.conv_b() + col);
#pragma unroll
        for (int w = 0; w < 3; ++w) acc += *(const f32x4*)(F.st_conv() + (size_t)(b * 3 + w) * CONV_DIM + col) * *(const f32x4*)(F.conv_w() + (size_t)w * CONV_DIM + col);
        const f32x4 xcur = *(const f32x4*)(F.XBC() + m * CONV_DIM + col); acc += xcur * *(const f32x4*)(F.conv_w() + (size_t)3 * CONV_DIM + col);
        f32x4 a; a.x = siluf_(acc.x); a.y = siluf_(acc.y); a.z = siluf_(acc.z); a.w = siluf_(acc.w);
        *(f32x4*)(F.XBCA() + m * CONV_DIM + col) = a;
        { typedef unsigned u32x2v __attribute__((ext_vector_type(2))); u32x2v w; w.x = pk2(a.x, a.y); w.y = pk2(a.z, a.w); *(u32x2v*)(F.XBCA16() + m * CONV_DIM + col) = w; }
        *(f32x4*)(F.out() + O_CVS + (size_t)(b * 3 + 0) * CONV_DIM + col) = *(const f32x4*)(F.st_conv() + (size_t)(b * 3 + 1) * CONV_DIM + col);
        *(f32x4*)(F.out() + O_CVS + (size_t)(b * 3 + 1) * CONV_DIM + col) = *(const f32x4*)(F.st_conv() + (size_t)(b * 3 + 2) * CONV_DIM + col);
        *(f32x4*)(F.out() + O_CVS + (size_t)(b * 3 + 2) * CONV_DIM + col) = xcur;
        if (c4 < 4) {
#pragma unroll
            for (int e = 0; e < 4; ++e) { const int h = c4 * 4 + e; const float x = F.GD()[m * 64 + 48 + h] + F.dt_bias()[h]; F.DT()[m * 16 + h] = x > 20.f ? x : log1pf(__expf(x)); } }
    }
}
template <bool CHK>
__device__ __forceinline__ void win_task(const Ctx& F, int task, int lane) {
    LAS float *qs, *sc, *ps, *imp; na_ptrs(F, qs, sc, ps, imp);
    const int m = task >> 2, g = task & 3; const bool dec = m >= MPROMPT; const int b = dec ? m - MPROMPT : m >> 12, t = m & (SEQ - 1);
#pragma unroll
    for (int pr = 0; pr < 2; ++pr) { float o0, o1; const bf16* q2 = F.QB() + (size_t)m * 1024 + g * 256 + pr * 128;
        if (!dec) { const WinKeysP kf{F.KWB() + (size_t)b * SEQ * 512, g, t}; naive_attn2<8>(q2, kf, qs, sc, ps, false, lane, o0, o1); }
        else { const WinKeysS kf{F.st_win() + (size_t)b * 512 * 512, F.KWB() + (size_t)m * 512, g}; naive_attn2<8>(q2, kf, qs, sc, ps, false, lane, o0, o1); }
        float* d0 = F.OWIN() + (size_t)m * 1024 + (g * 4 + pr * 2) * 64 + lane;
        if (CHK) { if (!(fabsf(o0 - d0[0]) <= 2e-3f) || !(fabsf(o1 - d0[64]) <= 2e-3f)) __hip_atomic_fetch_or((unsigned*)F.ctl + CW_CHK + 0, 1u, RLX_AGENT); }
        else { d0[0] = o0; d0[64] = o1; } }
}
template <bool CHK>
__device__ __forceinline__ void cmp_task(const Ctx& F, int task, int lane) {
    LAS float *qs, *sc, *ps, *imp; na_ptrs(F, qs, sc, ps, imp);
    const int m = task >> 2, g = task & 3; const bool dec = m >= MPROMPT; const int b = dec ? m - MPROMPT : m >> 12, t = m & (SEQ - 1);
    const int qpos = dec ? PAST : t, ncmp = dec ? NCMP_S : NCMP_P, nslc = dec ? NSLC_S : NSLC_P, jt = qpos >> 6;
    for (int i = lane; i < 544; i += 64) ps[i] = 0.f;
    const CmpKeys kf{dec ? F.KCMPS() + (size_t)b * NCMP_S * 512 : F.KCMPP() + (size_t)b * NCMP_P * 512, g, ncmp, qpos};
#pragma unroll
    for (int pr = 0; pr < 2; ++pr) { float o0, o1; naive_attn2<8>(F.QB() + (size_t)m * 1024 + g * 256 + pr * 128, kf, qs, sc, ps, true, lane, o0, o1);
        float* d0 = F.OCMP() + (size_t)m * 1024 + (g * 4 + pr * 2) * 64 + lane;
        if (CHK) { if (!(fabsf(o0 - d0[0]) <= 5e-3f + 0.02f * fabsf(o0)) || !(fabsf(o1 - d0[64]) <= 5e-3f + 0.02f * fabsf(o1))) __hip_atomic_fetch_or((unsigned*)F.ctl + CW_CHK + 0, 1u, RLX_AGENT);
                   if (!(fabsf(o0 - d0[0]) <= 0.05f) || !(fabsf(o1 - d0[64]) <= 0.05f)) __hip_atomic_fetch_or((unsigned*)F.ctl + CW_CHK + 3, 1u, RLX_AGENT); }
        else { d0[0] = o0; d0[64] = o1; } }
    float mine[3]; int cnt[3];
#pragma unroll
    for (int jj = 0; jj < 3; ++jj) { const int j = jj * 64 + lane; float v = 0.f; cnt[jj] = 0;
        if (j < nslc) { v = ps[4 * j] + 2.0f * (ps[4 * j + 1] + ps[4 * j + 2] + ps[4 * j + 3]) + ps[4 * j + 4]; if (j == 0 || j == jt || j == jt - 1) v = 1.0e4f; if (j > jt) v = -1.0e4f; imp[j] = v; }
        mine[jj] = v; }
    for (int k = 0; k < nslc; ++k) { const float v = imp[k];
#pragma unroll
        for (int jj = 0; jj < 3; ++jj) { const int j = jj * 64 + lane; cnt[jj] += ((v > mine[jj]) || (v == mine[jj] && k < j)) ? 1 : 0; } }
    int base = 0;
#pragma unroll
    for (int jj = 0; jj < 3; ++jj) { const int j = jj * 64 + lane; const bool sel = (j < nslc) && (cnt[jj] < 16); const unsigned long long bal = __ballot(sel);
        if (CHK && dec) { bool stored = false; for (int i = 0; i < 16; ++i) stored = stored || (F.SELIDX()[(size_t)task * 16 + i] == j);
            if (__ballot((j < nslc) && (stored != sel)) != 0ull && lane == 0) __hip_atomic_fetch_or((unsigned*)F.ctl + CW_CHK + 2, 1u, RLX_AGENT); }
        else if (CHK) { if (jj == 0 && lane == 0 && F.SELMASK()[task] != bal) { if (__hip_atomic_fetch_add((unsigned*)F.ctl + CW_CHK + 8, 1u, RLX_AGENT) >= 100u) __hip_atomic_fetch_or((unsigned*)F.ctl + CW_CHK + 1, 1u, RLX_AGENT); if (__popcll(F.SELMASK()[task] ^ bal) > 2) __hip_atomic_fetch_or((unsigned*)F.ctl + CW_CHK + 2, 1u, RLX_AGENT); } }
        else { if (sel) F.SELIDX()[(size_t)task * 16 + base + __popcll(bal & ((1ull << lane) - 1ull))] = j;
        if (!dec && jj == 0 && lane == 0) F.SELMASK()[task] = bal; }
        base += __popcll(bal); }
}
template <bool CHK>
__device__ __forceinline__ void sel_task(const Ctx& F, int task, int lane) {
    LAS float *qs, *sc, *ps, *imp; na_ptrs(F, qs, sc, ps, imp);
    const int m = task >> 2, g = task & 3; const bool dec = m >= MPROMPT; const int b = dec ? m - MPROMPT : m >> 12, t = m & (SEQ - 1);
#pragma unroll
    for (int pr = 0; pr < 2; ++pr) { float o0, o1; const bf16* q2 = F.QB() + (size_t)m * 1024 + g * 256 + pr * 128;
        if (!dec) { LAS int* il = (LAS int*)imp;
            const unsigned long long mk = F.SELMASK()[task]; if ((mk >> lane) & 1ull) il[__popcll(mk & ((1ull << lane) - 1ull))] = lane;
            const SelKeysP kf{(const int*)il, F.KSB() + (size_t)b * SEQ * 512, g, t}; naive_attn2<16>(q2, kf, qs, sc, ps, false, lane, o0, o1); }
        else { const SelKeysS kf{F.SELIDX() + (size_t)task * 16, F.page_table() + b * 64, F.cache_sel(), F.KSB() + (size_t)m * 512, g}; naive_attn2<16>(q2, kf, qs, sc, ps, false, lane, o0, o1); }
#pragma unroll
        for (int e = 0; e < 2; ++e) { const int hd = g * 4 + pr * 2 + e; const float* gt = F.GD() + (size_t)m * 64 + hd * 3; const size_t oi = (size_t)m * 1024 + hd * 64 + lane;
            const float a = gt[0] * F.OCMP()[oi] + gt[1] * (e ? o1 : o0) + gt[2] * F.OWIN()[oi]; bf16* dm = F.MIX() + (size_t)m * DM + hd * 64 + lane;
            if (CHK) { if (!(fabsf(a - bf2f(*dm)) <= 2e-3f + 0.01f * fabsf(a))) __hip_atomic_fetch_or((unsigned*)F.ctl + CW_CHK + 1, 1u, RLX_AGENT); } else *dm = (bf16)f2bf(a); } }
}
template <int U>
__device__ __forceinline__ void ssd_chain(const Ctx& F, int rowbase, int L, int h, int p, const float* s0, float* sfin, int lane) {
    const int grp = h >> 3; float h0 = 0.f, h1 = 0.f; if (s0) { h0 = s0[lane]; h1 = s0[64 + lane]; }
    const float A = -__expf(F.a_log()[h]), Dk = F.d_skip()[h];
    for (int t0 = 0; t0 < L; t0 += U) {
        float dt[U], x[U], B0[U], B1[U], C0[U], C1[U];
#pragma unroll
        for (int u = 0; u < U; ++u) { const size_t m = (size_t)(rowbase + t0 + u); dt[u] = F.DT()[m * 16 + h]; const float* r = F.XBCA() + m * CONV_DIM; x[u] = r[h * 64 + p];
            B0[u] = r[1024 + grp * 128 + lane]; B1[u] = r[1024 + grp * 128 + 64 + lane]; C0[u] = r[1280 + grp * 128 + lane]; C1[u] = r[1280 + grp * 128 + 64 + lane]; }
        float y[U];
#pragma unroll
        for (int u = 0; u < U; ++u) { const float dA = __expf(dt[u] * A), xd = dt[u] * x[u]; h0 = h0 * dA + xd * B0[u]; h1 = h1 * dA + xd * B1[u]; y[u] = wave_sum(C0[u] * h0 + C1[u] * h1) + Dk * x[u]; }
        if (lane == 0) {
#pragma unroll
            for (int u = 0; u < U; ++u) F.YSSD()[(size_t)(rowbase + t0 + u) * 1024 + h * 64 + p] = y[u]; }
    }
    sfin[lane] = h0; sfin[64 + lane] = h1;
}
__device__ __forceinline__ void ssd_task(const Ctx& F, int task, int lane) {
    if (task < NB * 16 * 64) { const int b = task >> 10, h = (task >> 6) & 15, p = task & 63; ssd_chain<4>(F, b * SEQ, SEQ, h, p, nullptr, F.out() + O_SSP + (size_t)task * 128, lane); }
    else { const int tk = task - NB * 16 * 64, b = tk >> 10, h = (tk >> 6) & 15, p = tk & 63; ssd_chain<1>(F, MPROMPT + b, 1, h, p, F.st_ssm() + (size_t)tk * 128, F.out() + O_SSS + (size_t)tk * 128, lane); }
}
__device__ __forceinline__ void ssd_decode_task(const Ctx& F, int task, int lane) {
    const int pg = task & 7, h = (task >> 3) & 15, b = task >> 7, grp = h >> 3; const size_t m = (size_t)MPROMPT + b;
    const float* r = F.XBCA() + m * CONV_DIM; const float dt = F.DT()[m * 16 + h], A = -__expf(F.a_log()[h]), Dk = F.d_skip()[h], dA = __expf(dt * A);
    const float B0 = r[1024 + grp * 128 + lane], B1 = r[1024 + grp * 128 + 64 + lane], C0 = r[1280 + grp * 128 + lane], C1 = r[1280 + grp * 128 + 64 + lane];
    const size_t sb = ((size_t)(b * 16 + h) * 64 + pg * 8) * 128;
    float h0[8], h1[8], x[8];
#pragma unroll
    for (int i = 0; i < 8; ++i) { h0[i] = F.st_ssm()[sb + i * 128 + lane]; h1[i] = F.st_ssm()[sb + i * 128 + 64 + lane]; x[i] = r[h * 64 + pg * 8 + i]; }
#pragma unroll
    for (int i = 0; i < 8; ++i) { const float xd = dt * x[i]; h0[i] = h0[i] * dA + xd * B0; h1[i] = h1[i] * dA + xd * B1;
        F.out()[O_SSS + sb + i * 128 + lane] = h0[i]; F.out()[O_SSS + sb + i * 128 + 64 + lane] = h1[i];
        const float y = wave_sum(C0 * h0[i] + C1 * h1[i]) + Dk * x[i]; if (lane == 0) F.YSSD()[m * 1024 + h * 64 + pg * 8 + i] = y; }
}
__device__ __forceinline__ void ssd_gate_task(const Ctx& F, int task, int lane) {
    const int m = task >> 1, grp = task & 1; const size_t o = (size_t)m * 1024 + grp * 512 + lane * 8;
    const f32x4 y0 = *(const f32x4*)(F.YSSD() + o), y1 = *(const f32x4*)(F.YSSD() + o + 4), z0 = *(const f32x4*)(F.Z() + o), z1 = *(const f32x4*)(F.Z() + o + 4);
    float v[8] = {y0.x * siluf_(z0.x), y0.y * siluf_(z0.y), y0.z * siluf_(z0.z), y0.w * siluf_(z0.w), y1.x * siluf_(z1.x), y1.y * siluf_(z1.y), y1.z * siluf_(z1.z), y1.w * siluf_(z1.w)};
    float ss = 0.f;
#pragma unroll
    for (int e = 0; e < 8; ++e) ss += v[e] * v[e];
    const float rstd = 1.0f / sqrtf(wave_sum(ss) * (1.0f / 512.0f) + NORM_EPS);
    const float* w = F.ssm_norm() + grp * 512 + lane * 8;
    v4u ow; ow.x = pk2(v[0] * rstd * w[0], v[1] * rstd * w[1]); ow.y = pk2(v[2] * rstd * w[2], v[3] * rstd * w[3]); ow.z = pk2(v[4] * rstd * w[4], v[5] * rstd * w[5]); ow.w = pk2(v[6] * rstd * w[6], v[7] * rstd * w[7]);
    *(v4u*)(F.MIX() + (size_t)m * DM + 1024 + grp * 512 + lane * 8) = ow;
}
__device__ __forceinline__ void final_norm_row(const Ctx& F, int m, int lane) {
    float s = m < MPROMPT ? (lane < 32 ? F.SS2()[(size_t)m * 32 + lane] : 0.f) : F.SS2S()[(size_t)(m - MPROMPT) * 64 + lane]; s = wave_sum(s);
    const float rstd = 1.0f / sqrtf(s * (1.0f / DM) + NORM_EPS);
    const f32x4* xr = (const f32x4*)(F.X2() + (size_t)m * DM) + lane; const f32x4* wr = (const f32x4*)F.ln_final() + lane;
    f32x4* o = (f32x4*)(m < MPROMPT ? F.out() + O_YP + (size_t)m * DM : F.out() + O_YS + (size_t)(m - MPROMPT) * DM) + lane;
#pragma unroll
    for (int j = 0; j < 8; ++j) o[64 * j] = xr[64 * j] * rstd * wr[64 * j];
}

namespace fa {
typedef short bf16x8 __attribute__((ext_vector_type(8)));
typedef short s16x4 __attribute__((ext_vector_type(4)));
typedef float f32x16 __attribute__((ext_vector_type(16)));
constexpr float C2 = 0.125f * 1.4426950408889634f, MASKV = -1.0e30f;
constexpr int LK = 0, LV = 16384, LWS = 32768, LDS_BYTES_FA = 34816;
__device__ __forceinline__ int crow(int r, int hi) { return (r & 3) + 8 * (r >> 2) + 4 * hi; }
__device__ __forceinline__ float max3f(float a, float b, float c) { float r; asm("v_max3_f32 %0, %1, %2, %3" : "=v"(r) : "v"(a), "v"(b), "v"(c)); return r; }
typedef float f32x2_t __attribute__((ext_vector_type(2))); typedef __bf16 bf16x2_t __attribute__((ext_vector_type(2)));
__device__ __forceinline__ unsigned cvtpk(float lo, float hi) { f32x2_t v = {lo, hi}; bf16x2_t b = __builtin_convertvector(v, bf16x2_t); return __builtin_bit_cast(unsigned, b); }
__device__ __forceinline__ float xmax(float v) { auto rr = __builtin_amdgcn_permlane32_swap(__float_as_uint(v), __float_as_uint(v), false, false); return fmaxf(__uint_as_float(rr[0]), __uint_as_float(rr[1])); }
__device__ __forceinline__ float xsum(float v) { auto rr = __builtin_amdgcn_permlane32_swap(__float_as_uint(v), __float_as_uint(v), false, false); return __uint_as_float(rr[0]) + __uint_as_float(rr[1]); }
__device__ __forceinline__ void qkt(f32x16& p0, f32x16& p1, const LAS unsigned char* Kt, const bf16x8* qr, int r32, int hi) {
    const LAS unsigned char* kb = Kt + hi * 1024 + r32 * 16;
    p0 = f32x16{}; p1 = f32x16{};
#pragma unroll
    for (int d0 = 0; d0 < 4; ++d0) {
        const bf16x8 b0 = *(const LAS bf16x8*)(kb + d0 * 2048), b1 = *(const LAS bf16x8*)(kb + d0 * 2048 + 512);
        p0 = __builtin_amdgcn_mfma_f32_32x32x16_bf16(b0, qr[d0], p0, 0, 0, 0); p1 = __builtin_amdgcn_mfma_f32_32x32x16_bf16(b1, qr[d0], p1, 0, 0, 0); }
}
__device__ __forceinline__ void pv(f32x16* o, unsigned vb, bf16x8 pa0, bf16x8 pa1, bf16x8 pa2, bf16x8 pa3) {
#pragma unroll
    for (int d0 = 0; d0 < 2; ++d0) { s16x4 lo[4], hi[4];
#pragma unroll
        for (int ks = 0; ks < 4; ++ks) {
            asm volatile("ds_read_b64_tr_b16 %0,%1 offset:%c2" : "=&v"(lo[ks]) : "v"(vb), "i"(d0 * 4096 + ks * 1024) : "memory");
            asm volatile("ds_read_b64_tr_b16 %0,%1 offset:%c2" : "=&v"(hi[ks]) : "v"(vb), "i"(d0 * 4096 + ks * 1024 + 512) : "memory"); }
        asm volatile("s_waitcnt lgkmcnt(0)" ::: "memory"); __builtin_amdgcn_sched_barrier(0);
#define FA_PK(k) (bf16x8){lo[k][0], lo[k][1], lo[k][2], lo[k][3], hi[k][0], hi[k][1], hi[k][2], hi[k][3]}
        o[d0] = __builtin_amdgcn_mfma_f32_32x32x16_bf16(pa0, FA_PK(0), o[d0], 0, 0, 0);
        o[d0] = __builtin_amdgcn_mfma_f32_32x32x16_bf16(pa1, FA_PK(1), o[d0], 0, 0, 0);
        o[d0] = __builtin_amdgcn_mfma_f32_32x32x16_bf16(pa2, FA_PK(2), o[d0], 0, 0, 0);
        o[d0] = __builtin_amdgcn_mfma_f32_32x32x16_bf16(pa3, FA_PK(3), o[d0], 0, 0, 0);
#undef FA_PK
    }
}
__device__ __forceinline__ float rowmax(const f32x16& p0, const f32x16& p1) {
    float a = max3f(p0[0], p0[1], p1[0]), b = max3f(p0[2], p0[3], p1[1]); a = max3f(a, p1[2], p1[3]);
#pragma unroll
    for (int r = 4; r < 16; r += 4) { a = max3f(a, p0[r], p0[r + 1]); b = max3f(b, p0[r + 2], p0[r + 3]); a = max3f(a, p1[r], p1[r + 1]); b = max3f(b, p1[r + 2], p1[r + 3]); }
    const float m = fmaxf(a, b);
    return xmax(m);
}
#define FA_BAR() asm volatile("s_waitcnt vmcnt(0) lgkmcnt(0)\n\ts_barrier" ::: "memory")

template <int MODE>
__device__ __forceinline__ void attn_unit(const Ctx& F, LAS unsigned char* shm, int b, int g, int qb) {
    const int tid = threadIdx.x, lane = tid & 63, r32 = lane & 31, hi = lane >> 5; const int wid = __builtin_amdgcn_readfirstlane(tid >> 6);
    const int hd = 4 * g + (wid & 3), th = wid >> 2, trel = 32 * th + r32; const size_t m = (size_t)b * SEQ + 64 * qb + trel;
    const int j_lo = MODE == 0 ? 0 : (qb > 8 ? qb - 8 : 0), j_hi = qb;
    const bf16* KV = (MODE == 0 ? F.KSB() : F.KWB()) + (size_t)b * SEQ * 512 + g * 64;
    const unsigned long long smask = MODE == 0 ? F.SELMASK()[m * 4 + g] : ~0ull;
    bf16x8 qr[4];
    { const bf16* Qp = F.QB() + m * 1024 + hd * 64 + hi * 8;
#pragma unroll
      for (int d0 = 0; d0 < 4; ++d0) qr[d0] = *(const bf16x8*)(Qp + 16 * d0); }
    const bf16* ksrc = KV + (size_t)lane * 512 + wid * 8;
    const bf16* vsrc = KV + 256 + (size_t)(16 * (wid & 3) + (lane >> 2)) * 512 + (wid >> 2) * 32 + (lane & 3) * 8;
    LAS unsigned char* kdst = shm + LK + wid * 1024 + lane * 16; LAS unsigned char* vdst = shm + LV + wid * 1024 + lane * 16;
    const unsigned vb0 = (unsigned)(uintptr_t)(shm + LV) + ((lane >> 4) & 1) * 32 + (lane & 3) * 8 + (4 * hi + ((lane & 15) >> 2)) * 64;
    LAS float* wsf = (LAS float*)(shm + LWS) + wid * 64;
    v4u kreg = *(const v4u*)(ksrc + (size_t)j_lo * 64 * 512), vreg = *(const v4u*)(vsrc + (size_t)j_lo * 64 * 512);
    *(LAS v4u*)kdst = kreg; *(LAS v4u*)vdst = vreg;
    FA_BAR();
    float mref = MASKV, lsum = 0.f; f32x16 o[2]; o[0] = f32x16{}; o[1] = f32x16{};
#define FA_TILE(DIAG) do { \
        const int buf = (j - j_lo) & 1; \
        if (!(DIAG)) { kreg = *(const v4u*)(ksrc + (size_t)(j + 1) * 64 * 512); vreg = *(const v4u*)(vsrc + (size_t)(j + 1) * 64 * 512); } \
        f32x16 p0, p1; \
        qkt(p0, p1, shm + LK + buf * 8192, qr, r32, hi); \
        if (DIAG) { _Pragma("unroll") for (int r = 0; r < 16; ++r) { const int kv = crow(r, hi); if (kv > trel) p0[r] = MASKV; if (kv + 32 > trel) p1[r] = MASKV; } } \
        if (MODE == 1 && qb >= 8 && j == j_lo) { _Pragma("unroll") for (int r = 0; r < 16; ++r) { const int kv = crow(r, hi); if (kv <= trel) p0[r] = MASKV; if (kv + 32 <= trel) p1[r] = MASKV; } } \
        const bool blocked = MODE == 0 && !((smask >> j) & 1ull); \
        float mt = rowmax(p0, p1); mt = (blocked || mt < -1.0e29f) ? MASKV : mt * C2; \
        const bool need = mt > mref + 8.0f; \
        if (__any(need)) { \
            const float mnew = need ? mt : mref, f = __builtin_amdgcn_exp2f(mref - mnew); lsum *= f; mref = mnew; \
            if (hi == 0) wsf[r32] = f; \
            asm volatile("s_waitcnt lgkmcnt(0)" ::: "memory"); \
            _Pragma("unroll") for (int r = 0; r < 16; ++r) { const float fr = wsf[crow(r, hi)]; o[0][r] *= fr; o[1][r] *= fr; } \
        } \
        const float nref = blocked ? -1.0e30f : (mref < -1.0e29f ? 0.f : -mref); float sacc = 0.f;        \
        _Pragma("unroll") for (int r = 0; r < 16; ++r) { p0[r] = __builtin_amdgcn_exp2f(__builtin_fmaf(p0[r], C2, nref)); p1[r] = __builtin_amdgcn_exp2f(__builtin_fmaf(p1[r], C2, nref)); sacc += p0[r] + p1[r]; } \
        lsum += sacc; \
        v4u pw0, pw1, pw2, pw3; \
        pw0.x = cvtpk(p0[0], p0[1]); pw0.y = cvtpk(p0[2], p0[3]); pw0.z = cvtpk(p0[4], p0[5]); pw0.w = cvtpk(p0[6], p0[7]); \
        pw1.x = cvtpk(p0[8], p0[9]); pw1.y = cvtpk(p0[10], p0[11]); pw1.z = cvtpk(p0[12], p0[13]); pw1.w = cvtpk(p0[14], p0[15]); \
        pw2.x = cvtpk(p1[0], p1[1]); pw2.y = cvtpk(p1[2], p1[3]); pw2.z = cvtpk(p1[4], p1[5]); pw2.w = cvtpk(p1[6], p1[7]); \
        pw3.x = cvtpk(p1[8], p1[9]); pw3.y = cvtpk(p1[10], p1[11]); pw3.z = cvtpk(p1[12], p1[13]); pw3.w = cvtpk(p1[14], p1[15]); \
        pv(o, vb0 + buf * 8192, __builtin_bit_cast(bf16x8, pw0), __builtin_bit_cast(bf16x8, pw1), __builtin_bit_cast(bf16x8, pw2), __builtin_bit_cast(bf16x8, pw3)); \
        if (!(DIAG)) { *(LAS v4u*)(kdst + (buf ^ 1) * 8192) = kreg; *(LAS v4u*)(vdst + (buf ^ 1) * 8192) = vreg; } \
        FA_BAR(); } while (0)
    int j = j_lo;
    for (; j < j_hi; ++j) FA_TILE(false);
    FA_TILE(true);
#undef FA_TILE
    lsum = xsum(lsum);
    if (hi == 0) wsf[32 + r32] = lsum;
    asm volatile("s_waitcnt lgkmcnt(0)" ::: "memory");
#pragma unroll
    for (int r = 0; r < 16; ++r) {
        const int q = crow(r, hi); const float rl = 1.0f / wsf[32 + q]; const size_t mm = (size_t)b * SEQ + 64 * qb + 32 * th + q; const size_t oi = mm * 1024 + hd * 64 + r32;
        if (MODE == 1) { F.OWIN()[oi] = o[0][r] * rl; F.OWIN()[oi + 32] = o[1][r] * rl; }
        else { const float* gt = F.GD() + mm * 64 + hd * 3; const float gc = gt[0], gs = gt[1], gw = gt[2];
            const float a0 = gc * F.OCMP()[oi] + gs * (o[0][r] * rl) + gw * F.OWIN()[oi], a1 = gc * F.OCMP()[oi + 32] + gs * (o[1][r] * rl) + gw * F.OWIN()[oi + 32];
            F.MIX()[mm * DM + hd * 64 + r32] = (bf16)f2bf(a0); F.MIX()[mm * DM + hd * 64 + 32 + r32] = (bf16)f2bf(a1); }
    }
    FA_BAR();
}
__device__ __forceinline__ void sel_phase(const Ctx& F, LAS unsigned char* shm) {
    for (int p = blockIdx.x; p < NB * 4 * 32; p += gridDim.x) { const int bg = p >> 5, s = p & 31; attn_unit<0>(F, shm, bg >> 2, bg & 3, 63 - s); attn_unit<0>(F, shm, bg >> 2, bg & 3, s); }
}
__device__ __forceinline__ void win_phase(const Ctx& F, LAS unsigned char* shm) {
    for (int u = blockIdx.x; u < NB * 4 * 64; u += gridDim.x) { const int bg = u >> 6, qb = u & 63; attn_unit<1>(F, shm, bg >> 2, bg & 3, qb); }
}
}
namespace cmpg {
typedef short bf16x8 __attribute__((ext_vector_type(8)));
typedef short s16x4 __attribute__((ext_vector_type(4)));
typedef float f32x16 __attribute__((ext_vector_type(16)));
typedef float f32x2_t __attribute__((ext_vector_type(2))); typedef __bf16 bf16x2_t __attribute__((ext_vector_type(2)));
__device__ __forceinline__ unsigned cvtpk(float lo, float hi) { f32x2_t v = {lo, hi}; bf16x2_t b = __builtin_convertvector(v, bf16x2_t); return __builtin_bit_cast(unsigned, b); }
__device__ __forceinline__ void glds16(const void* gsrc, unsigned lds_dst) { unsigned keep;
    asm volatile("s_mov_b32 %0, m0\n\ts_mov_b32 m0, %2\n\ts_nop 0\n\tglobal_load_lds_dwordx4 %1, off\n\ts_mov_b32 m0, %0" : "=&s"(keep) : "v"(gsrc), "s"(lds_dst) : "memory"); }
constexpr int A_CH = 516 * 16, A_BYTES = 8 * A_CH, B_BYTES = 32768, L_W2 = A_BYTES + 2 * B_BYTES, L_BIAS = L_W2 + 16384, LDS_BYTES_CMP = L_BIAS + 512;
static_assert(LDS_BYTES_CMP <= RING_BYTES, "compress LDS");
__device__ __forceinline__ void unit(const Ctx& F, LAS unsigned char* shm, int unit_id) {
    int tid_o = threadIdx.x; asm volatile("" : "+v"(tid_o));
    const int tid = tid_o, lane = tid & 63, r32 = lane & 31, hi = lane >> 5; const int wid = __builtin_amdgcn_readfirstlane(tid >> 6);
    const bool dec = unit_id < 256; const int uu = dec ? unit_id : unit_id - 256;
    const int b = dec ? uu >> 3 : uu >> 2, c = dec ? (uu >> 2) & 1 : (uu >> 1) & 1, q = dec ? uu & 3 : uu & 1, n0 = 128 * q, ncmp = dec ? NCMP_S : NCMP_P, maxpos = dec ? PAST - 1 : SEQ - 1;
    const float* src0 = dec ? F.cache_cmp() : F.out() + O_KCP + (size_t)b * SEQ * 512; const int* pt = F.page_table() + b * 64;
    const bf16* W1T = F.W1T() + (size_t)c * 128 * 2048;
    f32x4 ar[16]; f32x4 xr = (f32x4){0.f, 0.f, 0.f, 0.f};
    const bf16* pb0 = W1T + (size_t)lane * 2048 + (wid >> 2) * 16 * 64 + ((2 * wid) & 7) * 8;
    const unsigned ldsb = (unsigned)(uintptr_t)(shm + A_BYTES);
#define CG_BASE(blk) ({ int pos_ = 16 * (n0 + (blk)); pos_ = pos_ > maxpos - 15 ? maxpos - 15 : pos_; \
        const unsigned o_ = dec ? ((unsigned)pt[pos_ >> 7] * 128u + (unsigned)(pos_ & 127)) * 512u : (unsigned)pos_ * 512u; (unsigned)__builtin_amdgcn_readfirstlane((int)(o_ + (unsigned)c * 256u)); })
    unsigned bs[16];
#pragma unroll
    for (int e_ = 0; e_ < 16; ++e_) bs[e_] = CG_BASE(16 * wid + e_);
    const unsigned bsx = CG_BASE(128);
    const int lg = lane >> 4, lch = (lane & 15) >> 1, lhalf = lane & 1;
#define CG_LOAD(l_) do { \
        _Pragma("unroll") for (int e_ = 0; e_ < 16; ++e_) ar[e_] = *(const f32x4*)(src0 + (size_t)(bs[e_] + (unsigned)(l_) * 512u) + 4 * lane); \
        if (wid == 0) xr = *(const f32x4*)(src0 + (size_t)(bsx + (unsigned)(l_) * 512u) + 4 * lane); \
        _Pragma("unroll") for (int j_ = 0; j_ < 4; ++j_) glds16(pb0 + (j_ & 1) * 64 * 2048 + (j_ >> 1) * 8 + (l_) * 64, (unsigned)__builtin_amdgcn_readfirstlane(ldsb + ((l_) & 1) * B_BYTES + (4 * wid + j_) * 1024)); } while (0)
#define CG_STORE() do { typedef unsigned u32x2v_ __attribute__((ext_vector_type(2))); LAS unsigned char* a_ = shm + lch * A_CH + (4 * 16 * wid + lg) * 16 + lhalf * 8; \
        _Pragma("unroll") for (int e_ = 0; e_ < 16; ++e_) { u32x2v_ w_; w_.x = cvtpk(ar[e_].x, ar[e_].y); w_.y = cvtpk(ar[e_].z, ar[e_].w); *(LAS u32x2v_*)(a_ + e_ * 64) = w_; } \
        if (wid == 0) { u32x2v_ w2_; w2_.x = cvtpk(xr.x, xr.y); w2_.y = cvtpk(xr.z, xr.w); *(LAS u32x2v_*)(shm + lch * A_CH + (512 + lg) * 16 + lhalf * 8) = w2_; } } while (0)
    { const int f = tid >> 2, d0 = (tid & 3) * 16; const float* wp = F.cmp_w2() + ((size_t)c * 128 + f) * 64 + d0;
      const f32x4 w0 = *(const f32x4*)wp, w1 = *(const f32x4*)(wp + 4), w2 = *(const f32x4*)(wp + 8), w3 = *(const f32x4*)(wp + 12);
      v4u o0, o1; o0.x = cvtpk(w0.x, w0.y); o0.y = cvtpk(w0.z, w0.w); o0.z = cvtpk(w1.x, w1.y); o0.w = cvtpk(w1.z, w1.w); o1.x = cvtpk(w2.x, w2.y); o1.y = cvtpk(w2.z, w2.w); o1.z = cvtpk(w3.x, w3.y); o1.w = cvtpk(w3.z, w3.w);
      LAS unsigned char* wd = shm + L_W2 + ((d0 >> 5) * 8 + (f >> 4)) * 1024 + (f & 15) * 64 + (d0 & 31) * 2; *(LAS v4u*)wd = o0; *(LAS v4u*)(wd + 16) = o1;
      if (tid < 128) { float pe = 0.f;
#pragma unroll
          for (int kc = 0; kc < 16; ++kc) pe += F.PEB()[(c * 16 + kc) * 128 + tid];
          ((LAS float*)(shm + L_BIAS))[tid] = F.cmp_b1()[c * 128 + tid] + pe; } }
    f32x16 acc[2][4];
#pragma unroll
    for (int rb = 0; rb < 2; ++rb)
#pragma unroll
        for (int fb = 0; fb < 4; ++fb) acc[rb][fb] = f32x16{};
    CG_LOAD(0); CG_STORE();
    asm volatile("s_waitcnt vmcnt(0) lgkmcnt(0)\n\ts_barrier" ::: "memory");
    for (int l = 0; l < 16; ++l) {
        if (l < 15) CG_LOAD(l + 1);
#pragma nounroll
        for (int u = 0; u < 2; ++u)
#pragma nounroll
            for (int kk = 0; kk < 4; ++kk) {
                bf16x8 xfr[2];
#pragma unroll
                for (int rb = 0; rb < 2; ++rb) xfr[rb] = *(const LAS bf16x8*)(shm + (2 * kk + hi) * A_CH + (64 * wid + 32 * rb + r32 + 4 * u) * 16);
#pragma unroll
                for (int fb = 0; fb < 4; ++fb) { const bf16x8 wf = *(const LAS bf16x8*)(shm + A_BYTES + (l & 1) * B_BYTES + u * 16384 + (2 * kk + hi) * 2048 + (32 * fb + r32) * 16);
                    acc[0][fb] = __builtin_amdgcn_mfma_f32_32x32x16_bf16(wf, xfr[0], acc[0][fb], 0, 0, 0); acc[1][fb] = __builtin_amdgcn_mfma_f32_32x32x16_bf16(wf, xfr[1], acc[1][fb], 0, 0, 0); }
            }
        asm volatile("s_waitcnt lgkmcnt(0)\n\ts_barrier" ::: "memory");
        if (l < 15) CG_STORE();
        asm volatile("s_waitcnt vmcnt(0) lgkmcnt(0)\n\ts_barrier" ::: "memory");
    }
    const LAS float* hb = (const LAS float*)(shm + L_BIAS);
    const unsigned vb = (unsigned)(uintptr_t)(shm + L_W2) + ((lane >> 4) & 1) * 32 + (lane & 3) * 8 + (4 * hi + ((lane & 15) >> 2)) * 64;
    float* dstb = (dec ? F.KCMPS() : F.KCMPP()) + (size_t)b * ncmp * 512 + c * 256;
    const float b2a = F.cmp_b2()[c * 64 + r32], b2b = F.cmp_b2()[c * 64 + 32 + r32];
#pragma unroll
    for (int rb = 0; rb < 2; ++rb) {
        f32x16 o[2]; o[0] = f32x16{}; o[1] = f32x16{};
#pragma unroll
        for (int fb = 0; fb < 4; ++fb) {
            float h[16];
#pragma unroll
            for (int r = 0; r < 16; ++r) { const float x = acc[rb][fb][r] + hb[32 * fb + (r & 3) + 8 * (r >> 2) + 4 * hi]; h[r] = x / (1.0f + __expf(-x)); }
#pragma unroll
            for (int s2 = 0; s2 < 2; ++s2) {
                v4u pw; pw.x = cvtpk(h[8 * s2], h[8 * s2 + 1]); pw.y = cvtpk(h[8 * s2 + 2], h[8 * s2 + 3]); pw.z = cvtpk(h[8 * s2 + 4], h[8 * s2 + 5]); pw.w = cvtpk(h[8 * s2 + 6], h[8 * s2 + 7]);
                const int ks = 2 * fb + s2;
#pragma unroll
                for (int d0 = 0; d0 < 2; ++d0) { s16x4 lo, hi4;
                    asm volatile("ds_read_b64_tr_b16 %0,%1 offset:%c2" : "=&v"(lo) : "v"(vb), "i"(d0 * 8192 + ks * 1024) : "memory");
                    asm volatile("ds_read_b64_tr_b16 %0,%1 offset:%c2" : "=&v"(hi4) : "v"(vb), "i"(d0 * 8192 + ks * 1024 + 512) : "memory");
                    asm volatile("s_waitcnt lgkmcnt(0)" ::: "memory"); __builtin_amdgcn_sched_barrier(0);
                    const bf16x8 wf = (bf16x8){lo[0], lo[1], lo[2], lo[3], hi4[0], hi4[1], hi4[2], hi4[3]};
                    o[d0] = __builtin_amdgcn_mfma_f32_32x32x16_bf16(__builtin_bit_cast(bf16x8, pw), wf, o[d0], 0, 0, 0); }
            }
        }
#pragma unroll
        for (int r = 0; r < 16; ++r) { const int R = 64 * wid + 32 * rb + (r & 3) + 8 * (r >> 2) + 4 * hi, n = n0 + (R >> 2), g = R & 3;
            if (n < ncmp) { float* d = dstb + (size_t)n * 512 + g * 64; d[r32] = o[0][r] + b2a; d[32 + r32] = o[1][r] + b2b; } }
    }
    asm volatile("s_waitcnt vmcnt(0) lgkmcnt(0)\n\ts_barrier" ::: "memory");
#undef CG_BASE
#undef CG_LOAD
#undef CG_STORE
}

__device__ __forceinline__ void small_unit(const Ctx& F, LAS unsigned char* shm, int u) {
    const int tid = threadIdx.x, lane = tid & 63, r32 = lane & 31, hi = lane >> 5; const int wid = __builtin_amdgcn_readfirstlane(tid >> 6);
    const int b = u >> 6, c = (u >> 5) & 1, n0 = 8 * (u & 31), fb = wid & 3, lh = wid >> 2;
    constexpr int L_W2S = 0, L_BS = 16384, L_PA = 20480, L_PO = 36864;
    { const int f = tid >> 2, d0 = (tid & 3) * 16; const float* wp = F.cmp_w2() + ((size_t)c * 128 + f) * 64 + d0;
      const f32x4 w0 = *(const f32x4*)wp, w1 = *(const f32x4*)(wp + 4), w2 = *(const f32x4*)(wp + 8), w3 = *(const f32x4*)(wp + 12);
      v4u o0, o1; o0.x = cvtpk(w0.x, w0.y); o0.y = cvtpk(w0.z, w0.w); o0.z = cvtpk(w1.x, w1.y); o0.w = cvtpk(w1.z, w1.w); o1.x = cvtpk(w2.x, w2.y); o1.y = cvtpk(w2.z, w2.w); o1.z = cvtpk(w3.x, w3.y); o1.w = cvtpk(w3.z, w3.w);
      LAS unsigned char* wd = shm + L_W2S + ((d0 >> 5) * 8 + (f >> 4)) * 1024 + (f & 15) * 64 + (d0 & 31) * 2; *(LAS v4u*)wd = o0; *(LAS v4u*)(wd + 16) = o1;
      if (tid < 128) { float pe = 0.f;
#pragma unroll
          for (int kc = 0; kc < 16; ++kc) pe += F.PEB()[(c * 16 + kc) * 128 + tid];
          ((LAS float*)(shm + L_BS))[tid] = F.cmp_b1()[c * 128 + tid] + pe; } }
    const int bi = r32 >> 2, g = r32 & 3;
    const float* xb = F.out() + O_KCP + (size_t)b * SEQ * 512 + c * 256 + g * 64 + hi * 8;
    const bf16* wb = F.W1T() + (size_t)c * 128 * 2048 + (size_t)(32 * fb + r32) * 2048 + hi * 8;
    f32x16 acc = f32x16{};
    for (int li = 0; li < 8; ++li) { const int l = 2 * li + lh;
#pragma unroll
        for (int uu = 0; uu < 2; ++uu) { int pos = 16 * (n0 + bi + uu) + l; pos = pos > SEQ - 1 ? SEQ - 1 : pos; const float* xr = xb + (size_t)pos * 512; const bf16* wr = wb + (l + 16 * uu) * 64;
#pragma unroll
            for (int kk = 0; kk < 4; ++kk) { const f32x4 x0 = *(const f32x4*)(xr + 16 * kk), x1 = *(const f32x4*)(xr + 16 * kk + 4);
                v4u xw; xw.x = cvtpk(x0.x, x0.y); xw.y = cvtpk(x0.z, x0.w); xw.z = cvtpk(x1.x, x1.y); xw.w = cvtpk(x1.z, x1.w);
                acc = __builtin_amdgcn_mfma_f32_32x32x16_bf16(*(const bf16x8*)(wr + 16 * kk), __builtin_bit_cast(bf16x8, xw), acc, 0, 0, 0); } } }
    LAS float* pa = (LAS float*)(shm + L_PA) + fb * 1024;
    if (lh == 1) {
#pragma unroll
        for (int r = 0; r < 16; ++r) pa[r * 64 + lane] = acc[r]; }
    asm volatile("s_waitcnt vmcnt(0) lgkmcnt(0)\n\ts_barrier" ::: "memory");
    LAS float* po = (LAS float*)(shm + L_PO) + fb * 2048;
    if (lh == 0) {
        const LAS float* hb = (const LAS float*)(shm + L_BS);
        const unsigned vb = (unsigned)(uintptr_t)(shm + L_W2S) + ((lane >> 4) & 1) * 32 + (lane & 3) * 8 + (4 * hi + ((lane & 15) >> 2)) * 64 + fb * 2048;
        float h[16];
#pragma unroll
        for (int r = 0; r < 16; ++r) { const float x = acc[r] + pa[r * 64 + lane] + hb[32 * fb + (r & 3) + 8 * (r >> 2) + 4 * hi]; h[r] = x / (1.0f + __expf(-x)); }
        f32x16 o[2]; o[0] = f32x16{}; o[1] = f32x16{};
#pragma unroll
        for (int s2 = 0; s2 < 2; ++s2) {
            v4u pw; pw.x = cvtpk(h[8 * s2], h[8 * s2 + 1]); pw.y = cvtpk(h[8 * s2 + 2], h[8 * s2 + 3]); pw.z = cvtpk(h[8 * s2 + 4], h[8 * s2 + 5]); pw.w = cvtpk(h[8 * s2 + 6], h[8 * s2 + 7]);
#pragma unroll
            for (int d0 = 0; d0 < 2; ++d0) { s16x4 lo, hi4;
                asm volatile("ds_read_b64_tr_b16 %0,%1 offset:%c2" : "=&v"(lo) : "v"(vb), "i"(d0 * 8192 + s2 * 1024) : "memory");
                asm volatile("ds_read_b64_tr_b16 %0,%1 offset:%c2" : "=&v"(hi4) : "v"(vb), "i"(d0 * 8192 + s2 * 1024 + 512) : "memory");
                asm volatile("s_waitcnt lgkmcnt(0)" ::: "memory"); __builtin_amdgcn_sched_barrier(0);
                const bf16x8 wf = (bf16x8){lo[0], lo[1], lo[2], lo[3], hi4[0], hi4[1], hi4[2], hi4[3]};
                o[d0] = __builtin_amdgcn_mfma_f32_32x32x16_bf16(__builtin_bit_cast(bf16x8, pw), wf, o[d0], 0, 0, 0); } }
#pragma unroll
        for (int r = 0; r < 16; ++r) { po[r * 64 + lane] = o[0][r]; po[1024 + r * 64 + lane] = o[1][r]; }
    }
    asm volatile("s_waitcnt vmcnt(0) lgkmcnt(0)\n\ts_barrier" ::: "memory");
#pragma unroll
    for (int e = 0; e < 4; ++e) { const int idx = e * 512 + tid, d0 = idx >> 10, r = (idx >> 6) & 15, ln = idx & 63; const LAS float* pp = (const LAS float*)(shm + L_PO) + d0 * 1024 + r * 64 + ln;
        const float v = (pp[0] + pp[2048]) + (pp[4096] + pp[6144]);
        const int R = (r & 3) + 8 * (r >> 2) + 4 * (ln >> 5), n = n0 + (R >> 2), gg = R & 3, d = 32 * d0 + (ln & 31);
        if (n < NCMP_P) F.KCMPP()[((size_t)(b * NCMP_P + n) * 2 + c) * 256 + gg * 64 + d] = v + F.cmp_b2()[c * 64 + d]; }
    asm volatile("s_waitcnt vmcnt(0) lgkmcnt(0)\n\ts_barrier" ::: "memory");
}
}
namespace ssd {
typedef short bf16x8 __attribute__((ext_vector_type(8)));
typedef short s16x4 __attribute__((ext_vector_type(4)));
typedef float f32x16 __attribute__((ext_vector_type(16)));
typedef float f32x2_t __attribute__((ext_vector_type(2))); typedef __bf16 bf16x2_t __attribute__((ext_vector_type(2)));
__device__ __forceinline__ unsigned cvtpk(float lo, float hi) { f32x2_t v = {lo, hi}; bf16x2_t b = __builtin_convertvector(v, bf16x2_t); return __builtin_bit_cast(unsigned, b); }
constexpr int L_B = 0, L_X = 65536, L_ACS = 98304, L_E = 99328, LDS_BYTES_SSD = 100352;
__device__ __forceinline__ int crow(int r, int hi) { return (r & 3) + 8 * (r >> 2) + 4 * hi; }
#define SSD_BAR() asm volatile("s_waitcnt vmcnt(0) lgkmcnt(0)\n\ts_barrier" ::: "memory")
__device__ __forceinline__ void local_unit(const Ctx& F, LAS unsigned char* shm, int u) {
    const int tid = threadIdx.x, lane = tid & 63, r32 = lane & 31, hi = lane >> 5; const int wid = __builtin_amdgcn_readfirstlane(tid >> 6);
    const int b = u >> 8, c = (u >> 4) & 15, h = u & 15, grp = h >> 3; const size_t m0 = (size_t)b * SEQ + c * 256;
    const bf16* XA = F.XBCA16() + m0 * CONV_DIM; const float* DTp = F.DT() + m0 * 16 + h;
    LAS float* acs = (LAS float*)(shm + L_ACS); LAS float* et = (LAS float*)(shm + L_E);
    const float A = -__expf(F.a_log()[h]);
    if (wid == 0) { float a[4], tot = 0.f;
#pragma unroll
        for (int e = 0; e < 4; ++e) { tot += DTp[(size_t)(4 * lane + e) * 16] * A; a[e] = tot; }
        float x = tot;
#pragma unroll
        for (int o = 1; o < 64; o <<= 1) { const float y = __shfl_up(x, o); if (lane >= o) x += y; }
        const float excl = x - tot;
#pragma unroll
        for (int e = 0; e < 4; ++e) { acs[4 * lane + e] = excl + a[e]; F.ACS()[(m0 + 4 * lane + e) * 16 + h] = excl + a[e]; }
        if (lane == 63) F.DEC()[(b * 16 + c) * 16 + h] = __expf(x); }
    { const int s = tid >> 1, hf = tid & 1; const bf16* br = XA + (size_t)s * CONV_DIM + 1024 + grp * 128 + hf * 64;
#pragma unroll
      for (int i = 0; i < 8; ++i) *(LAS v4u*)(shm + L_B + (hf * 8 + i) * 4096 + s * 16) = *(const v4u*)(br + 8 * i);
      const bf16* xr = XA + (size_t)s * CONV_DIM + h * 64 + hf * 32; const float dt = DTp[(size_t)s * 16];
      LAS unsigned char* xd = shm + L_X + (hf * 16 + (s >> 4)) * 1024 + (s & 15) * 64;
#pragma unroll
      for (int i = 0; i < 4; ++i) { const v4u t = *(const v4u*)(xr + 8 * i); v4u o;
          o.x = cvtpk(__uint_as_float(t.x << 16) * dt, __uint_as_float(t.x & 0xffff0000u) * dt); o.y = cvtpk(__uint_as_float(t.y << 16) * dt, __uint_as_float(t.y & 0xffff0000u) * dt);
          o.z = cvtpk(__uint_as_float(t.z << 16) * dt, __uint_as_float(t.z & 0xffff0000u) * dt); o.w = cvtpk(__uint_as_float(t.w << 16) * dt, __uint_as_float(t.w & 0xffff0000u) * dt);
          *(LAS v4u*)(xd + i * 16) = o; } }
    bf16x8 cf[8];
    { const bf16* cr = XA + (size_t)(32 * wid + r32) * CONV_DIM + 1280 + grp * 128 + hi * 8;
#pragma unroll
      for (int kk = 0; kk < 8; ++kk) cf[kk] = *(const bf16x8*)(cr + 16 * kk); }
    SSD_BAR();
    if (tid < 256) et[tid] = __expf(acs[255] - acs[tid]);
    const float acl = acs[32 * wid + r32];
    f32x16 o[2]; o[0] = f32x16{}; o[1] = f32x16{};
    const int jmax = (32 * wid + 31) >> 6, lrel = 32 * wid + r32;
    const unsigned vbx = (unsigned)(uintptr_t)(shm + L_X) + ((lane >> 4) & 1) * 32 + (lane & 3) * 8 + (4 * hi + ((lane & 15) >> 2)) * 64;
    for (int j = 0; j <= jmax; ++j) {
        f32x16 p0 = f32x16{}, p1 = f32x16{};
        const LAS unsigned char* kb = shm + L_B + hi * 4096 + (64 * j + r32) * 16;
#pragma unroll
        for (int kk = 0; kk < 8; ++kk) { const bf16x8 b0 = *(const LAS bf16x8*)(kb + kk * 8192), b1 = *(const LAS bf16x8*)(kb + kk * 8192 + 512);
            p0 = __builtin_amdgcn_mfma_f32_32x32x16_bf16(b0, cf[kk], p0, 0, 0, 0); p1 = __builtin_amdgcn_mfma_f32_32x32x16_bf16(b1, cf[kk], p1, 0, 0, 0); }
#pragma unroll
        for (int q = 0; q < 4; ++q) { const f32x4 a0 = *(const LAS f32x4*)(acs + 64 * j + 8 * q + 4 * hi), a1 = *(const LAS f32x4*)(acs + 64 * j + 32 + 8 * q + 4 * hi);
#pragma unroll
            for (int e = 0; e < 4; ++e) { const int r = 4 * q + e, s0 = 64 * j + 8 * q + 4 * hi + e;
                p0[r] = (s0 <= lrel) ? p0[r] * __expf(acl - a0[e]) : 0.f; p1[r] = (s0 + 32 <= lrel) ? p1[r] * __expf(acl - a1[e]) : 0.f; } }
        v4u pw0, pw1, pw2, pw3;
        pw0.x = cvtpk(p0[0], p0[1]); pw0.y = cvtpk(p0[2], p0[3]); pw0.z = cvtpk(p0[4], p0[5]); pw0.w = cvtpk(p0[6], p0[7]);
        pw1.x = cvtpk(p0[8], p0[9]); pw1.y = cvtpk(p0[10], p0[11]); pw1.z = cvtpk(p0[12], p0[13]); pw1.w = cvtpk(p0[14], p0[15]);
        pw2.x = cvtpk(p1[0], p1[1]); pw2.y = cvtpk(p1[2], p1[3]); pw2.z = cvtpk(p1[4], p1[5]); pw2.w = cvtpk(p1[6], p1[7]);
        pw3.x = cvtpk(p1[8], p1[9]); pw3.y = cvtpk(p1[10], p1[11]); pw3.z = cvtpk(p1[12], p1[13]); pw3.w = cvtpk(p1[14], p1[15]);
        const unsigned vb = vbx + j * 4096;
#pragma unroll
        for (int d0 = 0; d0 < 2; ++d0) { s16x4 lo[4], hi4[4];
#pragma unroll
            for (int ks = 0; ks < 4; ++ks) {
                asm volatile("ds_read_b64_tr_b16 %0,%1 offset:%c2" : "=&v"(lo[ks]) : "v"(vb), "i"(d0 * 16384 + ks * 1024) : "memory");
                asm volatile("ds_read_b64_tr_b16 %0,%1 offset:%c2" : "=&v"(hi4[ks]) : "v"(vb), "i"(d0 * 16384 + ks * 1024 + 512) : "memory"); }
            asm volatile("s_waitcnt lgkmcnt(0)" ::: "memory"); __builtin_amdgcn_sched_barrier(0);
#define SSD_PK(k) (bf16x8){lo[k][0], lo[k][1], lo[k][2], lo[k][3], hi4[k][0], hi4[k][1], hi4[k][2], hi4[k][3]}
            o[d0] = __builtin_amdgcn_mfma_f32_32x32x16_bf16(__builtin_bit_cast(bf16x8, pw0), SSD_PK(0), o[d0], 0, 0, 0);
            o[d0] = __builtin_amdgcn_mfma_f32_32x32x16_bf16(__builtin_bit_cast(bf16x8, pw1), SSD_PK(1), o[d0], 0, 0, 0);
            o[d0] = __builtin_amdgcn_mfma_f32_32x32x16_bf16(__builtin_bit_cast(bf16x8, pw2), SSD_PK(2), o[d0], 0, 0, 0);
            o[d0] = __builtin_amdgcn_mfma_f32_32x32x16_bf16(__builtin_bit_cast(bf16x8, pw3), SSD_PK(3), o[d0], 0, 0, 0);
#undef SSD_PK
        }
    }
#pragma unroll
    for (int r = 0; r < 16; ++r) { float* yp = F.YSSD() + (m0 + 32 * wid + crow(r, hi)) * 1024 + h * 64 + r32; yp[0] = o[0][r]; yp[32] = o[1][r]; }
    { const int pb = wid & 1, nb = wid >> 1; f32x16 st = f32x16{};
      const int li = lane & 15, g16 = (lane >> 4) & 1, c4 = li & 3;
      const unsigned vbB = (unsigned)(uintptr_t)(shm + L_B) + (4 * nb + 2 * g16 + (c4 >> 1)) * 4096 + (4 * hi + (li >> 2)) * 16 + (c4 & 1) * 8;
      const unsigned vbA = vbx + pb * 16384;
      SSD_BAR();
      for (int ks = 0; ks < 16; ++ks) { s16x4 xl, xh, bl, bh;
          asm volatile("ds_read_b64_tr_b16 %0,%1" : "=&v"(xl) : "v"(vbA + ks * 1024) : "memory");
          asm volatile("ds_read_b64_tr_b16 %0,%1 offset:512" : "=&v"(xh) : "v"(vbA + ks * 1024) : "memory");
          asm volatile("ds_read_b64_tr_b16 %0,%1" : "=&v"(bl) : "v"(vbB + ks * 256) : "memory");
          asm volatile("ds_read_b64_tr_b16 %0,%1 offset:128" : "=&v"(bh) : "v"(vbB + ks * 256) : "memory");
          const f32x4 e0 = *(const LAS f32x4*)(et + 16 * ks + 4 * hi), e1 = *(const LAS f32x4*)(et + 16 * ks + 8 + 4 * hi);
          asm volatile("s_waitcnt lgkmcnt(0)" ::: "memory"); __builtin_amdgcn_sched_barrier(0);
          v4u xa;
          xa.x = cvtpk(__uint_as_float((unsigned)(unsigned short)xl[0] << 16) * e0[0], __uint_as_float((unsigned)(unsigned short)xl[1] << 16) * e0[1]);
          xa.y = cvtpk(__uint_as_float((unsigned)(unsigned short)xl[2] << 16) * e0[2], __uint_as_float((unsigned)(unsigned short)xl[3] << 16) * e0[3]);
          xa.z = cvtpk(__uint_as_float((unsigned)(unsigned short)xh[0] << 16) * e1[0], __uint_as_float((unsigned)(unsigned short)xh[1] << 16) * e1[1]);
          xa.w = cvtpk(__uint_as_float((unsigned)(unsigned short)xh[2] << 16) * e1[2], __uint_as_float((unsigned)(unsigned short)xh[3] << 16) * e1[3]);
          const bf16x8 bfr = (bf16x8){bl[0], bl[1], bl[2], bl[3], bh[0], bh[1], bh[2], bh[3]};
          st = __builtin_amdgcn_mfma_f32_32x32x16_bf16(__builtin_bit_cast(bf16x8, xa), bfr, st, 0, 0, 0); }
      float* sp = F.ST() + ((size_t)((b * 16 + c) * 16 + h)) * 8192 + 32 * nb + r32;
#pragma unroll
      for (int r = 0; r < 16; ++r) sp[(size_t)(32 * pb + crow(r, hi)) * 128] = st[r]; }
    SSD_BAR();
}

__device__ __forceinline__ void final_unit(const Ctx& F, LAS unsigned char* shm, int u) {
    const int tid = threadIdx.x, lane = tid & 63, r32 = lane & 31, hi = lane >> 5; const int wid = __builtin_amdgcn_readfirstlane(tid >> 6);
    const int qq = u & 3, grp = (u >> 2) & 1, c = (u >> 3) & 15, b = u >> 7, h = 8 * grp + wid; const size_t m0 = (size_t)b * SEQ + c * 256 + qq * 64;
    f32x16 acc[2][2];
#pragma unroll
    for (int pb = 0; pb < 2; ++pb) {
        bf16x8 sfr[8];
        { int lane_o = lane; asm volatile("" : "+v"(lane_o));
          const bf16* sp = F.SIN() + ((size_t)((b * 16 + c) * 16 + h) * 16 + pb * 8) * 512 + lane_o * 8;
#pragma unroll
          for (int kk = 0; kk < 8; ++kk) sfr[kk] = *(const bf16x8*)(sp + kk * 512); }
#pragma unroll
        for (int lb = 0; lb < 2; ++lb) { const bf16* cr = F.XBCA16() + (m0 + 32 * lb + r32) * CONV_DIM + 1280 + grp * 128 + hi * 8; f32x16 a = f32x16{};
#pragma unroll
            for (int kk = 0; kk < 8; ++kk) a = __builtin_amdgcn_mfma_f32_32x32x16_bf16(*(const bf16x8*)(cr + 16 * kk), sfr[kk], a, 0, 0, 0);
            acc[lb][pb] = a; }
    }
    LAS float* yt = (LAS float*)shm;
#pragma unroll
    for (int lb = 0; lb < 2; ++lb)
#pragma unroll
        for (int r = 0; r < 16; ++r) { LAS float* yp = yt + (32 * lb + crow(r, hi)) * 512 + wid * 64 + r32; yp[0] = acc[lb][0][r]; yp[32] = acc[lb][1][r]; }
    SSD_BAR();
    { const int hl = lane >> 3, hh = 8 * grp + hl, ch = hh * 64 + 8 * (lane & 7);
      const float Dk = F.d_skip()[hh]; const f32x4 n0 = *(const f32x4*)(F.ssm_norm() + ch), n1 = *(const f32x4*)(F.ssm_norm() + ch + 4);
#pragma unroll
      for (int half = 0; half < 2; ++half) {
          f32x4 yd[4][2], zz[4][2]; v4u xx[4]; float ea[4];
#pragma unroll
          for (int i = 0; i < 4; ++i) { const size_t mm = m0 + 8 * wid + 4 * half + i;
              yd[i][0] = *(const f32x4*)(F.YSSD() + mm * 1024 + ch); yd[i][1] = *(const f32x4*)(F.YSSD() + mm * 1024 + ch + 4); zz[i][0] = *(const f32x4*)(F.Z() + mm * 1024 + ch); zz[i][1] = *(const f32x4*)(F.Z() + mm * 1024 + ch + 4);
              xx[i] = *(const v4u*)(F.XBCA16() + mm * CONV_DIM + ch); ea[i] = __expf(F.ACS()[mm * 16 + hh]); }
#pragma unroll
          for (int i = 0; i < 4; ++i) { const int row = 8 * wid + 4 * half + i; const size_t mm = m0 + row;
              const f32x4 a0 = *(const LAS f32x4*)(yt + row * 512 + hl * 64 + 8 * (lane & 7)), a1 = *(const LAS f32x4*)(yt + row * 512 + hl * 64 + 8 * (lane & 7) + 4);
              float v[8] = {a0.x, a0.y, a0.z, a0.w, a1.x, a1.y, a1.z, a1.w};
              const float xv[8] = {__uint_as_float(xx[i].x << 16), __uint_as_float(xx[i].x & 0xffff0000u), __uint_as_float(xx[i].y << 16), __uint_as_float(xx[i].y & 0xffff0000u), __uint_as_float(xx[i].z << 16), __uint_as_float(xx[i].z & 0xffff0000u), __uint_as_float(xx[i].w << 16), __uint_as_float(xx[i].w & 0xffff0000u)};
              const float yv[8] = {yd[i][0].x, yd[i][0].y, yd[i][0].z, yd[i][0].w, yd[i][1].x, yd[i][1].y, yd[i][1].z, yd[i][1].w}, zv[8] = {zz[i][0].x, zz[i][0].y, zz[i][0].z, zz[i][0].w, zz[i][1].x, zz[i][1].y, zz[i][1].z, zz[i][1].w};
              float ss = 0.f;
#pragma unroll
              for (int e = 0; e < 8; ++e) { float y = v[e] * ea[i] + yv[e] + Dk * xv[e]; y *= zv[e] / (1.0f + __expf(-zv[e])); v[e] = y; ss += y * y; }
              const float rstd = 1.0f / sqrtf(wave_sum(ss) * (1.0f / 512.0f) + NORM_EPS);
              v4u w; w.x = cvtpk(v[0] * rstd * n0.x, v[1] * rstd * n0.y); w.y = cvtpk(v[2] * rstd * n0.z, v[3] * rstd * n0.w); w.z = cvtpk(v[4] * rstd * n1.x, v[5] * rstd * n1.y); w.w = cvtpk(v[6] * rstd * n1.z, v[7] * rstd * n1.w);
              *(v4u*)(F.MIX() + mm * DM + 1024 + ch) = w; } } }
    SSD_BAR();
}


__device__ __forceinline__ void carry_phase(const Ctx& F) {
    const int gt = blockIdx.x * (NWAVES * 64) + threadIdx.x, NGT = gridDim.x * NWAVES * 64;
    for (int i = gt; i < NB * 16 * 64 * 16; i += NGT) { const int n8 = i & 15, p = (i >> 4) & 63, h = (i >> 10) & 15, b = i >> 14;
        const int pb = p >> 5, kk = n8 >> 1, ln = (n8 & 1) * 32 + (p & 31);
        float sv[8] = {0.f, 0.f, 0.f, 0.f, 0.f, 0.f, 0.f, 0.f};
        for (int c = 0; c < 16; ++c) { const size_t ci = (size_t)(b * 16 + c) * 16 + h;
            v4u w; w.x = cvtpk(sv[0], sv[1]); w.y = cvtpk(sv[2], sv[3]); w.z = cvtpk(sv[4], sv[5]); w.w = cvtpk(sv[6], sv[7]);
            *(v4u*)(F.SIN() + ((ci * 16 + pb * 8 + kk) * 64 + ln) * 8) = w;
            const float dec = F.DEC()[ci]; const float* sp = F.ST() + ci * 8192 + (size_t)p * 128 + n8 * 8; const f32x4 a = *(const f32x4*)sp, d = *(const f32x4*)(sp + 4);
            sv[0] = sv[0] * dec + a.x; sv[1] = sv[1] * dec + a.y; sv[2] = sv[2] * dec + a.z; sv[3] = sv[3] * dec + a.w; sv[4] = sv[4] * dec + d.x; sv[5] = sv[5] * dec + d.y; sv[6] = sv[6] * dec + d.z; sv[7] = sv[7] * dec + d.w; }
        float* op = F.out() + O_SSP + ((size_t)(b * 16 + h) * 64 + p) * 128 + n8 * 8;
        *(f32x4*)op = (f32x4){sv[0], sv[1], sv[2], sv[3]}; *(f32x4*)(op + 4) = (f32x4){sv[4], sv[5], sv[6], sv[7]}; }
}
}
namespace cmpa {
using fa::bf16x8; using fa::f32x16;
constexpr int LK = 0, LV = 32768, LPS = 65536, PS_W = 8 * 264 * 4, IMP_W = 8 * 64 * 4, WAVE_B = PS_W + IMP_W;
static_assert(LPS + 8 * WAVE_B <= RING_BYTES, "cmpa LDS");
__device__ __forceinline__ float quad_sum(float v) {
    v += __int_as_float(__builtin_amdgcn_mov_dpp(__float_as_int(v), 0xB1, 0xF, 0xF, true));
    v += __int_as_float(__builtin_amdgcn_mov_dpp(__float_as_int(v), 0x4E, 0xF, 0xF, true));
    return v; }
__device__ __forceinline__ void unit(const Ctx& F, LAS unsigned char* shm, int b, int g, int qb) {
    const int tid = threadIdx.x, lane = tid & 63, r32 = lane & 31, hi = lane >> 5; const int wid = __builtin_amdgcn_readfirstlane(tid >> 6);
    const int ntile = (4 * qb + 3 + 63) >> 6;
    const float* KC = F.KCMPP() + (size_t)b * NCMP_P * 512 + g * 64;
    for (int t = 0; t < ntile; ++t) {
        int nk = 64 * t + lane; nk = nk > NCMP_P - 1 ? NCMP_P - 1 : nk; const float* kp = KC + (size_t)nk * 512 + wid * 8; const f32x4 k0 = *(const f32x4*)kp, k1 = *(const f32x4*)(kp + 4);
        v4u kw; kw.x = fa::cvtpk(k0.x, k0.y); kw.y = fa::cvtpk(k0.z, k0.w); kw.z = fa::cvtpk(k1.x, k1.y); kw.w = fa::cvtpk(k1.z, k1.w);
        *(LAS v4u*)(shm + LK + t * 8192 + wid * 1024 + lane * 16) = kw;
        int nv = 64 * t + 16 * (wid & 3) + (lane >> 2); nv = nv > NCMP_P - 1 ? NCMP_P - 1 : nv; const float* vp = KC + 256 + (size_t)nv * 512 + (wid >> 2) * 32 + (lane & 3) * 8; const f32x4 v0 = *(const f32x4*)vp, v1 = *(const f32x4*)(vp + 4);
        v4u vw; vw.x = fa::cvtpk(v0.x, v0.y); vw.y = fa::cvtpk(v0.z, v0.w); vw.z = fa::cvtpk(v1.x, v1.y); vw.w = fa::cvtpk(v1.z, v1.w);
        *(LAS v4u*)(shm + LV + t * 8192 + wid * 1024 + lane * 16) = vw; }
    const int tl = r32 >> 2, hd = 4 * g + (r32 & 3), t = 64 * qb + 8 * wid + tl; const size_t m = (size_t)b * SEQ + t;
    bf16x8 qr[4];
    { const bf16* Qp = F.QB() + m * 1024 + hd * 64 + hi * 8;
#pragma unroll
      for (int d0 = 0; d0 < 4; ++d0) qr[d0] = *(const bf16x8*)(Qp + 16 * d0); }
    FA_BAR();
    const int nvis = t >= 31 ? ((t - 31) >> 4) + 1 : 0;
    float mx = fa::MASKV, lsum = 0.f;
    for (int tt = 0; tt < ntile; ++tt) { f32x16 p0, p1; fa::qkt(p0, p1, shm + LK + tt * 8192, qr, r32, hi);
#pragma unroll
        for (int r = 0; r < 16; ++r) { const int n0 = 64 * tt + fa::crow(r, hi); p0[r] = n0 < nvis ? p0[r] * fa::C2 : fa::MASKV; p1[r] = n0 + 32 < nvis ? p1[r] * fa::C2 : fa::MASKV; }
        const float mn = fmaxf(mx, fa::rowmax(p0, p1)); float acc = 0.f;
#pragma unroll
        for (int r = 0; r < 16; ++r) { const int n0 = 64 * tt + fa::crow(r, hi); acc += (n0 < nvis ? __builtin_amdgcn_exp2f(p0[r] - mn) : 0.f) + (n0 + 32 < nvis ? __builtin_amdgcn_exp2f(p1[r] - mn) : 0.f); }
        lsum = lsum * __builtin_amdgcn_exp2f(mx - mn) + acc; mx = mn; }
    lsum = fa::xsum(lsum); const float inv = 1.0f / fmaxf(lsum, 1e-30f);
    LAS float* ps = (LAS float*)(shm + LPS + wid * WAVE_B); LAS float* impl = (LAS float*)(shm + LPS + wid * WAVE_B + PS_W);
    for (int i = lane; i < 8 * 264; i += 64) ps[i] = 0.f;
    asm volatile("s_waitcnt lgkmcnt(0)" ::: "memory");
    f32x16 o[2]; o[0] = f32x16{}; o[1] = f32x16{};
    const unsigned vb0 = (unsigned)(uintptr_t)(shm + LV) + ((lane >> 4) & 1) * 32 + (lane & 3) * 8 + (4 * hi + ((lane & 15) >> 2)) * 64;
    for (int tt = 0; tt < ntile; ++tt) { f32x16 p0, p1; fa::qkt(p0, p1, shm + LK + tt * 8192, qr, r32, hi);
#pragma unroll
        for (int r = 0; r < 16; ++r) { const int n0 = 64 * tt + fa::crow(r, hi); p0[r] = n0 < nvis ? __builtin_amdgcn_exp2f(p0[r] * fa::C2 - mx) * inv : 0.f; p1[r] = n0 + 32 < nvis ? __builtin_amdgcn_exp2f(p1[r] * fa::C2 - mx) * inv : 0.f; }
        v4u pw0, pw1, pw2, pw3;
        pw0.x = fa::cvtpk(p0[0], p0[1]); pw0.y = fa::cvtpk(p0[2], p0[3]); pw0.z = fa::cvtpk(p0[4], p0[5]); pw0.w = fa::cvtpk(p0[6], p0[7]);
        pw1.x = fa::cvtpk(p0[8], p0[9]); pw1.y = fa::cvtpk(p0[10], p0[11]); pw1.z = fa::cvtpk(p0[12], p0[13]); pw1.w = fa::cvtpk(p0[14], p0[15]);
        pw2.x = fa::cvtpk(p1[0], p1[1]); pw2.y = fa::cvtpk(p1[2], p1[3]); pw2.z = fa::cvtpk(p1[4], p1[5]); pw2.w = fa::cvtpk(p1[6], p1[7]);
        pw3.x = fa::cvtpk(p1[8], p1[9]); pw3.y = fa::cvtpk(p1[10], p1[11]); pw3.z = fa::cvtpk(p1[12], p1[13]); pw3.w = fa::cvtpk(p1[14], p1[15]);
        fa::pv(o, vb0 + tt * 8192, __builtin_bit_cast(bf16x8, pw0), __builtin_bit_cast(bf16x8, pw1), __builtin_bit_cast(bf16x8, pw2), __builtin_bit_cast(bf16x8, pw3));
#pragma unroll
        for (int r = 0; r < 16; ++r) { const float s0 = quad_sum(p0[r]), s1 = quad_sum(p1[r]);
            if ((r32 & 3) == (tt & 3)) { const int n0 = 64 * tt + fa::crow(r, hi); ps[tl * 264 + 1 + n0] = s0; ps[tl * 264 + 1 + n0 + 32] = s1; } } }
#pragma unroll
    for (int r = 0; r < 16; ++r) { const int q = fa::crow(r, hi); float* op = F.OCMP() + ((size_t)b * SEQ + 64 * qb + 8 * wid + (q >> 2)) * 1024 + (4 * g + (q & 3)) * 64 + r32; op[0] = o[0][r]; op[32] = o[1][r]; }
    asm volatile("s_waitcnt lgkmcnt(0)" ::: "memory");
    const int tk = lane >> 3, jsub = lane & 7; float mine[8];
#pragma unroll
    for (int k = 0; k < 8; ++k) { const int j = jsub + 8 * k; const LAS float* pp = ps + tk * 264 + 4 * j;
        float v = pp[0] + 2.0f * (pp[1] + pp[2] + pp[3]) + pp[4];
        if (j == 0 || j == qb || j == qb - 1) v = 1.0e4f; if (j > qb) v = -1.0e4f;
        mine[k] = v; impl[tk * 64 + j] = v; }
    asm volatile("s_waitcnt lgkmcnt(0)" ::: "memory");
    int cnt[8];
#pragma unroll
    for (int k = 0; k < 8; ++k) cnt[k] = 0;
    for (int i4 = 0; i4 < 16; ++i4) { const f32x4 vv = *(const LAS f32x4*)(impl + tk * 64 + 4 * i4);
#pragma unroll
        for (int e = 0; e < 4; ++e) { const float v = vv[e]; const int kk = 4 * i4 + e;
#pragma unroll
            for (int k = 0; k < 8; ++k) { const int j = jsub + 8 * k; cnt[k] += ((v > mine[k]) || (v == mine[k] && kk < j)) ? 1 : 0; } } }
    unsigned mlo = 0u, mhi = 0u;
#pragma unroll
    for (int k = 0; k < 8; ++k) { if (cnt[k] < 16) { const int j = jsub + 8 * k; if (j < 32) mlo |= 1u << j; else mhi |= 1u << (j - 32); } }
#pragma unroll
    for (int o2 = 1; o2 < 8; o2 <<= 1) { mlo |= (unsigned)__shfl_xor((int)mlo, o2); mhi |= (unsigned)__shfl_xor((int)mhi, o2); }
    if (jsub == 0) F.SELMASK()[((size_t)b * SEQ + 64 * qb + 8 * wid + tk) * 4 + g] = ((unsigned long long)mhi << 32) | mlo;
    FA_BAR();
}
__device__ __forceinline__ void phase(const Ctx& F, LAS unsigned char* shm) {
    for (int u = blockIdx.x; u < NB * 4 * 64; u += gridDim.x) { const int bg = u >> 6; int qb = u & 63; qb = (u >= 256) ? 63 - qb : qb; unit(F, shm, bg >> 2, bg & 3, qb); }
}
}
namespace sk {
typedef short bf16x8 __attribute__((ext_vector_type(8)));
typedef float f32x16 __attribute__((ext_vector_type(16)));
__device__ __forceinline__ int crow(int r, int hi) { return (r & 3) + 8 * (r >> 2) + 4 * hi; }
__device__ __forceinline__ float half_sum(float v) {
#pragma unroll
    for (int o = 1; o < 32; o <<= 1) v += __shfl_xor(v, o);
    return v; }
#define SK_BAR() asm volatile("s_waitcnt vmcnt(0) lgkmcnt(0)\n\ts_barrier" ::: "memory")
template <class Epi>
__device__ __forceinline__ void phase(LAS unsigned char* shm, const bf16* A, const bf16* Bt, int N, int K, int wg_rel, int nwg, const Epi& E) {
    const int tid = threadIdx.x, lane = tid & 63, r32 = lane & 31, hi = lane >> 5; const int wid = __builtin_amdgcn_readfirstlane(tid >> 6);
    const int ks = K >> 3; LAS float* red = (LAS float*)shm;
    for (int blk = wg_rel; blk < (N >> 5); blk += nwg) {
        const bf16* ap = A + (size_t)r32 * K + wid * ks + hi * 8; const bf16* bp = Bt + (size_t)(blk * 32 + r32) * K + wid * ks + hi * 8;
        f32x16 acc = f32x16{};
        for (int k = 0; k < ks; k += 256) { bf16x8 a[16], b[16];
#pragma unroll
            for (int i = 0; i < 16; ++i) { a[i] = *(const bf16x8*)(ap + k + 16 * i); b[i] = *(const bf16x8*)(bp + k + 16 * i); }
#pragma unroll
            for (int i = 0; i < 16; ++i) acc = __builtin_amdgcn_mfma_f32_32x32x16_bf16(a[i], b[i], acc, 0, 0, 0); }
#pragma unroll
        for (int r = 0; r < 16; ++r) red[(wid * 16 + r) * 64 + lane] = acc[r];
        SK_BAR();
        float v0 = 0.f, v1 = 0.f;
#pragma unroll
        for (int w = 0; w < 8; ++w) { v0 += red[(w * 16 + 2 * wid) * 64 + lane]; v1 += red[(w * 16 + 2 * wid + 1) * 64 + lane]; }
        E(blk, blk * 32 + r32, crow(2 * wid, hi), v0, crow(2 * wid + 1, hi), v1, r32);
        SK_BAR();
    }
}
struct EpiInS { bf16 *QB, *KVB; size_t kvstride; float *Z, *XBC, *GD, *out;
    __device__ __forceinline__ void one(int cp, int row, float v) const { const size_t m = (size_t)MPROMPT + row;
        if (cp < 1024) QB[m * 1024 + cp] = (bf16)f2bf(v);
        else if (cp < 2560) { const int which = (cp - 1024) >> 9, cc = (cp - 1024) & 511; KVB[(size_t)which * kvstride + m * 512 + cc] = (bf16)f2bf(v);
            float* fo = which == 0 ? out + O_KCS + (size_t)row * 512 : (which == 1 ? out + O_KSS + (size_t)row * 512 : out + O_KWS + (size_t)(row * 512 + 511) * 512); fo[cc] = v; }
        else if (cp < 3584) Z[m * 1024 + cp - 2560] = v;
        else if (cp < 5120) XBC[m * CONV_DIM + cp - 3584] = v;
        else if (cp < 5168) GD[m * 64 + cp - 5120] = 1.0f / (1.0f + __expf(-v));
        else if (cp < NCOLS_IN) GD[m * 64 + cp - 5120] = v; }
    __device__ __forceinline__ void operator()(int, int col, int r0, float v0, int r1, float v1, int) const { one(col, r0, v0); one(col, r1, v1); } };
struct EpiResS { const float* xres; float* X1; bf16* X1B; float* SS;
    __device__ __forceinline__ void operator()(int blk, int col, int r0, float v0, int r1, float v1, int r32) const {
        v0 += xres[(size_t)r0 * DM + col]; v1 += xres[(size_t)r1 * DM + col]; X1[(size_t)r0 * DM + col] = v0; X1[(size_t)r1 * DM + col] = v1;
        if (X1B) { X1B[(size_t)r0 * DM + col] = (bf16)f2bf(v0); X1B[(size_t)r1 * DM + col] = (bf16)f2bf(v1); }
        const float s0 = half_sum(v0 * v0), s1 = half_sum(v1 * v1); if (r32 == 0) { SS[r0 * 64 + blk] = s0; SS[r1 * 64 + blk] = s1; } } };
struct EpiUpS { bf16* H; const LAS float* rs;
    __device__ __forceinline__ void operator()(int, int col, int r0, float v0, int r1, float v1, int) const {
        float a = fmaxf(v0 * rs[r0], 0.f), b = fmaxf(v1 * rs[r1], 0.f); H[(size_t)r0 * DFF + col] = (bf16)f2bf(a * a); H[(size_t)r1 * DFF + col] = (bf16)f2bf(b * b); } };
}
namespace deca {
constexpr int L_QS = 0, L_SC = 1024, L_PART = 17408, L_PS = 25600, L_IMP = 27776;
#define DA_BAR() asm volatile("s_waitcnt vmcnt(0) lgkmcnt(0)\n\ts_barrier" ::: "memory")
__device__ __forceinline__ void load_row(const KeyRef& kr, const void* p, float (&k)[64]) {
    if (kr.f32) { const f32x4* q = (const f32x4*)p;
#pragma unroll
        for (int i = 0; i < 16; ++i) { const f32x4 t = q[i]; k[4 * i] = t.x; k[4 * i + 1] = t.y; k[4 * i + 2] = t.z; k[4 * i + 3] = t.w; } }
    else { const v4u* q = (const v4u*)p;
#pragma unroll
        for (int i = 0; i < 8; ++i) { const v4u t = q[i]; k[8 * i] = __uint_as_float(t.x << 16); k[8 * i + 1] = __uint_as_float(t.x & 0xffff0000u); k[8 * i + 2] = __uint_as_float(t.y << 16); k[8 * i + 3] = __uint_as_float(t.y & 0xffff0000u);
            k[8 * i + 4] = __uint_as_float(t.z << 16); k[8 * i + 5] = __uint_as_float(t.z & 0xffff0000u); k[8 * i + 6] = __uint_as_float(t.w << 16); k[8 * i + 7] = __uint_as_float(t.w & 0xffff0000u); } }
}
template <int NCH, int MODE, class KF>
__device__ __forceinline__ void unit(const Ctx& F, LAS unsigned char* shm, int m, int g, const KF& kf) {
    const int tid = threadIdx.x, lane = tid & 63; const int wid = __builtin_amdgcn_readfirstlane(tid >> 6);
    LAS float* qs = (LAS float*)(shm + L_QS); LAS float* sc = (LAS float*)(shm + L_SC); LAS float* part = (LAS float*)(shm + L_PART);
    constexpr int NK = NCH * 64, CPW = NCH / 8;
    if (tid < 256) qs[tid] = bf2f(F.QB()[(size_t)m * 1024 + g * 256 + tid]) * 0.125f;
    DA_BAR();
#pragma unroll
    for (int i = 0; i < CPW; ++i) { const int c = wid + 8 * i; const KeyRef kr = kf(c, lane); float s[4] = {-INFINITY, -INFINITY, -INFINITY, -INFINITY};
        if (kr.valid) { float k[64]; load_row(kr, kr.k, k);
#pragma unroll
            for (int h = 0; h < 4; ++h) { float a = 0.f;
#pragma unroll
                for (int d4 = 0; d4 < 16; ++d4) { const f32x4 q4 = *(const LAS f32x4*)(qs + h * 64 + 4 * d4); a += q4.x * k[4 * d4] + q4.y * k[4 * d4 + 1] + q4.z * k[4 * d4 + 2] + q4.w * k[4 * d4 + 3]; }
                s[h] = a; } }
#pragma unroll
        for (int h = 0; h < 4; ++h) sc[h * NK + c * 64 + lane] = s[h]; }
    DA_BAR();
    float mh[4], ih[4];
#pragma unroll
    for (int h = 0; h < 4; ++h) { float mx = -INFINITY;
        for (int c = 0; c < NCH; ++c) mx = fmaxf(mx, sc[h * NK + c * 64 + lane]);
        mx = wave_max(mx); if (mx == -INFINITY) mx = 0.f;
        float sm = 0.f;
        for (int c = 0; c < NCH; ++c) sm += __expf(sc[h * NK + c * 64 + lane] - mx);
        sm = wave_sum(sm); mh[h] = mx; ih[h] = 1.0f / fmaxf(sm, 1e-30f); }
    DA_BAR();
#pragma unroll
    for (int i = 0; i < CPW; ++i) { const int c = wid + 8 * i;
#pragma unroll
        for (int h = 0; h < 4; ++h) sc[h * NK + c * 64 + lane] = __expf(sc[h * NK + c * 64 + lane] - mh[h]) * ih[h]; }
#pragma unroll
    for (int h = 0; h < 4; ++h) { float a0[64];
#pragma unroll
        for (int d = 0; d < 64; ++d) a0[d] = 0.f;
#pragma unroll
        for (int i = 0; i < CPW; ++i) { const int c = wid + 8 * i; const KeyRef kr = kf(c, lane);
            if (kr.valid) { const float p0 = sc[h * NK + c * 64 + lane];
                if (kr.f32) { const f32x4* p = (const f32x4*)kr.v;
#pragma unroll
                    for (int j = 0; j < 16; ++j) { const f32x4 t = p[j]; a0[4 * j] += p0 * t.x; a0[4 * j + 1] += p0 * t.y; a0[4 * j + 2] += p0 * t.z; a0[4 * j + 3] += p0 * t.w; } }
                else { const v4u* p = (const v4u*)kr.v;
#pragma unroll
                    for (int j = 0; j < 8; ++j) { const v4u t = p[j]; a0[8 * j] += p0 * __uint_as_float(t.x << 16); a0[8 * j + 1] += p0 * __uint_as_float(t.x & 0xffff0000u); a0[8 * j + 2] += p0 * __uint_as_float(t.y << 16); a0[8 * j + 3] += p0 * __uint_as_float(t.y & 0xffff0000u);
                        a0[8 * j + 4] += p0 * __uint_as_float(t.z << 16); a0[8 * j + 5] += p0 * __uint_as_float(t.z & 0xffff0000u); a0[8 * j + 6] += p0 * __uint_as_float(t.w << 16); a0[8 * j + 7] += p0 * __uint_as_float(t.w & 0xffff0000u); } } } }
        part[(wid * 4 + h) * 64 + lane] = wave_reduce_t64(a0, lane); }
    DA_BAR();
    if (tid < 256) { const int h = tid >> 6, d = tid & 63; float o = 0.f;
#pragma unroll
        for (int w = 0; w < 8; ++w) o += part[(w * 4 + h) * 64 + d];
        const int hd = g * 4 + h; const size_t oi = (size_t)m * 1024 + hd * 64 + d;
        if (MODE == 0) F.OCMP()[oi] = o;
        else if (MODE == 1) F.OWIN()[oi] = o;
        else { const float* gt = F.GD() + (size_t)m * 64 + hd * 3; F.MIX()[(size_t)m * DM + hd * 64 + d] = (bf16)f2bf(gt[0] * F.OCMP()[oi] + gt[1] * o + gt[2] * F.OWIN()[oi]); } }
    if (MODE == 0 && wid == 0) {
        LAS float* ps = (LAS float*)(shm + L_PS); LAS float* imp = (LAS float*)(shm + L_IMP);
        for (int i = lane; i < 544; i += 64) ps[i] = 0.f;
        for (int c = 0; c < NCH; ++c) ps[1 + c * 64 + lane] = (sc[c * 64 + lane] + sc[NK + c * 64 + lane]) + (sc[2 * NK + c * 64 + lane] + sc[3 * NK + c * 64 + lane]);
        constexpr int nslc = NSLC_S, jt = PAST >> 6; float mine[3]; int cnt[3];
#pragma unroll
        for (int jj = 0; jj < 3; ++jj) { const int j = jj * 64 + lane; float v = 0.f; cnt[jj] = 0;
            if (j < nslc) { v = ps[4 * j] + 2.0f * (ps[4 * j + 1] + ps[4 * j + 2] + ps[4 * j + 3]) + ps[4 * j + 4]; if (j == 0 || j == jt || j == jt - 1) v = 1.0e4f; if (j > jt) v = -1.0e4f; imp[j] = v; }
            mine[jj] = v; }
        for (int k = 0; k < nslc; ++k) { const float v = imp[k];
#pragma unroll
            for (int jj = 0; jj < 3; ++jj) { const int j = jj * 64 + lane; cnt[jj] += ((v > mine[jj]) || (v == mine[jj] && k < j)) ? 1 : 0; } }
        int base = 0; const size_t task = (size_t)m * 4 + g;
#pragma unroll
        for (int jj = 0; jj < 3; ++jj) { const int j = jj * 64 + lane; const bool sel = (j < nslc) && (cnt[jj] < 16); const unsigned long long bal = __ballot(sel);
            if (sel) F.SELIDX()[task * 16 + base + __popcll(bal & ((1ull << lane) - 1ull))] = j;
            base += __popcll(bal); } }
    DA_BAR();
}
}
struct Args { const void* in[26]; float* out; unsigned char* ws; int ph_lo, ph_hi, li, pad; };
__global__ void __launch_bounds__(NWAVES * 64, 2) fwd_kernel(Args args) {
    extern __shared__ __attribute__((aligned(16))) unsigned char lds[];
    Ctx F;
    F.lds = (LAS unsigned char*)lds; F.MISC = (volatile LAS unsigned*)(F.lds + MISC_OFF);
    F.tid = threadIdx.x; F.lane = F.tid & 63; F.wave = __builtin_amdgcn_readfirstlane(F.tid >> 6);
    F.G = gridDim.x; { const int bx = blockIdx.x; F.vcu = (F.G % 8 == 0) ? (bx % 8) * (F.G / 8) + bx / 8 : bx; }
    F.ka = (const __attribute__((address_space(4))) unsigned long long*)__builtin_amdgcn_kernarg_segment_ptr();
    F.ctl = (gu32*)(F.ws() + WS_CTL);
    for (int u = F.tid; u < (LDS_BYTES - LDSCTL_OFF) / 4; u += NWAVES * 64) ((LAS unsigned*)(F.lds + LDSCTL_OFF))[u] = 0u;
    __syncthreads();
    XcdBarrier bar; bar.bar = (unsigned*)(F.ctl + CW_BAR); bar.x = 0; bar.st = nullptr;
    if (N_LAUNCHES == 1) bar = xcd_barrier_post((unsigned*)(F.ctl + CW_BAR), F.MISC + 8);
#ifdef PROBE_DBLBAR
#define PROBE_EXTRA_BAR xcd_barrier(bar);
#else
#define PROBE_EXTRA_BAR
#endif
#define GRID_BAR(seam) do { if (N_LAUNCHES != 1) { if (F.tid == 0) __hip_atomic_store(F.ctl + CW_TMO, 0xBADBA0u | (unsigned)(seam), RLX_AGENT); } else { xcd_barrier(bar); PROBE_EXTRA_BAR } } while (0)
    const int lo = args.ph_lo, hi = args.ph_hi;
#define IN(k) (lo <= (k) && (k) < hi)
#define BOTH(k) (IN(k) && IN((k) + 1))
    const int gw = F.vcu * NWAVES + F.wave, NGW = F.G * NWAVES;

    if (IN(0)) { p0_prologue(F); if (BOTH(0)) GRID_BAR(0); }
    if (IN(1)) {
        pg8::Gemm g{F.XN(), F.WIN(), MPROMPT, NIN, DM}; pg8::StaticOrder S; S.init(MPROMPT, NIN, F.G, (int)blockIdx.x);
        static_assert(WS_KSB - WS_KCB == WS_KWB - WS_KSB, "kv copies equally spaced");
        pg8::EpiInProj E{F.QB(), F.KCB(), (WS_KSB - WS_KCB) / 2, F.Z(), F.XBC(), F.GD(), F.out()};
        pg8::gemm_phase<pg8::EpiInProj, pg8::StaticOrder, true, true>(F.lds + RING_OFF, g, S, E);
        {
          const int rel = (F.G == 256) ? (int)blockIdx.x - 160 : (int)blockIdx.x, nw = (F.G == 256) ? 96 : F.G;
          if (rel >= 0) { const sk::EpiInS ES{F.QB(), F.KCB(), (WS_KSB - WS_KCB) / 2, F.Z(), F.XBC(), F.GD(), F.out()};
              sk::phase(F.lds + RING_OFF, F.XN() + (size_t)MPROMPT * DM, F.WIN(), NCOLS_IN, DM, rel, nw, ES); } }
        if (F.G == 256 && blockIdx.x >= 160) { __syncthreads(); weight_items(F, 0, W_ITEMS_P1, ((int)blockIdx.x - 160) * NWAVES + F.wave, 96 * NWAVES); }
        if (BOTH(1)) GRID_BAR(1);
    }
    if (IN(2)) {
        constexpr int NT_C = NB * NCMP_P * 2 + DECB * NCMP_S * 2;
#ifdef REP_CMPG
        for (int rep = 0; rep <= args.pad; ++rep)
#endif
        for (int u = blockIdx.x; u < 256; u += gridDim.x) cmpg::unit(F, F.lds + RING_OFF, u);
#ifdef REP_SMALL
        for (int rep = 0; rep <= args.pad; ++rep)
#endif
        for (int u = blockIdx.x; u < NB * 2 * 32; u += gridDim.x) cmpg::small_unit(F, F.lds + RING_OFF, u);
        __syncthreads();
        conv_prepass(F);
#ifdef REP_CONV
        conv_prepass(F);
#endif
        fa::win_phase(F, F.lds + RING_OFF); __syncthreads();
#ifdef REP_WIN
        fa::win_phase(F, F.lds + RING_OFF); __syncthreads();
#endif
#ifdef REP_DWIN
        for (int rep = 0; rep <= args.pad; ++rep)
#endif
        for (int u = F.G - 1 - (int)blockIdx.x; u < DECB * 4; u += F.G) { const int b = u >> 2, g = u & 3, m = MPROMPT + b;
            const WinKeysS kf{F.st_win() + (size_t)b * 512 * 512, F.KWB() + (size_t)m * 512, g}; deca::unit<8, 1>(F, F.lds + RING_OFF, m, g, kf); }
        if (BOTH(2)) GRID_BAR(2);
    }
    if (IN(3)) {
        constexpr int NT_S = NB * 16 * 64 + DECB * 16 * 64;
#ifdef CHK_DEC
        for (int it = MPROMPT * 4 + gw; it < MROWS * 4; it += NGW) win_task<true>(F, it, F.lane);
        __syncthreads();
#endif
#ifdef CHK_CMP
        { constexpr int NT_C2 = NB * NCMP_P * 2 + DECB * NCMP_S * 2; for (int it = gw; it < 200; it += NGW) compress_ref_check(F, (int)(((long)it * 168 + 7) % NT_C2), it & 3, F.lane, -1); }
        { constexpr int NT_C = NB * NCMP_P * 2 + DECB * NCMP_S * 2; for (int it = gw; it < 600; it += NGW) compress_task<true>(F, (int)(((long)it * 56 + 7) % NT_C), F.lane); }
        __syncthreads();
#endif
#ifdef CHK_ATT
        for (int it = gw; it < 135 * 4; it += NGW) win_task<true>(F, (it >> 2) * 61 * 4 + (it & 3), F.lane);
        __syncthreads();
#endif
#ifdef SSD_NAIVE
        for (int it = gw; it < NT_S; it += NGW) ssd_task(F, it, F.lane);
#else
#ifdef REP_LOC
        for (int rep = 0; rep <= args.pad; ++rep)
#endif
        for (int u = blockIdx.x; u < NB * 16 * 16; u += gridDim.x) ssd::local_unit(F, F.lds + RING_OFF, u);
        __syncthreads();
        if (F.G == 256) { if (blockIdx.x < 128) for (int it = (int)blockIdx.x * NWAVES + F.wave; it < DECB * 16 * 8; it += 128 * NWAVES) ssd_decode_task(F, it, F.lane); }
        else for (int it = gw; it < DECB * 16 * 8; it += NGW) ssd_decode_task(F, it, F.lane);
#endif
        __syncthreads();
#ifdef REP_CMPA
        for (int rep = 0; rep <= args.pad; ++rep)
#endif
        { cmpa::phase(F, F.lds + RING_OFF); __syncthreads(); }
        for (int u = F.G - 1 - (int)blockIdx.x; u < DECB * 4; u += F.G) { const int b = u >> 2, g = u & 3, m = MPROMPT + b;
            const CmpKeys kf{F.KCMPS() + (size_t)b * NCMP_S * 512, g, NCMP_S, PAST}; deca::unit<8, 0>(F, F.lds + RING_OFF, m, g, kf); }
        if (BOTH(3)) GRID_BAR(3);
    }
    if (IN(4)) {
#ifdef REP_DECA
        for (int rep = 0; rep <= args.pad; ++rep)
#endif
        for (int u = F.G - 1 - (int)blockIdx.x; u < DECB * 4; u += F.G) { const int b = u >> 2, g = u & 3, m = MPROMPT + b;
            const SelKeysS kf{F.SELIDX() + ((size_t)m * 4 + g) * 16, F.page_table() + b * 64, F.cache_sel(), F.KSB() + (size_t)m * 512, g}; deca::unit<16, 2>(F, F.lds + RING_OFF, m, g, kf); }
        __syncthreads();
        ssd::carry_phase(F); winbuf_copy(F);
        if (F.G == 256) { if (blockIdx.x < 128) weight_items(F, W_ITEMS_P1, W_ITEMS, (int)blockIdx.x * NWAVES + F.wave, 128 * NWAVES); }
        else weight_items(F, 0, W_ITEMS, gw, NGW);
        if (BOTH(4)) GRID_BAR(4); }
    if (IN(5)) {
#ifdef CHK_DEC
        for (int it = MPROMPT * 4 + gw; it < MROWS * 4; it += NGW) cmp_task<true>(F, it, F.lane);
        __syncthreads();
#endif
#ifdef CHK_CMPA
        for (int it = gw; it < 135 * 4; it += NGW) cmp_task<true>(F, (it >> 2) * 61 * 4 + (it & 3), F.lane);
        __syncthreads();
#endif
        fa::sel_phase(F, F.lds + RING_OFF); __syncthreads();
#ifdef REP_SEL
        fa::sel_phase(F, F.lds + RING_OFF); __syncthreads();
#endif
#ifdef DRY_SEL
        fa::sel_phase_dry<DRY_SEL>(F, F.lds + RING_OFF); __syncthreads();
#endif
#ifdef SSD_NAIVE
        for (int it = gw; it < MROWS * 2; it += NGW) ssd_gate_task(F, it, F.lane);
#else
        __syncthreads();
#ifdef REP_FIN
        for (int rep = 0; rep <= args.pad; ++rep)
#endif
        for (int u = blockIdx.x; u < NB * 16 * 2 * 4; u += gridDim.x) ssd::final_unit(F, F.lds + RING_OFF, u);
        for (int it = MPROMPT * 2 + gw; it < MROWS * 2; it += NGW) ssd_gate_task(F, it, F.lane);
#endif
        if (BOTH(5)) GRID_BAR(5);
    }
    if (IN(6)) {
#ifdef CHK_DEC
        for (int it = MPROMPT * 4 + gw; it < MROWS * 4; it += NGW) sel_task<true>(F, it, F.lane);
        __syncthreads();
#endif
#ifdef CHK_ATT
        for (int it = gw; it < 135 * 4; it += NGW) sel_task<true>(F, (it >> 2) * 61 * 4 + (it & 3), F.lane);
        __syncthreads();
#endif
        pg8::Gemm g{F.MIX(), F.WOUT(), MPROMPT, DM, DM}; pg8::StaticOrder S; S.init(MPROMPT, DM, F.G, (int)blockIdx.x);
        pg8::EpiResid E{F.x_prompt(), F.x_sample(), DM, F.X1(), F.X1B(), F.SS1()};
        pg8::gemm_phase<pg8::EpiResid, pg8::StaticOrder, true, true>(F.lds + RING_OFF, g, S, E);
        { const sk::EpiResS ES{F.x_sample(), F.X1() + (size_t)MPROMPT * DM, F.X1B() + (size_t)MPROMPT * DM, F.SS1S()};
          sk::phase(F.lds + RING_OFF, F.MIX() + (size_t)MPROMPT * DM, F.WOUT(), DM, DM, (int)blockIdx.x, F.G, ES); }
        if (BOTH(6)) GRID_BAR(6);
    }
    if (IN(7)) {
        pg8::Gemm g{F.X1B(), F.WUP(), MPROMPT, DFF, DM}; pg8::StaticOrder S; S.init(MPROMPT, DFF, F.G, (int)blockIdx.x);
        pg8::EpiUp E{F.H(), F.SS1()};
        pg8::gemm_phase<pg8::EpiUp, pg8::StaticOrder, true, true>(F.lds + RING_OFF, g, S, E);
        { LAS float* rs = (LAS float*)(F.lds + RING_OFF + 32768);
          if (F.tid < 32) { float t = 0.f; for (int i = 0; i < 64; ++i) t += F.SS1S()[F.tid * 64 + i]; rs[F.tid] = 1.0f / sqrtf(t * (1.0f / DM) + NORM_EPS); }
          __syncthreads();
          const sk::EpiUpS ES{F.H() + (size_t)MPROMPT * DFF, rs};
          sk::phase(F.lds + RING_OFF, F.X1B() + (size_t)MPROMPT * DM, F.WUP(), DFF, DM, (int)blockIdx.x, F.G, ES); }
        if (BOTH(7)) GRID_BAR(7);
    }
    if (IN(8)) {
        pg8::Gemm g{F.H(), F.WDN(), MPROMPT, DM, DFF}; pg8::StaticOrder S; S.init(MPROMPT, DM, F.G, (int)blockIdx.x);
        pg8::EpiResid E{F.X1(), F.X1() + (size_t)MPROMPT * DM, DM, F.X2(), nullptr, F.SS2()};
        pg8::gemm_phase<pg8::EpiResid, pg8::StaticOrder, true, true>(F.lds + RING_OFF, g, S, E);
        { const sk::EpiResS ES{F.X1() + (size_t)MPROMPT * DM, F.X2() + (size_t)MPROMPT * DM, nullptr, F.SS2S()};
          sk::phase(F.lds + RING_OFF, F.H() + (size_t)MPROMPT * DFF, F.WDN(), DM, DFF, (int)blockIdx.x, F.G, ES); }
        if (BOTH(8)) GRID_BAR(8);
    }
    if (IN(9)) { for (int m = gw; m < MROWS; m += NGW) final_norm_row(F, m, F.lane);
#if defined(CHK_ATT) || defined(CHK_CMP) || defined(CHK_CMPA) || defined(CHK_DEC) || defined(CHK_ANY)
        if (blockIdx.x == 0 && F.tid == 0) { unsigned mask = 0u;
            for (int k = 0; k < 8; ++k) if (__hip_atomic_load((unsigned*)F.ctl + CW_CHK + k, RLX_AGENT)) mask |= 1u << k;
            if (mask & 31u) F.out()[O_KCS] = 1.0e6f * (float)(1u + (mask & 31u));
            if (mask >> 5) F.out()[O_KSS] = 1.0e9f * (float)(1u + (mask >> 5)); }
#endif
    }
#undef IN
#undef BOTH
}

extern "C" void kernel_launch(void* const* d_in, const int* in_sizes, int n_in, void* d_out, int out_size, void* d_ws, size_t ws_size, hipStream_t stream) {
    static int grid = 0;
    if (grid == 0) {
        if (n_in != 26 || (size_t)out_size != O_END || ws_size < WS_END) { fprintf(stderr, "kernel_launch: unexpected shapes: n_in %d out %d ws %zu (need %zu)\n", n_in, out_size, ws_size, (size_t)WS_END); grid = -1; return; }
        int dev = 0, cus = 0, per_cu = 0;
        if (hipGetDevice(&dev) != hipSuccess || hipDeviceGetAttribute(&cus, hipDeviceAttributeMultiprocessorCount, dev) != hipSuccess) { grid = -1; return; }
        if (hipFuncSetAttribute((const void*)fwd_kernel, hipFuncAttributeMaxDynamicSharedMemorySize, LDS_BYTES) != hipSuccess) { fprintf(stderr, "kernel_launch: hipFuncSetAttribute failed\n"); grid = -1; return; }
        if (hipOccupancyMaxActiveBlocksPerMultiprocessor(&per_cu, (const void*)fwd_kernel, NWAVES * 64, LDS_BYTES) != hipSuccess || per_cu < 1) fprintf(stderr, "kernel_launch: occupancy query reports %d\n", per_cu);
        (void)hipGetLastError();
        grid = cus;
    }
    if (grid < 0) return;
    if (hipMemsetAsync((char*)d_ws + WS_CTL, 0, CTL_ZERO_BYTES, stream) != hipSuccess) return;
    Args a{};
    for (int i = 0; i < 26; ++i) a.in[i] = d_in[i];
    a.out = (float*)d_out; a.ws = (unsigned char*)d_ws;
    for (int li = 0; li < N_LAUNCHES; ++li) {
        a.ph_lo = (N_LAUNCHES == 1) ? 0 : li; a.ph_hi = (N_LAUNCHES == 1) ? N_PHASES : li + 1; a.li = li; a.pad = 0;
#if defined(REP_CMPG) || defined(REP_DWIN) || defined(REP_SMALL) || defined(REP_FIN) || defined(REP_LOC) || defined(REP_DECA) || defined(REP_CMPA)
        a.pad = 1;
#endif
        hipLaunchKernelGGL(fwd_kernel, dim3(grid), dim3(NWAVES * 64), LDS_BYTES, stream, a);
        if (hipPeekAtLastError() != hipSuccess) { fprintf(stderr, "kernel_launch: launch %d failed\n", li); break; }
    }
}
```

```cpp
#include <hip/hip_runtime.h>
#include <cstdio>
#include <cstdint>

constexpr int DM = 2048, SEQ = 4096, NB = 2, MPROMPT = NB * SEQ, DECB = 32, PAST = 8192, MROWS = MPROMPT + DECB, MP = 8448;
constexpr int NCOLS_IN = 5184, NIN = 5376;
constexpr int DFF = 8192, CONV_DIM = 1536, DIN = 1024;
constexpr int NCMP_P = 255, NCMP_S = 511, NSLC_P = 64, NSLC_S = 129;
constexpr float NORM_EPS = 1e-5f;
constexpr size_t O_YP = 0, O_YS = O_YP + (size_t)MPROMPT * DM, O_KCP = O_YS + (size_t)DECB * DM, O_KSP = O_KCP + (size_t)MPROMPT * 512, O_KWP = O_KSP + (size_t)MPROMPT * 512,
                 O_CVP = O_KWP + (size_t)NB * 512 * 512, O_SSP = O_CVP + (size_t)NB * 3 * CONV_DIM, O_KCS = O_SSP + (size_t)NB * 16 * 64 * 128, O_KSS = O_KCS + (size_t)DECB * 512,
                 O_KWS = O_KSS + (size_t)DECB * 512, O_CVS = O_KWS + (size_t)DECB * 512 * 512, O_SSS = O_CVS + (size_t)DECB * 3 * CONV_DIM, O_END = O_SSS + (size_t)DECB * 16 * 64 * 128;
static_assert(O_END == 38790144, "d_out size");
namespace pg8 {
#define PG8_LAS __attribute__((address_space(3)))
typedef unsigned short bf16_t;
typedef short bf16x8 __attribute__((ext_vector_type(8)));
typedef float f32x4 __attribute__((ext_vector_type(4)));
typedef unsigned u32x4 __attribute__((ext_vector_type(4)));
constexpr int BM = 256, BK = 64, HALF = 128, HTB = HALF * BK * 2  , STAGE_BYTES = 8 * HTB, NXCD = 8, WGM = 8;

__host__ __device__ __forceinline__ int lds_byte(int r, int c) { const int st = (r >> 4) * 2 + (c >> 5), rr = r & 15, cc = c & 31, ob = rr * 64 + cc * 2; return st * 1024 + (ob ^ (((ob >> 9) & 1) << 5)); }
__host__ __device__ __forceinline__ void stage_rc(int b, int& R, int& C) { const int st = b / 1024, sb = b % 1024, swz = sb ^ (((sb >> 9) & 1) << 5); R = (st >> 1) * 16 + swz / 64; C = (st & 1) * 32 + (swz % 64) / 2; }
__host__ __device__ __forceinline__ int perm32(int rho) { const int n = rho >> 4, i = rho & 15; return 8 * (i >> 2) + 4 * n + (i & 3); }

struct Unit { int pm, pn; };
struct Gemm { const bf16_t* A; const bf16_t* Bt; int M, N, K; };

struct StaticOrder {
    int nM, nN, nwg, G, c;
    __host__ __device__ void init(int M, int N, int G_, int c_) { nM = M / BM; nN = N / BM; nwg = nM * nN; G = G_; c = c_; }
    __host__ __device__ bool next(int i, Unit& u) const {
        const long L = (long)i * G + c; if (L >= nwg) return false;
        int wgid = (int)L; { const int q = nwg / NXCD, r = nwg % NXCD, xcd = wgid % NXCD, off = wgid / NXCD; wgid = (xcd < r ? xcd * (q + 1) : r * (q + 1) + (xcd - r) * q) + off; }
        const int nig = WGM * nN, gid = wgid / nig, fm = gid * WGM, gsz = (nM - fm) < WGM ? (nM - fm) : WGM;
        u.pm = fm + ((wgid % nig) % gsz); u.pn = (wgid % nig) / gsz; return true;
    }
    __device__ __forceinline__ void a_ready(const Unit&) const {}
    __device__ __forceinline__ void done(const Unit&) const {}
};

__device__ __forceinline__ unsigned cvt_pk_bf16(float lo, float hi) { unsigned r; asm volatile("v_cvt_pk_bf16_f32 %0, %1, %2" : "=v"(r) : "v"(lo), "v"(hi)); return r; }
typedef float f32x2 __attribute__((ext_vector_type(2)));
__device__ __forceinline__ void st_bf16x4(bf16_t* p, const f32x4 v) { typedef unsigned u32x2v __attribute__((ext_vector_type(2))); u32x2v w; w.x = cvt_pk_bf16(v[0], v[1]); w.y = cvt_pk_bf16(v[2], v[3]); *(u32x2v*)p = w; }
__device__ __forceinline__ float sigmoidf_(float x) { return 1.0f / (1.0f + __expf(-x)); }
__device__ __forceinline__ void st_bf16x8(bf16_t* p, const f32x4 a, const f32x4 b) { u32x4 w; w.x = cvt_pk_bf16(a[0], a[1]); w.y = cvt_pk_bf16(a[2], a[3]); w.z = cvt_pk_bf16(b[0], b[1]); w.w = cvt_pk_bf16(b[2], b[3]); *(u32x4*)p = w; }
struct EpiInProj {
    static constexpr bool PERM = true, AFTER_DRAIN = false;
    bf16_t *QB, *KVB; size_t kvstride; float *Z, *XBC, *GD, *out;
    __device__ __forceinline__ void operator()(const f32x4 (&acc)[2][2][4][2], const Unit& u, int wr, int wc, int fr, int fq) const {
        const int pn = u.pn, rbase = u.pm * BM + wr * 64 + fr, cl = wc * 32 + 8 * fq;
        if (pn < 4) {
#pragma unroll
            for (int ai = 0; ai < 2; ++ai)
#pragma unroll
                for (int m = 0; m < 4; ++m) { const int row = rbase + ai * HALF + m * 16; if (row < MROWS) { bf16_t* p = QB + (size_t)row * 1024 + pn * 256 + cl;
#pragma unroll
                    for (int bj = 0; bj < 2; ++bj) st_bf16x8(p + bj * HALF, acc[ai][bj][m][0], acc[ai][bj][m][1]); } }
        } else if (pn < 10) {
            const int which = (pn - 4) >> 1, cb = ((pn - 4) & 1) * 256 + cl; bf16_t* B = KVB + (size_t)which * kvstride;
#pragma unroll
            for (int ai = 0; ai < 2; ++ai)
#pragma unroll
                for (int m = 0; m < 4; ++m) { const int row = rbase + ai * HALF + m * 16; if (row < MROWS) {
                    float* fo = nullptr;
                    if (row < MPROMPT) { if (which == 0) fo = out + O_KCP + (size_t)row * 512; else if (which == 1) fo = out + O_KSP + (size_t)row * 512; else { const int t = row & (SEQ - 1); if (t >= SEQ - 512) fo = out + O_KWP + (size_t)((row >> 12) * 512 + t - (SEQ - 512)) * 512; } }
                    else { const int s = row - MPROMPT; fo = which == 0 ? out + O_KCS + (size_t)s * 512 : (which == 1 ? out + O_KSS + (size_t)s * 512 : out + O_KWS + (size_t)(s * 512 + 511) * 512); }
                    bf16_t* p = B + (size_t)row * 512 + cb;
#pragma unroll
                    for (int bj = 0; bj < 2; ++bj) { const f32x4 v0 = acc[ai][bj][m][0], v1 = acc[ai][bj][m][1]; st_bf16x8(p + bj * HALF, v0, v1);
                        if (fo) { *(f32x4*)(fo + cb + bj * HALF) = v0; *(f32x4*)(fo + cb + bj * HALF + 4) = v1; } } } }
        } else if (pn < 20) {
            float* base = pn < 14 ? Z : XBC; const int ld = pn < 14 ? 1024 : CONV_DIM, cb = (pn < 14 ? (pn - 10) : (pn - 14)) * 256 + cl;
#pragma unroll
            for (int ai = 0; ai < 2; ++ai)
#pragma unroll
                for (int m = 0; m < 4; ++m) { const int row = rbase + ai * HALF + m * 16; if (row < MROWS) { float* p = base + (size_t)row * ld + cb;
#pragma unroll
                    for (int bj = 0; bj < 2; ++bj) { *(f32x4*)(p + bj * HALF) = acc[ai][bj][m][0]; *(f32x4*)(p + bj * HALF + 4) = acc[ai][bj][m][1]; } } }
        } else {
#pragma unroll
            for (int ai = 0; ai < 2; ++ai)
#pragma unroll
                for (int m = 0; m < 4; ++m) { const int row = rbase + ai * HALF + m * 16; if (row < MROWS && cl < 64) {
#pragma unroll
                    for (int n = 0; n < 2; ++n) { const int col = cl + 4 * n; f32x4 v = acc[ai][0][m][n]; if (col < 48) { v[0] = sigmoidf_(v[0]); v[1] = sigmoidf_(v[1]); v[2] = sigmoidf_(v[2]); v[3] = sigmoidf_(v[3]); } *(f32x4*)(GD + (size_t)row * 64 + col) = v; } } }
        }
    }
};
struct EpiResid {
    static constexpr bool PERM = true, AFTER_DRAIN = false;
    const float* xp; const float* xs; int ldx; float* X1; bf16_t* X1B; float* SS;
    __device__ __forceinline__ void operator()(const f32x4 (&acc)[2][2][4][2], const Unit& u, int wr, int wc, int fr, int fq) const {
        const int pn = u.pn, rbase = u.pm * BM + wr * 64 + fr, cb = pn * 256 + wc * 32 + 8 * fq;
#pragma unroll
        for (int ai = 0; ai < 2; ++ai) {
            f32x4 pre[4][2][2];
#pragma unroll
            for (int m = 0; m < 4; ++m) { const int row = rbase + ai * HALF + m * 16; const float* xr = row < MPROMPT ? xp + (size_t)row * ldx : xs + (size_t)(row - MPROMPT) * ldx;
#pragma unroll
                for (int bj = 0; bj < 2; ++bj)
#pragma unroll
                    for (int n = 0; n < 2; ++n) pre[m][bj][n] = row < MROWS ? *(const f32x4*)(xr + cb + bj * HALF + n * 4) : (f32x4){0.f, 0.f, 0.f, 0.f}; }
            asm volatile("" ::: "memory");
#pragma unroll
            for (int m = 0; m < 4; ++m) { const int row = rbase + ai * HALF + m * 16; const bool ok = row < MROWS; float ss = 0.f;
#pragma unroll
                for (int bj = 0; bj < 2; ++bj) { const int col = cb + bj * HALF; const f32x4 v0 = acc[ai][bj][m][0] + pre[m][bj][0], v1 = acc[ai][bj][m][1] + pre[m][bj][1];
                    if (ok) { *(f32x4*)(X1 + (size_t)row * DM + col) = v0; *(f32x4*)(X1 + (size_t)row * DM + col + 4) = v1; if (X1B) st_bf16x8(X1B + (size_t)row * DM + col, v0, v1); }
                    ss += ((v0[0] * v0[0] + v0[1] * v0[1]) + (v0[2] * v0[2] + v0[3] * v0[3])) + ((v1[0] * v1[0] + v1[1] * v1[1]) + (v1[2] * v1[2] + v1[3] * v1[3])); }
                ss += __shfl_xor(ss, 16); ss += __shfl_xor(ss, 32);
                if (ok && fq == 0) SS[(size_t)row * 32 + pn * 4 + wc] = ss; }
        }
    }
};
struct EpiUp {
    static constexpr bool PERM = true, AFTER_DRAIN = false;
    bf16_t* H; const float* SS;
    __device__ __forceinline__ void operator()(const f32x4 (&acc)[2][2][4][2], const Unit& u, int wr, int wc, int fr, int fq) const {
        const int pn = u.pn, rbase = u.pm * BM + wr * 64 + fr, cb = pn * 256 + wc * 32 + 8 * fq;
#pragma unroll
        for (int ai = 0; ai < 2; ++ai)
#pragma unroll
            for (int m = 0; m < 4; ++m) { const int row = rbase + ai * HALF + m * 16; const bool ok = row < MROWS;
                float t = 0.f; if (ok) { const f32x4 a = *(const f32x4*)(SS + (size_t)row * 32 + fq * 8), b = *(const f32x4*)(SS + (size_t)row * 32 + fq * 8 + 4); t = ((a[0] + a[1]) + (a[2] + a[3])) + ((b[0] + b[1]) + (b[2] + b[3])); }
                t += __shfl_xor(t, 16); t += __shfl_xor(t, 32);
                const float rstd = 1.0f / sqrtf(t * (1.0f / DM) + NORM_EPS);
                if (ok) { bf16_t* p = H + (size_t)row * DFF + cb;
#pragma unroll
                    for (int bj = 0; bj < 2; ++bj) { f32x4 v0 = acc[ai][bj][m][0] * rstd, v1 = acc[ai][bj][m][1] * rstd;
                        v0[0] = fmaxf(v0[0], 0.f); v0[1] = fmaxf(v0[1], 0.f); v0[2] = fmaxf(v0[2], 0.f); v0[3] = fmaxf(v0[3], 0.f); v1[0] = fmaxf(v1[0], 0.f); v1[1] = fmaxf(v1[1], 0.f); v1[2] = fmaxf(v1[2], 0.f); v1[3] = fmaxf(v1[3], 0.f);
                        v0 = v0 * v0; v1 = v1 * v1;
                        u32x4 w; w.x = cvt_pk_bf16(v0[0], v0[1]); w.y = cvt_pk_bf16(v0[2], v0[3]); w.z = cvt_pk_bf16(v1[0], v1[1]); w.w = cvt_pk_bf16(v1[2], v1[3]);
                        *(u32x4*)(p + bj * HALF) = w; } } }
    }
};
template <class Epi, class Sched, bool ALIGN_EPI = false, bool SP2 = false>
__device__ __forceinline__ void gemm_phase(PG8_LAS unsigned char* lds, const Gemm g, const Sched& S, const Epi& E) {
    const int tid = threadIdx.x, wid = __builtin_amdgcn_readfirstlane(tid >> 6), lane = tid & 63, wr = wid >> 2, wc = wid & 3, fr = lane & 15, fq = lane >> 4;
    const int K = g.K, nt = K / BK;
    unsigned voffA[2], voffB[2];
#pragma unroll
    for (int i = 0; i < 2; ++i) { int R, C; stage_rc(tid * 16 + i * 8192, R, C); const int Rb = Epi::PERM ? ((R & ~31) + perm32(R & 31)) : R;
        voffA[i] = (unsigned)(R * K + C) * 2u; voffB[i] = (unsigned)(Rb * K + C) * 2u; }
    const size_t kstep = (size_t)(BK * 2);
    const size_t hstep = (size_t)HALF * K * 2;
    const size_t tstep = 2 * hstep;
    const unsigned ldsw = (unsigned)wid * 1024u;
    const int aoff = lds_byte(wr * 64 + fr, fq * 8), boff = lds_byte(wc * 32 + fr, fq * 8);
#define PG8_SA(b, h) (((b) * 2 + (h)) * HTB)
#define PG8_SB(b, h) ((4 + (b) * 2 + (h)) * HTB)
#define PG8_STAGE(bufoff, gbase, voff) do { _Pragma("unroll") for (int _i = 0; _i < 2; ++_i) \
        __builtin_amdgcn_global_load_lds((const unsigned*)((const char*)(gbase) + (voff)[_i]), (PG8_LAS unsigned*)(lds + (bufoff) + ldsw + _i * 8192), 16, 0, 0); } while (0)
#define PG8_LDA(dst, b, h) do { _Pragma("unroll") for (int m = 0; m < 4; ++m) _Pragma("unroll") for (int k = 0; k < 2; ++k) dst[m][k] = *(const PG8_LAS bf16x8*)(lds + PG8_SA(b, h) + aoff + m * 2048 + k * 1024); } while (0)
#define PG8_LDB(dst, b, h) do { _Pragma("unroll") for (int n = 0; n < 2; ++n) _Pragma("unroll") for (int k = 0; k < 2; ++k) dst[n][k] = *(const PG8_LAS bf16x8*)(lds + PG8_SB(b, h) + boff + n * 2048 + k * 1024); } while (0)
#define PG8_MMA(ai, bj, At, Bt) do { __builtin_amdgcn_s_setprio(1); _Pragma("unroll") for (int m = 0; m < 4; ++m) _Pragma("unroll") for (int n = 0; n < 2; ++n) _Pragma("unroll") for (int k = 0; k < 2; ++k) \
        acc[ai][bj][m][n] = __builtin_amdgcn_mfma_f32_16x16x32_bf16(Bt[n][k], At[m][k], acc[ai][bj][m][n], 0, 0, 0); __builtin_amdgcn_s_setprio(0); } while (0)
#define PG8_WAIT_V(n) asm volatile("s_waitcnt vmcnt(" #n ")" ::: "memory")
#define PG8_WAIT_L(n) asm volatile("s_waitcnt lgkmcnt(" #n ")" ::: "memory")
#define PG8_BAR __builtin_amdgcn_s_barrier()
#define PG8_SCHED __builtin_amdgcn_sched_barrier(0)
    Unit cur, nxt; int ui = 0;
    if (!S.next(0, cur)) return;
    f32x4 acc[2][2][4][2];
#pragma unroll
    for (int a = 0; a < 2; ++a)
#pragma unroll
        for (int b = 0; b < 2; ++b)
#pragma unroll
            for (int m = 0; m < 4; ++m)
#pragma unroll
                for (int n = 0; n < 2; ++n) acc[a][b][m][n] = (f32x4){0.f, 0.f, 0.f, 0.f};
    bf16x8 At[4][2], B0[2][2], B1[2][2];
    const char* cA = (const char*)g.A + (size_t)cur.pm * tstep; const char* cB = (const char*)g.Bt + (size_t)cur.pn * tstep;
    S.a_ready(cur);
    if constexpr (SP2) {
        PG8_STAGE(PG8_SB(0, 0), cB, voffB); PG8_STAGE(PG8_SB(0, 1), cB + hstep, voffB); PG8_STAGE(PG8_SA(0, 0), cA, voffA); PG8_STAGE(PG8_SA(0, 1), cA + hstep, voffA);
        if (wr == 1) PG8_BAR;
        PG8_WAIT_V(2); PG8_BAR;
        PG8_STAGE(PG8_SB(1, 0), cB + kstep, voffB); PG8_STAGE(PG8_SA(1, 0), cA + kstep, voffA); PG8_STAGE(PG8_SB(1, 1), cB + hstep + kstep, voffB);
        PG8_WAIT_V(6); PG8_BAR;
    } else {
        PG8_STAGE(PG8_SB(0, 0), cB, voffB); PG8_STAGE(PG8_SA(0, 0), cA, voffA); PG8_STAGE(PG8_SB(0, 1), cB + hstep, voffB); PG8_STAGE(PG8_SA(0, 1), cA + hstep, voffA);
        if (wr == 1) PG8_BAR;
        PG8_WAIT_V(4); PG8_BAR;
        PG8_STAGE(PG8_SB(1, 0), cB + kstep, voffB); PG8_STAGE(PG8_SA(1, 0), cA + kstep, voffA); PG8_STAGE(PG8_SB(1, 1), cB + hstep + kstep, voffB);
        PG8_WAIT_V(6); PG8_BAR;
    }
    for (;;) {
        const bool has_next = S.next(ui + 1, nxt);
        const char* nA = has_next ? (const char*)g.A + (size_t)nxt.pm * tstep : cA; const char* nB = has_next ? (const char*)g.Bt + (size_t)nxt.pn * tstep : cB;
        for (int t = 0; t < nt; t += 2) {
            const bool last = (t == nt - 2);
            const char* a1 = cA + (size_t)(t + 1) * kstep;
            const char* a2 = last ? nA : cA + (size_t)(t + 2) * kstep; const char* b2 = last ? nB : cB + (size_t)(t + 2) * kstep;
            const char* a3 = a2 + kstep; const char* b3 = b2 + kstep;
            if (last && has_next) S.a_ready(nxt);
            if constexpr (SP2) {
            PG8_LDB(B0, 0, 0); PG8_LDB(B1, 0, 1); PG8_SCHED; PG8_LDA(At, 0, 0); PG8_STAGE(PG8_SA(1, 1), a1 + hstep, voffA);
            PG8_WAIT_V(8); PG8_WAIT_L(0); PG8_BAR; PG8_MMA(0, 0, At, B0); PG8_MMA(0, 1, At, B1); PG8_BAR; PG8_SCHED;
            PG8_LDA(At, 0, 1); PG8_STAGE(PG8_SB(0, 0), b2, voffB); PG8_STAGE(PG8_SB(0, 1), b2 + hstep, voffB); PG8_STAGE(PG8_SA(0, 0), a2, voffA);
            PG8_WAIT_V(8); PG8_WAIT_L(0); PG8_BAR; PG8_MMA(1, 0, At, B0); PG8_MMA(1, 1, At, B1); PG8_BAR; PG8_SCHED;
            PG8_LDB(B0, 1, 0); PG8_LDB(B1, 1, 1); PG8_SCHED; PG8_LDA(At, 1, 0); PG8_STAGE(PG8_SA(0, 1), a2 + hstep, voffA);
            PG8_WAIT_V(8); PG8_WAIT_L(0); PG8_BAR; PG8_MMA(0, 0, At, B0); PG8_MMA(0, 1, At, B1); PG8_BAR; PG8_SCHED;
            PG8_LDA(At, 1, 1); PG8_STAGE(PG8_SB(1, 0), b3, voffB); PG8_STAGE(PG8_SB(1, 1), b3 + hstep, voffB); PG8_STAGE(PG8_SA(1, 0), a3, voffA);
            PG8_WAIT_V(8); PG8_WAIT_L(0); PG8_BAR; PG8_MMA(1, 0, At, B0); PG8_MMA(1, 1, At, B1); PG8_BAR; PG8_SCHED;
            } else {
            PG8_LDB(B0, 0, 0); PG8_SCHED; PG8_LDA(At, 0, 0); PG8_STAGE(PG8_SA(1, 1), a1 + hstep, voffA);
            PG8_WAIT_L(8); PG8_BAR; PG8_WAIT_L(0); PG8_MMA(0, 0, At, B0); PG8_BAR; PG8_SCHED;
            PG8_LDB(B1, 0, 1); PG8_STAGE(PG8_SB(0, 0), b2, voffB);
            PG8_BAR; PG8_WAIT_L(0); PG8_MMA(0, 1, At, B1); PG8_BAR;
            PG8_LDA(At, 0, 1); PG8_STAGE(PG8_SA(0, 0), a2, voffA);
            PG8_BAR; PG8_WAIT_L(0); PG8_MMA(1, 0, At, B0); PG8_BAR; PG8_SCHED;
            PG8_STAGE(PG8_SB(0, 1), b2 + hstep, voffB);
            PG8_WAIT_V(6); PG8_BAR; PG8_MMA(1, 1, At, B1); PG8_BAR;
            PG8_LDB(B0, 1, 0); PG8_SCHED; PG8_LDA(At, 1, 0); PG8_STAGE(PG8_SA(0, 1), a2 + hstep, voffA);
            PG8_WAIT_L(8); PG8_BAR; PG8_WAIT_L(0); PG8_MMA(0, 0, At, B0); PG8_BAR; PG8_SCHED;
            PG8_LDB(B1, 1, 1); PG8_STAGE(PG8_SB(1, 0), b3, voffB);
            PG8_BAR; PG8_WAIT_L(0); PG8_MMA(0, 1, At, B1); PG8_BAR;
            PG8_LDA(At, 1, 1); PG8_STAGE(PG8_SA(1, 0), a3, voffA);
            PG8_BAR; PG8_WAIT_L(0); PG8_MMA(1, 0, At, B0); PG8_BAR; PG8_SCHED;
            PG8_STAGE(PG8_SB(1, 1), b3 + hstep, voffB);
            PG8_WAIT_V(6); PG8_BAR; PG8_MMA(1, 1, At, B1); PG8_BAR;
            }
        }
        if constexpr (ALIGN_EPI) { if (wr == 0) PG8_BAR; }
        if constexpr (!Epi::AFTER_DRAIN) { E(acc, cur, wr, wc, fr, fq); S.done(cur); }
        if (!has_next) break;
#pragma unroll
        for (int a = 0; a < 2; ++a)
#pragma unroll
            for (int b = 0; b < 2; ++b)
#pragma unroll
                for (int m = 0; m < 4; ++m)
#pragma unroll
                    for (int n = 0; n < 2; ++n) acc[a][b][m][n] = (f32x4){0.f, 0.f, 0.f, 0.f};
        cur = nxt; cA = nA; cB = nB; ++ui;
        if constexpr (ALIGN_EPI) { if (wr == 1) PG8_BAR; }
    }
    PG8_WAIT_V(0);
    if constexpr (!ALIGN_EPI) { if (wr == 0) PG8_BAR; }
    PG8_BAR;
    if constexpr (Epi::AFTER_DRAIN) { E.fused(acc, cur, wr, wc, fr, fq, lds, wid, lane); S.done(cur); }
#undef PG8_SA
#undef PG8_SB
#undef PG8_STAGE
#undef PG8_LDA
#undef PG8_LDB
#undef PG8_MMA
#undef PG8_WAIT_V
#undef PG8_WAIT_L
#undef PG8_BAR
#undef PG8_SCHED
}
}
#define GAS __attribute__((address_space(1)))
#define LAS __attribute__((address_space(3)))
typedef unsigned short bf16;
typedef unsigned v4u __attribute__((ext_vector_type(4)));
typedef float f32x4 __attribute__((ext_vector_type(4)));
typedef short bf16x8 __attribute__((ext_vector_type(8)));
typedef GAS unsigned gu32;
typedef GAS unsigned long long gu64;
#define RLX_AGENT __ATOMIC_RELAXED, __HIP_MEMORY_SCOPE_AGENT
#define LDS_WAIT() asm volatile("s_waitcnt lgkmcnt(0)" ::: "memory")
#define VM_WAIT() asm volatile("s_waitcnt vmcnt(0)" ::: "memory")
__device__ __forceinline__ unsigned long long rt() { return __builtin_amdgcn_s_memrealtime(); }
__device__ __forceinline__ unsigned f2bf(float f) { unsigned u = __builtin_bit_cast(unsigned, f); return (u + 0x7fffu + ((u >> 16) & 1u)) >> 16; }
__device__ __forceinline__ unsigned pk2(float lo, float hi) { return f2bf(lo) | (f2bf(hi) << 16); }

#define XB_TMO      128
#define XB_XCNT(j)  (256  + 64 * (j))
#define XB_XSUB(j)  (1280 + 64 * (j))
#define XB_XGEN(j)  (2304 + 64 * (j))
#define XB_TOP      3328
#define XB_TOPGEN   3392
#define XCD_BAR_WORDS 3456
#define XB_SPIN_CAP (1u << 18)

__device__ __forceinline__ unsigned xb_ld(unsigned* p)              { return __hip_atomic_load(p, __ATOMIC_RELAXED, __HIP_MEMORY_SCOPE_AGENT); }
__device__ __forceinline__ unsigned xb_add(unsigned* p, unsigned v) { return __hip_atomic_fetch_add(p, v, __ATOMIC_RELAXED, __HIP_MEMORY_SCOPE_AGENT); }
__device__ __forceinline__ unsigned xb_xcc_id() { return (unsigned)__builtin_amdgcn_s_getreg((3 << 11) | 20) & 0xFu; }
#define XB_SPIN(cond, bar) do { unsigned _sp = 0; while (cond) { __builtin_amdgcn_s_sleep(1); \
    if ((++_sp & 255u) == 0u) { if (xb_ld(&(bar)[XB_TMO])) break; if (_sp > XB_SPIN_CAP) { atomicAdd(&(bar)[XB_TMO], 1u); break; } } } } while (0)

struct XcdBarrier {
    unsigned* bar; unsigned x;
    volatile LAS unsigned* st;
};

__device__ __forceinline__ XcdBarrier xcd_barrier_post(unsigned* bar, volatile LAS unsigned* st) {
    XcdBarrier b; b.bar = bar; b.x = xb_xcc_id(); b.st = st;
    if (threadIdx.x == 0) (void)xb_add(&bar[XB_XCNT(b.x)], 1u);
    return b;
}
__device__ __forceinline__ void xcd_barrier_complete(unsigned* bar, unsigned x, unsigned& nloc, unsigned& nx) {
    const unsigned G = gridDim.x * gridDim.y * gridDim.z;
    unsigned sum, cnt, mine, sp = 0u;
    for (;;) {
        sum = 0u; cnt = 0u; mine = 0u;
#pragma unroll
        for (unsigned j = 0; j < 16; ++j) { const unsigned c = xb_ld(&bar[XB_XCNT(j)]); sum += c; cnt += (c > 0u) ? 1u : 0u; mine = (j == x) ? c : mine; }
        if (sum == G) break;
        __builtin_amdgcn_s_sleep(1);
        if ((++sp & 255u) == 0u) { if (xb_ld(&bar[XB_TMO])) break; if (sp > XB_SPIN_CAP) { atomicAdd(&bar[XB_TMO], 1u); break; } }
    }
    nloc = mine > 0u ? mine : 1u; nx = cnt > 0u ? cnt : 1u;
}

__device__ __forceinline__ void xcd_barrier(const XcdBarrier& b) {
    asm volatile("s_waitcnt vmcnt(0)" ::: "memory");
    __syncthreads();
    if (threadIdx.x == 0) {
        unsigned* bar = b.bar;
        __builtin_amdgcn_s_waitcnt(0);
        unsigned nloc = b.st[0], nx = b.st[1];
        if (nloc == 0u) { xcd_barrier_complete(bar, b.x, nloc, nx); b.st[0] = nloc; b.st[1] = nx; }
        const unsigned old = xb_add(&bar[XB_XSUB(b.x)], 1u);
        const unsigned gen = old / nloc;
        if (old + 1u == (gen + 1u) * nloc) {
            __builtin_amdgcn_fence(__ATOMIC_RELEASE, "agent");
            asm volatile("s_waitcnt vmcnt(0)" ::: "memory");
            const unsigned og = xb_add(&bar[XB_TOP], 1u);
            const unsigned tg = og / nx;
            if (og + 1u == (tg + 1u) * nx) xb_add(&bar[XB_TOPGEN], 1u);
            else XB_SPIN(xb_ld(&bar[XB_TOPGEN]) == tg, bar);
            __builtin_amdgcn_fence(__ATOMIC_ACQUIRE, "agent");
            xb_add(&bar[XB_XGEN(b.x)], 1u);
            asm volatile("s_waitcnt vmcnt(0)" ::: "memory");
        } else {
            XB_SPIN(xb_ld(&bar[XB_XGEN(b.x)]) == gen, bar);
            __builtin_amdgcn_fence(__ATOMIC_ACQUIRE, "agent");
            asm volatile("s_waitcnt vmcnt(0)" ::: "memory");
        }
    }
    __syncthreads();
}

constexpr int NWAVES = 8;
#ifndef MK_N_LAUNCHES
#define MK_N_LAUNCHES 1
#endif
constexpr int N_PHASES = 10;
constexpr int N_LAUNCHES = MK_N_LAUNCHES;
static_assert(N_LAUNCHES == 1 || N_LAUNCHES == N_PHASES, "MK_N_LAUNCHES is 1 or 10");

constexpr size_t MiB = 1u << 20;
constexpr size_t al(size_t x) { return (x + MiB - 1) / MiB * MiB; }
constexpr size_t WS_CTL = 0, CTL_ZERO_BYTES = 32768;
constexpr size_t WS_WIN = 2 * MiB;
constexpr size_t WS_WOUT = WS_WIN + al((size_t)NIN * DM * 2);
constexpr size_t WS_WUP = WS_WOUT + al((size_t)DM * DM * 2);
constexpr size_t WS_WDN = WS_WUP + al((size_t)DFF * DM * 2);
constexpr size_t WS_XN = WS_WDN + al((size_t)DM * DFF * 2);
constexpr size_t WS_QB = WS_XN + al((size_t)MP * DM * 2);
constexpr size_t WS_KCB = WS_QB + al((size_t)MP * 1024 * 2);
constexpr size_t WS_KSB = WS_KCB + al((size_t)MP * 512 * 2);
constexpr size_t WS_KWB = WS_KSB + al((size_t)MP * 512 * 2);
constexpr size_t WS_Z = WS_KWB + al((size_t)MP * 512 * 2);
constexpr size_t WS_XBC = WS_Z + al((size_t)MP * 1024 * 4);
constexpr size_t WS_GD = WS_XBC + al((size_t)MP * CONV_DIM * 4);
constexpr size_t WS_XBCA = WS_GD + al((size_t)MP * 64 * 4);
constexpr size_t WS_DT = WS_XBCA + al((size_t)MP * CONV_DIM * 4);
constexpr size_t WS_KCMPP = WS_DT + al((size_t)MP * 16 * 4);
constexpr size_t WS_KCMPS = WS_KCMPP + al((size_t)NB * NCMP_P * 512 * 4);
constexpr size_t WS_OWIN = WS_KCMPS + al((size_t)DECB * NCMP_S * 512 * 4);
constexpr size_t WS_OCMP = WS_OWIN + al((size_t)MP * 1024 * 4);
constexpr size_t WS_SELIDX = WS_OCMP + al((size_t)MP * 1024 * 4);
constexpr size_t WS_SELMASK = WS_SELIDX + al((size_t)MP * 64 * 4);
constexpr size_t WS_YSSD = WS_SELMASK + al((size_t)MPROMPT * 4 * 8);
constexpr size_t WS_MIX = WS_YSSD + al((size_t)MP * 1024 * 4);
constexpr size_t WS_X1 = WS_MIX + al((size_t)MP * DM * 2);
constexpr size_t WS_X1B = WS_X1 + al((size_t)MP * DM * 4);
constexpr size_t WS_SS1 = WS_X1B + al((size_t)MP * DM * 2);
constexpr size_t WS_H = WS_SS1 + al((size_t)MP * 32 * 4);
constexpr size_t WS_X2 = WS_H + al((size_t)MP * DFF * 2);
constexpr size_t WS_SS2 = WS_X2 + al((size_t)MP * DM * 4);
constexpr size_t WS_W1T = WS_SS2 + al((size_t)MP * 32 * 4);
constexpr size_t WS_PEB = WS_W1T + al((size_t)2 * 128 * 2048 * 2);
constexpr size_t WS_XBCA16 = WS_PEB + MiB;
constexpr size_t WS_ST = WS_XBCA16 + al((size_t)MP * CONV_DIM * 2);
constexpr size_t WS_DEC = WS_ST + al((size_t)NB * 16 * 16 * 8192 * 4);
constexpr size_t WS_ACS = WS_DEC + MiB;
constexpr size_t WS_SS1S = WS_ACS + al((size_t)MPROMPT * 16 * 4);
constexpr size_t WS_SS2S = WS_SS1S + MiB;
constexpr size_t WS_SIN = WS_SS2S + MiB;
constexpr size_t WS_END = WS_SIN + al((size_t)NB * 16 * 16 * 8192 * 2);
constexpr int CW_TMO = 0, CW_CODE = 1, CW_CHK = 8, CW_BAR = 4096;

constexpr int RING_OFF = 0, RING_BYTES = 155648;
constexpr int LDSCTL_OFF = RING_BYTES, MISC_OFF = LDSCTL_OFF + 320;
constexpr int LDS_BYTES = 156160;
static_assert(MISC_OFF + 128 <= LDS_BYTES, "LDS map");

struct Ctx {
    LAS unsigned char* lds; volatile LAS unsigned* MISC; gu32* ctl;
    int tid, lane, wave, vcu, G;
    const __attribute__((address_space(4))) unsigned long long* ka;
    __device__ __forceinline__ const float* x_prompt() const { return (const float*)ka[0]; }
    __device__ __forceinline__ const float* x_sample() const { return (const float*)ka[1]; }
    __device__ __forceinline__ const float* cache_cmp() const { return (const float*)ka[2]; }
    __device__ __forceinline__ const float* cache_sel() const { return (const float*)ka[3]; }
    __device__ __forceinline__ const float* st_win() const { return (const float*)ka[4]; }
    __device__ __forceinline__ const float* st_conv() const { return (const float*)ka[5]; }
    __device__ __forceinline__ const float* st_ssm() const { return (const float*)ka[6]; }
    __device__ __forceinline__ const int* page_table() const { return (const int*)ka[7]; }
    __device__ __forceinline__ const float* ln_mix() const { return (const float*)ka[8]; }
    __device__ __forceinline__ const float* w_in() const { return (const float*)ka[9]; }
    __device__ __forceinline__ const float* cmp_pe() const { return (const float*)ka[10]; }
    __device__ __forceinline__ const float* cmp_w1() const { return (const float*)ka[11]; }
    __device__ __forceinline__ const float* cmp_b1() const { return (const float*)ka[12]; }
    __device__ __forceinline__ const float* cmp_w2() const { return (const float*)ka[13]; }
    __device__ __forceinline__ const float* cmp_b2() const { return (const float*)ka[14]; }
    __device__ __forceinline__ const float* conv_w() const { return (const float*)ka[15]; }
    __device__ __forceinline__ const float* conv_b() const { return (const float*)ka[16]; }
    __device__ __forceinline__ const float* dt_bias() const { return (const float*)ka[17]; }
    __device__ __forceinline__ const float* a_log() const { return (const float*)ka[18]; }
    __device__ __forceinline__ const float* d_skip() const { return (const float*)ka[19]; }
    __device__ __forceinline__ const float* ssm_norm() const { return (const float*)ka[20]; }
    __device__ __forceinline__ const float* w_out() const { return (const float*)ka[21]; }
    __device__ __forceinline__ const float* ln_mlp() const { return (const float*)ka[22]; }
    __device__ __forceinline__ const float* w_up() const { return (const float*)ka[23]; }
    __device__ __forceinline__ const float* w_down() const { return (const float*)ka[24]; }
    __device__ __forceinline__ const float* ln_final() const { return (const float*)ka[25]; }
    __device__ __forceinline__ float* out() const { return (float*)ka[26]; }
    __device__ __forceinline__ unsigned char* ws() const { return (unsigned char*)ka[27]; }
    __device__ __forceinline__ bf16* WIN() const { return (bf16*)(ws() + WS_WIN); }
    __device__ __forceinline__ bf16* WOUT() const { return (bf16*)(ws() + WS_WOUT); }
    __device__ __forceinline__ bf16* WUP() const { return (bf16*)(ws() + WS_WUP); }
    __device__ __forceinline__ bf16* WDN() const { return (bf16*)(ws() + WS_WDN); }
    __device__ __forceinline__ bf16* XN() const { return (bf16*)(ws() + WS_XN); }
    __device__ __forceinline__ bf16* QB() const { return (bf16*)(ws() + WS_QB); }
    __device__ __forceinline__ bf16* KCB() const { return (bf16*)(ws() + WS_KCB); }
    __device__ __forceinline__ bf16* KSB() const { return (bf16*)(ws() + WS_KSB); }
    __device__ __forceinline__ bf16* KWB() const { return (bf16*)(ws() + WS_KWB); }
    __device__ __forceinline__ bf16* MIX() const { return (bf16*)(ws() + WS_MIX); }
    __device__ __forceinline__ bf16* X1B() const { return (bf16*)(ws() + WS_X1B); }
    __device__ __forceinline__ bf16* H() const { return (bf16*)(ws() + WS_H); }
    __device__ __forceinline__ float* Z() const { return (float*)(ws() + WS_Z); }
    __device__ __forceinline__ float* XBC() const { return (float*)(ws() + WS_XBC); }
    __device__ __forceinline__ float* GD() const { return (float*)(ws() + WS_GD); }
    __device__ __forceinline__ float* XBCA() const { return (float*)(ws() + WS_XBCA); }
    __device__ __forceinline__ float* DT() const { return (float*)(ws() + WS_DT); }
    __device__ __forceinline__ float* KCMPP() const { return (float*)(ws() + WS_KCMPP); }
    __device__ __forceinline__ float* KCMPS() const { return (float*)(ws() + WS_KCMPS); }
    __device__ __forceinline__ float* OWIN() const { return (float*)(ws() + WS_OWIN); }
    __device__ __forceinline__ float* OCMP() const { return (float*)(ws() + WS_OCMP); }
    __device__ __forceinline__ float* YSSD() const { return (float*)(ws() + WS_YSSD); }
    __device__ __forceinline__ float* X1() const { return (float*)(ws() + WS_X1); }
    __device__ __forceinline__ float* SS1() const { return (float*)(ws() + WS_SS1); }
    __device__ __forceinline__ float* X2() const { return (float*)(ws() + WS_X2); }
    __device__ __forceinline__ float* SS2() const { return (float*)(ws() + WS_SS2); }
    __device__ __forceinline__ int* SELIDX() const { return (int*)(ws() + WS_SELIDX); }
    __device__ __forceinline__ unsigned long long* SELMASK() const { return (unsigned long long*)(ws() + WS_SELMASK); }
    __device__ __forceinline__ bf16* W1T() const { return (bf16*)(ws() + WS_W1T); }
    __device__ __forceinline__ float* PEB() const { return (float*)(ws() + WS_PEB); }
    __device__ __forceinline__ bf16* XBCA16() const { return (bf16*)(ws() + WS_XBCA16); }
    __device__ __forceinline__ float* ST() const { return (float*)(ws() + WS_ST); }
    __device__ __forceinline__ float* DEC() const { return (float*)(ws() + WS_DEC); }
    __device__ __forceinline__ float* ACS() const { return (float*)(ws() + WS_ACS); }
    __device__ __forceinline__ float* SS1S() const { return (float*)(ws() + WS_SS1S); }
    __device__ __forceinline__ float* SS2S() const { return (float*)(ws() + WS_SS2S); }
    __device__ __forceinline__ bf16* SIN() const { return (bf16*)(ws() + WS_SIN); }
};
__device__ __forceinline__ float bf2f(bf16 x) { return __uint_as_float((unsigned)x << 16); }
__device__ __forceinline__ float wave_sum(float v) {
#pragma unroll
    for (int o = 1; o < 64; o <<= 1) v += __shfl_xor(v, o);
    return v;
}
__device__ __forceinline__ float wave_max(float v) {
#pragma unroll
    for (int o = 1; o < 64; o <<= 1) v = fmaxf(v, __shfl_xor(v, o));
    return v;
}
__device__ __forceinline__ float wave_reduce_t64(float (&a)[64], int lane) {
#pragma unroll
    for (int i = 0; i < 32; ++i) { const bool up = (lane & 32) != 0; const float keep = up ? a[i + 32] : a[i], send = up ? a[i] : a[i + 32]; a[i] = keep + __shfl_xor(send, 32); }
#pragma unroll
    for (int i = 0; i < 16; ++i) { const bool up = (lane & 16) != 0; const float keep = up ? a[i + 16] : a[i], send = up ? a[i] : a[i + 16]; a[i] = keep + __shfl_xor(send, 16); }
#pragma unroll
    for (int i = 0; i < 8; ++i) { const bool up = (lane & 8) != 0; const float keep = up ? a[i + 8] : a[i], send = up ? a[i] : a[i + 8]; a[i] = keep + __shfl_xor(send, 8); }
#pragma unroll
    for (int i = 0; i < 4; ++i) { const bool up = (lane & 4) != 0; const float keep = up ? a[i + 4] : a[i], send = up ? a[i] : a[i + 4]; a[i] = keep + __shfl_xor(send, 4); }
#pragma unroll
    for (int i = 0; i < 2; ++i) { const bool up = (lane & 2) != 0; const float keep = up ? a[i + 2] : a[i], send = up ? a[i] : a[i + 2]; a[i] = keep + __shfl_xor(send, 2); }
    { const bool up = (lane & 1) != 0; const float keep = up ? a[1] : a[0], send = up ? a[0] : a[1]; a[0] = keep + __shfl_xor(send, 1); }
    return a[0];
}
__device__ __forceinline__ float siluf_(float x) { return x / (1.0f + __expf(-x)); }
__device__ __forceinline__ float rdlane(float v, int l) { return __int_as_float(__builtin_amdgcn_readlane(__float_as_int(v), l)); }

__device__ __forceinline__ int win_oldcol(int n) { return n < 2560 ? n : (n < 5120 ? n + 48 : (n < 5168 ? n - 2560 : (n < NCOLS_IN ? n : -1))); }
template <int MODE  >
__device__ __forceinline__ void p0_transpose_item(const float* W, int K, int Nsrc, int Ndst, bf16* WT, const float* rowscale, LAS float* scr, int item, int lane) {
    const int nblk = Ndst / 32, kb = item / nblk, nb = item % nblk, k0 = 64 * kb, n0 = 32 * nb;
    const int ncol = MODE == 1 ? win_oldcol(n0 + (lane & 31)) : n0 + (lane & 31);
    float tv[32];
#pragma unroll
    for (int i = 0; i < 32; ++i) { const int kk = 2 * i + (lane >> 5); float v = 0.f; if (ncol >= 0) v = W[(size_t)(k0 + kk) * Nsrc + ncol]; tv[i] = v; }
#pragma unroll
    for (int i = 0; i < 32; ++i) { const int kk = 2 * i + (lane >> 5); float v = tv[i]; if (rowscale) v *= rowscale[k0 + kk]; scr[kk * 33 + (lane & 31)] = v; }
    LDS_WAIT(); asm volatile("" ::: "memory");
    const int c = lane & 7;
#pragma unroll
    for (int j = 0; j < 4; ++j) { const int n = (lane >> 3) + 8 * j; const LAS float* s = scr + (8 * c) * 33 + n;
        v4u o; o.x = pk2(s[0 * 33], s[1 * 33]); o.y = pk2(s[2 * 33], s[3 * 33]); o.z = pk2(s[4 * 33], s[5 * 33]); o.w = pk2(s[6 * 33], s[7 * 33]);
        *(GAS v4u*)(WT + (size_t)(n0 + n) * K + k0 + 8 * c) = o; }
    LDS_WAIT(); asm volatile("" ::: "memory");
}
__device__ __forceinline__ void p0_prologue(const Ctx& F) {
    LAS float* scr = (LAS float*)(F.lds + RING_OFF + F.wave * 16384);
    const int gw = F.vcu * NWAVES + F.wave, NGW = F.G * NWAVES;
    constexpr int I_IN = (DM / 64) * (NIN / 32);
    for (int it = gw; it < I_IN; it += NGW) p0_transpose_item<1>(F.w_in(), DM, NCOLS_IN, NIN, F.WIN(), nullptr, scr, it, F.lane);
    for (int it = gw; it < 2 * 128; it += NGW) { const int c = it >> 7; p0_transpose_item<0>(F.cmp_w1() + (size_t)c * 2048 * 128, 2048, 128, 128, F.W1T() + (size_t)c * 128 * 2048, nullptr, scr, it & 127, F.lane); }
    for (int it = gw; it < 64; it += NGW) { const int c = it >> 5, fh = (it >> 4) & 1, kc = it & 15, f = fh * 64 + F.lane; const float* w = F.cmp_w1() + ((size_t)c * 2048 + kc * 128) * 128 + f; const float* pe = F.cmp_pe() + c * 2048 + kc * 128; float acc = 0.f;
#pragma unroll 16
        for (int k = 0; k < 128; ++k) acc += pe[k] * w[(size_t)k * 128];
        F.PEB()[(c * 16 + kc) * 128 + f] = acc; }
    for (int m = gw; m < MP; m += NGW) {
        GAS unsigned long long* o8 = (GAS unsigned long long*)(F.XN() + (size_t)m * DM) + F.lane;
        if (m >= MROWS) { GAS unsigned long long* z8 = (GAS unsigned long long*)(F.MIX() + (size_t)m * DM) + F.lane;
#pragma unroll
            for (int j = 0; j < 8; ++j) { o8[64 * j] = 0ull; z8[64 * j] = 0ull; }
            continue; }
        const float* xrow = m < MPROMPT ? F.x_prompt() + (size_t)m * DM : F.x_sample() + (size_t)(m - MPROMPT) * DM;
        const GAS f32x4* xr = (const GAS f32x4*)xrow + F.lane; const GAS f32x4* wr = (const GAS f32x4*)F.ln_mix() + F.lane;
        f32x4 v[8]; float s = 0.f;
#pragma unroll
        for (int j = 0; j < 8; ++j) { v[j] = xr[64 * j]; s += (v[j].x * v[j].x + v[j].y * v[j].y) + (v[j].z * v[j].z + v[j].w * v[j].w); }
        const float rstd = 1.0f / sqrtf(wave_sum(s) * (1.0f / DM) + NORM_EPS);
#pragma unroll
        for (int j = 0; j < 8; ++j) { const f32x4 w = wr[64 * j]; o8[64 * j] = (unsigned long long)pk2(v[j].x * rstd * w.x, v[j].y * rstd * w.y) | ((unsigned long long)pk2(v[j].z * rstd * w.z, v[j].w * rstd * w.w) << 32); }
    }
}
constexpr int W_ITEMS = (DM / 64) * (DM / 32) + (DM / 64) * (DFF / 32) + (DFF / 64) * (DM / 32), W_ITEMS_P1 = 7680;
__device__ __forceinline__ void weight_items(const Ctx& F, int it0, int it1, int wv, int nw) {
    LAS float* scr = (LAS float*)(F.lds + RING_OFF + F.wave * 16384);
    constexpr int I_OUT = (DM / 64) * (DM / 32), I_UP = (DM / 64) * (DFF / 32);
    for (int it = it0 + wv; it < it1; it += nw) {
        int r = it;
        if (r < I_OUT) { p0_transpose_item<0>(F.w_out(), DM, DM, DM, F.WOUT(), nullptr, scr, r, F.lane); continue; } r -= I_OUT;
        if (r < I_UP) { p0_transpose_item<0>(F.w_up(), DM, DFF, DFF, F.WUP(), F.ln_mlp(), scr, r, F.lane); continue; } r -= I_UP;
        p0_transpose_item<0>(F.w_down(), DFF, DM, DM, F.WDN(), nullptr, scr, r, F.lane);
    }
}
__device__ __forceinline__ void winbuf_copy(const Ctx& F) {
    { const int gt = F.vcu * (NWAVES * 64) + F.tid, NGT = F.G * NWAVES * 64; constexpr int TOT = DECB * 511 * 128;
      for (int i = gt; i < TOT; i += NGT) { const int b = i / (511 * 128), r = i % (511 * 128), row = r >> 7, c4 = r & 127;
          *(f32x4*)(F.out() + O_KWS + ((size_t)(b * 512 + row) * 512) + c4 * 4) = *(const f32x4*)(F.st_win() + ((size_t)(b * 512 + row + 1) * 512) + c4 * 4); } }
}

struct KeyRef { const void* k; const void* v; int f32; int valid; };
template <int NCH, class KF>
__device__ __forceinline__ void naive_attn2(const bf16* q2, const KF& kf, LAS float* qs, LAS float* sc, LAS float* ps, bool use_ps, int lane, float& o0, float& o1) {
    qs[lane] = bf2f(q2[lane]) * 0.125f; qs[64 + lane] = bf2f(q2[64 + lane]) * 0.125f;
    for (int c = 0; c < NCH; ++c) {
        const KeyRef kr = kf(c, lane);
        float s0 = -INFINITY, s1 = -INFINITY;
        if (kr.valid) {
            float k[64];
            if (kr.f32) { const f32x4* p = (const f32x4*)kr.k;
#pragma unroll
                for (int i = 0; i < 16; ++i) { const f32x4 t = p[i]; k[4 * i] = t.x; k[4 * i + 1] = t.y; k[4 * i + 2] = t.z; k[4 * i + 3] = t.w; } }
            else { const v4u* p = (const v4u*)kr.k;
#pragma unroll
                for (int i = 0; i < 8; ++i) { const v4u t = p[i]; k[8 * i] = __uint_as_float(t.x << 16); k[8 * i + 1] = __uint_as_float(t.x & 0xffff0000u); k[8 * i + 2] = __uint_as_float(t.y << 16); k[8 * i + 3] = __uint_as_float(t.y & 0xffff0000u);
                    k[8 * i + 4] = __uint_as_float(t.z << 16); k[8 * i + 5] = __uint_as_float(t.z & 0xffff0000u); k[8 * i + 6] = __uint_as_float(t.w << 16); k[8 * i + 7] = __uint_as_float(t.w & 0xffff0000u); } }
            s0 = 0.f; s1 = 0.f;
#pragma unroll
            for (int d = 0; d < 64; ++d) { s0 += qs[d] * k[d]; s1 += qs[64 + d] * k[d]; }
        }
        sc[c * 64 + lane] = s0; sc[NCH * 64 + c * 64 + lane] = s1;
    }
#pragma unroll
    for (int hh = 0; hh < 2; ++hh) { LAS float* s = sc + hh * NCH * 64; float m = -INFINITY;
        for (int c = 0; c < NCH; ++c) m = fmaxf(m, s[c * 64 + lane]);
        m = wave_max(m); if (m == -INFINITY) m = 0.f;
        float sum = 0.f;
        for (int c = 0; c < NCH; ++c) { const float e = __expf(s[c * 64 + lane] - m); s[c * 64 + lane] = e; sum += e; }
        sum = wave_sum(sum); const float inv = 1.0f / fmaxf(sum, 1e-30f);
        for (int c = 0; c < NCH; ++c) { const float p = s[c * 64 + lane] * inv; s[c * 64 + lane] = p; if (use_ps) ps[1 + c * 64 + lane] += p; } }
    o0 = 0.f; o1 = 0.f;
#pragma unroll
    for (int hh = 0; hh < 2; ++hh) {
        float a0[64];
#pragma unroll
        for (int d = 0; d < 64; ++d) a0[d] = 0.f;
        for (int c = 0; c < NCH; ++c) {
            const KeyRef kr = kf(c, lane);
            if (kr.valid) {
                const float p0 = sc[hh * NCH * 64 + c * 64 + lane];
                if (kr.f32) { const f32x4* p = (const f32x4*)kr.v;
#pragma unroll
                    for (int i = 0; i < 16; ++i) { const f32x4 t = p[i]; a0[4 * i] += p0 * t.x; a0[4 * i + 1] += p0 * t.y; a0[4 * i + 2] += p0 * t.z; a0[4 * i + 3] += p0 * t.w; } }
                else { const v4u* p = (const v4u*)kr.v;
#pragma unroll
                    for (int i = 0; i < 8; ++i) { const v4u t = p[i]; a0[8 * i] += p0 * __uint_as_float(t.x << 16); a0[8 * i + 1] += p0 * __uint_as_float(t.x & 0xffff0000u); a0[8 * i + 2] += p0 * __uint_as_float(t.y << 16); a0[8 * i + 3] += p0 * __uint_as_float(t.y & 0xffff0000u);
                        a0[8 * i + 4] += p0 * __uint_as_float(t.z << 16); a0[8 * i + 5] += p0 * __uint_as_float(t.z & 0xffff0000u); a0[8 * i + 6] += p0 * __uint_as_float(t.w << 16); a0[8 * i + 7] += p0 * __uint_as_float(t.w & 0xffff0000u); } }
            }
        }
        const float s0 = wave_reduce_t64(a0, lane); if (hh == 0) o0 = s0; else o1 = s0;
    }
}
struct CmpKeys { const float* base; int g, ncmp, qpos;
    __device__ __forceinline__ KeyRef operator()(int c, int l) const { const int n = c * 64 + l; KeyRef r; r.valid = (n < ncmp) && (16 * n + 31 <= qpos); r.f32 = 1; r.k = base + (size_t)(r.valid ? n : 0) * 512 + g * 64; r.v = (const float*)r.k + 256; return r; } };
struct WinKeysP { const bf16* kw; int g, t;
    __device__ __forceinline__ KeyRef operator()(int c, int l) const { const int pos = t - 511 + c * 64 + l; KeyRef r; r.valid = pos >= 0; r.f32 = 0; r.k = kw + (size_t)(r.valid ? pos : 0) * 512 + g * 64; r.v = (const bf16*)r.k + 256; return r; } };
struct WinKeysS { const float* st; const bf16* nw; int g;
    __device__ __forceinline__ KeyRef operator()(int c, int l) const { const int i = 1 + c * 64 + l; KeyRef r; r.valid = 1;
        if (i < 512) { r.f32 = 1; r.k = st + (size_t)i * 512 + g * 64; r.v = (const float*)r.k + 256; } else { r.f32 = 0; r.k = nw + g * 64; r.v = nw + 256 + g * 64; } return r; } };
struct SelKeysP { const int* idx; const bf16* ks; int g, qpos;
    __device__ __forceinline__ KeyRef operator()(int c, int l) const { const int pos = idx[c] * 64 + l; KeyRef r; r.valid = pos <= qpos; r.f32 = 0; r.k = ks + (size_t)(r.valid ? pos : 0) * 512 + g * 64; r.v = (const bf16*)r.k + 256; return r; } };
struct SelKeysS { const int* idx; const int* pt; const float* cache; const bf16* nw; int g;
    __device__ __forceinline__ KeyRef operator()(int c, int l) const { const int pos = idx[c] * 64 + l; KeyRef r; r.valid = pos <= PAST;
        if (pos < PAST) { const int page = pt[pos >> 7]; r.f32 = 1; r.k = cache + ((size_t)page * 128 + (pos & 127)) * 512 + g * 64; r.v = (const float*)r.k + 256; } else { r.f32 = 0; r.k = nw + g * 64; r.v = nw + 256 + g * 64; } return r; } };

constexpr int NA_WAVE_LDS = 14336;
__device__ __forceinline__ void na_ptrs(const Ctx& F, LAS float*& qs, LAS float*& sc, LAS float*& ps, LAS float*& imp) {
    LAS unsigned char* b = F.lds + RING_OFF + F.wave * NA_WAVE_LDS; qs = (LAS float*)b; sc = (LAS float*)(b + 512); ps = (LAS float*)(b + 8704); imp = (LAS float*)(b + 10880); }

template <bool CHK>
__device__ __forceinline__ void compress_task(const Ctx& F, int task, int lane) {
    constexpr int NT_P = NB * NCMP_P * 2;
    const bool dec = task >= NT_P; const int tt = dec ? task - NT_P : task, ncmp = dec ? NCMP_S : NCMP_P, bb = tt / (ncmp * 2), rr = tt % (ncmp * 2), n = rr >> 1, c = rr & 1;
    float h0[4] = {0.f, 0.f, 0.f, 0.f}, h1[4] = {0.f, 0.f, 0.f, 0.f};
    const float* w1 = F.cmp_w1() + (size_t)c * 2048 * 128; const float* pe = F.cmp_pe() + c * 2048;
    for (int l = 0; l < 32; ++l) {
        const int pos = 16 * n + l; const float* row;
        if (!dec) row = F.out() + O_KCP + (size_t)(bb * SEQ + pos) * 512; else { const int page = F.page_table()[bb * 64 + (pos >> 7)]; row = F.cache_cmp() + ((size_t)page * 128 + (pos & 127)) * 512; }
        const float pv = pe[l * 64 + lane]; float xg[4];
#pragma unroll
        for (int g = 0; g < 4; ++g) xg[g] = row[c * 256 + g * 64 + lane] + pv;
        const float* wl = w1 + (size_t)l * 64 * 128;
#pragma unroll 8
        for (int d = 0; d < 64; ++d) { const float wa = wl[d * 128 + lane], wb = wl[d * 128 + 64 + lane];
#pragma unroll
            for (int g = 0; g < 4; ++g) { const float xv = rdlane(xg[g], d); h0[g] += xv * wa; h1[g] += xv * wb; } }
    }
    const float ba = F.cmp_b1()[c * 128 + lane], bb1 = F.cmp_b1()[c * 128 + 64 + lane];
#pragma unroll
    for (int g = 0; g < 4; ++g) { h0[g] = siluf_(h0[g] + ba); h1[g] = siluf_(h1[g] + bb1); }
    const float* w2 = F.cmp_w2() + (size_t)c * 128 * 64; const float b2 = F.cmp_b2()[c * 64 + lane];
    float o[4] = {b2, b2, b2, b2};
    for (int f = 0; f < 64; ++f) { const float wa = w2[f * 64 + lane], wb = w2[(64 + f) * 64 + lane];
#pragma unroll
        for (int g = 0; g < 4; ++g) o[g] += rdlane(h0[g], f) * wa + rdlane(h1[g], f) * wb; }
    float* dst = (dec ? F.KCMPS() : F.KCMPP()) + ((size_t)(bb * ncmp + n) * 2 + c) * 256;
#pragma unroll
    for (int g = 0; g < 4; ++g) { if (CHK) { const float df = fabsf(o[g] - dst[g * 64 + lane]);
            if (!(df <= 0.02f + 0.02f * fabsf(o[g]))) __hip_atomic_fetch_or((unsigned*)F.ctl + CW_CHK + (!dec ? 0 : ((n & 127) == 127 ? 1 : 2)), 1u, RLX_AGENT);
            if (!(df <= 0.2f)) __hip_atomic_fetch_or((unsigned*)F.ctl + CW_CHK + 3, 1u, RLX_AGENT); } else dst[g * 64 + lane] = o[g]; }
}
__device__ __forceinline__ void compress_ref_check(const Ctx& F, int task, int g, int lane, int dbgslot) {
    constexpr int NT_P = NB * NCMP_P * 2;
    const bool dec = task >= NT_P; const int tt = dec ? task - NT_P : task, ncmp = dec ? NCMP_S : NCMP_P, bb = tt / (ncmp * 2), rr = tt % (ncmp * 2), n = rr >> 1, c = rr & 1;
    LAS float* hl = (LAS float*)(F.lds + RING_OFF + F.wave * NA_WAVE_LDS);
    float ha = 0.f, hb2 = 0.f;
    for (int k = 0; k < 2048; ++k) { const int l = k >> 6, d = k & 63, pos = 16 * n + l; const float* row;
        if (!dec) row = F.out() + O_KCP + (size_t)(bb * SEQ + pos) * 512; else { const int page = F.page_table()[bb * 64 + (pos >> 7)]; row = F.cache_cmp() + ((size_t)page * 128 + (pos & 127)) * 512; }
        const float x = row[c * 256 + g * 64 + d] + F.cmp_pe()[c * 2048 + k]; const float* w = F.cmp_w1() + ((size_t)c * 2048 + k) * 128;
        ha += x * w[lane]; hb2 += x * w[64 + lane]; }
    if (dbgslot >= 0) { const float* HD = (const float*)F.H() + (size_t)dbgslot * 512 * 128 + (size_t)(((n & 127) << 2) + g) * 128; float pa = 0.f, pb = 0.f; for (int kc = 0; kc < 16; ++kc) { pa += F.PEB()[(c * 16 + kc) * 128 + lane]; pb += F.PEB()[(c * 16 + kc) * 128 + 64 + lane]; }
        if (!(fabsf(HD[lane] + pa - ha) <= 0.05f + 0.05f * fabsf(ha)) || !(fabsf(HD[64 + lane] + pb - hb2) <= 0.05f + 0.05f * fabsf(hb2))) __hip_atomic_fetch_or((unsigned*)F.ctl + CW_CHK + 5 + dbgslot, 1u, RLX_AGENT); }
    ha += F.cmp_b1()[c * 128 + lane]; hb2 += F.cmp_b1()[c * 128 + 64 + lane];
    hl[lane] = ha / (1.0f + __expf(-ha)); hl[64 + lane] = hb2 / (1.0f + __expf(-hb2));
    float o = F.cmp_b2()[c * 64 + lane];
    for (int f = 0; f < 128; ++f) o += hl[f] * F.cmp_w2()[((size_t)c * 128 + f) * 64 + lane];
    const float got = (dec ? F.KCMPS() : F.KCMPP())[((size_t)(bb * ncmp + n) * 2 + c) * 256 + g * 64 + lane];
    if (!(fabsf(o - got) <= 0.05f + 0.05f * fabsf(o))) __hip_atomic_fetch_or((unsigned*)F.ctl + CW_CHK + 4, 1u, RLX_AGENT);
}
__device__ __forceinline__ void conv_prepass(const Ctx& F) {
    const int gt = F.vcu * (NWAVES * 64) + F.tid, NGT = F.G * NWAVES * 64;
    constexpr int TOTP = (MPROMPT / 8) * (CONV_DIM / 4);
    for (int i = gt; i < TOTP; i += NGT) {
        const int rb = i / (CONV_DIM / 4), c4 = i % (CONV_DIM / 4), col = c4 * 4, m0 = rb * 8, t0 = m0 & (SEQ - 1), b = m0 >> 12;
        f32x4 xr[11];
#pragma unroll
        for (int k = 0; k < 11; ++k) xr[k] = (t0 - 3 + k >= 0) ? *(const f32x4*)(F.XBC() + (size_t)(m0 - 3 + k) * CONV_DIM + col) : (f32x4){0.f, 0.f, 0.f, 0.f};
        const f32x4 bias = *(const f32x4*)(F.conv_b() + col), w0 = *(const f32x4*)(F.conv_w() + col), w1 = *(const f32x4*)(F.conv_w() + CONV_DIM + col), w2 = *(const f32x4*)(F.conv_w() + 2 * CONV_DIM + col), w3 = *(const f32x4*)(F.conv_w() + 3 * CONV_DIM + col);
#pragma unroll
        for (int r = 0; r < 8; ++r) { const f32x4 acc = bias + xr[r] * w0 + xr[r + 1] * w1 + xr[r + 2] * w2 + xr[r + 3] * w3;
            typedef unsigned u32x2v __attribute__((ext_vector_type(2))); u32x2v w; w.x = pk2(siluf_(acc.x), siluf_(acc.y)); w.y = pk2(siluf_(acc.z), siluf_(acc.w)); *(u32x2v*)(F.XBCA16() + (size_t)(m0 + r) * CONV_DIM + col) = w;
            if (t0 + r >= SEQ - 3) *(f32x4*)(F.out() + O_CVP + (size_t)(b * 3 + (t0 + r - (SEQ - 3))) * CONV_DIM + col) = xr[r + 3]; }
        if (c4 < 4) {
#pragma unroll
            for (int r = 0; r < 8; ++r)
#pragma unroll
                for (int e = 0; e < 4; ++e) { const int h = c4 * 4 + e; const float x = F.GD()[(size_t)(m0 + r) * 64 + 48 + h] + F.dt_bias()[h]; F.DT()[(size_t)(m0 + r) * 16 + h] = x > 20.f ? x : log1pf(__expf(x)); } }
    }
    constexpr int TOTS = DECB * (CONV_DIM / 4);
    for (int i = gt; i < TOTS; i += NGT) {
        const int b = i / (CONV_DIM / 4), c4 = i % (CONV_DIM / 4), col = c4 * 4; const size_t m = (size_t)MPROMPT + b;
        f32x4 acc = *(const f32x4*)(F.conv_b() + col);
#pragma unroll
        for (int w = 0; w < 3; ++w) acc += *(const f32x4*)(F.st_conv() + (size_t)(b * 3 + w) * CONV_DIM + col) * *(const f32x4*)(F.conv_w() + (size_t)w * CONV_DIM + col);
        const f32x4 xcur = *(const f32x4*)(F.XBC() + m * CONV_DIM + col); acc += xcur * *(const f32x4*)(F.conv_w() + (size_t)3 * CONV_DIM + col);
        f32x4 a; a.x = siluf_(acc.x); a.y = siluf_(acc.y); a.z = siluf_(acc.z); a.w = siluf_(acc.w);
        *(f32x4*)(F.XBCA() + m * CONV_DIM + col) = a;
        { typedef unsigned u32x2v __attribute__((ext_vector_type(2))); u32x2v w; w.x = pk2(a.x, a.y); w.y = pk2(a.z, a.w); *(u32x2v*)(F.XBCA16() + m * CONV_DIM + col) = w; }
        *(f32x4*)(F.out() + O_CVS + (size_t)(b * 3 + 0) * CONV_DIM + col) = *(const f32x4*)(F.st_conv() + (size_t)(b * 3 + 1) * CONV_DIM + col);
        *(f32x4*)(F.out() + O_CVS + (size_t)(b * 3 + 1) * CONV_DIM + col) = *(const f32x4*)(F.st_conv() + (size_t)(b * 3 + 2) * CONV_DIM + col);
        *(f32x4*)(F.out() + O_CVS + (size_t)(b * 3 + 2) * CONV_DIM + col) = xcur;
        if (c4 < 4) {
#pragma unroll
            for (int e = 0; e < 4; ++e) { const int h = c4 * 4 + e; const float x = F.GD()[m * 64 + 48 + h] + F.dt_bias()[h]; F.DT()[m * 16 + h] = x > 20.f ? x : log1pf(__expf(x)); } }
    }
}
template <bool CHK>
__device__ __forceinline__ void win_task(const Ctx& F, int task, int lane) {
    LAS float *qs, *sc, *ps, *imp; na_ptrs(F, qs, sc, ps, imp);
    const int m = task >> 2, g = task & 3; const bool dec = m >= MPROMPT; const int b = dec ? m - MPROMPT : m >> 12, t = m & (SEQ - 1);
#pragma unroll
    for (int pr = 0; pr < 2; ++pr) { float o0, o1; const bf16* q2 = F.QB() + (size_t)m * 1024 + g * 256 + pr * 128;
        if (!dec) { const WinKeysP kf{F.KWB() + (size_t)b * SEQ * 512, g, t}; naive_attn2<8>(q2, kf, qs, sc, ps, false, lane, o0, o1); }
        else { const WinKeysS kf{F.st_win() + (size_t)b * 512 * 512, F.KWB() + (size_t)m * 512, g}; naive_attn2<8>(q2, kf, qs, sc, ps, false, lane, o0, o1); }
        float* d0 = F.OWIN() + (size_t)m * 1024 + (g * 4 + pr * 2) * 64 + lane;
        if (CHK) { if (!(fabsf(o0 - d0[0]) <= 2e-3f) || !(fabsf(o1 - d0[64]) <= 2e-3f)) __hip_atomic_fetch_or((unsigned*)F.ctl + CW_CHK + 0, 1u, RLX_AGENT); }
        else { d0[0] = o0; d0[64] = o1; } }
}
template <bool CHK>
__device__ __forceinline__ void cmp_task(const Ctx& F, int task, int lane) {
    LAS float *qs, *sc, *ps, *imp; na_ptrs(F, qs, sc, ps, imp);
    const int m = task >> 2, g = task & 3; const bool dec = m >= MPROMPT; const int b = dec ? m - MPROMPT : m >> 12, t = m & (SEQ - 1);
    const int qpos = dec ? PAST : t, ncmp = dec ? NCMP_S : NCMP_P, nslc = dec ? NSLC_S : NSLC_P, jt = qpos >> 6;
    for (int i = lane; i < 544; i += 64) ps[i] = 0.f;
    const CmpKeys kf{dec ? F.KCMPS() + (size_t)b * NCMP_S * 512 : F.KCMPP() + (size_t)b * NCMP_P * 512, g, ncmp, qpos};
#pragma unroll
    for (int pr = 0; pr < 2; ++pr) { float o0, o1; naive_attn2<8>(F.QB() + (size_t)m * 1024 + g * 256 + pr * 128, kf, qs, sc, ps, true, lane, o0, o1);
        float* d0 = F.OCMP() + (size_t)m * 1024 + (g * 4 + pr * 2) * 64 + lane;
        if (CHK) { if (!(fabsf(o0 - d0[0]) <= 5e-3f + 0.02f * fabsf(o0)) || !(fabsf(o1 - d0[64]) <= 5e-3f + 0.02f * fabsf(o1))) __hip_atomic_fetch_or((unsigned*)F.ctl + CW_CHK + 0, 1u, RLX_AGENT);
                   if (!(fabsf(o0 - d0[0]) <= 0.05f) || !(fabsf(o1 - d0[64]) <= 0.05f)) __hip_atomic_fetch_or((unsigned*)F.ctl + CW_CHK + 3, 1u, RLX_AGENT); }
        else { d0[0] = o0; d0[64] = o1; } }
    float mine[3]; int cnt[3];
#pragma unroll
    for (int jj = 0; jj < 3; ++jj) { const int j = jj * 64 + lane; float v = 0.f; cnt[jj] = 0;
        if (j < nslc) { v = ps[4 * j] + 2.0f * (ps[4 * j + 1] + ps[4 * j + 2] + ps[4 * j + 3]) + ps[4 * j + 4]; if (j == 0 || j == jt || j == jt - 1) v = 1.0e4f; if (j > jt) v = -1.0e4f; imp[j] = v; }
        mine[jj] = v; }
    for (int k = 0; k < nslc; ++k) { const float v = imp[k];
#pragma unroll
        for (int jj = 0; jj < 3; ++jj) { const int j = jj * 64 + lane; cnt[jj] += ((v > mine[jj]) || (v == mine[jj] && k < j)) ? 1 : 0; } }
    int base = 0;
#pragma unroll
    for (int jj = 0; jj < 3; ++jj) { const int j = jj * 64 + lane; const bool sel = (j < nslc) && (cnt[jj] < 16); const unsigned long long bal = __ballot(sel);
        if (CHK && dec) { bool stored = false; for (int i = 0; i < 16; ++i) stored = stored || (F.SELIDX()[(size_t)task * 16 + i] == j);
            if (__ballot((j < nslc) && (stored != sel)) != 0ull && lane == 0) __hip_atomic_fetch_or((unsigned*)F.ctl + CW_CHK + 2, 1u, RLX_AGENT); }
        else if (CHK) { if (jj == 0 && lane == 0 && F.SELMASK()[task] != bal) { if (__hip_atomic_fetch_add((unsigned*)F.ctl + CW_CHK + 8, 1u, RLX_AGENT) >= 100u) __hip_atomic_fetch_or((unsigned*)F.ctl + CW_CHK + 1, 1u, RLX_AGENT); if (__popcll(F.SELMASK()[task] ^ bal) > 2) __hip_atomic_fetch_or((unsigned*)F.ctl + CW_CHK + 2, 1u, RLX_AGENT); } }
        else { if (sel) F.SELIDX()[(size_t)task * 16 + base + __popcll(bal & ((1ull << lane) - 1ull))] = j;
        if (!dec && jj == 0 && lane == 0) F.SELMASK()[task] = bal; }
        base += __popcll(bal); }
}
template <bool CHK>
__device__ __forceinline__ void sel_task(const Ctx& F, int task, int lane) {
    LAS float *qs, *sc, *ps, *imp; na_ptrs(F, qs, sc, ps, imp);
    const int m = task >> 2, g = task & 3; const bool dec = m >= MPROMPT; const int b = dec ? m - MPROMPT : m >> 12, t = m & (SEQ - 1);
#pragma unroll
    for (int pr = 0; pr < 2; ++pr) { float o0, o1; const bf16* q2 = F.QB() + (size_t)m * 1024 + g * 256 + pr * 128;
        if (!dec) { LAS int* il = (LAS int*)imp;
            const unsigned long long mk = F.SELMASK()[task]; if ((mk >> lane) & 1ull) il[__popcll(mk & ((1ull << lane) - 1ull))] = lane;
            const SelKeysP kf{(const int*)il, F.KSB() + (size_t)b * SEQ * 512, g, t}; naive_attn2<16>(q2, kf, qs, sc, ps, false, lane, o0, o1); }
        else { const SelKeysS kf{F.SELIDX() + (size_t)task * 16, F.page_table() + b * 64, F.cache_sel(), F.KSB() + (size_t)m * 512, g}; naive_attn2<16>(q2, kf, qs, sc, ps, false, lane, o0, o1); }
#pragma unroll
        for (int e = 0; e < 2; ++e) { const int hd = g * 4 + pr * 2 + e; const float* gt = F.GD() + (size_t)m * 64 + hd * 3; const size_t oi = (size_t)m * 1024 + hd * 64 + lane;
            const float a = gt[0] * F.OCMP()[oi] + gt[1] * (e ? o1 : o0) + gt[2] * F.OWIN()[oi]; bf16* dm = F.MIX() + (size_t)m * DM + hd * 64 + lane;
            if (CHK) { if (!(fabsf(a - bf2f(*dm)) <= 2e-3f + 0.01f * fabsf(a))) __hip_atomic_fetch_or((unsigned*)F.ctl + CW_CHK + 1, 1u, RLX_AGENT); } else *dm = (bf16)f2bf(a); } }
}
template <int U>
__device__ __forceinline__ void ssd_chain(const Ctx& F, int rowbase, int L, int h, int p, const float* s0, float* sfin, int lane) {
    const int grp = h >> 3; float h0 = 0.f, h1 = 0.f; if (s0) { h0 = s0[lane]; h1 = s0[64 + lane]; }
    const float A = -__expf(F.a_log()[h]), Dk = F.d_skip()[h];
    for (int t0 = 0; t0 < L; t0 += U) {
        float dt[U], x[U], B0[U], B1[U], C0[U], C1[U];
#pragma unroll
        for (int u = 0; u < U; ++u) { const size_t m = (size_t)(rowbase + t0 + u); dt[u] = F.DT()[m * 16 + h]; const float* r = F.XBCA() + m * CONV_DIM; x[u] = r[h * 64 + p];
            B0[u] = r[1024 + grp * 128 + lane]; B1[u] = r[1024 + grp * 128 + 64 + lane]; C0[u] = r[1280 + grp * 128 + lane]; C1[u] = r[1280 + grp * 128 + 64 + lane]; }
        float y[U];
#pragma unroll
        for (int u = 0; u < U; ++u) { const float dA = __expf(dt[u] * A), xd = dt[u] * x[u]; h0 = h0 * dA + xd * B0[u]; h1 = h1 * dA + xd * B1[u]; y[u] = wave_sum(C0[u] * h0 + C1[u] * h1) + Dk * x[u]; }
        if (lane == 0) {
#pragma unroll
            for (int u = 0; u < U; ++u) F.YSSD()[(size_t)(rowbase + t0 + u) * 1024 + h * 64 + p] = y[u]; }
    }
    sfin[lane] = h0; sfin[64 + lane] = h1;
}
__device__ __forceinline__ void ssd_task(const Ctx& F, int task, int lane) {
    if (task < NB * 16 * 64) { const int b = task >> 10, h = (task >> 6) & 15, p = task & 63; ssd_chain<4>(F, b * SEQ, SEQ, h, p, nullptr, F.out() + O_SSP + (size_t)task * 128, lane); }
    else { const int tk = task - NB * 16 * 64, b = tk >> 10, h = (tk >> 6) & 15, p = tk & 63; ssd_chain<1>(F, MPROMPT + b, 1, h, p, F.st_ssm() + (size_t)tk * 128, F.out() + O_SSS + (size_t)tk * 128, lane); }
}
__device__ __forceinline__ void ssd_decode_task(const Ctx& F, int task, int lane) {
    const int pg = task & 7, h = (task >> 3) & 15, b = task >> 7, grp = h >> 3; const size_t m = (size_t)MPROMPT + b;
    const float* r = F.XBCA() + m * CONV_DIM; const float dt = F.DT()[m * 16 + h], A = -__expf(F.a_log()[h]), Dk = F.d_skip()[h], dA = __expf(dt * A);
    const float B0 = r[1024 + grp * 128 + lane], B1 = r[1024 + grp * 128 + 64 + lane], C0 = r[1280 + grp * 128 + lane], C1 = r[1280 + grp * 128 + 64 + lane];
    const size_t sb = ((size_t)(b * 16 + h) * 64 + pg * 8) * 128;
    float h0[8], h1[8], x[8];
#pragma unroll
    for (int i = 0; i < 8; ++i) { h0[i] = F.st_ssm()[sb + i * 128 + lane]; h1[i] = F.st_ssm()[sb + i * 128 + 64 + lane]; x[i] = r[h * 64 + pg * 8 + i]; }
#pragma unroll
    for (int i = 0; i < 8; ++i) { const float xd = dt * x[i]; h0[i] = h0[i] * dA + xd * B0; h1[i] = h1[i] * dA + xd * B1;
        F.out()[O_SSS + sb + i * 128 + lane] = h0[i]; F.out()[O_SSS + sb + i * 128 + 64 + lane] = h1[i];
        const float y = wave_sum(C0 * h0[i] + C1 * h1[i]) + Dk * x[i]; if (lane == 0) F.YSSD()[m * 1024 + h * 64 + pg * 8 + i] = y; }
}
__device__ __forceinline__ void ssd_gate_task(const Ctx& F, int task, int lane) {
    const int m = task >> 1, grp = task & 1; const size_t o = (size_t)m * 1024 + grp * 512 + lane * 8;
    const f32x4 y0 = *(const f32x4*)(F.YSSD() + o), y1 = *(const f32x4*)(F.YSSD() + o + 4), z0 = *(const f32x4*)(F.Z() + o), z1 = *(const f32x4*)(F.Z() + o + 4);
    float v[8] = {y0.x * siluf_(z0.x), y0.y * siluf_(z0.y), y0.z * siluf_(z0.z), y0.w * siluf_(z0.w), y1.x * siluf_(z1.x), y1.y * siluf_(z1.y), y1.z * siluf_(z1.z), y1.w * siluf_(z1.w)};
    float ss = 0.f;
#pragma unroll
    for (int e = 0; e < 8; ++e) ss += v[e] * v[e];
    const float rstd = 1.0f / sqrtf(wave_sum(ss) * (1.0f / 512.0f) + NORM_EPS);
    const float* w = F.ssm_norm() + grp * 512 + lane * 8;
    v4u ow; ow.x = pk2(v[0] * rstd * w[0], v[1] * rstd * w[1]); ow.y = pk2(v[2] * rstd * w[2], v[3] * rstd * w[3]); ow.z = pk2(v[4] * rstd * w[4], v[5] * rstd * w[5]); ow.w = pk2(v[6] * rstd * w[6], v[7] * rstd * w[7]);
    *(v4u*)(F.MIX() + (size_t)m * DM + 1024 + grp * 512 + lane * 8) = ow;
}
__device__ __forceinline__ void final_norm_row(const Ctx& F, int m, int lane) {
    float s = m < MPROMPT ? (lane < 32 ? F.SS2()[(size_t)m * 32 + lane] : 0.f) : F.SS2S()[(size_t)(m - MPROMPT) * 64 + lane]; s = wave_sum(s);
    const float rstd = 1.0f / sqrtf(s * (1.0f / DM) + NORM_EPS);
    const f32x4* xr = (const f32x4*)(F.X2() + (size_t)m * DM) + lane; const f32x4* wr = (const f32x4*)F.ln_final() + lane;
    f32x4* o = (f32x4*)(m < MPROMPT ? F.out() + O_YP + (size_t)m * DM : F.out() + O_YS + (size_t)(m - MPROMPT) * DM) + lane;
#pragma unroll
    for (int j = 0; j < 8; ++j) o[64 * j] = xr[64 * j] * rstd * wr[64 * j];
}

namespace fa {
typedef short bf16x8 __attribute__((ext_vector_type(8)));
typedef short s16x4 __attribute__((ext_vector_type(4)));
typedef float f32x16 __attribute__((ext_vector_type(16)));
constexpr float C2 = 0.125f * 1.4426950408889634f, MASKV = -1.0e30f;
constexpr int LK = 0, LV = 16384, LWS = 32768, LDS_BYTES_FA = 34816;
__device__ __forceinline__ int crow(int r, int hi) { return (r & 3) + 8 * (r >> 2) + 4 * hi; }
__device__ __forceinline__ float max3f(float a, float b, float c) { float r; asm("v_max3_f32 %0, %1, %2, %3" : "=v"(r) : "v"(a), "v"(b), "v"(c)); return r; }
typedef float f32x2_t __attribute__((ext_vector_type(2))); typedef __bf16 bf16x2_t __attribute__((ext_vector_type(2)));
__device__ __forceinline__ unsigned cvtpk(float lo, float hi) { f32x2_t v = {lo, hi}; bf16x2_t b = __builtin_convertvector(v, bf16x2_t); return __builtin_bit_cast(unsigned, b); }
__device__ __forceinline__ float xmax(float v) { auto rr = __builtin_amdgcn_permlane32_swap(__float_as_uint(v), __float_as_uint(v), false, false); return fmaxf(__uint_as_float(rr[0]), __uint_as_float(rr[1])); }
__device__ __forceinline__ float xsum(float v) { auto rr = __builtin_amdgcn_permlane32_swap(__float_as_uint(v), __float_as_uint(v), false, false); return __uint_as_float(rr[0]) + __uint_as_float(rr[1]); }
__device__ __forceinline__ void qkt(f32x16& p0, f32x16& p1, const LAS unsigned char* Kt, const bf16x8* qr, int r32, int hi) {
    const LAS unsigned char* kb = Kt + hi * 1024 + r32 * 16;
    p0 = f32x16{}; p1 = f32x16{};
#pragma unroll
    for (int d0 = 0; d0 < 4; ++d0) {
        const bf16x8 b0 = *(const LAS bf16x8*)(kb + d0 * 2048), b1 = *(const LAS bf16x8*)(kb + d0 * 2048 + 512);
        p0 = __builtin_amdgcn_mfma_f32_32x32x16_bf16(b0, qr[d0], p0, 0, 0, 0); p1 = __builtin_amdgcn_mfma_f32_32x32x16_bf16(b1, qr[d0], p1, 0, 0, 0); }
}
__device__ __forceinline__ void pv(f32x16* o, unsigned vb, bf16x8 pa0, bf16x8 pa1, bf16x8 pa2, bf16x8 pa3) {
#pragma unroll
    for (int d0 = 0; d0 < 2; ++d0) { s16x4 lo[4], hi[4];
#pragma unroll
        for (int ks = 0; ks < 4; ++ks) {
            asm volatile("ds_read_b64_tr_b16 %0,%1 offset:%c2" : "=&v"(lo[ks]) : "v"(vb), "i"(d0 * 4096 + ks * 1024) : "memory");
            asm volatile("ds_read_b64_tr_b16 %0,%1 offset:%c2" : "=&v"(hi[ks]) : "v"(vb), "i"(d0 * 4096 + ks * 1024 + 512) : "memory"); }
        asm volatile("s_waitcnt lgkmcnt(0)" ::: "memory"); __builtin_amdgcn_sched_barrier(0);
#define FA_PK(k) (bf16x8){lo[k][0], lo[k][1], lo[k][2], lo[k][3], hi[k][0], hi[k][1], hi[k][2], hi[k][3]}
        o[d0] = __builtin_amdgcn_mfma_f32_32x32x16_bf16(pa0, FA_PK(0), o[d0], 0, 0, 0);
        o[d0] = __builtin_amdgcn_mfma_f32_32x32x16_bf16(pa1, FA_PK(1), o[d0], 0, 0, 0);
        o[d0] = __builtin_amdgcn_mfma_f32_32x32x16_bf16(pa2, FA_PK(2), o[d0], 0, 0, 0);
        o[d0] = __builtin_amdgcn_mfma_f32_32x32x16_bf16(pa3, FA_PK(3), o[d0], 0, 0, 0);
#undef FA_PK
    }
}
__device__ __forceinline__ float rowmax(const f32x16& p0, const f32x16& p1) {
    float a = max3f(p0[0], p0[1], p1[0]), b = max3f(p0[2], p0[3], p1[1]); a = max3f(a, p1[2], p1[3]);
#pragma unroll
    for (int r = 4; r < 16; r += 4) { a = max3f(a, p0[r], p0[r + 1]); b = max3f(b, p0[r + 2], p0[r + 3]); a = max3f(a, p1[r], p1[r + 1]); b = max3f(b, p1[r + 2], p1[r + 3]); }
    const float m = fmaxf(a, b);
    return xmax(m);
}
#define FA_BAR() asm volatile("s_waitcnt vmcnt(0) lgkmcnt(0)\n\ts_barrier" ::: "memory")

template <int MODE>
__device__ __forceinline__ void attn_unit(const Ctx& F, LAS unsigned char* shm, int b, int g, int qb) {
    const int tid = threadIdx.x, lane = tid & 63, r32 = lane & 31, hi = lane >> 5; const int wid = __builtin_amdgcn_readfirstlane(tid >> 6);
    const int hd = 4 * g + (wid & 3), th = wid >> 2, trel = 32 * th + r32; const size_t m = (size_t)b * SEQ + 64 * qb + trel;
    const int j_lo = MODE == 0 ? 0 : (qb > 8 ? qb - 8 : 0), j_hi = qb;
    const bf16* KV = (MODE == 0 ? F.KSB() : F.KWB()) + (size_t)b * SEQ * 512 + g * 64;
    const unsigned long long smask = MODE == 0 ? F.SELMASK()[m * 4 + g] : ~0ull;
    bf16x8 qr[4];
    { const bf16* Qp = F.QB() + m * 1024 + hd * 64 + hi * 8;
#pragma unroll
      for (int d0 = 0; d0 < 4; ++d0) qr[d0] = *(const bf16x8*)(Qp + 16 * d0); }
    const bf16* ksrc = KV + (size_t)lane * 512 + wid * 8;
    const bf16* vsrc = KV + 256 + (size_t)(16 * (wid & 3) + (lane >> 2)) * 512 + (wid >> 2) * 32 + (lane & 3) * 8;
    LAS unsigned char* kdst = shm + LK + wid * 1024 + lane * 16; LAS unsigned char* vdst = shm + LV + wid * 1024 + lane * 16;
    const unsigned vb0 = (unsigned)(uintptr_t)(shm + LV) + ((lane >> 4) & 1) * 32 + (lane & 3) * 8 + (4 * hi + ((lane & 15) >> 2)) * 64;
    LAS float* wsf = (LAS float*)(shm + LWS) + wid * 64;
    v4u kreg = *(const v4u*)(ksrc + (size_t)j_lo * 64 * 512), vreg = *(const v4u*)(vsrc + (size_t)j_lo * 64 * 512);
    *(LAS v4u*)kdst = kreg; *(LAS v4u*)vdst = vreg;
    FA_BAR();
    float mref = MASKV, lsum = 0.f; f32x16 o[2]; o[0] = f32x16{}; o[1] = f32x16{};
#define FA_TILE(DIAG) do { \
        const int buf = (j - j_lo) & 1; \
        if (!(DIAG)) { kreg = *(const v4u*)(ksrc + (size_t)(j + 1) * 64 * 512); vreg = *(const v4u*)(vsrc + (size_t)(j + 1) * 64 * 512); } \
        f32x16 p0, p1; \
        qkt(p0, p1, shm + LK + buf * 8192, qr, r32, hi); \
        if (DIAG) { _Pragma("unroll") for (int r = 0; r < 16; ++r) { const int kv = crow(r, hi); if (kv > trel) p0[r] = MASKV; if (kv + 32 > trel) p1[r] = MASKV; } } \
        if (MODE == 1 && qb >= 8 && j == j_lo) { _Pragma("unroll") for (int r = 0; r < 16; ++r) { const int kv = crow(r, hi); if (kv <= trel) p0[r] = MASKV; if (kv + 32 <= trel) p1[r] = MASKV; } } \
        const bool blocked = MODE == 0 && !((smask >> j) & 1ull); \
        float mt = rowmax(p0, p1); mt = (blocked || mt < -1.0e29f) ? MASKV : mt * C2; \
        const bool need = mt > mref + 8.0f; \
        if (__any(need)) { \
            const float mnew = need ? mt : mref, f = __builtin_amdgcn_exp2f(mref - mnew); lsum *= f; mref = mnew; \
            if (hi == 0) wsf[r32] = f; \
            asm volatile("s_waitcnt lgkmcnt(0)" ::: "memory"); \
            _Pragma("unroll") for (int r = 0; r < 16; ++r) { const float fr = wsf[crow(r, hi)]; o[0][r] *= fr; o[1][r] *= fr; } \
        } \
        const float nref = blocked ? -1.0e30f : (mref < -1.0e29f ? 0.f : -mref); float sacc = 0.f;        \
        _Pragma("unroll") for (int r = 0; r < 16; ++r) { p0[r] = __builtin_amdgcn_exp2f(__builtin_fmaf(p0[r], C2, nref)); p1[r] = __builtin_amdgcn_exp2f(__builtin_fmaf(p1[r], C2, nref)); sacc += p0[r] + p1[r]; } \
        lsum += sacc; \
        v4u pw0, pw1, pw2, pw3; \
        pw0.x = cvtpk(p0[0], p0[1]); pw0.y = cvtpk(p0[2], p0[3]); pw0.z = cvtpk(p0[4], p0[5]); pw0.w = cvtpk(p0[6], p0[7]); \
        pw1.x = cvtpk(p0[8], p0[9]); pw1.y = cvtpk(p0[10], p0[11]); pw1.z = cvtpk(p0[12], p0[13]); pw1.w = cvtpk(p0[14], p0[15]); \
        pw2.x = cvtpk(p1[0], p1[1]); pw2.y = cvtpk(p1[2], p1[3]); pw2.z = cvtpk(p1[4], p1[5]); pw2.w = cvtpk(p1[6], p1[7]); \
        pw3.x = cvtpk(p1[8], p1[9]); pw3.y = cvtpk(p1[10], p1[11]); pw3.z = cvtpk(p1[12], p1[13]); pw3.w = cvtpk(p1[14], p1[15]); \
        pv(o, vb0 + buf * 8192, __builtin_bit_cast(bf16x8, pw0), __builtin_bit_cast(bf16x8, pw1), __builtin_bit_cast(bf16x8, pw2), __builtin_bit_cast(bf16x8, pw3)); \
        if (!(DIAG)) { *(LAS v4u*)(kdst + (buf ^ 1) * 8192) = kreg; *(LAS v4u*)(vdst + (buf ^ 1) * 8192) = vreg; } \
        FA_BAR(); } while (0)
    int j = j_lo;
    for (; j < j_hi; ++j) FA_TILE(false);
    FA_TILE(true);
#undef FA_TILE
    lsum = xsum(lsum);
    if (hi == 0) wsf[32 + r32] = lsum;
    asm volatile("s_waitcnt lgkmcnt(0)" ::: "memory");
#pragma unroll
    for (int r = 0; r < 16; ++r) {
        const int q = crow(r, hi); const float rl = 1.0f / wsf[32 + q]; const size_t mm = (size_t)b * SEQ + 64 * qb + 32 * th + q; const size_t oi = mm * 1024 + hd * 64 + r32;
        if (MODE == 1) { F.OWIN()[oi] = o[0][r] * rl; F.OWIN()[oi + 32] = o[1][r] * rl; }
        else { const float* gt = F.GD() + mm * 64 + hd * 3; const float gc = gt[0], gs = gt[1], gw = gt[2];
            const float a0 = gc * F.OCMP()[oi] + gs * (o[0][r] * rl) + gw * F.OWIN()[oi], a1 = gc * F.OCMP()[oi + 32] + gs * (o[1][r] * rl) + gw * F.OWIN()[oi + 32];
            F.MIX()[mm * DM + hd * 64 + r32] = (bf16)f2bf(a0); F.MIX()[mm * DM + hd * 64 + 32 + r32] = (bf16)f2bf(a1); }
    }
    FA_BAR();
}
__device__ __forceinline__ void sel_phase(const Ctx& F, LAS unsigned char* shm) {
    for (int p = blockIdx.x; p < NB * 4 * 32; p += gridDim.x) { const int bg = p >> 5, s = p & 31; attn_unit<0>(F, shm, bg >> 2, bg & 3, 63 - s); attn_unit<0>(F, shm, bg >> 2, bg & 3, s); }
}
__device__ __forceinline__ void win_phase(const Ctx& F, LAS unsigned char* shm) {
    for (int u = blockIdx.x; u < NB * 4 * 64; u += gridDim.x) { const int bg = u >> 6, qb = u & 63; attn_unit<1>(F, shm, bg >> 2, bg & 3, qb); }
}
}
namespace cmpg {
typedef short bf16x8 __attribute__((ext_vector_type(8)));
typedef short s16x4 __attribute__((ext_vector_type(4)));
typedef float f32x16 __attribute__((ext_vector_type(16)));
typedef float f32x2_t __attribute__((ext_vector_type(2))); typedef __bf16 bf16x2_t __attribute__((ext_vector_type(2)));
__device__ __forceinline__ unsigned cvtpk(float lo, float hi) { f32x2_t v = {lo, hi}; bf16x2_t b = __builtin_convertvector(v, bf16x2_t); return __builtin_bit_cast(unsigned, b); }
__device__ __forceinline__ void glds16(const void* gsrc, unsigned lds_dst) { unsigned keep;
    asm volatile("s_mov_b32 %0, m0\n\ts_mov_b32 m0, %2\n\ts_nop 0\n\tglobal_load_lds_dwordx4 %1, off\n\ts_mov_b32 m0, %0" : "=&s"(keep) : "v"(gsrc), "s"(lds_dst) : "memory"); }
constexpr int A_CH = 516 * 16, A_BYTES = 8 * A_CH, B_BYTES = 32768, L_W2 = A_BYTES + 2 * B_BYTES, L_BIAS = L_W2 + 16384, LDS_BYTES_CMP = L_BIAS + 512;
static_assert(LDS_BYTES_CMP <= RING_BYTES, "compress LDS");
__device__ __forceinline__ void unit(const Ctx& F, LAS unsigned char* shm, int unit_id) {
    int tid_o = threadIdx.x; asm volatile("" : "+v"(tid_o));
    const int tid = tid_o, lane = tid & 63, r32 = lane & 31, hi = lane >> 5; const int wid = __builtin_amdgcn_readfirstlane(tid >> 6);
    const bool dec = unit_id < 256; const int uu = dec ? unit_id : unit_id - 256;
    const int b = dec ? uu >> 3 : uu >> 2, c = dec ? (uu >> 2) & 1 : (uu >> 1) & 1, q = dec ? uu & 3 : uu & 1, n0 = 128 * q, ncmp = dec ? NCMP_S : NCMP_P, maxpos = dec ? PAST - 1 : SEQ - 1;
    const float* src0 = dec ? F.cache_cmp() : F.out() + O_KCP + (size_t)b * SEQ * 512; const int* pt = F.page_table() + b * 64;
    const bf16* W1T = F.W1T() + (size_t)c * 128 * 2048;
    f32x4 ar[16]; f32x4 xr = (f32x4){0.f, 0.f, 0.f, 0.f};
    const bf16* pb0 = W1T + (size_t)lane * 2048 + (wid >> 2) * 16 * 64 + ((2 * wid) & 7) * 8;
    const unsigned ldsb = (unsigned)(uintptr_t)(shm + A_BYTES);
#define CG_BASE(blk) ({ int pos_ = 16 * (n0 + (blk)); pos_ = pos_ > maxpos - 15 ? maxpos - 15 : pos_; \
        const unsigned o_ = dec ? ((unsigned)pt[pos_ >> 7] * 128u + (unsigned)(pos_ & 127)) * 512u : (unsigned)pos_ * 512u; (unsigned)__builtin_amdgcn_readfirstlane((int)(o_ + (unsigned)c * 256u)); })
    unsigned bs[16];
#pragma unroll
    for (int e_ = 0; e_ < 16; ++e_) bs[e_] = CG_BASE(16 * wid + e_);
    const unsigned bsx = CG_BASE(128);
    const int lg = lane >> 4, lch = (lane & 15) >> 1, lhalf = lane & 1;
#define CG_LOAD(l_) do { \
        _Pragma("unroll") for (int e_ = 0; e_ < 16; ++e_) ar[e_] = *(const f32x4*)(src0 + (size_t)(bs[e_] + (unsigned)(l_) * 512u) + 4 * lane); \
        if (wid == 0) xr = *(const f32x4*)(src0 + (size_t)(bsx + (unsigned)(l_) * 512u) + 4 * lane); \
        _Pragma("unroll") for (int j_ = 0; j_ < 4; ++j_) glds16(pb0 + (j_ & 1) * 64 * 2048 + (j_ >> 1) * 8 + (l_) * 64, (unsigned)__builtin_amdgcn_readfirstlane(ldsb + ((l_) & 1) * B_BYTES + (4 * wid + j_) * 1024)); } while (0)
#define CG_STORE() do { typedef unsigned u32x2v_ __attribute__((ext_vector_type(2))); LAS unsigned char* a_ = shm + lch * A_CH + (4 * 16 * wid + lg) * 16 + lhalf * 8; \
        _Pragma("unroll") for (int e_ = 0; e_ < 16; ++e_) { u32x2v_ w_; w_.x = cvtpk(ar[e_].x, ar[e_].y); w_.y = cvtpk(ar[e_].z, ar[e_].w); *(LAS u32x2v_*)(a_ + e_ * 64) = w_; } \
        if (wid == 0) { u32x2v_ w2_; w2_.x = cvtpk(xr.x, xr.y); w2_.y = cvtpk(xr.z, xr.w); *(LAS u32x2v_*)(shm + lch * A_CH + (512 + lg) * 16 + lhalf * 8) = w2_; } } while (0)
    { const int f = tid >> 2, d0 = (tid & 3) * 16; const float* wp = F.cmp_w2() + ((size_t)c * 128 + f) * 64 + d0;
      const f32x4 w0 = *(const f32x4*)wp, w1 = *(const f32x4*)(wp + 4), w2 = *(const f32x4*)(wp + 8), w3 = *(const f32x4*)(wp + 12);
      v4u o0, o1; o0.x = cvtpk(w0.x, w0.y); o0.y = cvtpk(w0.z, w0.w); o0.z = cvtpk(w1.x, w1.y); o0.w = cvtpk(w1.z, w1.w); o1.x = cvtpk(w2.x, w2.y); o1.y = cvtpk(w2.z, w2.w); o1.z = cvtpk(w3.x, w3.y); o1.w = cvtpk(w3.z, w3.w);
      LAS unsigned char* wd = shm + L_W2 + ((d0 >> 5) * 8 + (f >> 4)) * 1024 + (f & 15) * 64 + (d0 & 31) * 2; *(LAS v4u*)wd = o0; *(LAS v4u*)(wd + 16) = o1;
      if (tid < 128) { float pe = 0.f;
#pragma unroll
          for (int kc = 0; kc < 16; ++kc) pe += F.PEB()[(c * 16 + kc) * 128 + tid];
          ((LAS float*)(shm + L_BIAS))[tid] = F.cmp_b1()[c * 128 + tid] + pe; } }
    f32x16 acc[2][4];
#pragma unroll
    for (int rb = 0; rb < 2; ++rb)
#pragma unroll
        for (int fb = 0; fb < 4; ++fb) acc[rb][fb] = f32x16{};
    CG_LOAD(0); CG_STORE();
    asm volatile("s_waitcnt vmcnt(0) lgkmcnt(0)\n\ts_barrier" ::: "memory");
    for (int l = 0; l < 16; ++l) {
        if (l < 15) CG_LOAD(l + 1);
#pragma nounroll
        for (int u = 0; u < 2; ++u)
#pragma nounroll
            for (int kk = 0; kk < 4; ++kk) {
                bf16x8 xfr[2];
#pragma unroll
                for (int rb = 0; rb < 2; ++rb) xfr[rb] = *(const LAS bf16x8*)(shm + (2 * kk + hi) * A_CH + (64 * wid + 32 * rb + r32 + 4 * u) * 16);
#pragma unroll
                for (int fb = 0; fb < 4; ++fb) { const bf16x8 wf = *(const LAS bf16x8*)(shm + A_BYTES + (l & 1) * B_BYTES + u * 16384 + (2 * kk + hi) * 2048 + (32 * fb + r32) * 16);
                    acc[0][fb] = __builtin_amdgcn_mfma_f32_32x32x16_bf16(wf, xfr[0], acc[0][fb], 0, 0, 0); acc[1][fb] = __builtin_amdgcn_mfma_f32_32x32x16_bf16(wf, xfr[1], acc[1][fb], 0, 0, 0); }
            }
        asm volatile("s_waitcnt lgkmcnt(0)\n\ts_barrier" ::: "memory");
        if (l < 15) CG_STORE();
        asm volatile("s_waitcnt vmcnt(0) lgkmcnt(0)\n\ts_barrier" ::: "memory");
    }
    const LAS float* hb = (const LAS float*)(shm + L_BIAS);
    const unsigned vb = (unsigned)(uintptr_t)(shm + L_W2) + ((lane >> 4) & 1) * 32 + (lane & 3) * 8 + (4 * hi + ((lane & 15) >> 2)) * 64;
    float* dstb = (dec ? F.KCMPS() : F.KCMPP()) + (size_t)b * ncmp * 512 + c * 256;
    const float b2a = F.cmp_b2()[c * 64 + r32], b2b = F.cmp_b2()[c * 64 + 32 + r32];
#pragma unroll
    for (int rb = 0; rb < 2; ++rb) {
        f32x16 o[2]; o[0] = f32x16{}; o[1] = f32x16{};
#pragma unroll
        for (int fb = 0; fb < 4; ++fb) {
            float h[16];
#pragma unroll
            for (int r = 0; r < 16; ++r) { const float x = acc[rb][fb][r] + hb[32 * fb + (r & 3) + 8 * (r >> 2) + 4 * hi]; h[r] = x / (1.0f + __expf(-x)); }
#pragma unroll
            for (int s2 = 0; s2 < 2; ++s2) {
                v4u pw; pw.x = cvtpk(h[8 * s2], h[8 * s2 + 1]); pw.y = cvtpk(h[8 * s2 + 2], h[8 * s2 + 3]); pw.z = cvtpk(h[8 * s2 + 4], h[8 * s2 + 5]); pw.w = cvtpk(h[8 * s2 + 6], h[8 * s2 + 7]);
                const int ks = 2 * fb + s2;
#pragma unroll
                for (int d0 = 0; d0 < 2; ++d0) { s16x4 lo, hi4;
                    asm volatile("ds_read_b64_tr_b16 %0,%1 offset:%c2" : "=&v"(lo) : "v"(vb), "i"(d0 * 8192 + ks * 1024) : "memory");
                    asm volatile("ds_read_b64_tr_b16 %0,%1 offset:%c2" : "=&v"(hi4) : "v"(vb), "i"(d0 * 8192 + ks * 1024 + 512) : "memory");
                    asm volatile("s_waitcnt lgkmcnt(0)" ::: "memory"); __builtin_amdgcn_sched_barrier(0);
                    const bf16x8 wf = (bf16x8){lo[0], lo[1], lo[2], lo[3], hi4[0], hi4[1], hi4[2], hi4[3]};
                    o[d0] = __builtin_amdgcn_mfma_f32_32x32x16_bf16(__builtin_bit_cast(bf16x8, pw), wf, o[d0], 0, 0, 0); }
            }
        }
#pragma unroll
        for (int r = 0; r < 16; ++r) { const int R = 64 * wid + 32 * rb + (r & 3) + 8 * (r >> 2) + 4 * hi, n = n0 + (R >> 2), g = R & 3;
            if (n < ncmp) { float* d = dstb + (size_t)n * 512 + g * 64; d[r32] = o[0][r] + b2a; d[32 + r32] = o[1][r] + b2b; } }
    }
    asm volatile("s_waitcnt vmcnt(0) lgkmcnt(0)\n\ts_barrier" ::: "memory");
#undef CG_BASE
#undef CG_LOAD
#undef CG_STORE
}

__device__ __forceinline__ void small_unit(const Ctx& F, LAS unsigned char* shm, int u) {
    const int tid = threadIdx.x, lane = tid & 63, r32 = lane & 31, hi = lane >> 5; const int wid = __builtin_amdgcn_readfirstlane(tid >> 6);
    const int b = u >> 6, c = (u >> 5) & 1, n0 = 8 * (u & 31), fb = wid & 3, lh = wid >> 2;
    constexpr int L_W2S = 0, L_BS = 16384, L_PA = 20480, L_PO = 36864;
    { const int f = tid >> 2, d0 = (tid & 3) * 16; const float* wp = F.cmp_w2() + ((size_t)c * 128 + f) * 64 + d0;
      const f32x4 w0 = *(const f32x4*)wp, w1 = *(const f32x4*)(wp + 4), w2 = *(const f32x4*)(wp + 8), w3 = *(const f32x4*)(wp + 12);
      v4u o0, o1; o0.x = cvtpk(w0.x, w0.y); o0.y = cvtpk(w0.z, w0.w); o0.z = cvtpk(w1.x, w1.y); o0.w = cvtpk(w1.z, w1.w); o1.x = cvtpk(w2.x, w2.y); o1.y = cvtpk(w2.z, w2.w); o1.z = cvtpk(w3.x, w3.y); o1.w = cvtpk(w3.z, w3.w);
      LAS unsigned char* wd = shm + L_W2S + ((d0 >> 5) * 8 + (f >> 4)) * 1024 + (f & 15) * 64 + (d0 & 31) * 2; *(LAS v4u*)wd = o0; *(LAS v4u*)(wd + 16) = o1;
      if (tid < 128) { float pe = 0.f;
#pragma unroll
          for (int kc = 0; kc < 16; ++kc) pe += F.PEB()[(c * 16 + kc) * 128 + tid];
          ((LAS float*)(shm + L_BS))[tid] = F.cmp_b1()[c * 128 + tid] + pe; } }
    const int bi = r32 >> 2, g = r32 & 3;
    const float* xb = F.out() + O_KCP + (size_t)b * SEQ * 512 + c * 256 + g * 64 + hi * 8;
    const bf16* wb = F.W1T() + (size_t)c * 128 * 2048 + (size_t)(32 * fb + r32) * 2048 + hi * 8;
    f32x16 acc = f32x16{};
    for (int li = 0; li < 8; ++li) { const int l = 2 * li + lh;
#pragma unroll
        for (int uu = 0; uu < 2; ++uu) { int pos = 16 * (n0 + bi + uu) + l; pos = pos > SEQ - 1 ? SEQ - 1 : pos; const float* xr = xb + (size_t)pos * 512; const bf16* wr = wb + (l + 16 * uu) * 64;
#pragma unroll
            for (int kk = 0; kk < 4; ++kk) { const f32x4 x0 = *(const f32x4*)(xr + 16 * kk), x1 = *(const f32x4*)(xr + 16 * kk + 4);
                v4u xw; xw.x = cvtpk(x0.x, x0.y); xw.y = cvtpk(x0.z, x0.w); xw.z = cvtpk(x1.x, x1.y); xw.w = cvtpk(x1.z, x1.w);
                acc = __builtin_amdgcn_mfma_f32_32x32x16_bf16(*(const bf16x8*)(wr + 16 * kk), __builtin_bit_cast(bf16x8, xw), acc, 0, 0, 0); } } }
    LAS float* pa = (LAS float*)(shm + L_PA) + fb * 1024;
    if (lh == 1) {
#pragma unroll
        for (int r = 0; r < 16; ++r) pa[r * 64 + lane] = acc[r]; }
    asm volatile("s_waitcnt vmcnt(0) lgkmcnt(0)\n\ts_barrier" ::: "memory");
    LAS float* po = (LAS float*)(shm + L_PO) + fb * 2048;
    if (lh == 0) {
        const LAS float* hb = (const LAS float*)(shm + L_BS);
        const unsigned vb = (unsigned)(uintptr_t)(shm + L_W2S) + ((lane >> 4) & 1) * 32 + (lane & 3) * 8 + (4 * hi + ((lane & 15) >> 2)) * 64 + fb * 2048;
        float h[16];
#pragma unroll
        for (int r = 0; r < 16; ++r) { const float x = acc[r] + pa[r * 64 + lane] + hb[32 * fb + (r & 3) + 8 * (r >> 2) + 4 * hi]; h[r] = x / (1.0f + __expf(-x)); }
        f32x16 o[2]; o[0] = f32x16{}; o[1] = f32x16{};
#pragma unroll
        for (int s2 = 0; s2 < 2; ++s2) {
            v4u pw; pw.x = cvtpk(h[8 * s2], h[8 * s2 + 1]); pw.y = cvtpk(h[8 * s2 + 2], h[8 * s2 + 3]); pw.z = cvtpk(h[8 * s2 + 4], h[8 * s2 + 5]); pw.w = cvtpk(h[8 * s2 + 6], h[8 * s2 + 7]);
#pragma unroll
            for (int d0 = 0; d0 < 2; ++d0) { s16x4 lo, hi4;
                asm volatile("ds_read_b64_tr_b16 %0,%1 offset:%c2" : "=&v"(lo) : "v"(vb), "i"(d0 * 8192 + s2 * 1024) : "memory");
                asm volatile("ds_read_b64_tr_b16 %0,%1 offset:%c2" : "=&v"(hi4) : "v"(vb), "i"(d0 * 8192 + s2 * 1024 + 512) : "memory");
                asm volatile("s_waitcnt lgkmcnt(0)" ::: "memory"); __builtin_amdgcn_sched_barrier(0);
                const bf16x8 wf = (bf16x8){lo[0], lo[1], lo[2], lo[3], hi4[0], hi4[1], hi4[2], hi4[3]};
                o[d0] = __builtin_amdgcn_mfma_f32_32x32x16_bf16(__builtin_bit_cast(bf16x8, pw), wf, o[d0], 0, 0, 0); } }
#pragma unroll
        for (int r = 0; r < 16; ++r) { po[r * 64 + lane] = o[0][r]; po[1024 + r * 64 + lane] = o[1][r]; }
    }
    asm volatile("s_waitcnt vmcnt(0) lgkmcnt(0)\n\ts_barrier" ::: "memory");
#pragma unroll
    for (int e = 0; e < 4; ++e) { const int idx = e * 512 + tid, d0 = idx >> 10, r = (idx >> 6) & 15, ln = idx & 63; const LAS float* pp = (const LAS float*)(shm + L_PO) + d0 * 1024 + r * 64 + ln;
        const float v = (pp[0] + pp[2048]) + (pp[4096] + pp[6144]);
        const int R = (r & 3) + 8 * (r >> 2) + 4 * (ln >> 5), n = n0 + (R >> 2), gg = R & 3, d = 32 * d0 + (ln & 31);
        if (n < NCMP_P) F.KCMPP()[((size_t)(b * NCMP_P + n) * 2 + c) * 256 + gg * 64 + d] = v + F.cmp_b2()[c * 64 + d]; }
    asm volatile("s_waitcnt vmcnt(0) lgkmcnt(0)\n\ts_barrier" ::: "memory");
}
}
namespace ssd {
typedef short bf16x8 __attribute__((ext_vector_type(8)));
typedef short s16x4 __attribute__((ext_vector_type(4)));
typedef float f32x16 __attribute__((ext_vector_type(16)));
typedef float f32x2_t __attribute__((ext_vector_type(2))); typedef __bf16 bf16x2_t __attribute__((ext_vector_type(2)));
__device__ __forceinline__ unsigned cvtpk(float lo, float hi) { f32x2_t v = {lo, hi}; bf16x2_t b = __builtin_convertvector(v, bf16x2_t); return __builtin_bit_cast(unsigned, b); }
constexpr int L_B = 0, L_X = 65536, L_ACS = 98304, L_E = 99328, LDS_BYTES_SSD = 100352;
__device__ __forceinline__ int crow(int r, int hi) { return (r & 3) + 8 * (r >> 2) + 4 * hi; }
#define SSD_BAR() asm volatile("s_waitcnt vmcnt(0) lgkmcnt(0)\n\ts_barrier" ::: "memory")
__device__ __forceinline__ void local_unit(const Ctx& F, LAS unsigned char* shm, int u) {
    const int tid = threadIdx.x, lane = tid & 63, r32 = lane & 31, hi = lane >> 5; const int wid = __builtin_amdgcn_readfirstlane(tid >> 6);
    const int b = u >> 8, c = (u >> 4) & 15, h = u & 15, grp = h >> 3; const size_t m0 = (size_t)b * SEQ + c * 256;
    const bf16* XA = F.XBCA16() + m0 * CONV_DIM; const float* DTp = F.DT() + m0 * 16 + h;
    LAS float* acs = (LAS float*)(shm + L_ACS); LAS float* et = (LAS float*)(shm + L_E);
    const float A = -__expf(F.a_log()[h]);
    if (wid == 0) { float a[4], tot = 0.f;
#pragma unroll
        for (int e = 0; e < 4; ++e) { tot += DTp[(size_t)(4 * lane + e) * 16] * A; a[e] = tot; }
        float x = tot;
#pragma unroll
        for (int o = 1; o < 64; o <<= 1) { const float y = __shfl_up(x, o); if (lane >= o) x += y; }
        const float excl = x - tot;
#pragma unroll
        for (int e = 0; e < 4; ++e) { acs[4 * lane + e] = excl + a[e]; F.ACS()[(m0 + 4 * lane + e) * 16 + h] = excl + a[e]; }
        if (lane == 63) F.DEC()[(b * 16 + c) * 16 + h] = __expf(x); }
    { const int s = tid >> 1, hf = tid & 1; const bf16* br = XA + (size_t)s * CONV_DIM + 1024 + grp * 128 + hf * 64;
#pragma unroll
      for (int i = 0; i < 8; ++i) *(LAS v4u*)(shm + L_B + (hf * 8 + i) * 4096 + s * 16) = *(const v4u*)(br + 8 * i);
      const bf16* xr = XA + (size_t)s * CONV_DIM + h * 64 + hf * 32; const float dt = DTp[(size_t)s * 16];
      LAS unsigned char* xd = shm + L_X + (hf * 16 + (s >> 4)) * 1024 + (s & 15) * 64;
#pragma unroll
      for (int i = 0; i < 4; ++i) { const v4u t = *(const v4u*)(xr + 8 * i); v4u o;
          o.x = cvtpk(__uint_as_float(t.x << 16) * dt, __uint_as_float(t.x & 0xffff0000u) * dt); o.y = cvtpk(__uint_as_float(t.y << 16) * dt, __uint_as_float(t.y & 0xffff0000u) * dt);
          o.z = cvtpk(__uint_as_float(t.z << 16) * dt, __uint_as_float(t.z & 0xffff0000u) * dt); o.w = cvtpk(__uint_as_float(t.w << 16) * dt, __uint_as_float(t.w & 0xffff0000u) * dt);
          *(LAS v4u*)(xd + i * 16) = o; } }
    bf16x8 cf[8];
    { const bf16* cr = XA + (size_t)(32 * wid + r32) * CONV_DIM + 1280 + grp * 128 + hi * 8;
#pragma unroll
      for (int kk = 0; kk < 8; ++kk) cf[kk] = *(const bf16x8*)(cr + 16 * kk); }
    SSD_BAR();
    if (tid < 256) et[tid] = __expf(acs[255] - acs[tid]);
    const float acl = acs[32 * wid + r32];
    f32x16 o[2]; o[0] = f32x16{}; o[1] = f32x16{};
    const int jmax = (32 * wid + 31) >> 6, lrel = 32 * wid + r32;
    const unsigned vbx = (unsigned)(uintptr_t)(shm + L_X) + ((lane >> 4) & 1) * 32 + (lane & 3) * 8 + (4 * hi + ((lane & 15) >> 2)) * 64;
    for (int j = 0; j <= jmax; ++j) {
        f32x16 p0 = f32x16{}, p1 = f32x16{};
        const LAS unsigned char* kb = shm + L_B + hi * 4096 + (64 * j + r32) * 16;
#pragma unroll
        for (int kk = 0; kk < 8; ++kk) { const bf16x8 b0 = *(const LAS bf16x8*)(kb + kk * 8192), b1 = *(const LAS bf16x8*)(kb + kk * 8192 + 512);
            p0 = __builtin_amdgcn_mfma_f32_32x32x16_bf16(b0, cf[kk], p0, 0, 0, 0); p1 = __builtin_amdgcn_mfma_f32_32x32x16_bf16(b1, cf[kk], p1, 0, 0, 0); }
#pragma unroll
        for (int q = 0; q < 4; ++q) { const f32x4 a0 = *(const LAS f32x4*)(acs + 64 * j + 8 * q + 4 * hi), a1 = *(const LAS f32x4*)(acs + 64 * j + 32 + 8 * q + 4 * hi);
#pragma unroll
            for (int e = 0; e < 4; ++e) { const int r = 4 * q + e, s0 = 64 * j + 8 * q + 4 * hi + e;
                p0[r] = (s0 <= lrel) ? p0[r] * __expf(acl - a0[e]) : 0.f; p1[r] = (s0 + 32 <= lrel) ? p1[r] * __expf(acl - a1[e]) : 0.f; } }
        v4u pw0, pw1, pw2, pw3;
        pw0.x = cvtpk(p0[0], p0[1]); pw0.y = cvtpk(p0[2], p0[3]); pw0.z = cvtpk(p0[4], p0[5]); pw0.w = cvtpk(p0[6], p0[7]);
        pw1.x = cvtpk(p0[8], p0[9]); pw1.y = cvtpk(p0[10], p0[11]); pw1.z = cvtpk(p0[12], p0[13]); pw1.w = cvtpk(p0[14], p0[15]);
        pw2.x = cvtpk(p1[0], p1[1]); pw2.y = cvtpk(p1[2], p1[3]); pw2.z = cvtpk(p1[4], p1[5]); pw2.w = cvtpk(p1[6], p1[7]);
        pw3.x = cvtpk(p1[8], p1[9]); pw3.y = cvtpk(p1[10], p1[11]); pw3.z = cvtpk(p1[12], p1[13]); pw3.w = cvtpk(p1[14], p1[15]);
        const unsigned vb = vbx + j * 4096;
#pragma unroll
        for (int d0 = 0; d0 < 2; ++d0) { s16x4 lo[4], hi4[4];
#pragma unroll
            for (int ks = 0; ks < 4; ++ks) {
                asm volatile("ds_read_b64_tr_b16 %0,%1 offset:%c2" : "=&v"(lo[ks]) : "v"(vb), "i"(d0 * 16384 + ks * 1024) : "memory");
                asm volatile("ds_read_b64_tr_b16 %0,%1 offset:%c2" : "=&v"(hi4[ks]) : "v"(vb), "i"(d0 * 16384 + ks * 1024 + 512) : "memory"); }
            asm volatile("s_waitcnt lgkmcnt(0)" ::: "memory"); __builtin_amdgcn_sched_barrier(0);
#define SSD_PK(k) (bf16x8){lo[k][0], lo[k][1], lo[k][2], lo[k][3], hi4[k][0], hi4[k][1], hi4[k][2], hi4[k][3]}
            o[d0] = __builtin_amdgcn_mfma_f32_32x32x16_bf16(__builtin_bit_cast(bf16x8, pw0), SSD_PK(0), o[d0], 0, 0, 0);
            o[d0] = __builtin_amdgcn_mfma_f32_32x32x16_bf16(__builtin_bit_cast(bf16x8, pw1), SSD_PK(1), o[d0], 0, 0, 0);
            o[d0] = __builtin_amdgcn_mfma_f32_32x32x16_bf16(__builtin_bit_cast(bf16x8, pw2), SSD_PK(2), o[d0], 0, 0, 0);
            o[d0] = __builtin_amdgcn_mfma_f32_32x32x16_bf16(__builtin_bit_cast(bf16x8, pw3), SSD_PK(3), o[d0], 0, 0, 0);
#undef SSD_PK
        }
    }
#pragma unroll
    for (int r = 0; r < 16; ++r) { float* yp = F.YSSD() + (m0 + 32 * wid + crow(r, hi)) * 1024 + h * 64 + r32; yp[0] = o[0][r]; yp[32] = o[1][r]; }
    { const int pb = wid & 1, nb = wid >> 1; f32x16 st = f32x16{};
      const int li = lane & 15, g16 = (lane >> 4) & 1, c4 = li & 3;
      const unsigned vbB = (unsigned)(uintptr_t)(shm + L_B) + (4 * nb + 2 * g16 + (c4 >> 1)) * 4096 + (4 * hi + (li >> 2)) * 16 + (c4 & 1) * 8;
      const unsigned vbA = vbx + pb * 16384;
      SSD_BAR();
      for (int ks = 0; ks < 16; ++ks) { s16x4 xl, xh, bl, bh;
          asm volatile("ds_read_b64_tr_b16 %0,%1" : "=&v"(xl) : "v"(vbA + ks * 1024) : "memory");
          asm volatile("ds_read_b64_tr_b16 %0,%1 offset:512" : "=&v"(xh) : "v"(vbA + ks * 1024) : "memory");
          asm volatile("ds_read_b64_tr_b16 %0,%1" : "=&v"(bl) : "v"(vbB + ks * 256) : "memory");
          asm volatile("ds_read_b64_tr_b16 %0,%1 offset:128" : "=&v"(bh) : "v"(vbB + ks * 256) : "memory");
          const f32x4 e0 = *(const LAS f32x4*)(et + 16 * ks + 4 * hi), e1 = *(const LAS f32x4*)(et + 16 * ks + 8 + 4 * hi);
          asm volatile("s_waitcnt lgkmcnt(0)" ::: "memory"); __builtin_amdgcn_sched_barrier(0);
          v4u xa;
          xa.x = cvtpk(__uint_as_float((unsigned)(unsigned short)xl[0] << 16) * e0[0], __uint_as_float((unsigned)(unsigned short)xl[1] << 16) * e0[1]);
          xa.y = cvtpk(__uint_as_float((unsigned)(unsigned short)xl[2] << 16) * e0[2], __uint_as_float((unsigned)(unsigned short)xl[3] << 16) * e0[3]);
          xa.z = cvtpk(__uint_as_float((unsigned)(unsigned short)xh[0] << 16) * e1[0], __uint_as_float((unsigned)(unsigned short)xh[1] << 16) * e1[1]);
          xa.w = cvtpk(__uint_as_float((unsigned)(unsigned short)xh[2] << 16) * e1[2], __uint_as_float((unsigned)(unsigned short)xh[3] << 16) * e1[3]);
          const bf16x8 bfr = (bf16x8){bl[0], bl[1], bl[2], bl[3], bh[0], bh[1], bh[2], bh[3]};
          st = __builtin_amdgcn_mfma_f32_32x32x16_bf16(__builtin_bit_cast(bf16x8, xa), bfr, st, 0, 0, 0); }
      float* sp = F.ST() + ((size_t)((b * 16 + c) * 16 + h)) * 8192 + 32 * nb + r32;
#pragma unroll
      for (int r = 0; r < 16; ++r) sp[(size_t)(32 * pb + crow(r, hi)) * 128] = st[r]; }
    SSD_BAR();
}

__device__ __forceinline__ void final_unit(const Ctx& F, LAS unsigned char* shm, int u) {
    const int tid = threadIdx.x, lane = tid & 63, r32 = lane & 31, hi = lane >> 5; const int wid = __builtin_amdgcn_readfirstlane(tid >> 6);
    const int qq = u & 3, grp = (u >> 2) & 1, c = (u >> 3) & 15, b = u >> 7, h = 8 * grp + wid; const size_t m0 = (size_t)b * SEQ + c * 256 + qq * 64;
    f32x16 acc[2][2];
#pragma unroll
    for (int pb = 0; pb < 2; ++pb) {
        bf16x8 sfr[8];
        { int lane_o = lane; asm volatile("" : "+v"(lane_o));
          const bf16* sp = F.SIN() + ((size_t)((b * 16 + c) * 16 + h) * 16 + pb * 8) * 512 + lane_o * 8;
#pragma unroll
          for (int kk = 0; kk < 8; ++kk) sfr[kk] = *(const bf16x8*)(sp + kk * 512); }
#pragma unroll
        for (int lb = 0; lb < 2; ++lb) { const bf16* cr = F.XBCA16() + (m0 + 32 * lb + r32) * CONV_DIM + 1280 + grp * 128 + hi * 8; f32x16 a = f32x16{};
#pragma unroll
            for (int kk = 0; kk < 8; ++kk) a = __builtin_amdgcn_mfma_f32_32x32x16_bf16(*(const bf16x8*)(cr + 16 * kk), sfr[kk], a, 0, 0, 0);
            acc[lb][pb] = a; }
    }
    LAS float* yt = (LAS float*)shm;
#pragma unroll
    for (int lb = 0; lb < 2; ++lb)
#pragma unroll
        for (int r = 0; r < 16; ++r) { LAS float* yp = yt + (32 * lb + crow(r, hi)) * 512 + wid * 64 + r32; yp[0] = acc[lb][0][r]; yp[32] = acc[lb][1][r]; }
    SSD_BAR();
    { const int hl = lane >> 3, hh = 8 * grp + hl, ch = hh * 64 + 8 * (lane & 7);
      const float Dk = F.d_skip()[hh]; const f32x4 n0 = *(const f32x4*)(F.ssm_norm() + ch), n1 = *(const f32x4*)(F.ssm_norm() + ch + 4);
#pragma unroll
      for (int half = 0; half < 2; ++half) {
          f32x4 yd[4][2], zz[4][2]; v4u xx[4]; float ea[4];
#pragma unroll
          for (int i = 0; i < 4; ++i) { const size_t mm = m0 + 8 * wid + 4 * half + i;
              yd[i][0] = *(const f32x4*)(F.YSSD() + mm * 1024 + ch); yd[i][1] = *(const f32x4*)(F.YSSD() + mm * 1024 + ch + 4); zz[i][0] = *(const f32x4*)(F.Z() + mm * 1024 + ch); zz[i][1] = *(const f32x4*)(F.Z() + mm * 1024 + ch + 4);
              xx[i] = *(const v4u*)(F.XBCA16() + mm * CONV_DIM + ch); ea[i] = __expf(F.ACS()[mm * 16 + hh]); }
#pragma unroll
          for (int i = 0; i < 4; ++i) { const int row = 8 * wid + 4 * half + i; const size_t mm = m0 + row;
              const f32x4 a0 = *(const LAS f32x4*)(yt + row * 512 + hl * 64 + 8 * (lane & 7)), a1 = *(const LAS f32x4*)(yt + row * 512 + hl * 64 + 8 * (lane & 7) + 4);
              float v[8] = {a0.x, a0.y, a0.z, a0.w, a1.x, a1.y, a1.z, a1.w};
              const float xv[8] = {__uint_as_float(xx[i].x << 16), __uint_as_float(xx[i].x & 0xffff0000u), __uint_as_float(xx[i].y << 16), __uint_as_float(xx[i].y & 0xffff0000u), __uint_as_float(xx[i].z << 16), __uint_as_float(xx[i].z & 0xffff0000u), __uint_as_float(xx[i].w << 16), __uint_as_float(xx[i].w & 0xffff0000u)};
              const float yv[8] = {yd[i][0].x, yd[i][0].y, yd[i][0].z, yd[i][0].w, yd[i][1].x, yd[i][1].y, yd[i][1].z, yd[i][1].w}, zv[8] = {zz[i][0].x, zz[i][0].y, zz[i][0].z, zz[i][0].w, zz[i][1].x, zz[i][1].y, zz[i][1].z, zz[i][1].w};
              float ss = 0.f;
#pragma unroll
              for (int e = 0; e < 8; ++e) { float y = v[e] * ea[i] + yv[e] + Dk * xv[e]; y *= zv[e] / (1.0f + __expf(-zv[e])); v[e] = y; ss += y * y; }
              const float rstd = 1.0f / sqrtf(wave_sum(ss) * (1.0f / 512.0f) + NORM_EPS);
              v4u w; w.x = cvtpk(v[0] * rstd * n0.x, v[1] * rstd * n0.y); w.y = cvtpk(v[2] * rstd * n0.z, v[3] * rstd * n0.w); w.z = cvtpk(v[4] * rstd * n1.x, v[5] * rstd * n1.y); w.w = cvtpk(v[6] * rstd * n1.z, v[7] * rstd * n1.w);
              *(v4u*)(F.MIX() + mm * DM + 1024 + ch) = w; } } }
    SSD_BAR();
}


__device__ __forceinline__ void carry_phase(const Ctx& F) {
    const int gt = blockIdx.x * (NWAVES * 64) + threadIdx.x, NGT = gridDim.x * NWAVES * 64;
    for (int i = gt; i < NB * 16 * 64 * 16; i += NGT) { const int n8 = i & 15, p = (i >> 4) & 63, h = (i >> 10) & 15, b = i >> 14;
        const int pb = p >> 5, kk = n8 >> 1, ln = (n8 & 1) * 32 + (p & 31);
        float sv[8] = {0.f, 0.f, 0.f, 0.f, 0.f, 0.f, 0.f, 0.f};
        for (int c = 0; c < 16; ++c) { const size_t ci = (size_t)(b * 16 + c) * 16 + h;
            v4u w; w.x = cvtpk(sv[0], sv[1]); w.y = cvtpk(sv[2], sv[3]); w.z = cvtpk(sv[4], sv[5]); w.w = cvtpk(sv[6], sv[7]);
            *(v4u*)(F.SIN() + ((ci * 16 + pb * 8 + kk) * 64 + ln) * 8) = w;
            const float dec = F.DEC()[ci]; const float* sp = F.ST() + ci * 8192 + (size_t)p * 128 + n8 * 8; const f32x4 a = *(const f32x4*)sp, d = *(const f32x4*)(sp + 4);
            sv[0] = sv[0] * dec + a.x; sv[1] = sv[1] * dec + a.y; sv[2] = sv[2] * dec + a.z; sv[3] = sv[3] * dec + a.w; sv[4] = sv[4] * dec + d.x; sv[5] = sv[5] * dec + d.y; sv[6] = sv[6] * dec + d.z; sv[7] = sv[7] * dec + d.w; }
        float* op = F.out() + O_SSP + ((size_t)(b * 16 + h) * 64 + p) * 128 + n8 * 8;
        *(f32x4*)op = (f32x4){sv[0], sv[1], sv[2], sv[3]}; *(f32x4*)(op + 4) = (f32x4){sv[4], sv[5], sv[6], sv[7]}; }
}
}
namespace cmpa {
using fa::bf16x8; using fa::f32x16;
constexpr int LK = 0, LV = 32768, LPS = 65536, PS_W = 8 * 264 * 4, IMP_W = 8 * 64 * 4, WAVE_B = PS_W + IMP_W;
static_assert(LPS + 8 * WAVE_B <= RING_BYTES, "cmpa LDS");
__device__ __forceinline__ float quad_sum(float v) {
    v += __int_as_float(__builtin_amdgcn_mov_dpp(__float_as_int(v), 0xB1, 0xF, 0xF, true));
    v += __int_as_float(__builtin_amdgcn_mov_dpp(__float_as_int(v), 0x4E, 0xF, 0xF, true));
    return v; }
__device__ __forceinline__ void unit(const Ctx& F, LAS unsigned char* shm, int b, int g, int qb) {
    const int tid = threadIdx.x, lane = tid & 63, r32 = lane & 31, hi = lane >> 5; const int wid = __builtin_amdgcn_readfirstlane(tid >> 6);
    const int ntile = (4 * qb + 3 + 63) >> 6;
    const float* KC = F.KCMPP() + (size_t)b * NCMP_P * 512 + g * 64;
    for (int t = 0; t < ntile; ++t) {
        int nk = 64 * t + lane; nk = nk > NCMP_P - 1 ? NCMP_P - 1 : nk; const float* kp = KC + (size_t)nk * 512 + wid * 8; const f32x4 k0 = *(const f32x4*)kp, k1 = *(const f32x4*)(kp + 4);
        v4u kw; kw.x = fa::cvtpk(k0.x, k0.y); kw.y = fa::cvtpk(k0.z, k0.w); kw.z = fa::cvtpk(k1.x, k1.y); kw.w = fa::cvtpk(k1.z, k1.w);
        *(LAS v4u*)(shm + LK + t * 8192 + wid * 1024 + lane * 16) = kw;
        int nv = 64 * t + 16 * (wid & 3) + (lane >> 2); nv = nv > NCMP_P - 1 ? NCMP_P - 1 : nv; const float* vp = KC + 256 + (size_t)nv * 512 + (wid >> 2) * 32 + (lane & 3) * 8; const f32x4 v0 = *(const f32x4*)vp, v1 = *(const f32x4*)(vp + 4);
        v4u vw; vw.x = fa::cvtpk(v0.x, v0.y); vw.y = fa::cvtpk(v0.z, v0.w); vw.z = fa::cvtpk(v1.x, v1.y); vw.w = fa::cvtpk(v1.z, v1.w);
        *(LAS v4u*)(shm + LV + t * 8192 + wid * 1024 + lane * 16) = vw; }
    const int tl = r32 >> 2, hd = 4 * g + (r32 & 3), t = 64 * qb + 8 * wid + tl; const size_t m = (size_t)b * SEQ + t;
    bf16x8 qr[4];
    { const bf16* Qp = F.QB() + m * 1024 + hd * 64 + hi * 8;
#pragma unroll
      for (int d0 = 0; d0 < 4; ++d0) qr[d0] = *(const bf16x8*)(Qp + 16 * d0); }
    FA_BAR();
    const int nvis = t >= 31 ? ((t - 31) >> 4) + 1 : 0;
    float mx = fa::MASKV, lsum = 0.f;
    for (int tt = 0; tt < ntile; ++tt) { f32x16 p0, p1; fa::qkt(p0, p1, shm + LK + tt * 8192, qr, r32, hi);
#pragma unroll
        for (int r = 0; r < 16; ++r) { const int n0 = 64 * tt + fa::crow(r, hi); p0[r] = n0 < nvis ? p0[r] * fa::C2 : fa::MASKV; p1[r] = n0 + 32 < nvis ? p1[r] * fa::C2 : fa::MASKV; }
        const float mn = fmaxf(mx, fa::rowmax(p0, p1)); float acc = 0.f;
#pragma unroll
        for (int r = 0; r < 16; ++r) { const int n0 = 64 * tt + fa::crow(r, hi); acc += (n0 < nvis ? __builtin_amdgcn_exp2f(p0[r] - mn) : 0.f) + (n0 + 32 < nvis ? __builtin_amdgcn_exp2f(p1[r] - mn) : 0.f); }
        lsum = lsum * __builtin_amdgcn_exp2f(mx - mn) + acc; mx = mn; }
    lsum = fa::xsum(lsum); const float inv = 1.0f / fmaxf(lsum, 1e-30f);
    LAS float* ps = (LAS float*)(shm + LPS + wid * WAVE_B); LAS float* impl = (LAS float*)(shm + LPS + wid * WAVE_B + PS_W);
    for (int i = lane; i < 8 * 264; i += 64) ps[i] = 0.f;
    asm volatile("s_waitcnt lgkmcnt(0)" ::: "memory");
    f32x16 o[2]; o[0] = f32x16{}; o[1] = f32x16{};
    const unsigned vb0 = (unsigned)(uintptr_t)(shm + LV) + ((lane >> 4) & 1) * 32 + (lane & 3) * 8 + (4 * hi + ((lane & 15) >> 2)) * 64;
    for (int tt = 0; tt < ntile; ++tt) { f32x16 p0, p1; fa::qkt(p0, p1, shm + LK + tt * 8192, qr, r32, hi);
#pragma unroll
        for (int r = 0; r < 16; ++r) { const int n0 = 64 * tt + fa::crow(r, hi); p0[r] = n0 < nvis ? __builtin_amdgcn_exp2f(p0[r] * fa::C2 - mx) * inv : 0.f; p1[r] = n0 + 32 < nvis ? __builtin_amdgcn_exp2f(p1[r] * fa::C2 - mx) * inv : 0.f; }
        v4u pw0, pw1, pw2, pw3;
        pw0.x = fa::cvtpk(p0[0], p0[1]); pw0.y = fa::cvtpk(p0[2], p0[3]); pw0.z = fa::cvtpk(p0[4], p0[5]); pw0.w = fa::cvtpk(p0[6], p0[7]);
        pw1.x = fa::cvtpk(p0[8], p0[9]); pw1.y = fa::cvtpk(p0[10], p0[11]); pw1.z = fa::cvtpk(p0[12], p0[13]); pw1.w = fa::cvtpk(p0[14], p0[15]);
        pw2.x = fa::cvtpk(p1[0], p1[1]); pw2.y = fa::cvtpk(p1[2], p1[3]); pw2.z = fa::cvtpk(p1[4], p1[5]); pw2.w = fa::cvtpk(p1[6], p1[7]);
        pw3.x = fa::cvtpk(p1[8], p1[9]); pw3.y = fa::cvtpk(p1[10], p1[11]); pw3.z = fa::cvtpk(p1[12], p1[13]); pw3.w = fa::cvtpk(p1[14], p1[15]);
        fa::pv(o, vb0 + tt * 8192, __builtin_bit_cast(bf16x8, pw0), __builtin_bit_cast(bf16x8, pw1), __builtin_bit_cast(bf16x8, pw2), __builtin_bit_cast(bf16x8, pw3));
#pragma unroll
        for (int r = 0; r < 16; ++r) { const float s0 = quad_sum(p0[r]), s1 = quad_sum(p1[r]);
            if ((r32 & 3) == (tt & 3)) { const int n0 = 64 * tt + fa::crow(r, hi); ps[tl * 264 + 1 + n0] = s0; ps[tl * 264 + 1 + n0 + 32] = s1; } } }
#pragma unroll
    for (int r = 0; r < 16; ++r) { const int q = fa::crow(r, hi); float* op = F.OCMP() + ((size_t)b * SEQ + 64 * qb + 8 * wid + (q >> 2)) * 1024 + (4 * g + (q & 3)) * 64 + r32; op[0] = o[0][r]; op[32] = o[1][r]; }
    asm volatile("s_waitcnt lgkmcnt(0)" ::: "memory");
    const int tk = lane >> 3, jsub = lane & 7; float mine[8];
#pragma unroll
    for (int k = 0; k < 8; ++k) { const int j = jsub + 8 * k; const LAS float* pp = ps + tk * 264 + 4 * j;
        float v = pp[0] + 2.0f * (pp[1] + pp[2] + pp[3]) + pp[4];
        if (j == 0 || j == qb || j == qb - 1) v = 1.0e4f; if (j > qb) v = -1.0e4f;
        mine[k] = v; impl[tk * 64 + j] = v; }
    asm volatile("s_waitcnt lgkmcnt(0)" ::: "memory");
    int cnt[8];
#pragma unroll
    for (int k = 0; k < 8; ++k) cnt[k] = 0;
    for (int i4 = 0; i4 < 16; ++i4) { const f32x4 vv = *(const LAS f32x4*)(impl + tk * 64 + 4 * i4);
#pragma unroll
        for (int e = 0; e < 4; ++e) { const float v = vv[e]; const int kk = 4 * i4 + e;
#pragma unroll
            for (int k = 0; k < 8; ++k) { const int j = jsub + 8 * k; cnt[k] += ((v > mine[k]) || (v == mine[k] && kk < j)) ? 1 : 0; } } }
    unsigned mlo = 0u, mhi = 0u;
#pragma unroll
    for (int k = 0; k < 8; ++k) { if (cnt[k] < 16) { const int j = jsub + 8 * k; if (j < 32) mlo |= 1u << j; else mhi |= 1u << (j - 32); } }
#pragma unroll
    for (int o2 = 1; o2 < 8; o2 <<= 1) { mlo |= (unsigned)__shfl_xor((int)mlo, o2); mhi |= (unsigned)__shfl_xor((int)mhi, o2); }
    if (jsub == 0) F.SELMASK()[((size_t)b * SEQ + 64 * qb + 8 * wid + tk) * 4 + g] = ((unsigned long long)mhi << 32) | mlo;
    FA_BAR();
}
__device__ __forceinline__ void phase(const Ctx& F, LAS unsigned char* shm) {
    for (int u = blockIdx.x; u < NB * 4 * 64; u += gridDim.x) { const int bg = u >> 6; int qb = u & 63; qb = (u >= 256) ? 63 - qb : qb; unit(F, shm, bg >> 2, bg & 3, qb); }
}
}
namespace sk {
typedef short bf16x8 __attribute__((ext_vector_type(8)));
typedef float f32x16 __attribute__((ext_vector_type(16)));
__device__ __forceinline__ int crow(int r, int hi) { return (r & 3) + 8 * (r >> 2) + 4 * hi; }
__device__ __forceinline__ float half_sum(float v) {
#pragma unroll
    for (int o = 1; o < 32; o <<= 1) v += __shfl_xor(v, o);
    return v; }
#define SK_BAR() asm volatile("s_waitcnt vmcnt(0) lgkmcnt(0)\n\ts_barrier" ::: "memory")
template <class Epi>
__device__ __forceinline__ void phase(LAS unsigned char* shm, const bf16* A, const bf16* Bt, int N, int K, int wg_rel, int nwg, const Epi& E) {
    const int tid = threadIdx.x, lane = tid & 63, r32 = lane & 31, hi = lane >> 5; const int wid = __builtin_amdgcn_readfirstlane(tid >> 6);
    const int ks = K >> 3; LAS float* red = (LAS float*)shm;
    for (int blk = wg_rel; blk < (N >> 5); blk += nwg) {
        const bf16* ap = A + (size_t)r32 * K + wid * ks + hi * 8; const bf16* bp = Bt + (size_t)(blk * 32 + r32) * K + wid * ks + hi * 8;
        f32x16 acc = f32x16{};
        for (int k = 0; k < ks; k += 256) { bf16x8 a[16], b[16];
#pragma unroll
            for (int i = 0; i < 16; ++i) { a[i] = *(const bf16x8*)(ap + k + 16 * i); b[i] = *(const bf16x8*)(bp + k + 16 * i); }
#pragma unroll
            for (int i = 0; i < 16; ++i) acc = __builtin_amdgcn_mfma_f32_32x32x16_bf16(a[i], b[i], acc, 0, 0, 0); }
#pragma unroll
        for (int r = 0; r < 16; ++r) red[(wid * 16 + r) * 64 + lane] = acc[r];
        SK_BAR();
        float v0 = 0.f, v1 = 0.f;
#pragma unroll
        for (int w = 0; w < 8; ++w) { v0 += red[(w * 16 + 2 * wid) * 64 + lane]; v1 += red[(w * 16 + 2 * wid + 1) * 64 + lane]; }
        E(blk, blk * 32 + r32, crow(2 * wid, hi), v0, crow(2 * wid + 1, hi), v1, r32);
        SK_BAR();
    }
}
struct EpiInS { bf16 *QB, *KVB; size_t kvstride; float *Z, *XBC, *GD, *out;
    __device__ __forceinline__ void one(int cp, int row, float v) const { const size_t m = (size_t)MPROMPT + row;
        if (cp < 1024) QB[m * 1024 + cp] = (bf16)f2bf(v);
        else if (cp < 2560) { const int which = (cp - 1024) >> 9, cc = (cp - 1024) & 511; KVB[(size_t)which * kvstride + m * 512 + cc] = (bf16)f2bf(v);
            float* fo = which == 0 ? out + O_KCS + (size_t)row * 512 : (which == 1 ? out + O_KSS + (size_t)row * 512 : out + O_KWS + (size_t)(row * 512 + 511) * 512); fo[cc] = v; }
        else if (cp < 3584) Z[m * 1024 + cp - 2560] = v;
        else if (cp < 5120) XBC[m * CONV_DIM + cp - 3584] = v;
        else if (cp < 5168) GD[m * 64 + cp - 5120] = 1.0f / (1.0f + __expf(-v));
        else if (cp < NCOLS_IN) GD[m * 64 + cp - 5120] = v; }
    __device__ __forceinline__ void operator()(int, int col, int r0, float v0, int r1, float v1, int) const { one(col, r0, v0); one(col, r1, v1); } };
struct EpiResS { const float* xres; float* X1; bf16* X1B; float* SS;
    __device__ __forceinline__ void operator()(int blk, int col, int r0, float v0, int r1, float v1, int r32) const {
        v0 += xres[(size_t)r0 * DM + col]; v1 += xres[(size_t)r1 * DM + col]; X1[(size_t)r0 * DM + col] = v0; X1[(size_t)r1 * DM + col] = v1;
        if (X1B) { X1B[(size_t)r0 * DM + col] = (bf16)f2bf(v0); X1B[(size_t)r1 * DM + col] = (bf16)f2bf(v1); }
        const float s0 = half_sum(v0 * v0), s1 = half_sum(v1 * v1); if (r32 == 0) { SS[r0 * 64 + blk] = s0; SS[r1 * 64 + blk] = s1; } } };
struct EpiUpS { bf16* H; const LAS float* rs;
    __device__ __forceinline__ void operator()(int, int col, int r0, float v0, int r1, float v1, int) const {
        float a = fmaxf(v0 * rs[r0], 0.f), b = fmaxf(v1 * rs[r1], 0.f); H[(size_t)r0 * DFF + col] = (bf16)f2bf(a * a); H[(size_t)r1 * DFF + col] = (bf16)f2bf(b * b); } };
}
namespace deca {
constexpr int L_QS = 0, L_SC = 1024, L_PART = 17408, L_PS = 25600, L_IMP = 27776;
#define DA_BAR() asm volatile("s_waitcnt vmcnt(0) lgkmcnt(0)\n\ts_barrier" ::: "memory")
__device__ __forceinline__ void load_row(const KeyRef& kr, const void* p, float (&k)[64]) {
    if (kr.f32) { const f32x4* q = (const f32x4*)p;
#pragma unroll
        for (int i = 0; i < 16; ++i) { const f32x4 t = q[i]; k[4 * i] = t.x; k[4 * i + 1] = t.y; k[4 * i + 2] = t.z; k[4 * i + 3] = t.w; } }
    else { const v4u* q = (const v4u*)p;
#pragma unroll
        for (int i = 0; i < 8; ++i) { const v4u t = q[i]; k[8 * i] = __uint_as_float(t.x << 16); k[8 * i + 1] = __uint_as_float(t.x & 0xffff0000u); k[8 * i + 2] = __uint_as_float(t.y << 16); k[8 * i + 3] = __uint_as_float(t.y & 0xffff0000u);
            k[8 * i + 4] = __uint_as_float(t.z << 16); k[8 * i + 5] = __uint_as_float(t.z & 0xffff0000u); k[8 * i + 6] = __uint_as_float(t.w << 16); k[8 * i + 7] = __uint_as_float(t.w & 0xffff0000u); } }
}
template <int NCH, int MODE, class KF>
__device__ __forceinline__ void unit(const Ctx& F, LAS unsigned char* shm, int m, int g, const KF& kf) {
    const int tid = threadIdx.x, lane = tid & 63; const int wid = __builtin_amdgcn_readfirstlane(tid >> 6);
    LAS float* qs = (LAS float*)(shm + L_QS); LAS float* sc = (LAS float*)(shm + L_SC); LAS float* part = (LAS float*)(shm + L_PART);
    constexpr int NK = NCH * 64, CPW = NCH / 8;
    if (tid < 256) qs[tid] = bf2f(F.QB()[(size_t)m * 1024 + g * 256 + tid]) * 0.125f;
    DA_BAR();
#pragma unroll
    for (int i = 0; i < CPW; ++i) { const int c = wid + 8 * i; const KeyRef kr = kf(c, lane); float s[4] = {-INFINITY, -INFINITY, -INFINITY, -INFINITY};
        if (kr.valid) { float k[64]; load_row(kr, kr.k, k);
#pragma unroll
            for (int h = 0; h < 4; ++h) { float a = 0.f;
#pragma unroll
                for (int d4 = 0; d4 < 16; ++d4) { const f32x4 q4 = *(const LAS f32x4*)(qs + h * 64 + 4 * d4); a += q4.x * k[4 * d4] + q4.y * k[4 * d4 + 1] + q4.z * k[4 * d4 + 2] + q4.w * k[4 * d4 + 3]; }
                s[h] = a; } }
#pragma unroll
        for (int h = 0; h < 4; ++h) sc[h * NK + c * 64 + lane] = s[h]; }
    DA_BAR();
    float mh[4], ih[4];
#pragma unroll
    for (int h = 0; h < 4; ++h) { float mx = -INFINITY;
        for (int c = 0; c < NCH; ++c) mx = fmaxf(mx, sc[h * NK + c * 64 + lane]);
        mx = wave_max(mx); if (mx == -INFINITY) mx = 0.f;
        float sm = 0.f;
        for (int c = 0; c < NCH; ++c) sm += __expf(sc[h * NK + c * 64 + lane] - mx);
        sm = wave_sum(sm); mh[h] = mx; ih[h] = 1.0f / fmaxf(sm, 1e-30f); }
    DA_BAR();
#pragma unroll
    for (int i = 0; i < CPW; ++i) { const int c = wid + 8 * i;
#pragma unroll
        for (int h = 0; h < 4; ++h) sc[h * NK + c * 64 + lane] = __expf(sc[h * NK + c * 64 + lane] - mh[h]) * ih[h]; }
#pragma unroll
    for (int h = 0; h < 4; ++h) { float a0[64];
#pragma unroll
        for (int d = 0; d < 64; ++d) a0[d] = 0.f;
#pragma unroll
        for (int i = 0; i < CPW; ++i) { const int c = wid + 8 * i; const KeyRef kr = kf(c, lane);
            if (kr.valid) { const float p0 = sc[h * NK + c * 64 + lane];
                if (kr.f32) { const f32x4* p = (const f32x4*)kr.v;
#pragma unroll
                    for (int j = 0; j < 16; ++j) { const f32x4 t = p[j]; a0[4 * j] += p0 * t.x; a0[4 * j + 1] += p0 * t.y; a0[4 * j + 2] += p0 * t.z; a0[4 * j + 3] += p0 * t.w; } }
                else { const v4u* p = (const v4u*)kr.v;
#pragma unroll
                    for (int j = 0; j < 8; ++j) { const v4u t = p[j]; a0[8 * j] += p0 * __uint_as_float(t.x << 16); a0[8 * j + 1] += p0 * __uint_as_float(t.x & 0xffff0000u); a0[8 * j + 2] += p0 * __uint_as_float(t.y << 16); a0[8 * j + 3] += p0 * __uint_as_float(t.y & 0xffff0000u);
                        a0[8 * j + 4] += p0 * __uint_as_float(t.z << 16); a0[8 * j + 5] += p0 * __uint_as_float(t.z & 0xffff0000u); a0[8 * j + 6] += p0 * __uint_as_float(t.w << 16); a0[8 * j + 7] += p0 * __uint_as_float(t.w & 0xffff0000u); } } } }
        part[(wid * 4 + h) * 64 + lane] = wave_reduce_t64(a0, lane); }
    DA_BAR();
    if (tid < 256) { const int h = tid >> 6, d = tid & 63; float o = 0.f;
#pragma unroll
        for (int w = 0; w < 8; ++w) o += part[(w * 4 + h) * 64 + d];
        const int hd = g * 4 + h; const size_t oi = (size_t)m * 1024 + hd * 64 + d;
        if (MODE == 0) F.OCMP()[oi] = o;
        else if (MODE == 1) F.OWIN()[oi] = o;
        else { const float* gt = F.GD() + (size_t)m * 64 + hd * 3; F.MIX()[(size_t)m * DM + hd * 64 + d] = (bf16)f2bf(gt[0] * F.OCMP()[oi] + gt[1] * o + gt[2] * F.OWIN()[oi]); } }
    if (MODE == 0 && wid == 0) {
        LAS float* ps = (LAS float*)(shm + L_PS); LAS float* imp = (LAS float*)(shm + L_IMP);
        for (int i = lane; i < 544; i += 64) ps[i] = 0.f;
        for (int c = 0; c < NCH; ++c) ps[1 + c * 64 + lane] = (sc[c * 64 + lane] + sc[NK + c * 64 + lane]) + (sc[2 * NK + c * 64 + lane] + sc[3 * NK + c * 64 + lane]);
        constexpr int nslc = NSLC_S, jt = PAST >> 6; float mine[3]; int cnt[3];
#pragma unroll
        for (int jj = 0; jj < 3; ++jj) { const int j = jj * 64 + lane; float v = 0.f; cnt[jj] = 0;
            if (j < nslc) { v = ps[4 * j] + 2.0f * (ps[4 * j + 1] + ps[4 * j + 2] + ps[4 * j + 3]) + ps[4 * j + 4]; if (j == 0 || j == jt || j == jt - 1) v = 1.0e4f; if (j > jt) v = -1.0e4f; imp[j] = v; }
            mine[jj] = v; }
        for (int k = 0; k < nslc; ++k) { const float v = imp[k];
#pragma unroll
            for (int jj = 0; jj < 3; ++jj) { const int j = jj * 64 + lane; cnt[jj] += ((v > mine[jj]) || (v == mine[jj] && k < j)) ? 1 : 0; } }
        int base = 0; const size_t task = (size_t)m * 4 + g;
#pragma unroll
        for (int jj = 0; jj < 3; ++jj) { const int j = jj * 64 + lane; const bool sel = (j < nslc) && (cnt[jj] < 16); const unsigned long long bal = __ballot(sel);
            if (sel) F.SELIDX()[task * 16 + base + __popcll(bal & ((1ull << lane) - 1ull))] = j;
            base += __popcll(bal); } }
    DA_BAR();
}
}
struct Args { const void* in[26]; float* out; unsigned char* ws; int ph_lo, ph_hi, li, pad; };
__global__ void __launch_bounds__(NWAVES * 64, 2) fwd_kernel(Args args) {
    extern __shared__ __attribute__((aligned(16))) unsigned char lds[];
    Ctx F;
    F.lds = (LAS unsigned char*)lds; F.MISC = (volatile LAS unsigned*)(F.lds + MISC_OFF);
    F.tid = threadIdx.x; F.lane = F.tid & 63; F.wave = __builtin_amdgcn_readfirstlane(F.tid >> 6);
    F.G = gridDim.x; { const int bx = blockIdx.x; F.vcu = (F.G % 8 == 0) ? (bx % 8) * (F.G / 8) + bx / 8 : bx; }
    F.ka = (const __attribute__((address_space(4))) unsigned long long*)__builtin_amdgcn_kernarg_segment_ptr();
    F.ctl = (gu32*)(F.ws() + WS_CTL);
    for (int u = F.tid; u < (LDS_BYTES - LDSCTL_OFF) / 4; u += NWAVES * 64) ((LAS unsigned*)(F.lds + LDSCTL_OFF))[u] = 0u;
    __syncthreads();
    XcdBarrier bar; bar.bar = (unsigned*)(F.ctl + CW_BAR); bar.x = 0; bar.st = nullptr;
    if (N_LAUNCHES == 1) bar = xcd_barrier_post((unsigned*)(F.ctl + CW_BAR), F.MISC + 8);
#ifdef PROBE_DBLBAR
#define PROBE_EXTRA_BAR xcd_barrier(bar);
#else
#define PROBE_EXTRA_BAR
#endif
#define GRID_BAR(seam) do { if (N_LAUNCHES != 1) { if (F.tid == 0) __hip_atomic_store(F.ctl + CW_TMO, 0xBADBA0u | (unsigned)(seam), RLX_AGENT); } else { xcd_barrier(bar); PROBE_EXTRA_BAR } } while (0)
    const int lo = args.ph_lo, hi = args.ph_hi;
#define IN(k) (lo <= (k) && (k) < hi)
#define BOTH(k) (IN(k) && IN((k) + 1))
    const int gw = F.vcu * NWAVES + F.wave, NGW = F.G * NWAVES;

    if (IN(0)) { p0_prologue(F); if (BOTH(0)) GRID_BAR(0); }
    if (IN(1)) {
        pg8::Gemm g{F.XN(), F.WIN(), MPROMPT, NIN, DM}; pg8::StaticOrder S; S.init(MPROMPT, NIN, F.G, (int)blockIdx.x);
        static_assert(WS_KSB - WS_KCB == WS_KWB - WS_KSB, "kv copies equally spaced");
        pg8::EpiInProj E{F.QB(), F.KCB(), (WS_KSB - WS_KCB) / 2, F.Z(), F.XBC(), F.GD(), F.out()};
        pg8::gemm_phase<pg8::EpiInProj, pg8::StaticOrder, true, true>(F.lds + RING_OFF, g, S, E);
        {
          const int rel = (F.G == 256) ? (int)blockIdx.x - 160 : (int)blockIdx.x, nw = (F.G == 256) ? 96 : F.G;
          if (rel >= 0) { const sk::EpiInS ES{F.QB(), F.KCB(), (WS_KSB - WS_KCB) / 2, F.Z(), F.XBC(), F.GD(), F.out()};
              sk::phase(F.lds + RING_OFF, F.XN() + (size_t)MPROMPT * DM, F.WIN(), NCOLS_IN, DM, rel, nw, ES); } }
        if (F.G == 256 && blockIdx.x >= 160) { __syncthreads(); weight_items(F, 0, W_ITEMS_P1, ((int)blockIdx.x - 160) * NWAVES + F.wave, 96 * NWAVES); }
        if (BOTH(1)) GRID_BAR(1);
    }
    if (IN(2)) {
        constexpr int NT_C = NB * NCMP_P * 2 + DECB * NCMP_S * 2;
#ifdef REP_CMPG
        for (int rep = 0; rep <= args.pad; ++rep)
#endif
        for (int u = blockIdx.x; u < 256; u += gridDim.x) cmpg::unit(F, F.lds + RING_OFF, u);
#ifdef REP_SMALL
        for (int rep = 0; rep <= args.pad; ++rep)
#endif
        for (int u = blockIdx.x; u < NB * 2 * 32; u += gridDim.x) cmpg::small_unit(F, F.lds + RING_OFF, u);
        __syncthreads();
        conv_prepass(F);
#ifdef REP_CONV
        conv_prepass(F);
#endif
        fa::win_phase(F, F.lds + RING_OFF); __syncthreads();
#ifdef REP_WIN
        fa::win_phase(F, F.lds + RING_OFF); __syncthreads();
#endif
#ifdef REP_DWIN
        for (int rep = 0; rep <= args.pad; ++rep)
#endif
        for (int u = F.G - 1 - (int)blockIdx.x; u < DECB * 4; u += F.G) { const int b = u >> 2, g = u & 3, m = MPROMPT + b;
            const WinKeysS kf{F.st_win() + (size_t)b * 512 * 512, F.KWB() + (size_t)m * 512, g}; deca::unit<8, 1>(F, F.lds + RING_OFF, m, g, kf); }
        if (BOTH(2)) GRID_BAR(2);
    }
    if (IN(3)) {
        constexpr int NT_S = NB * 16 * 64 + DECB * 16 * 64;
#ifdef CHK_DEC
        for (int it = MPROMPT * 4 + gw; it < MROWS * 4; it += NGW) win_task<true>(F, it, F.lane);
        __syncthreads();
#endif
#ifdef CHK_CMP
        { constexpr int NT_C2 = NB * NCMP_P * 2 + DECB * NCMP_S * 2; for (int it = gw; it < 200; it += NGW) compress_ref_check(F, (int)(((long)it * 168 + 7) % NT_C2), it & 3, F.lane, -1); }
        { constexpr int NT_C = NB * NCMP_P * 2 + DECB * NCMP_S * 2; for (int it = gw; it < 600; it += NGW) compress_task<true>(F, (int)(((long)it * 56 + 7) % NT_C), F.lane); }
        __syncthreads();
#endif
#ifdef CHK_ATT
        for (int it = gw; it < 135 * 4; it += NGW) win_task<true>(F, (it >> 2) * 61 * 4 + (it & 3), F.lane);
        __syncthreads();
#endif
#ifdef SSD_NAIVE
        for (int it = gw; it < NT_S; it += NGW) ssd_task(F, it, F.lane);
#else
#ifdef REP_LOC
        for (int rep = 0; rep <= args.pad; ++rep)
#endif
        for (int u = blockIdx.x; u < NB * 16 * 16; u += gridDim.x) ssd::local_unit(F, F.lds + RING_OFF, u);
        __syncthreads();
        if (F.G == 256) { if (blockIdx.x < 128) for (int it = (int)blockIdx.x * NWAVES + F.wave; it < DECB * 16 * 8; it += 128 * NWAVES) ssd_decode_task(F, it, F.lane); }
        else for (int it = gw; it < DECB * 16 * 8; it += NGW) ssd_decode_task(F, it, F.lane);
#endif
        __syncthreads();
#ifdef REP_CMPA
        for (int rep = 0; rep <= args.pad; ++rep)
#endif
        { cmpa::phase(F, F.lds + RING_OFF); __syncthreads(); }
        for (int u = F.G - 1 - (int)blockIdx.x; u < DECB * 4; u += F.G) { const int b = u >> 2, g = u & 3, m = MPROMPT + b;
            const CmpKeys kf{F.KCMPS() + (size_t)b * NCMP_S * 512, g, NCMP_S, PAST}; deca::unit<8, 0>(F, F.lds + RING_OFF, m, g, kf); }
        if (BOTH(3)) GRID_BAR(3);
    }
    if (IN(4)) {
#ifdef REP_DECA
        for (int rep = 0; rep <= args.pad; ++rep)
#endif
        for (int u = F.G - 1 - (int)blockIdx.x; u < DECB * 4; u += F.G) { const int b = u >> 2, g = u & 3, m = MPROMPT + b;
            const SelKeysS kf{F.SELIDX() + ((size_t)m * 4 + g) * 16, F.page_table() + b * 64, F.cache_sel(), F.KSB() + (size_t)m * 512, g}; deca::unit<16, 2>(F, F.lds + RING_OFF, m, g, kf); }
        __syncthreads();
        ssd::carry_phase(F); winbuf_copy(F);
        if (F.G == 256) { if (blockIdx.x < 128) weight_items(F, W_ITEMS_P1, W_ITEMS, (int)blockIdx.x * NWAVES + F.wave, 128 * NWAVES); }
        else weight_items(F, 0, W_ITEMS, gw, NGW);
        if (BOTH(4)) GRID_BAR(4); }
    if (IN(5)) {
#ifdef CHK_DEC
        for (int it = MPROMPT * 4 + gw; it < MROWS * 4; it += NGW) cmp_task<true>(F, it, F.lane);
        __syncthreads();
#endif
#ifdef CHK_CMPA
        for (int it = gw; it < 135 * 4; it += NGW) cmp_task<true>(F, (it >> 2) * 61 * 4 + (it & 3), F.lane);
        __syncthreads();
#endif
        fa::sel_phase(F, F.lds + RING_OFF); __syncthreads();
#ifdef REP_SEL
        fa::sel_phase(F, F.lds + RING_OFF); __syncthreads();
#endif
#ifdef DRY_SEL
        fa::sel_phase_dry<DRY_SEL>(F, F.lds + RING_OFF); __syncthreads();
#endif
#ifdef SSD_NAIVE
        for (int it = gw; it < MROWS * 2; it += NGW) ssd_gate_task(F, it, F.lane);
#else
        __syncthreads();
#ifdef REP_FIN
        for (int rep = 0; rep <= args.pad; ++rep)
#endif
        for (int u = blockIdx.x; u < NB * 16 * 2 * 4; u += gridDim.x) ssd::final_unit(F, F.lds + RING_OFF, u);
        for (int it = MPROMPT * 2 + gw; it < MROWS * 2; it += NGW) ssd_gate_task(F, it, F.lane);
#endif
        if (BOTH(5)) GRID_BAR(5);
    }
    if (IN(6)) {
#ifdef CHK_DEC
        for (int it = MPROMPT * 4 + gw; it < MROWS * 4; it += NGW) sel_task<true>(F, it, F.lane);
        __syncthreads();
#endif
#ifdef CHK_ATT
        for (int it = gw; it < 135 * 4; it += NGW) sel_task<true>(F, (it >> 2) * 61 * 4 + (it & 3), F.lane);
        __syncthreads();
#endif
        pg8::Gemm g{F.MIX(), F.WOUT(), MPROMPT, DM, DM}; pg8::StaticOrder S; S.init(MPROMPT, DM, F.G, (int)blockIdx.x);
        pg8::EpiResid E{F.x_prompt(), F.x_sample(), DM, F.X1(), F.X1B(), F.SS1()};
        pg8::gemm_phase<pg8::EpiResid, pg8::StaticOrder, true, true>(F.lds + RING_OFF, g, S, E);
        { const sk::EpiResS ES{F.x_sample(), F.X1() + (size_t)MPROMPT * DM, F.X1B() + (size_t)MPROMPT * DM, F.SS1S()};
          sk::phase(F.lds + RING_OFF, F.MIX() + (size_t)MPROMPT * DM, F.WOUT(), DM, DM, (int)blockIdx.x, F.G, ES); }
        if (BOTH(6)) GRID_BAR(6);
    }
    if (IN(7)) {
        pg8::Gemm g{F.X1B(), F.WUP(), MPROMPT, DFF, DM}; pg8::StaticOrder S; S.init(MPROMPT, DFF, F.G, (int)blockIdx.x);
        pg8::EpiUp E{F.H(), F.SS1()};
        pg8::gemm_phase<pg8::EpiUp, pg8::StaticOrder, true, true>(F.lds + RING_OFF, g, S, E);
        { LAS float* rs = (LAS float*)(F.lds + RING_OFF + 32768);
          if (F.tid < 32) { float t = 0.f; for (int i = 0; i < 64; ++i) t += F.SS1S()[F.tid * 64 + i]; rs[F.tid] = 1.0f / sqrtf(t * (1.0f / DM) + NORM_EPS); }
          __syncthreads();
          const sk::EpiUpS ES{F.H() + (size_t)MPROMPT * DFF, rs};
          sk::phase(F.lds + RING_OFF, F.X1B() + (size_t)MPROMPT * DM, F.WUP(), DFF, DM, (int)blockIdx.x, F.G, ES); }
        if (BOTH(7)) GRID_BAR(7);
    }
    if (IN(8)) {
        pg8::Gemm g{F.H(), F.WDN(), MPROMPT, DM, DFF}; pg8::StaticOrder S; S.init(MPROMPT, DM, F.G, (int)blockIdx.x);
        pg8::EpiResid E{F.X1(), F.X1() + (size_t)MPROMPT * DM, DM, F.X2(), nullptr, F.SS2()};
        pg8::gemm_phase<pg8::EpiResid, pg8::StaticOrder, true, true>(F.lds + RING_OFF, g, S, E);
        { const sk::EpiResS ES{F.X1() + (size_t)MPROMPT * DM, F.X2() + (size_t)MPROMPT * DM, nullptr, F.SS2S()};
          sk::phase(F.lds + RING_OFF, F.H() + (size_t)MPROMPT * DFF, F.WDN(), DM, DFF, (int)blockIdx.x, F.G, ES); }
        if (BOTH(8)) GRID_BAR(8);
    }
    if (IN(9)) { for (int m = gw; m < MROWS; m += NGW) final_norm_row(F, m, F.lane);
#if defined(CHK_ATT) || defined(CHK_CMP) || defined(CHK_CMPA) || defined(CHK_DEC) || defined(CHK_ANY)
        if (blockIdx.x == 0 && F.tid == 0) { unsigned mask = 0u;
            for (int k = 0; k < 8; ++k) if (__hip_atomic_load((unsigned*)F.ctl + CW_CHK + k, RLX_AGENT)) mask |= 1u << k;
            if (mask & 31u) F.out()[O_KCS] = 1.0e6f * (float)(1u + (mask & 31u));
            if (mask >> 5) F.out()[O_KSS] = 1.0e9f * (float)(1u + (mask >> 5)); }
#endif
    }
#undef IN
#undef BOTH
}

extern "C" void kernel_launch(void* const* d_in, const int* in_sizes, int n_in, void* d_out, int out_size, void* d_ws, size_t ws_size, hipStream_t stream) {
    static int grid = 0;
    if (grid == 0) {
        if (n_in != 26 || (size_t)out_size != O_END || ws_size < WS_END) { fprintf(stderr, "kernel_launch: unexpected shapes: n_in %d out %d ws %zu (need %zu)\n", n_in, out_size, ws_size, (size_t)WS_END); grid = -1; return; }
        int dev = 0, cus = 0, per_cu = 0;
        if (hipGetDevice(&dev) != hipSuccess || hipDeviceGetAttribute(&cus, hipDeviceAttributeMultiprocessorCount, dev) != hipSuccess) { grid = -1; return; }
        if (hipFuncSetAttribute((const void*)fwd_kernel, hipFuncAttributeMaxDynamicSharedMemorySize, LDS_BYTES) != hipSuccess) { fprintf(stderr, "kernel_launch: hipFuncSetAttribute failed\n"); grid = -1; return; }
        if (hipOccupancyMaxActiveBlocksPerMultiprocessor(&per_cu, (const void*)fwd_kernel, NWAVES * 64, LDS_BYTES) != hipSuccess || per_cu < 1) fprintf(stderr, "kernel_launch: occupancy query reports %d\n", per_cu);
        (void)hipGetLastError();
        grid = cus;
    }
    if (grid < 0) return;
    if (hipMemsetAsync((char*)d_ws + WS_CTL, 0, CTL_ZERO_BYTES, stream) != hipSuccess) return;
    Args a{};
    for (int i = 0; i < 26; ++i) a.in[i] = d_in[i];
    a.out = (float*)d_out; a.ws = (unsigned char*)d_ws;
    for (int li = 0; li < N_LAUNCHES; ++li) {
        a.ph_lo = (N_LAUNCHES == 1) ? 0 : li; a.ph_hi = (N_LAUNCHES == 1) ? N_PHASES : li + 1; a.li = li; a.pad = 0;
#if defined(REP_CMPG) || defined(REP_DWIN) || defined(REP_SMALL) || defined(REP_FIN) || defined(REP_LOC) || defined(REP_DECA) || defined(REP_CMPA)
        a.pad = 1;
#endif
        hipLaunchKernelGGL(fwd_kernel, dim3(grid), dim3(NWAVES * 64), LDS_BYTES, stream, a);
        if (hipPeekAtLastError() != hipSuccess) { fprintf(stderr, "kernel_launch: launch %d failed\n", li); break; }
    }
}
```
